# Optimizing an MI355X kernel written in HIP

```python
import math
import jax
import jax.numpy as jnp
from jax import lax
import numpy as np

D_MODEL = 1024
BATCH = 1
SEQ = 16384
DEPTH = 4

N_BRANCHES = 4
A_HEADS = 4
A_HEAD_DIM = 64
A_WIDTH = A_HEADS * A_HEAD_DIM
A_CHUNK = 64
B_PAIRS = ((128, 1), (512, 4), (2048, 16))
B_GROUPS = len(B_PAIRS)
B_HEADS = 4
B_HEAD_DIM = 64
B_WIDTH = B_HEADS * B_HEAD_DIM
B_QKV_WIDTH = B_GROUPS * B_WIDTH
C_HEADS = 4
C_HEAD_DIM = 64
C_WIDTH = C_HEADS * C_HEAD_DIM
C_CONV = 5
C_CHUNK = 64
D_Q_HEADS = 8
D_KV_HEADS = 2
D_HEAD_DIM = 64
D_Q_WIDTH = D_Q_HEADS * D_HEAD_DIM
D_KV_WIDTH = D_KV_HEADS * D_HEAD_DIM
D_WINDOW = 128
D_BLOCK = 128
ROPE_THETA = 10000.0
D_FF = 2816
N_EXPERTS = 8
TOP_K = 2
D_FF_EXPERT = 1408
MOE_BLOCK = 128
N_DENSE = (DEPTH + 1) // 2
N_MOE = DEPTH // 2
DEEPNORM_ALPHA = (2 * DEPTH) ** 0.25
DEEPNORM_BETA = (8 * DEPTH) ** -0.25
LN_EPS = 1e-5

IN_SEGMENTS = (
    ('gates', N_BRANCHES * D_MODEL),
    ('a_q', A_WIDTH), ('a_k', A_WIDTH), ('a_v', A_WIDTH), ('a_o', A_WIDTH),
    ('a_if', 2 * 2 * A_HEADS),
    ('b_q', B_QKV_WIDTH), ('b_k', B_QKV_WIDTH), ('b_v', B_QKV_WIDTH),
    ('c_qkv', 3 * C_WIDTH), ('c_gate', C_WIDTH), ('c_beta', 2 * C_HEADS), ('c_decay', 2 * C_HEADS),
    ('d_q', D_Q_WIDTH), ('d_k', D_KV_WIDTH), ('d_v', D_KV_WIDTH),
)
N_IN = sum(size for _, size in IN_SEGMENTS)

kernel_name = 'hybrid_gated_mlstm_dilated_deltanet_swa_moe_encoder'

F32 = jnp.float32


def split_columns(proj):
    parts = {}
    off = 0
    for name, size in IN_SEGMENTS:
        parts[name] = proj[..., off:off + size]
        off += size
    return parts


def layer_norm(x, w, b):
    xf = x.astype(F32)
    mu = xf.mean(-1, keepdims=True)
    var = jnp.square(xf - mu).mean(-1, keepdims=True)
    return ((xf - mu) * lax.rsqrt(var + LN_EPS) * w.astype(F32) + b.astype(F32)).astype(x.dtype)


def rope_tables(seq_len, dim):
    inv_freq = ROPE_THETA ** (-jnp.arange(0, dim, 2, dtype=F32) / dim)
    ang = jnp.arange(seq_len, dtype=F32)[:, None] * inv_freq[None, :]
    return jnp.cos(ang), jnp.sin(ang)


def apply_rope(t, cos, sin):
    t = t.astype(F32)
    half = t.shape[-1] // 2
    t1, t2 = t[..., :half], t[..., half:]
    c = cos[None, :, None, :]
    s = sin[None, :, None, :]
    return jnp.concatenate([t1 * c - t2 * s, t2 * c + t1 * s], axis=-1)


def banded_attention(q, k, v, half_window, block, sink=None):
    Bn, T, Hq, Dh = q.shape
    Hkv = k.shape[2]
    G = Hq // Hkv
    nb = -(-T // block)
    Tp = nb * block
    pad = Tp - T
    qb = jnp.pad(q.astype(F32), ((0, 0), (0, pad), (0, 0), (0, 0))).reshape(Bn, nb, block, Hkv, G, Dh)
    kp = jnp.pad(k.astype(F32), ((0, 0), (block, pad + block), (0, 0), (0, 0))).reshape(Bn, nb + 2, block, Hkv, Dh)
    vp = jnp.pad(v.astype(F32), ((0, 0), (block, pad + block), (0, 0), (0, 0))).reshape(Bn, nb + 2, block, Hkv, Dh)
    kw = jnp.concatenate([kp[:, :-2], kp[:, 1:-1], kp[:, 2:]], axis=2)
    vw = jnp.concatenate([vp[:, :-2], vp[:, 1:-1], vp[:, 2:]], axis=2)
    qpos = jnp.arange(Tp).reshape(nb, block)
    kpos = (jnp.arange(nb)[:, None] - 1) * block + jnp.arange(3 * block)[None, :]
    valid = ((jnp.abs(qpos[:, :, None] - kpos[:, None, :]) <= half_window)
             & (kpos[:, None, :] >= 0) & (kpos[:, None, :] < T))
    s = jnp.einsum('bnqhgd,bnkhd->bnhgqk', qb, kw) * (Dh ** -0.5)
    s = jnp.where(valid[None, :, None, None], s, -jnp.inf)
    m = s.max(-1)
    if sink is not None:
        sink_b = sink.astype(F32).reshape(Hkv, G)[None, None, :, :, None]
        m = jnp.maximum(m, sink_b)
    p = jnp.exp(s - m[..., None])
    l = p.sum(-1)
    if sink is not None:
        l = l + jnp.exp(sink_b - m)
    acc = jnp.einsum('bnhgqk,bnkhd->bnqhgd', p, vw).reshape(Bn, Tp, Hq, Dh)[:, :T]
    m = m.transpose(0, 1, 4, 2, 3).reshape(Bn, Tp, Hq)[:, :T]
    l = l.transpose(0, 1, 4, 2, 3).reshape(Bn, Tp, Hq)[:, :T]
    return acc, m, l


def dilated_attention(q, k, v, window, dilation):
    Bn, S = q.shape[0], q.shape[1]
    half = window // (2 * dilation)
    sub = S // dilation

    def to_strided(t):
        rest = t.shape[2:]
        return t.reshape((Bn, sub, dilation) + rest).swapaxes(1, 2).reshape((Bn * dilation, sub) + rest)

    def from_strided(t):
        rest = t.shape[2:]
        return t.reshape((Bn, dilation, sub) + rest).swapaxes(1, 2).reshape((Bn, S) + rest)

    acc, m, l = banded_attention(to_strided(q), to_strided(k), to_strided(v), half, half)
    return from_strided(acc), from_strided(m), from_strided(l)


def mlstm_chunkwise(q, k, v, i_pre, log_f):
    Bn, H, S, Dh = q.shape
    L = A_CHUNK
    N = S // L
    q = q.reshape(Bn, H, N, L, Dh)
    k = k.reshape(Bn, H, N, L, Dh)
    v = v.reshape(Bn, H, N, L, Dh)
    ig = i_pre.reshape(Bn, H, N, L)
    b = jnp.cumsum(log_f.reshape(Bn, H, N, L), axis=-1)
    causal = jnp.tril(jnp.ones((L, L), bool))
    d_log = jnp.where(causal, b[..., :, None] - b[..., None, :] + ig[..., None, :], -jnp.inf)
    m_intra = d_log.max(-1)
    w_qk = jnp.exp(d_log - m_intra[..., None]) * jnp.einsum('bhntd,bhnsd->bhnts', q, k)
    intra_num = jnp.einsum('bhnts,bhnsd->bhntd', w_qk, v)
    intra_den = w_qk.sum(-1)
    b_last = b[..., -1]
    s_log = b_last[..., None] - b + ig
    m_chunk = s_log.max(-1)
    s_w = jnp.exp(s_log - m_chunk[..., None])
    c_chunk = jnp.einsum('bhnsd,bhnse->bhnde', k * s_w[..., None], v)
    n_chunk = jnp.einsum('bhns,bhnsd->bhnd', s_w, k)

    def step(carry, inp):
        c, n, m = carry
        bl, mc, cc, nc = inp
        m_new = jnp.maximum(bl + m, mc)
        dec = jnp.exp(bl + m - m_new)
        gain = jnp.exp(mc - m_new)
        c_new = dec[..., None, None] * c + gain[..., None, None] * cc
        n_new = dec[..., None] * n + gain[..., None] * nc
        return (c_new, n_new, m_new), (c, n, m)

    init = (jnp.zeros((Bn, H, Dh, Dh), F32), jnp.zeros((Bn, H, Dh), F32), jnp.zeros((Bn, H), F32))
    xs = (jnp.moveaxis(b_last, 2, 0), jnp.moveaxis(m_chunk, 2, 0),
          jnp.moveaxis(c_chunk, 2, 0), jnp.moveaxis(n_chunk, 2, 0))
    _, (c_prev, n_prev, m_prev) = lax.scan(step, init, xs)
    c_prev = jnp.moveaxis(c_prev, 0, 2)
    n_prev = jnp.moveaxis(n_prev, 0, 2)
    m_prev = jnp.moveaxis(m_prev, 0, 2)
    inter_log = b + m_prev[..., None]
    m_t = jnp.maximum(inter_log, m_intra)
    a_inter = jnp.exp(inter_log - m_t)
    a_intra = jnp.exp(m_intra - m_t)
    num = (a_inter[..., None] * jnp.einsum('bhntd,bhnde->bhnte', q, c_prev)
           + a_intra[..., None] * intra_num)
    den = a_inter * jnp.einsum('bhntd,bhnd->bhnt', q, n_prev) + a_intra * intra_den
    h = num / jnp.maximum(jnp.abs(den), jnp.exp(-m_t))[..., None]
    return h.reshape(Bn, H, S, Dh)


def gated_delta_chunkwise(q, k, v, beta, g):
    Bn, H, S, Dk = q.shape
    Dv = v.shape[-1]
    L = C_CHUNK
    N = S // L
    q = q.reshape(Bn, H, N, L, Dk)
    k = k.reshape(Bn, H, N, L, Dk)
    v = v.reshape(Bn, H, N, L, Dv)
    beta = beta.reshape(Bn, H, N, L)
    gc = jnp.cumsum(g.reshape(Bn, H, N, L), axis=-1)
    incl = jnp.tril(jnp.ones((L, L), bool))
    strict = jnp.tril(jnp.ones((L, L), bool), -1)
    decay = jnp.exp(jnp.where(incl, gc[..., :, None] - gc[..., None, :], -jnp.inf))
    k_beta = k * beta[..., None]
    a_strict = jnp.where(strict, jnp.einsum('bhnid,bhnjd->bhnij', k_beta, k) * decay, 0.0)
    rhs = jnp.concatenate([v * beta[..., None], k_beta * jnp.exp(gc)[..., None]], axis=-1)
    sol = lax.linalg.triangular_solve(a_strict, rhs, left_side=True, lower=True, unit_diagonal=True)
    u, w = sol[..., :Dv], sol[..., Dv:]
    attn = jnp.where(incl, jnp.einsum('bhnid,bhnjd->bhnij', q, k) * decay, 0.0)
    g_last = gc[..., -1]
    k_dec = k * jnp.exp(g_last[..., None] - gc)[..., None]

    def step(state, inp):
        u_n, w_n, kd_n, dl_n = inp
        v_new = u_n - jnp.einsum('bhld,bhde->bhle', w_n, state)
        new_state = dl_n[..., None, None] * state + jnp.einsum('bhld,bhle->bhde', kd_n, v_new)
        return new_state, (state, v_new)

    init = jnp.zeros((Bn, H, Dk, Dv), F32)
    xs = (jnp.moveaxis(u, 2, 0), jnp.moveaxis(w, 2, 0), jnp.moveaxis(k_dec, 2, 0),
          jnp.moveaxis(jnp.exp(g_last), 2, 0))
    _, (s_prev, v_new) = lax.scan(step, init, xs)
    s_prev = jnp.moveaxis(s_prev, 0, 2)
    v_new = jnp.moveaxis(v_new, 0, 2)
    o = (jnp.einsum('bhnld,bhnde->bhnle', q * jnp.exp(gc)[..., None], s_prev)
         + jnp.einsum('bhnij,bhnje->bhnie', attn, v_new))
    return o.reshape(Bn, H, S, Dv)


def flip_seq(t):
    return jnp.flip(t, axis=2)


def mlstm_branch(p, gate_bias, norm_w):
    Bn, S, _ = p['a_q'].shape
    to_heads = lambda t: t.astype(F32).reshape(Bn, S, A_HEADS, A_HEAD_DIM).transpose(0, 2, 1, 3)
    q = to_heads(p['a_q'])
    k = to_heads(p['a_k']) * (A_HEAD_DIM ** -0.5)
    v = to_heads(p['a_v'])
    gp = p['a_if'].astype(F32).reshape(Bn, S, 2, 2, A_HEADS) + gate_bias.astype(F32)
    gp = gp.transpose(2, 3, 0, 4, 1)
    h_fwd = mlstm_chunkwise(q, k, v, gp[0, 0], jax.nn.log_sigmoid(gp[0, 1]))
    h_bwd = flip_seq(mlstm_chunkwise(flip_seq(q), flip_seq(k), flip_seq(v),
                                     flip_seq(gp[1, 0]), flip_seq(jax.nn.log_sigmoid(gp[1, 1]))))
    h = (h_fwd + h_bwd).transpose(0, 2, 1, 3)
    mu = h.mean(-1, keepdims=True)
    var = jnp.square(h - mu).mean(-1, keepdims=True)
    h = ((h - mu) * lax.rsqrt(var + LN_EPS)).reshape(Bn, S, A_WIDTH) * norm_w.astype(F32)
    return jax.nn.sigmoid(p['a_o'].astype(F32)) * h


def dilated_branch(p, cos, sin):
    Bn, S, _ = p['b_q'].shape
    shp = (Bn, S, B_GROUPS, B_HEADS, B_HEAD_DIM)
    q = apply_rope(p['b_q'].reshape(Bn, S, B_GROUPS * B_HEADS, B_HEAD_DIM), cos, sin).reshape(shp)
    k = apply_rope(p['b_k'].reshape(Bn, S, B_GROUPS * B_HEADS, B_HEAD_DIM), cos, sin).reshape(shp)
    v = p['b_v'].astype(F32).reshape(shp)
    accs, ms, ls = [], [], []
    for grp, (window, dilation) in enumerate(B_PAIRS):
        acc, m, l = dilated_attention(q[:, :, grp], k[:, :, grp], v[:, :, grp], window, dilation)
        accs.append(acc)
        ms.append(m)
        ls.append(l)
    acc = jnp.stack(accs)
    m = jnp.stack(ms)
    l = jnp.stack(ls)
    wgt = jnp.exp(m - m.max(0, keepdims=True))
    out = (wgt[..., None] * acc).sum(0) / (wgt * l).sum(0)[..., None]
    return out.reshape(Bn, S, B_WIDTH)


def deltanet_branch(p, conv_w, a_log, dt_bias, norm_w):
    Bn, S, _ = p['c_qkv'].shape
    qkv = p['c_qkv']
    qkv = lax.conv_general_dilated(qkv, conv_w[:, None, :].astype(qkv.dtype), window_strides=(1,),
                                   padding=[(C_CONV // 2, C_CONV // 2)],
                                   dimension_numbers=('NWC', 'WIO', 'NWC'),
                                   feature_group_count=3 * C_WIDTH)
    qkv = jax.nn.silu(qkv.astype(F32))
    q, k, v = jnp.split(qkv, 3, axis=-1)
    to_heads = lambda t: t.reshape(Bn, S, C_HEADS, C_HEAD_DIM).transpose(0, 2, 1, 3)
    l2n = lambda t: t * lax.rsqrt(jnp.sum(t * t, -1, keepdims=True) + 1e-6)
    q = l2n(to_heads(q)) * (C_HEAD_DIM ** -0.5)
    k = l2n(to_heads(k))
    v = to_heads(v)
    beta = jax.nn.sigmoid(p['c_beta'].astype(F32).reshape(Bn, S, 2, C_HEADS))
    g = -jnp.exp(a_log.astype(F32)) * jax.nn.softplus(
        p['c_decay'].astype(F32).reshape(Bn, S, 2, C_HEADS) + dt_bias.astype(F32))
    beta = beta.transpose(2, 0, 3, 1)
    g = g.transpose(2, 0, 3, 1)
    o_fwd = gated_delta_chunkwise(q, k, v, beta[0], g[0])
    o_bwd = flip_seq(gated_delta_chunkwise(flip_seq(q), flip_seq(k), flip_seq(v),
                                           flip_seq(beta[1]), flip_seq(g[1])))
    o = (o_fwd + o_bwd).transpose(0, 2, 1, 3)
    o = o * lax.rsqrt(jnp.mean(o * o, -1, keepdims=True) + 1e-6) * norm_w.astype(F32)
    o = o * jax.nn.silu(p['c_gate'].astype(F32).reshape(Bn, S, C_HEADS, C_HEAD_DIM))
    return o.reshape(Bn, S, C_WIDTH)


def window_branch(p, sink, cos, sin):
    Bn, S, _ = p['d_q'].shape
    q = apply_rope(p['d_q'].reshape(Bn, S, D_Q_HEADS, D_HEAD_DIM), cos, sin)
    k = apply_rope(p['d_k'].reshape(Bn, S, D_KV_HEADS, D_HEAD_DIM), cos, sin)
    v = p['d_v'].astype(F32).reshape(Bn, S, D_KV_HEADS, D_HEAD_DIM)
    acc, m, l = banded_attention(q, k, v, D_WINDOW, D_BLOCK, sink=sink)
    return (acc / l[..., None]).reshape(Bn, S, D_Q_WIDTH)


def token_mixing(x, w_in, a_gate_bias, a_norm_w, c_conv_w, c_a_log, c_dt_bias, c_norm_w, d_sink,
                 w_branch_a, w_branch_b, w_branch_c, w_branch_d, w_out, cos, sin):
    Bn, S, _ = x.shape
    p = split_columns(jnp.matmul(x, w_in))
    y_a = mlstm_branch(p, a_gate_bias, a_norm_w).astype(x.dtype)
    y_b = dilated_branch(p, cos, sin).astype(x.dtype)
    y_c = deltanet_branch(p, c_conv_w, c_a_log, c_dt_bias, c_norm_w).astype(x.dtype)
    y_d = window_branch(p, d_sink, cos, sin).astype(x.dtype)
    gates = jax.nn.sigmoid(p['gates'].astype(F32).reshape(Bn, S, N_BRANCHES, D_MODEL))
    merged = (gates[:, :, 0] * jnp.matmul(y_a, w_branch_a).astype(F32)
              + gates[:, :, 1] * jnp.matmul(y_b, w_branch_b).astype(F32)
              + gates[:, :, 2] * jnp.matmul(y_c, w_branch_c).astype(F32)
              + gates[:, :, 3] * jnp.matmul(y_d, w_branch_d).astype(F32))
    return jnp.matmul(merged.astype(x.dtype), w_out).astype(x.dtype)


def swiglu(x, w1, w3, w2):
    return jnp.matmul(jax.nn.silu(jnp.matmul(x, w1)) * jnp.matmul(x, w3), w2).astype(x.dtype)


def moe_swiglu(x, router_w, w1, w3, w2):
    Bn, S, D = x.shape
    T = Bn * S
    A = T * TOP_K
    xt = x.reshape(T, D)
    logits = jnp.matmul(xt, router_w).astype(F32)
    top_logit, top_idx = lax.top_k(logits, TOP_K)
    gates = jax.nn.softmax(top_logit, axis=-1)
    flat_e = top_idx.reshape(A).astype(jnp.int32)
    order = jnp.argsort(flat_e).astype(jnp.int32)
    sorted_e = flat_e[order]
    counts = jnp.bincount(flat_e, length=N_EXPERTS).astype(jnp.int32)
    padded = (counts + MOE_BLOCK - 1) // MOE_BLOCK * MOE_BLOCK
    ends = jnp.cumsum(padded)
    starts_p = ends - padded
    starts = jnp.cumsum(counts) - counts
    dest = starts_p[sorted_e] + jnp.arange(A, dtype=jnp.int32) - starts[sorted_e]
    n_blocks = -(-A // MOE_BLOCK) + N_EXPERTS
    slot_token = jnp.zeros(n_blocks * MOE_BLOCK, jnp.int32).at[dest].set(order // TOP_K)
    block_start = jnp.arange(n_blocks, dtype=jnp.int32) * MOE_BLOCK
    block_expert = jnp.minimum(jnp.searchsorted(ends, block_start, side='right'), N_EXPERTS - 1)
    xb = xt[slot_token].reshape(n_blocks, MOE_BLOCK, D)

    def expert_block(args):
        xi, e = args
        return jnp.matmul(jax.nn.silu(jnp.matmul(xi, w1[e])) * jnp.matmul(xi, w3[e]), w2[e])

    yb = lax.map(expert_block, (xb, block_expert)).reshape(n_blocks * MOE_BLOCK, D)
    slot_of = jnp.zeros(A, jnp.int32).at[order].set(dest).reshape(T, TOP_K)
    y = jnp.einsum('tk,tkd->td', gates.astype(yb.dtype), yb[slot_of])
    return y.reshape(Bn, S, D).astype(x.dtype)


def setup_inputs(seed: int = 0) -> dict:
    key = jax.random.key(seed)
    ks = jax.random.split(key, 32)
    L = DEPTH
    nrm = lambda k, shape, scale: jax.random.normal(k, shape, F32) * scale
    x = nrm(ks[0], (BATCH, SEQ, D_MODEL), 1.0)
    w_in = nrm(ks[1], (L, D_MODEL, N_IN), D_MODEL ** -0.5)
    i_bias = nrm(ks[2], (L, 2, A_HEADS), 0.1)
    f_bias = 3.0 + 3.0 * jax.random.uniform(ks[3], (L, 2, A_HEADS), F32)
    a_gate_bias = jnp.stack([i_bias, f_bias], axis=2)
    a_norm_w = 1.0 + nrm(ks[4], (L, A_WIDTH), 0.02)
    c_conv_w = nrm(ks[5], (L, C_CONV, 3 * C_WIDTH), C_CONV ** -0.5)
    c_a_log = jnp.log(jax.random.uniform(ks[6], (L, 2, C_HEADS), F32, minval=1.0, maxval=16.0))
    dt = jnp.exp(jax.random.uniform(ks[7], (L, 2, C_HEADS), F32,
                                    minval=math.log(1e-3), maxval=math.log(1e-1)))
    c_dt_bias = dt + jnp.log(-jnp.expm1(-dt))
    c_norm_w = 1.0 + nrm(ks[8], (L, C_HEAD_DIM), 0.02)
    d_sink = nrm(ks[9], (L, D_Q_HEADS), 0.5)
    w_branch_a = nrm(ks[10], (L, A_WIDTH, D_MODEL), DEEPNORM_BETA * A_WIDTH ** -0.5)
    w_branch_b = nrm(ks[11], (L, B_WIDTH, D_MODEL), DEEPNORM_BETA * B_WIDTH ** -0.5)
    w_branch_c = nrm(ks[12], (L, C_WIDTH, D_MODEL), DEEPNORM_BETA * C_WIDTH ** -0.5)
    w_branch_d = nrm(ks[13], (L, D_Q_WIDTH, D_MODEL), DEEPNORM_BETA * D_Q_WIDTH ** -0.5)
    w_out = nrm(ks[14], (L, D_MODEL, D_MODEL), DEEPNORM_BETA * D_MODEL ** -0.5)
    ln1_w = 1.0 + nrm(ks[15], (L, D_MODEL), 0.02)
    ln1_b = nrm(ks[16], (L, D_MODEL), 0.02)
    ln2_w = 1.0 + nrm(ks[17], (L, D_MODEL), 0.02)
    ln2_b = nrm(ks[18], (L, D_MODEL), 0.02)
    ffn_w1 = nrm(ks[19], (N_DENSE, D_MODEL, D_FF), DEEPNORM_BETA * D_MODEL ** -0.5)
    ffn_w3 = nrm(ks[20], (N_DENSE, D_MODEL, D_FF), DEEPNORM_BETA * D_MODEL ** -0.5)
    ffn_w2 = nrm(ks[21], (N_DENSE, D_FF, D_MODEL), DEEPNORM_BETA * D_FF ** -0.5)
    moe_router = nrm(ks[22], (N_MOE, D_MODEL, N_EXPERTS), D_MODEL ** -0.5)
    moe_w1 = nrm(ks[23], (N_MOE, N_EXPERTS, D_MODEL, D_FF_EXPERT), DEEPNORM_BETA * D_MODEL ** -0.5)
    moe_w3 = nrm(ks[24], (N_MOE, N_EXPERTS, D_MODEL, D_FF_EXPERT), DEEPNORM_BETA * D_MODEL ** -0.5)
    moe_w2 = nrm(ks[25], (N_MOE, N_EXPERTS, D_FF_EXPERT, D_MODEL), DEEPNORM_BETA * D_FF_EXPERT ** -0.5)
    return {'x': x, 'w_in': w_in, 'a_gate_bias': a_gate_bias, 'a_norm_w': a_norm_w,
            'c_conv_w': c_conv_w, 'c_a_log': c_a_log, 'c_dt_bias': c_dt_bias, 'c_norm_w': c_norm_w,
            'd_sink': d_sink, 'w_branch_a': w_branch_a, 'w_branch_b': w_branch_b,
            'w_branch_c': w_branch_c, 'w_branch_d': w_branch_d, 'w_out': w_out,
            'ln1_w': ln1_w, 'ln1_b': ln1_b, 'ln2_w': ln2_w, 'ln2_b': ln2_b,
            'ffn_w1': ffn_w1, 'ffn_w3': ffn_w3, 'ffn_w2': ffn_w2,
            'moe_router': moe_router, 'moe_w1': moe_w1, 'moe_w3': moe_w3, 'moe_w2': moe_w2}


def reference(x, w_in, a_gate_bias, a_norm_w, c_conv_w, c_a_log, c_dt_bias, c_norm_w, d_sink,
              w_branch_a, w_branch_b, w_branch_c, w_branch_d, w_out, ln1_w, ln1_b, ln2_w, ln2_b,
              ffn_w1, ffn_w3, ffn_w2, moe_router, moe_w1, moe_w3, moe_w2):
    cos, sin = rope_tables(x.shape[1], B_HEAD_DIM)
    for layer in range(DEPTH):
        mix = token_mixing(x, w_in[layer], a_gate_bias[layer], a_norm_w[layer], c_conv_w[layer],
                           c_a_log[layer], c_dt_bias[layer], c_norm_w[layer], d_sink[layer],
                           w_branch_a[layer], w_branch_b[layer], w_branch_c[layer], w_branch_d[layer],
                           w_out[layer], cos, sin)
        x = layer_norm(DEEPNORM_ALPHA * x + mix, ln1_w[layer], ln1_b[layer])
        j = layer // 2
        if layer % 2 == 0:
            f = swiglu(x, ffn_w1[j], ffn_w3[j], ffn_w2[j])
        else:
            f = moe_swiglu(x, moe_router[j], moe_w1[j], moe_w3[j], moe_w2[j])
        x = layer_norm(DEEPNORM_ALPHA * x + f, ln2_w[layer], ln2_b[layer])
    return x
```

```cpp
#include <hip/hip_runtime.h>
#include <hip/hip_cooperative_groups.h>
#include <cstdio>
namespace cg = cooperative_groups;

typedef _Float16 h16;
typedef h16 h8v __attribute__((ext_vector_type(8)));
typedef h16 h4v __attribute__((ext_vector_type(4)));
typedef float f4v __attribute__((ext_vector_type(4)));
typedef float f16v __attribute__((ext_vector_type(16)));
typedef unsigned int u4v __attribute__((ext_vector_type(4)));
#define DI __device__ __forceinline__

constexpr int SEQ = 16384, DM = 1024, NIN = 9248, NSM = 5120;
constexpr int LDH = 72;
constexpr float ALPHA = 1.6817928305074290f;
constexpr int NSLOT = 33792;
constexpr int MLD = 68;

constexpr size_t OFF_X16 = 0;
constexpr size_t OFF_WSM = OFF_X16 + (size_t)SEQ * DM * 2;
constexpr size_t OFF_WG = OFF_WSM + (size_t)NSM * 1024 * 2;
constexpr size_t OFF_WBR = OFF_WG + (size_t)4096 * 1024 * 2;
constexpr size_t OFF_WOUT = OFF_WBR + (size_t)1280 * 1024 * 2;
constexpr size_t OFF_WFF = OFF_WOUT + (size_t)1024 * 1024 * 2;
constexpr size_t OFF_PS = OFF_WFF + (size_t)69206016;
constexpr size_t OFF_PSCAL = OFF_PS + (size_t)SEQ * NSM * 2;
constexpr size_t OFF_Y = OFF_PSCAL + (size_t)SEQ * 32 * 4;
constexpr size_t OFF_MERGED = OFF_Y + (size_t)SEQ * 1280 * 2;
constexpr size_t OFF_ROPE = OFF_MERGED + (size_t)SEQ * DM * 2;
constexpr size_t OFF_SCA = OFF_ROPE + (size_t)SEQ * 32 * 4 * 2;
constexpr size_t OFF_SCAS = OFF_SCA + (size_t)2048 * 4160 * 4;
constexpr size_t OFF_CQKV = OFF_SCAS + (size_t)2048 * 4 * 4;
constexpr size_t OFF_CU = OFF_CQKV + (size_t)SEQ * 768 * 2;
constexpr size_t OFF_CW = OFF_CU + (size_t)2048 * 4096 * 4;
constexpr size_t OFF_CKD = OFF_CW + (size_t)2048 * 4096 * 2;
constexpr size_t OFF_CDL = OFF_CKD + (size_t)2048 * 4096 * 2;
constexpr size_t OFF_CS = OFF_CDL + (size_t)2048 * 4;
constexpr size_t OFF_CVN = OFF_CS + (size_t)2048 * 4096 * 2;
constexpr size_t OFF_OB = OFF_CVN + (size_t)2048 * 4096 * 2;
constexpr size_t OFF_MLB = OFF_OB + (size_t)3 * SEQ * 256 * 2;
constexpr size_t OFF_MOE = OFF_MLB + (size_t)3 * SEQ * 4 * 2 * 4;
constexpr size_t MOE_CNT = OFF_MOE;
constexpr size_t MOE_TE = MOE_CNT + 256;
constexpr size_t MOE_TP = MOE_TE + 32768 * 4;
constexpr size_t MOE_TG = MOE_TP + 32768 * 4;
constexpr size_t MOE_TS = MOE_TG + 32768 * 4;
constexpr size_t MOE_ST = MOE_TS + 32768 * 4;
constexpr size_t MOE_SG = MOE_ST + (size_t)NSLOT * 4;
constexpr size_t WS_END = MOE_SG + (size_t)NSLOT * 4;
constexpr size_t OFF_GATES = OFF_PS;
constexpr size_t OFF_H = OFF_PS;
constexpr size_t OFF_YB = OFF_PS + (size_t)NSLOT * 1408 * 2;

struct Params {
  const float* x; const float* w_in; const float* a_gate_bias; const float* a_norm_w; const float* c_conv_w;
  const float* c_a_log; const float* c_dt_bias; const float* c_norm_w; const float* d_sink;
  const float* w_br_a; const float* w_br_b; const float* w_br_c; const float* w_br_d; const float* w_out;
  const float* ln1_w; const float* ln1_b; const float* ln2_w; const float* ln2_b;
  const float* ffn_w1; const float* ffn_w3; const float* ffn_w2;
  const float* moe_router; const float* moe_w1; const float* moe_w3; const float* moe_w2;
  float* out; unsigned char* ws;
};

DI int otid() { int t = threadIdx.x; asm volatile("" : "+v"(t)); return t; }
DI float sigmoid_(float x) { return 1.f / (1.f + __expf(-x)); }
DI float silu_(float x) { return x / (1.f + __expf(-x)); }
DI float softplus_(float x) { return x > 20.f ? x : log1pf(__expf(x)); }
DI float logsigmoid_(float x) { return fminf(x, 0.f) - log1pf(__expf(-fabsf(x))); }
DI f4v mfma16(h8v a, h8v b, f4v c) { return __builtin_amdgcn_mfma_f32_16x16x32_f16(a, b, c, 0, 0, 0); }
DI f16v mfma32(h8v a, h8v b, f16v c) { return __builtin_amdgcn_mfma_f32_32x32x16_f16(a, b, c, 0, 0, 0); }
DI float wave_incl_sum(float v, int lane) {
#pragma unroll
  for (int o = 1; o < 64; o <<= 1) { float t = __shfl_up(v, o); if (lane >= o) v += t; }
  return v;
}
DI float wave_incl_max(float v, int lane) {
#pragma unroll
  for (int o = 1; o < 64; o <<= 1) { float t = __shfl_up(v, o); if (lane >= o) v = fmaxf(v, t); }
  return v;
}
DI float wave_max(float v) {
#pragma unroll
  for (int o = 32; o >= 1; o >>= 1) v = fmaxf(v, __shfl_xor(v, o));
  return v;
}
DI float wave_sum(float v) {
#pragma unroll
  for (int o = 32; o >= 1; o >>= 1) v += __shfl_xor(v, o);
  return v;
}
DI float grp16_sum(float v) { v += __shfl_xor(v, 1); v += __shfl_xor(v, 2); v += __shfl_xor(v, 4); v += __shfl_xor(v, 8); return v; }
DI float grp16_max(float v) { v = fmaxf(v, __shfl_xor(v, 1)); v = fmaxf(v, __shfl_xor(v, 2)); v = fmaxf(v, __shfl_xor(v, 4)); v = fmaxf(v, __shfl_xor(v, 8)); return v; }

DI void mm64(const h16* A, const h16* B, f4v (&acc)[4], int w, int lane) {
  const int r = lane & 15, q = lane >> 4;
#pragma unroll
  for (int s = 0; s < 2; ++s) {
    h8v a = *(const h8v*)&A[(16 * w + r) * LDH + 32 * s + 8 * q];
#pragma unroll
    for (int nt = 0; nt < 4; ++nt) {
      h8v b = *(const h8v*)&B[(16 * nt + r) * LDH + 32 * s + 8 * q];
      acc[nt] = mfma16(a, b, acc[nt]);
    }
  }
}
DI h8v perm_frag(const h16* img, int row, int s, int q) {
  h4v lo = *(const h4v*)&img[row * LDH + 32 * s + 4 * q];
  h4v hi = *(const h4v*)&img[row * LDH + 32 * s + 16 + 4 * q];
  return __builtin_shufflevector(lo, hi, 0, 1, 2, 3, 4, 5, 6, 7);
}
DI h8v pack8(f4v a, f4v b) {
  h8v r;
  r[0] = (h16)a[0]; r[1] = (h16)a[1]; r[2] = (h16)a[2]; r[3] = (h16)a[3];
  r[4] = (h16)b[0]; r[5] = (h16)b[1]; r[6] = (h16)b[2]; r[7] = (h16)b[3];
  return r;
}
DI void st_h4(h16* p, f4v v) { h4v o; o[0] = (h16)v[0]; o[1] = (h16)v[1]; o[2] = (h16)v[2]; o[3] = (h16)v[3]; *(h4v*)p = o; }

DI void conv_unit(const float* __restrict__ src, int ld, int col0, int k0, h16* __restrict__ dst, int K, int n0, h16* lds) {
  const int t = otid();
  __syncthreads();
  {
    const int c = t & 31, kq = t >> 5;
#pragma unroll
    for (int i = 0; i < 8; ++i) {
      int kk = kq + 8 * i;
      lds[c * LDH + kk] = (h16)src[(size_t)(k0 + kk) * ld + col0 + c];
    }
  }
  __syncthreads();
  {
    const int c = t >> 3, ks = (t & 7) * 8;
    *(u4v*)&dst[(size_t)(n0 + c) * K + k0 + ks] = *(const u4v*)&lds[c * LDH + ks];
  }
}

DI int map_small(int n) {
  if (n < 1024) return 4096 + n;
  if (n < 3328) return 5136 + (n - 1024);
  if (n < 4352) return 7440 + (n - 3328);
  return 8480 + (n - 4352);
}

DI void phase_convert(const Params& p, int l, int bid, int nb, h16* lds) {
  unsigned char* ws = p.ws;
  const float* win = p.w_in + (size_t)l * 1024 * NIN;
  const int jj = l >> 1;
  const bool moe = (l & 1);
  const int nffn = moe ? 8 * 2112 : (2816 + 1408);
  const int total = 2560 + 2048 + 640 + 512 + nffn;
  for (int u = bid; u < total; u += nb) {
    int v = u;
    const float* src; int ld, col0, k0, K, n0; h16* dst;
    if (v < 2560) { n0 = (v >> 4) * 32; k0 = (v & 15) * 64; col0 = map_small(n0); src = win; ld = NIN; K = 1024; dst = (h16*)(ws + OFF_WSM); }
    else if ((v -= 2560) < 2048) { n0 = (v >> 4) * 32; k0 = (v & 15) * 64; col0 = n0; src = win; ld = NIN; K = 1024; dst = (h16*)(ws + OFF_WG); }
    else if ((v -= 2048) < 640) {
      int b, kt;
      if (v < 384) { b = v >> 7; v &= 127; kt = 4; } else { b = 3; v -= 384; kt = 8; }
      n0 = (v / kt) * 32; k0 = (v % kt) * 64; K = kt * 64;
      const float* base = (b == 0) ? p.w_br_a : (b == 1) ? p.w_br_b : (b == 2) ? p.w_br_c : p.w_br_d;
      src = base + (size_t)l * K * 1024; ld = 1024; col0 = n0; dst = (h16*)(ws + OFF_WBR) + (size_t)b * 262144;
    }
    else if ((v -= 640) < 512) { n0 = (v >> 4) * 32; k0 = (v & 15) * 64; col0 = n0; src = p.w_out + (size_t)l * 1024 * 1024; ld = 1024; K = 1024; dst = (h16*)(ws + OFF_WOUT); }
    else {
      v -= 512;
      if (!moe) {
        if (v < 2816) {
          int nbk = v >> 4; k0 = (v & 15) * 64; n0 = nbk * 32; col0 = (nbk >> 1) * 32;
          src = ((nbk & 1) ? p.ffn_w3 : p.ffn_w1) + (size_t)jj * 1024 * 2816; ld = 2816; K = 1024; dst = (h16*)(ws + OFF_WFF);
        } else {
          v -= 2816; n0 = (v / 44) * 32; k0 = (v % 44) * 64; col0 = n0; K = 2816;
          src = p.ffn_w2 + (size_t)jj * 2816 * 1024; ld = 1024; dst = (h16*)(ws + OFF_WFF) + (size_t)5632 * 1024;
        }
      } else {
        int e = v / 2112; v -= e * 2112;
        if (v < 1408) {
          int nbk = v >> 4; k0 = (v & 15) * 64; n0 = nbk * 32; col0 = (nbk >> 1) * 32;
          src = ((nbk & 1) ? p.moe_w3 : p.moe_w1) + (size_t)(jj * 8 + e) * 1024 * 1408; ld = 1408; K = 1024;
          dst = (h16*)(ws + OFF_WFF) + (size_t)e * 2816 * 1024;
        } else {
          v -= 1408; n0 = (v / 22) * 32; k0 = (v % 22) * 64; col0 = n0; K = 1408;
          src = p.moe_w2 + (size_t)(jj * 8 + e) * 1408 * 1024; ld = 1024;
          dst = (h16*)(ws + OFF_WFF) + (size_t)8 * 2816 * 1024 + (size_t)e * 1024 * 1408;
        }
      }
    }
    conv_unit(src, ld, col0, k0, dst, K, n0, lds);
  }
  if (moe) {
    int* cnt = (int*)(ws + MOE_CNT);
    int* st = (int*)(ws + MOE_ST);
    const int gt = bid * 256 + otid(), gs = nb * 256;
    if (gt < 64) cnt[gt] = 0;
    for (int i = gt; i < NSLOT; i += gs) st[i] = 0;
  }
}

DI void phase_init(const Params& p, int bid, int nb) {
  float* rc = (float*)(p.ws + OFF_ROPE);
  float* rs = rc + (size_t)SEQ * 32;
  const int gt = bid * 256 + otid(), gs = nb * 256;
  for (int i = gt; i < SEQ * 32; i += gs) {
    int pos = i >> 5, d = i & 31;
    float inv = (float)pow(10000.0, -(double)d / 32.0);
    float ang = (float)pos * inv;
    rc[i] = cosf(ang); rs[i] = sinf(ang);
  }
  h16* x16 = (h16*)(p.ws + OFF_X16);
  for (int i = gt; i < SEQ * DM / 4; i += gs) {
    float4 v = ((const float4*)p.x)[i];
    h4v o; o[0] = (h16)v.x; o[1] = (h16)v.y; o[2] = (h16)v.z; o[3] = (h16)v.w;
    *(h4v*)&x16[(size_t)i * 4] = o;
  }
}

template <bool GATHER>
DI void gemm_main(const h16* __restrict__ A, int lda, const int* __restrict__ idx, int m0,
                  const h16* __restrict__ B, int ldb, int n0, int K, h16* lds, f16v (&acc)[2][2]) {
  const int tid = otid(), lane = tid & 63, wv = tid >> 6, wm = wv >> 1, wn = wv & 1;
  h16* As = lds; h16* Bs = lds + 128 * LDH;
  const int lr = tid >> 1, lc = (tid & 1) * 32;
  const h16* ap = A + (size_t)(GATHER ? idx[m0 + lr] : (m0 + lr)) * lda + lc;
  const h16* bp = B + (size_t)(n0 + lr) * ldb + lc;
  u4v ra[4], rb[4];
#pragma unroll
  for (int i = 0; i < 4; ++i) { ra[i] = *(const u4v*)(ap + 8 * i); rb[i] = *(const u4v*)(bp + 8 * i); }
  const int nk = K >> 6;
  for (int kt = 0; kt < nk; ++kt) {
    __syncthreads();
#pragma unroll
    for (int i = 0; i < 4; ++i) { *(u4v*)&As[lr * LDH + lc + 8 * i] = ra[i]; *(u4v*)&Bs[lr * LDH + lc + 8 * i] = rb[i]; }
    __syncthreads();
    if (kt + 1 < nk) {
      ap += 64; bp += 64;
#pragma unroll
      for (int i = 0; i < 4; ++i) { ra[i] = *(const u4v*)(ap + 8 * i); rb[i] = *(const u4v*)(bp + 8 * i); }
    }
#pragma unroll
    for (int ks = 0; ks < 4; ++ks) {
      h8v af[2], bf[2];
#pragma unroll
      for (int i = 0; i < 2; ++i) af[i] = *(const h8v*)&As[(wm * 64 + i * 32 + (lane & 31)) * LDH + ks * 16 + 8 * (lane >> 5)];
#pragma unroll
      for (int j = 0; j < 2; ++j) bf[j] = *(const h8v*)&Bs[(wn * 64 + j * 32 + (lane & 31)) * LDH + ks * 16 + 8 * (lane >> 5)];
#pragma unroll
      for (int i = 0; i < 2; ++i)
#pragma unroll
        for (int j = 0; j < 2; ++j) acc[i][j] = mfma32(bf[j], af[i], acc[i][j]);
    }
  }
}
DI void acc_zero(f16v (&acc)[2][2]) {
#pragma unroll
  for (int i = 0; i < 2; ++i)
#pragma unroll
    for (int j = 0; j < 2; ++j)
#pragma unroll
      for (int r = 0; r < 16; ++r) acc[i][j][r] = 0.f;
}
template <class Epi>
DI void gemm_epilogue(f16v (&acc)[2][2], int m0, int n0, Epi epi) {
  const int tid = otid(), lane = tid & 63, wv = tid >> 6, wm = wv >> 1, wn = wv & 1, h = lane >> 5;
#pragma unroll
  for (int i = 0; i < 2; ++i) {
    const int m = m0 + wm * 64 + i * 32 + (lane & 31);
#pragma unroll
    for (int g = 0; g < 4; ++g) {
      const int n = n0 + wn * 64 + 8 * g + 4 * h;
      f4v v0 = {acc[i][0][4 * g], acc[i][0][4 * g + 1], acc[i][0][4 * g + 2], acc[i][0][4 * g + 3]};
      f4v v1 = {acc[i][1][4 * g], acc[i][1][4 * g + 1], acc[i][1][4 * g + 2], acc[i][1][4 * g + 3]};
      epi(m, n, v0, v1);
    }
  }
}

DI void scal_unit(const Params& p, int l, int unit, float* lds) {
  const float* xs = (l == 0) ? p.x : p.out;
  const float* win = p.w_in + (size_t)l * 1024 * NIN;
  float* ps = (float*)(p.ws + OFF_PSCAL);
  float* xt = lds;
  float* wt = lds + 64 * 65;
  const int t = otid(), tok = t >> 2, jg = t & 3;
  float acc[8];
#pragma unroll
  for (int i = 0; i < 8; ++i) acc[i] = 0.f;
  const int t0 = unit * 64;
  for (int k0 = 0; k0 < 1024; k0 += 64) {
    __syncthreads();
#pragma unroll
    for (int i = 0; i < 16; ++i) { int e = t + 256 * i; int r = e >> 6, c = e & 63; xt[r * 65 + c] = xs[(size_t)(t0 + r) * DM + k0 + c]; }
#pragma unroll
    for (int i = 0; i < 8; ++i) { int e = t + 256 * i; int kk = e >> 5, c = e & 31; int col = (c < 16) ? (5120 + c) : (8464 + (c - 16)); wt[kk * 32 + c] = win[(size_t)(k0 + kk) * NIN + col]; }
    __syncthreads();
#pragma unroll 8
    for (int kk = 0; kk < 64; ++kk) {
      float xv = xt[tok * 65 + kk];
#pragma unroll
      for (int i = 0; i < 8; ++i) acc[i] += xv * wt[kk * 32 + jg * 8 + i];
    }
  }
#pragma unroll
  for (int i = 0; i < 8; ++i) ps[(size_t)(t0 + tok) * 32 + jg * 8 + i] = acc[i];
}

DI void phase_p1(const Params& p, int l, int bid, int nb, unsigned char* smem) {
  unsigned char* ws = p.ws;
  const h16* x16 = (const h16*)(ws + OFF_X16);
  const h16* wsm = (const h16*)(ws + OFF_WSM);
  h16* ps = (h16*)(ws + OFF_PS);
  const float* rc = (const float*)(ws + OFF_ROPE);
  const float* rs = rc + (size_t)SEQ * 32;
  const int total = 256 + 128 * 40;
  for (int u = bid; u < total; u += nb) {
    if (u < 256) { scal_unit(p, l, u, (float*)smem); continue; }
    const int tl = u - 256, mt = tl / 40, nt = tl % 40, m0 = mt * 128, n0 = nt * 128;
    f16v acc[2][2]; acc_zero(acc);
    gemm_main<false>(x16, DM, nullptr, m0, wsm, 1024, n0, 1024, (h16*)smem, acc);
    gemm_epilogue(acc, m0, n0, [&](int m, int n, f4v v0, f4v v1) {
      const bool rope = (n >= 1024 && n < 2560) || (n >= 4352 && n < 4992);
      if (rope) {
        const int d = n & 31;
        f4v c = *(const f4v*)&rc[(size_t)m * 32 + d], s = *(const f4v*)&rs[(size_t)m * 32 + d];
        f4v o0 = v0 * c - v1 * s, o1 = v1 * c + v0 * s;
        v0 = o0; v1 = o1;
      }
      st_h4(&ps[(size_t)m * NSM + n], v0);
      st_h4(&ps[(size_t)m * NSM + n + 32], v1);
    });
  }
}

DI void img_store_nat(h16* img, int row, int seg, u4v a, u4v b) {
  *(u4v*)&img[row * LDH + 16 * seg] = a; *(u4v*)&img[row * LDH + 16 * seg + 8] = b;
}
DI void img_store_T(h16* img, int row, int seg, u4v a, u4v b) {
  const h16* pa = (const h16*)&a; const h16* pb = (const h16*)&b;
#pragma unroll
  for (int i = 0; i < 8; ++i) { img[(16 * seg + i) * LDH + row] = pa[i]; img[(16 * seg + 8 + i) * LDH + row] = pb[i]; }
}

template <int NKB>
DI void attn_unit(const Params& p, int l, int mode, int grp, int head, int r0, int dil, int i0, int sub_len, int W, h16* lds) {
  unsigned char* ws = p.ws;
  const h16* P = (const h16*)(ws + OFF_PS);
  h16* Qi = lds; h16* Ki = lds + 64 * LDH; h16* Vt = lds + 128 * LDH; h16* Pi = lds + 192 * LDH;
  const int tid = otid(), lane = tid & 63, w = tid >> 6, r = lane & 15, q = lane >> 4;
  const int lrow = tid >> 2, seg = tid & 3;
  int qcol, kcol, vcol;
  if (mode == 0) { qcol = 1024 + grp * 256 + head * 64; kcol = 1792 + grp * 256 + head * 64; vcol = 2560 + grp * 256 + head * 64; }
  else { qcol = 4352 + head * 64; kcol = 4864 + (head >> 2) * 64; vcol = 4992 + (head >> 2) * 64; }
  __syncthreads();
  {
    const size_t pos = (size_t)r0 + (size_t)dil * (i0 + lrow);
    const h16* g = P + pos * NSM + qcol + 16 * seg;
    img_store_nat(Qi, lrow, seg, *(const u4v*)g, *(const u4v*)(g + 8));
  }
  float mrow[4], lsum[4];
  f4v O[4];
  float m_init = -1e30f, l_init = 0.f;
  if (mode == 1) { m_init = p.d_sink[l * 8 + head]; l_init = 1.f; }
#pragma unroll
  for (int i = 0; i < 4; ++i) { mrow[i] = m_init; lsum[i] = l_init; O[i] = (f4v){0.f, 0.f, 0.f, 0.f}; }
  for (int kb = 0; kb < NKB; ++kb) {
    const int j0 = i0 - W + 64 * kb;
    if (j0 < 0 || j0 >= sub_len) continue;
    __syncthreads();
    {
      const size_t pos = (size_t)r0 + (size_t)dil * (j0 + lrow);
      const h16* gk = P + pos * NSM + kcol + 16 * seg;
      const h16* gv = P + pos * NSM + vcol + 16 * seg;
      img_store_nat(Ki, lrow, seg, *(const u4v*)gk, *(const u4v*)(gk + 8));
      img_store_T(Vt, lrow, seg, *(const u4v*)gv, *(const u4v*)(gv + 8));
    }
    __syncthreads();
    f4v S[4];
#pragma unroll
    for (int i = 0; i < 4; ++i) S[i] = (f4v){0.f, 0.f, 0.f, 0.f};
    mm64(Qi, Ki, S, w, lane);
    float mx[4], al[4], rsum[4];
    bool vm[4][4];
#pragma unroll
    for (int rg = 0; rg < 4; ++rg) {
      const int row = 16 * w + 4 * q + rg;
      float m_ = -1e30f;
#pragma unroll
      for (int nt = 0; nt < 4; ++nt) {
        const int key = 16 * nt + r;
        const int delta = row - key + W - 64 * kb;
        const bool ok = (delta >= -W) && (delta <= W);
        vm[nt][rg] = ok;
        float s = S[nt][rg] * 0.125f;
        S[nt][rg] = s;
        if (ok) m_ = fmaxf(m_, s);
      }
      mx[rg] = grp16_max(m_);
    }
#pragma unroll
    for (int rg = 0; rg < 4; ++rg) {
      const float mn = fmaxf(mrow[rg], mx[rg]);
      al[rg] = __expf(mrow[rg] - mn);
      mrow[rg] = mn;
      float rs_ = 0.f;
#pragma unroll
      for (int nt = 0; nt < 4; ++nt) {
        float pv = vm[nt][rg] ? __expf(S[nt][rg] - mn) : 0.f;
        rs_ += pv;
        Pi[(16 * w + 4 * q + rg) * LDH + 16 * nt + r] = (h16)pv;
      }
      rsum[rg] = grp16_sum(rs_);
      lsum[rg] = lsum[rg] * al[rg] + rsum[rg];
    }
#pragma unroll
    for (int et = 0; et < 4; ++et)
#pragma unroll
      for (int rg = 0; rg < 4; ++rg) O[et][rg] *= al[rg];
    __syncthreads();
    mm64(Pi, Vt, O, w, lane);
  }
#pragma unroll
  for (int rg = 0; rg < 4; ++rg) {
    const int row = 16 * w + 4 * q + rg;
    const size_t pos = (size_t)r0 + (size_t)dil * (i0 + row);
    const float inv = 1.f / lsum[rg];
    if (mode == 0) {
      h16* ob = (h16*)(ws + OFF_OB) + ((size_t)grp * SEQ + pos) * 256 + head * 64;
#pragma unroll
      for (int et = 0; et < 4; ++et) ob[16 * et + r] = (h16)(O[et][rg] * inv);
      if (r == 0) {
        float* ml = (float*)(ws + OFF_MLB) + (((size_t)grp * SEQ + pos) * 4 + head) * 2;
        ml[0] = mrow[rg]; ml[1] = lsum[rg];
      }
    } else {
      h16* y = (h16*)(ws + OFF_Y) + pos * 1280 + 768 + head * 64;
#pragma unroll
      for (int et = 0; et < 4; ++et) y[16 * et + r] = (h16)(O[et][rg] * inv);
    }
  }
}

DI void bcombine_unit(const Params& p, int unit) {
  unsigned char* ws = p.ws;
  const int gi = unit * 256 + otid();
  const int seg = gi & 7, head = (gi >> 3) & 3, pos = gi >> 5;
  const float* ml = (const float*)(ws + OFF_MLB);
  const h16* ob = (const h16*)(ws + OFF_OB);
  float m[3], lv[3];
#pragma unroll
  for (int g = 0; g < 3; ++g) { const float* q = ml + (((size_t)g * SEQ + pos) * 4 + head) * 2; m[g] = q[0]; lv[g] = q[1]; }
  const float M = fmaxf(m[0], fmaxf(m[1], m[2]));
  float wg[3], den = 0.f;
#pragma unroll
  for (int g = 0; g < 3; ++g) { wg[g] = __expf(m[g] - M) * lv[g]; den += wg[g]; }
  const float inv = 1.f / den;
  float o[8];
#pragma unroll
  for (int i = 0; i < 8; ++i) o[i] = 0.f;
#pragma unroll
  for (int g = 0; g < 3; ++g) {
    h8v v = *(const h8v*)&ob[((size_t)g * SEQ + pos) * 256 + head * 64 + seg * 8];
#pragma unroll
    for (int i = 0; i < 8; ++i) o[i] += wg[g] * (float)v[i];
  }
  h8v ov;
#pragma unroll
  for (int i = 0; i < 8; ++i) ov[i] = (h16)(o[i] * inv);
  *(h8v*)((h16*)(ws + OFF_Y) + (size_t)pos * 1280 + 256 + head * 64 + seg * 8) = ov;
}

DI void mlstm_a1_unit(const Params& p, int l, int head, int oc, h16* lds) {
  unsigned char* ws = p.ws;
  const h16* P = (const h16*)(ws + OFF_PS);
  const float* pscal = (const float*)(ws + OFF_PSCAL);
  float* sca = (float*)(ws + OFF_SCA);
  float* scas = (float*)(ws + OFF_SCAS);
  h16* Ks0 = lds; h16* Ks1 = lds + 64 * LDH; h16* Vt = lds + 128 * LDH;
  float* sw = (float*)(lds + 192 * LDH);
  const int tid = otid(), lane = tid & 63, w = tid >> 6, r = lane & 15, q = lane >> 4;
  __syncthreads();
  if (w < 2) {
    const int dir = w;
    const int rr = dir ? 63 - lane : lane;
    const size_t pos = (size_t)oc * 64 + rr;
    const float* gb = p.a_gate_bias + l * 16;
    const float ig = pscal[pos * 32 + dir * 8 + head] + gb[dir * 8 + head];
    const float lf = logsigmoid_(pscal[pos * 32 + dir * 8 + 4 + head] + gb[dir * 8 + 4 + head]);
    const float b = wave_incl_sum(lf, lane);
    const float blast = __shfl(b, 63);
    const float slog = blast - b + ig;
    const float mc = wave_max(slog);
    sw[dir * 64 + rr] = __expf(slog - mc) * 0.125f;
    if (lane == 0) {
      const int nloc = dir ? 255 - oc : oc;
      float* s4 = scas + ((size_t)(dir * 4 + head) * 256 + nloc) * 4;
      s4[0] = blast; s4[1] = mc;
    }
  }
  __syncthreads();
  {
    const int lrow = tid >> 2, seg = tid & 3;
    const size_t pos = (size_t)oc * 64 + lrow;
    const h16* gk = P + pos * NSM + 256 + head * 64 + 16 * seg;
    const h16* gv = P + pos * NSM + 512 + head * 64 + 16 * seg;
    h8v k0 = *(const h8v*)gk, k1 = *(const h8v*)(gk + 8);
    u4v v0 = *(const u4v*)gv, v1 = *(const u4v*)(gv + 8);
    const float s0 = sw[lrow], s1 = sw[64 + lrow];
#pragma unroll
    for (int i = 0; i < 8; ++i) {
      Ks0[(16 * seg + i) * LDH + lrow] = (h16)((float)k0[i] * s0);
      Ks0[(16 * seg + 8 + i) * LDH + lrow] = (h16)((float)k1[i] * s0);
      Ks1[(16 * seg + i) * LDH + lrow] = (h16)((float)k0[i] * s1);
      Ks1[(16 * seg + 8 + i) * LDH + lrow] = (h16)((float)k1[i] * s1);
    }
    img_store_T(Vt, lrow, seg, v0, v1);
  }
  __syncthreads();
#pragma unroll
  for (int dir = 0; dir < 2; ++dir) {
    const h16* Ks = dir ? Ks1 : Ks0;
    const int nloc = dir ? 255 - oc : oc;
    float* dst = sca + ((size_t)(dir * 4 + head) * 256 + nloc) * 4160;
    f4v acc[4];
#pragma unroll
    for (int i = 0; i < 4; ++i) acc[i] = (f4v){0.f, 0.f, 0.f, 0.f};
    mm64(Vt, Ks, acc, w, lane);
#pragma unroll
    for (int nt = 0; nt < 4; ++nt)
#pragma unroll
      for (int rg = 0; rg < 4; ++rg) dst[(16 * w + 4 * q + rg) * 64 + 16 * nt + r] = acc[nt][rg];
    if (w == dir) {
      float s = 0.f;
#pragma unroll 8
      for (int j = 0; j < 64; ++j) s += (float)Ks[lane * LDH + j];
      dst[4096 + lane] = s;
    }
  }
}

DI void mlstm_a2_unit(const Params& p, int unit) {
  unsigned char* ws = p.ws;
  float* sca = (float*)(ws + OFF_SCA);
  float* scas = (float*)(ws + OFF_SCAS);
  const int dh = unit / 17, sl = unit % 17;
  const int e = sl * 256 + otid();
  if (e >= 4160) return;
  float* base = sca + (size_t)dh * 256 * 4160 + e;
  float* s4 = scas + (size_t)dh * 256 * 4;
  float m = 0.f, c = 0.f;
  for (int n0 = 0; n0 < 256; n0 += 8) {
    float cc[8];
#pragma unroll
    for (int i = 0; i < 8; ++i) cc[i] = base[(size_t)(n0 + i) * 4160];
#pragma unroll
    for (int i = 0; i < 8; ++i) {
      const float bl = s4[(n0 + i) * 4], mc = s4[(n0 + i) * 4 + 1];
      const float mn = fmaxf(bl + m, mc);
      const float dec = __expf(bl + m - mn), gain = __expf(mc - mn);
      base[(size_t)(n0 + i) * 4160] = c;
      if (e == 0) s4[(n0 + i) * 4 + 2] = m;
      c = dec * c + gain * cc[i];
      m = mn;
    }
  }
}

DI void mlstm_a3_unit(const Params& p, int l, int head, int oc, h16* lds) {
  unsigned char* ws = p.ws;
  const h16* P = (const h16*)(ws + OFF_PS);
  const float* pscal = (const float*)(ws + OFF_PSCAL);
  const float* sca = (const float*)(ws + OFF_SCA);
  const float* scas = (const float*)(ws + OFF_SCAS);
  h16* Qi = lds; h16* Ki = lds + 64 * LDH; h16* Vt = lds + 128 * LDH; h16* Wi = lds + 192 * LDH; h16* Ci = lds + 256 * LDH;
  float* fl = (float*)(lds + 320 * LDH);
  float* rowterm = fl;
  float* colterm = fl + 128;
  float* ainter = fl + 256;
  float* emt = fl + 384;
  float* nvec = fl + 512;
  float* qn = fl + 576;
  const int tid = otid(), lane = tid & 63, w = tid >> 6, r = lane & 15, q = lane >> 4;
  const int lrow = tid >> 2, seg = tid & 3;
  __syncthreads();
  {
    const size_t pos = (size_t)oc * 64 + lrow;
    const h16* g = P + pos * NSM + head * 64 + 16 * seg;
    img_store_nat(Qi, lrow, seg, *(const u4v*)g, *(const u4v*)(g + 8));
    img_store_nat(Ki, lrow, seg, *(const u4v*)(g + 256), *(const u4v*)(g + 264));
    img_store_T(Vt, lrow, seg, *(const u4v*)(g + 512), *(const u4v*)(g + 520));
  }
  if (w < 2) {
    const int dir = w;
    const int rr = dir ? 63 - lane : lane;
    const size_t pos = (size_t)oc * 64 + rr;
    const int nloc = dir ? 255 - oc : oc;
    const float* gb = p.a_gate_bias + l * 16;
    const float ig = pscal[pos * 32 + dir * 8 + head] + gb[dir * 8 + head];
    const float lf = logsigmoid_(pscal[pos * 32 + dir * 8 + 4 + head] + gb[dir * 8 + 4 + head]);
    const float b = wave_incl_sum(lf, lane);
    const float u = ig - b;
    const float pm = wave_incl_max(u, lane);
    const float m_intra = b + pm;
    const float mprev = scas[((size_t)(dir * 4 + head) * 256 + nloc) * 4 + 2];
    const float mt = fmaxf(b + mprev, m_intra);
    rowterm[dir * 64 + rr] = b - mt;
    colterm[dir * 64 + rr] = u;
    ainter[dir * 64 + rr] = __expf(b + mprev - mt);
    emt[dir * 64 + rr] = __expf(-mt);
  }
  f4v hacc[4];
#pragma unroll
  for (int i = 0; i < 4; ++i) hacc[i] = (f4v){0.f, 0.f, 0.f, 0.f};
#pragma unroll 1
  for (int dir = 0; dir < 2; ++dir) {
    const int nloc = dir ? 255 - oc : oc;
    const float* src = sca + ((size_t)(dir * 4 + head) * 256 + nloc) * 4160;
    __syncthreads();
    {
      const float4* s4 = (const float4*)(src + lrow * 64 + 16 * seg);
      float4 a = s4[0], b = s4[1], c = s4[2], d = s4[3];
      h8v o0, o1;
      o0[0] = (h16)a.x; o0[1] = (h16)a.y; o0[2] = (h16)a.z; o0[3] = (h16)a.w; o0[4] = (h16)b.x; o0[5] = (h16)b.y; o0[6] = (h16)b.z; o0[7] = (h16)b.w;
      o1[0] = (h16)c.x; o1[1] = (h16)c.y; o1[2] = (h16)c.z; o1[3] = (h16)c.w; o1[4] = (h16)d.x; o1[5] = (h16)d.y; o1[6] = (h16)d.z; o1[7] = (h16)d.w;
      *(h8v*)&Ci[lrow * LDH + 16 * seg] = o0; *(h8v*)&Ci[lrow * LDH + 16 * seg + 8] = o1;
      if (tid < 64) nvec[tid] = src[4096 + tid];
    }
    __syncthreads();
    f4v S[4];
#pragma unroll
    for (int i = 0; i < 4; ++i) S[i] = (f4v){0.f, 0.f, 0.f, 0.f};
    mm64(Qi, Ki, S, w, lane);
    float dint[4];
#pragma unroll
    for (int rg = 0; rg < 4; ++rg) {
      const int t = 16 * w + 4 * q + rg;
      const float rt = rowterm[dir * 64 + t];
      float sum = 0.f;
#pragma unroll
      for (int nt = 0; nt < 4; ++nt) {
        const int s = 16 * nt + r;
        const bool ok = dir ? (s >= t) : (s <= t);
        const float wv = ok ? __expf(rt + colterm[dir * 64 + s]) * S[nt][rg] * 0.125f : 0.f;
        sum += wv;
        Wi[t * LDH + s] = (h16)wv;
      }
      dint[rg] = grp16_sum(sum);
    }
    {
      float s = 0.f;
#pragma unroll
      for (int i = 0; i < 16; ++i) s += (float)Qi[lrow * LDH + 16 * seg + i] * nvec[16 * seg + i];
      s += __shfl_xor(s, 1); s += __shfl_xor(s, 2);
      if (seg == 0) qn[lrow] = s;
    }
    __syncthreads();
    f4v a1[4], a2[4];
#pragma unroll
    for (int i = 0; i < 4; ++i) { a1[i] = (f4v){0.f, 0.f, 0.f, 0.f}; a2[i] = (f4v){0.f, 0.f, 0.f, 0.f}; }
    mm64(Wi, Vt, a1, w, lane);
    mm64(Qi, Ci, a2, w, lane);
#pragma unroll
    for (int rg = 0; rg < 4; ++rg) {
      const int t = 16 * w + 4 * q + rg;
      const float ai = ainter[dir * 64 + t];
      const float den = ai * qn[t] + dint[rg];
      const float dn = 1.f / fmaxf(fabsf(den), emt[dir * 64 + t]);
#pragma unroll
      for (int et = 0; et < 4; ++et) hacc[et][rg] += (a1[et][rg] + ai * a2[et][rg]) * dn;
    }
  }
  const float* nw = p.a_norm_w + l * 256 + head * 64;
#pragma unroll
  for (int rg = 0; rg < 4; ++rg) {
    const int t = 16 * w + 4 * q + rg;
    const size_t pos = (size_t)oc * 64 + t;
    float s = hacc[0][rg] + hacc[1][rg] + hacc[2][rg] + hacc[3][rg];
    const float mu = grp16_sum(s) * (1.f / 64.f);
    float vs = 0.f;
#pragma unroll
    for (int et = 0; et < 4; ++et) { float d = hacc[et][rg] - mu; vs += d * d; }
    const float var = grp16_sum(vs) * (1.f / 64.f);
    const float rstd = rsqrtf(var + 1e-5f);
    h16* y = (h16*)(ws + OFF_Y) + pos * 1280 + head * 64;
    const h16* ao = P + pos * NSM + 768 + head * 64;
#pragma unroll
    for (int et = 0; et < 4; ++et) {
      const int e = 16 * et + r;
      y[e] = (h16)((hacc[et][rg] - mu) * rstd * nw[e] * sigmoid_((float)ao[e]));
    }
  }
}

template <int DIR>
DI void dn_solve4(const float* M, const h16* Ki, const h16* Vi, const float* betal, const float* gcl, int half, int c, int pp, float (&x)[16]) {
  const h16* src = half ? (Ki + c) : (Vi + c);
#pragma unroll
  for (int k = 0; k < 16; ++k) x[k] = 0.f;
#pragma unroll
  for (int il = 0; il < 64; ++il) {
    const int ri = DIR ? 63 - il : il;
    float part = 0.f;
#pragma unroll
    for (int k = 0; k < (il + 3) / 4; ++k) {
      const int jl0 = 4 * k;
      float mv = DIR ? M[ri * MLD + 63 - jl0 - pp] : M[ri * MLD + jl0 + pp];
      if (jl0 + 3 >= il) mv = (jl0 + pp < il) ? mv : 0.f;
      part += mv * x[k];
    }
    part += __shfl_xor(part, 1); part += __shfl_xor(part, 2);
    const float e = half ? __expf(gcl[ri]) : 1.f;
    const float xi = betal[ri] * (float)src[ri * LDH] * e - part;
    if ((il & 3) == pp) x[il >> 2] = xi;
  }
}

DI void dn_c1_unit(const Params& p, int l, int head, int oc, h16* lds) {
  unsigned char* ws = p.ws;
  const h16* P = (const h16*)(ws + OFF_PS);
  const float* pscal = (const float*)(ws + OFF_PSCAL);
  h16* cq = (h16*)(ws + OFF_CQKV);
  h16* Ki = lds; h16* Vi = lds + 64 * LDH;
  float* M = (float*)(lds + 128 * LDH);
  float* betal = M + 64 * MLD;
  float* gcl = betal + 128;
  float* glast = gcl + 128;
  const int tid = otid(), lane = tid & 63, w = tid >> 6, r = lane & 15, q = lane >> 4;
  const int lrow = tid >> 2, seg = tid & 3;
  __syncthreads();
  {
    const int pos = oc * 64 + lrow;
    const float* cw = p.c_conv_w + (size_t)l * 5 * 768;
    float vq[16], vk[16], vv[16];
#pragma unroll
    for (int i = 0; i < 16; ++i) { vq[i] = 0.f; vk[i] = 0.f; vv[i] = 0.f; }
#pragma unroll
    for (int j = 0; j < 5; ++j) {
      const int pp = pos + j - 2;
      if (pp < 0 || pp >= SEQ) continue;
      const h16* g = P + (size_t)pp * NSM + 3328 + head * 64 + 16 * seg;
      h8v q0 = *(const h8v*)g, q1 = *(const h8v*)(g + 8);
      h8v k0 = *(const h8v*)(g + 256), k1 = *(const h8v*)(g + 264);
      h8v v0 = *(const h8v*)(g + 512), v1 = *(const h8v*)(g + 520);
      const float* wq = cw + j * 768 + head * 64 + 16 * seg;
#pragma unroll
      for (int i = 0; i < 8; ++i) {
        vq[i] += wq[i] * (float)q0[i]; vq[8 + i] += wq[8 + i] * (float)q1[i];
        vk[i] += wq[256 + i] * (float)k0[i]; vk[8 + i] += wq[264 + i] * (float)k1[i];
        vv[i] += wq[512 + i] * (float)v0[i]; vv[8 + i] += wq[520 + i] * (float)v1[i];
      }
    }
    float sq = 0.f, sk = 0.f;
#pragma unroll
    for (int i = 0; i < 16; ++i) { vq[i] = silu_(vq[i]); vk[i] = silu_(vk[i]); vv[i] = silu_(vv[i]); sq += vq[i] * vq[i]; sk += vk[i] * vk[i]; }
    sq += __shfl_xor(sq, 1); sq += __shfl_xor(sq, 2);
    sk += __shfl_xor(sk, 1); sk += __shfl_xor(sk, 2);
    const float rq = rsqrtf(sq + 1e-6f) * 0.125f, rk = rsqrtf(sk + 1e-6f);
    h8v oq0, oq1, ok0, ok1, ov0, ov1;
#pragma unroll
    for (int i = 0; i < 8; ++i) {
      oq0[i] = (h16)(vq[i] * rq); oq1[i] = (h16)(vq[8 + i] * rq);
      ok0[i] = (h16)(vk[i] * rk); ok1[i] = (h16)(vk[8 + i] * rk);
      ov0[i] = (h16)vv[i]; ov1[i] = (h16)vv[8 + i];
    }
    h16* o = cq + (size_t)pos * 768 + head * 64 + 16 * seg;
    *(h8v*)o = oq0; *(h8v*)(o + 8) = oq1;
    *(h8v*)(o + 256) = ok0; *(h8v*)(o + 264) = ok1;
    *(h8v*)(o + 512) = ov0; *(h8v*)(o + 520) = ov1;
    *(h8v*)&Ki[lrow * LDH + 16 * seg] = ok0; *(h8v*)&Ki[lrow * LDH + 16 * seg + 8] = ok1;
    *(h8v*)&Vi[lrow * LDH + 16 * seg] = ov0; *(h8v*)&Vi[lrow * LDH + 16 * seg + 8] = ov1;
  }
  if (w < 2) {
    const int dir = w;
    const int rr = dir ? 63 - lane : lane;
    const size_t pos = (size_t)oc * 64 + rr;
    const float beta = sigmoid_(pscal[pos * 32 + 16 + dir * 4 + head]);
    const float g = -__expf(p.c_a_log[l * 8 + dir * 4 + head]) * softplus_(pscal[pos * 32 + 24 + dir * 4 + head] + p.c_dt_bias[l * 8 + dir * 4 + head]);
    const float gc = wave_incl_sum(g, lane);
    const float gl = __shfl(gc, 63);
    betal[dir * 64 + rr] = beta; gcl[dir * 64 + rr] = gc;
    if (lane == 0) {
      glast[dir] = gl;
      const int nloc = dir ? 255 - oc : oc;
      ((float*)(ws + OFF_CDL))[(size_t)(dir * 4 + head) * 256 + nloc] = __expf(gl);
    }
  }
  __syncthreads();
  {
    f4v kk[4];
#pragma unroll
    for (int i = 0; i < 4; ++i) kk[i] = (f4v){0.f, 0.f, 0.f, 0.f};
    mm64(Ki, Ki, kk, w, lane);
#pragma unroll
    for (int nt = 0; nt < 4; ++nt)
#pragma unroll
      for (int rg = 0; rg < 4; ++rg) {
        const int i = 16 * w + 4 * q + rg, j = 16 * nt + r;
        float v = 0.f;
        if (j < i) v = betal[i] * kk[nt][rg] * __expf(gcl[i] - gcl[j]);
        else if (j > i) v = betal[64 + i] * kk[nt][rg] * __expf(gcl[64 + i] - gcl[64 + j]);
        M[i * MLD + j] = v;
      }
  }
  __syncthreads();
  {
    const int c = tid >> 2, pp = tid & 3;
#pragma unroll 1
    for (int dh2 = 0; dh2 < 4; ++dh2) {
      const int dir = dh2 >> 1, half = dh2 & 1;
      const int nloc = dir ? 255 - oc : oc;
      const size_t unit = (size_t)(dir * 4 + head) * 256 + nloc;
      float x[16];
      if (dir == 0) dn_solve4<0>(M, Ki, Vi, betal, gcl, half, c, pp, x);
      else dn_solve4<1>(M, Ki, Vi, betal + 64, gcl + 64, half, c, pp, x);
      if (half == 0) {
        float* ud = (float*)(ws + OFF_CU) + unit * 4096;
        const int slice = c >> 4, el = c & 15;
#pragma unroll
        for (int k = 0; k < 16; ++k) {
          const int il = 4 * k + pp;
          const int rr = dir ? 63 - il : il;
          ud[((slice * 4 + (rr >> 4)) * 64 + el + 16 * ((rr & 15) >> 2)) * 4 + (rr & 3)] = x[k];
        }
      } else {
        h16* wd = (h16*)(ws + OFF_CW) + unit * 4096;
        const int s = c >> 5, lq = (c & 15) >> 2, jjx = (c & 3) + 4 * ((c & 31) >> 4);
#pragma unroll
        for (int k = 0; k < 16; ++k) {
          const int il = 4 * k + pp;
          const int rr = dir ? 63 - il : il;
          wd[(((rr >> 4) * 2 + s) * 64 + (rr & 15) + 16 * lq) * 8 + jjx] = (h16)(-x[k]);
        }
      }
    }
  }
#pragma unroll
  for (int dir = 0; dir < 2; ++dir) {
    const int nloc = dir ? 255 - oc : oc;
    const size_t unit = (size_t)(dir * 4 + head) * 256 + nloc;
    h16* kd = (h16*)(ws + OFF_CKD) + unit * 4096;
    const float gl = glast[dir];
#pragma unroll
    for (int it = 0; it < 4; ++it) {
      const int e = tid + 256 * it;
      const int d = e & 63, rq = e >> 6;
      const int r0 = 4 * rq;
      h4v o;
#pragma unroll
      for (int i = 0; i < 4; ++i) o[i] = (h16)((float)Ki[(r0 + i) * LDH + d] * __expf(gl - gcl[dir * 64 + r0 + i]));
      const int tile = d >> 4, s = r0 >> 5, ln = (d & 15) + 16 * ((r0 & 15) >> 2), j4 = 4 * ((r0 & 31) >> 4);
      *(h4v*)&kd[((tile * 2 + s) * 64 + ln) * 8 + j4] = o;
    }
  }
}

DI void dn_c2_unit(const Params& p, int dh) {
  unsigned char* ws = p.ws;
  const int tid = otid(), lane = tid & 63, w = tid >> 6;
  const h16* cw = (const h16*)(ws + OFF_CW) + (size_t)dh * 256 * 4096;
  const h16* ckd = (const h16*)(ws + OFF_CKD) + (size_t)dh * 256 * 4096;
  const float* cu = (const float*)(ws + OFF_CU) + (size_t)dh * 256 * 4096;
  const float* cdl = (const float*)(ws + OFF_CDL) + (size_t)dh * 256;
  h16* cs = (h16*)(ws + OFF_CS) + (size_t)dh * 256 * 4096;
  h16* cvn = (h16*)(ws + OFF_CVN) + (size_t)dh * 256 * 4096;
  f4v S[4];
#pragma unroll
  for (int i = 0; i < 4; ++i) S[i] = (f4v){0.f, 0.f, 0.f, 0.f};
  h8v wA[4][2], kA[4][2]; f4v uu[4]; float dl;
#pragma unroll
  for (int t = 0; t < 4; ++t) {
#pragma unroll
    for (int s = 0; s < 2; ++s) {
      wA[t][s] = *(const h8v*)&cw[((t * 2 + s) * 64 + lane) * 8];
      kA[t][s] = *(const h8v*)&ckd[((t * 2 + s) * 64 + lane) * 8];
    }
    uu[t] = *(const f4v*)&cu[((w * 4 + t) * 64 + lane) * 4];
  }
  dl = cdl[0];
  for (int n = 0; n < 256; ++n) {
    h8v wN[4][2], kN[4][2]; f4v uN[4]; float dlN = 0.f;
    const int nn = (n + 1 < 256) ? n + 1 : n;
    {
      const h16* cw1 = cw + (size_t)nn * 4096; const h16* ck1 = ckd + (size_t)nn * 4096; const float* cu1 = cu + (size_t)nn * 4096;
#pragma unroll
      for (int t = 0; t < 4; ++t) {
#pragma unroll
        for (int s = 0; s < 2; ++s) {
          wN[t][s] = *(const h8v*)&cw1[((t * 2 + s) * 64 + lane) * 8];
          kN[t][s] = *(const h8v*)&ck1[((t * 2 + s) * 64 + lane) * 8];
        }
        uN[t] = *(const f4v*)&cu1[((w * 4 + t) * 64 + lane) * 4];
      }
      dlN = cdl[nn];
    }
    h8v Sb[2];
    Sb[0] = pack8(S[0], S[1]); Sb[1] = pack8(S[2], S[3]);
    h16* cs1 = cs + (size_t)n * 4096; h16* cv1 = cvn + (size_t)n * 4096;
    *(h8v*)&cs1[((w * 2 + 0) * 64 + lane) * 8] = Sb[0];
    *(h8v*)&cs1[((w * 2 + 1) * 64 + lane) * 8] = Sb[1];
    f4v vn[4];
#pragma unroll
    for (int t = 0; t < 4; ++t) { vn[t] = uu[t]; vn[t] = mfma16(wA[t][0], Sb[0], vn[t]); vn[t] = mfma16(wA[t][1], Sb[1], vn[t]); }
    h8v Vb[2];
    Vb[0] = pack8(vn[0], vn[1]); Vb[1] = pack8(vn[2], vn[3]);
    *(h8v*)&cv1[((w * 2 + 0) * 64 + lane) * 8] = Vb[0];
    *(h8v*)&cv1[((w * 2 + 1) * 64 + lane) * 8] = Vb[1];
#pragma unroll
    for (int t = 0; t < 4; ++t) { S[t] *= dl; S[t] = mfma16(kA[t][0], Vb[0], S[t]); S[t] = mfma16(kA[t][1], Vb[1], S[t]); }
#pragma unroll
    for (int t = 0; t < 4; ++t) { wA[t][0] = wN[t][0]; wA[t][1] = wN[t][1]; kA[t][0] = kN[t][0]; kA[t][1] = kN[t][1]; uu[t] = uN[t]; }
    dl = dlN;
  }
}

DI void dn_c3_unit(const Params& p, int l, int head, int oc, h16* lds) {
  unsigned char* ws = p.ws;
  const h16* P = (const h16*)(ws + OFF_PS);
  const float* pscal = (const float*)(ws + OFF_PSCAL);
  const h16* cq = (const h16*)(ws + OFF_CQKV);
  h16* Qi = lds; h16* Ki = lds + 64 * LDH;
  h16* AT = lds + 128 * LDH;
  h16* QG = lds + 256 * LDH;
  float* gcl = (float*)(lds + 384 * LDH);
  float* Ol = (float*)lds;
  const int tid = otid(), lane = tid & 63, w = tid >> 6, r = lane & 15, q = lane >> 4;
  const int lrow = tid >> 2, seg = tid & 3;
  __syncthreads();
  {
    const size_t pos = (size_t)oc * 64 + lrow;
    const h16* g = cq + pos * 768 + head * 64 + 16 * seg;
    img_store_nat(Qi, lrow, seg, *(const u4v*)g, *(const u4v*)(g + 8));
    img_store_nat(Ki, lrow, seg, *(const u4v*)(g + 256), *(const u4v*)(g + 264));
  }
  if (w < 2) {
    const int dir = w;
    const int rr = dir ? 63 - lane : lane;
    const size_t pos = (size_t)oc * 64 + rr;
    const float g = -__expf(p.c_a_log[l * 8 + dir * 4 + head]) * softplus_(pscal[pos * 32 + 24 + dir * 4 + head] + p.c_dt_bias[l * 8 + dir * 4 + head]);
    gcl[dir * 64 + rr] = wave_incl_sum(g, lane);
  }
  __syncthreads();
  {
    f4v S[4];
#pragma unroll
    for (int i = 0; i < 4; ++i) S[i] = (f4v){0.f, 0.f, 0.f, 0.f};
    mm64(Qi, Ki, S, w, lane);
#pragma unroll
    for (int dir = 0; dir < 2; ++dir) {
#pragma unroll
      for (int nt = 0; nt < 4; ++nt)
#pragma unroll
        for (int rg = 0; rg < 4; ++rg) {
          const int i = 16 * w + 4 * q + rg, j = 16 * nt + r;
          const bool ok = dir ? (j >= i) : (j <= i);
          const float v = ok ? S[nt][rg] * __expf(gcl[dir * 64 + i] - gcl[dir * 64 + j]) : 0.f;
          AT[(dir * 64 + i) * LDH + j] = (h16)v;
        }
      const float eg = __expf(gcl[dir * 64 + lrow]);
#pragma unroll
      for (int i = 0; i < 16; ++i) QG[(dir * 64 + lrow) * LDH + 16 * seg + i] = (h16)((float)Qi[lrow * LDH + 16 * seg + i] * eg);
    }
  }
  __syncthreads();
  f4v o[4];
#pragma unroll
  for (int i = 0; i < 4; ++i) o[i] = (f4v){0.f, 0.f, 0.f, 0.f};
#pragma unroll
  for (int dir = 0; dir < 2; ++dir) {
    const int nloc = dir ? 255 - oc : oc;
    const size_t unit = (size_t)(dir * 4 + head) * 256 + nloc;
    const h16* cs = (const h16*)(ws + OFF_CS) + unit * 4096;
    const h16* cv = (const h16*)(ws + OFF_CVN) + unit * 4096;
#pragma unroll
    for (int s = 0; s < 2; ++s) {
      const h8v Sb = *(const h8v*)&cs[((w * 2 + s) * 64 + lane) * 8];
      const h8v Vb = *(const h8v*)&cv[((w * 2 + s) * 64 + lane) * 8];
#pragma unroll
      for (int it = 0; it < 4; ++it) {
        o[it] = mfma16(perm_frag(QG + dir * 64 * LDH, 16 * it + r, s, q), Sb, o[it]);
        o[it] = mfma16(perm_frag(AT + dir * 64 * LDH, 16 * it + r, s, q), Vb, o[it]);
      }
    }
  }
  __syncthreads();
#pragma unroll
  for (int it = 0; it < 4; ++it)
#pragma unroll
    for (int rg = 0; rg < 4; ++rg) Ol[(16 * it + 4 * q + rg) * 65 + 16 * w + r] = o[it][rg];
  __syncthreads();
  {
    const size_t pos = (size_t)oc * 64 + lrow;
    float v[16]; float ss = 0.f;
#pragma unroll
    for (int i = 0; i < 16; ++i) { v[i] = Ol[lrow * 65 + 16 * seg + i]; ss += v[i] * v[i]; }
    ss += __shfl_xor(ss, 1); ss += __shfl_xor(ss, 2);
    const float rms = rsqrtf(ss * (1.f / 64.f) + 1e-6f);
    const float* nw = p.c_norm_w + l * 64 + 16 * seg;
    const h16* cg_ = P + pos * NSM + 4096 + head * 64 + 16 * seg;
    h8v g0 = *(const h8v*)cg_, g1 = *(const h8v*)(cg_ + 8);
    h8v o0, o1;
#pragma unroll
    for (int i = 0; i < 8; ++i) {
      o0[i] = (h16)(v[i] * rms * nw[i] * silu_((float)g0[i]));
      o1[i] = (h16)(v[8 + i] * rms * nw[8 + i] * silu_((float)g1[i]));
    }
    h16* y = (h16*)(ws + OFF_Y) + pos * 1280 + 512 + head * 64 + 16 * seg;
    *(h8v*)y = o0; *(h8v*)(y + 8) = o1;
  }
}

DI void phase_m1(const Params& p, int l, int bid, int nb, h16* lds) {
  for (int u = bid; u < 2048; u += nb) {
    if (u < 1024) dn_c1_unit(p, l, u & 3, u >> 2, lds);
    else { const int v = u - 1024; mlstm_a1_unit(p, l, v & 3, v >> 2, lds); }
  }
}
DI void phase_m2(const Params& p, int l, int bid, int nb, h16* lds) {
  const int total = 8 + 136 + 2048 + 3072;
  for (int u = bid; u < total; u += nb) {
    int v = u;
    if (v < 8) { dn_c2_unit(p, v); continue; }
    if ((v -= 8) < 136) { mlstm_a2_unit(p, v); continue; }
    if ((v -= 136) < 2048) { attn_unit<5>(p, l, 1, 0, v & 7, 0, 1, (v >> 3) * 64, SEQ, 128, lds); continue; }
    v -= 2048;
    const int grp = v >> 10, x = v & 1023, head = x & 3, tl = x >> 2;
    const int dil = (grp == 0) ? 1 : (grp == 1) ? 4 : 16;
    const int sub = SEQ / dil, tps = sub >> 6;
    const int res = tl / tps, ti = tl % tps;
    attn_unit<3>(p, l, 0, grp, head, res, dil, ti * 64, sub, 64, lds);
  }
}
DI void phase_m3(const Params& p, int l, int bid, int nb, h16* lds) {
  const int total = 1024 + 1024 + 2048;
  for (int u = bid; u < total; u += nb) {
    int v = u;
    if (v < 1024) { mlstm_a3_unit(p, l, v & 3, v >> 2, lds); continue; }
    if ((v -= 1024) < 1024) { dn_c3_unit(p, l, v & 3, v >> 2, lds); continue; }
    bcombine_unit(p, v - 1024);
  }
}

DI void phase_gates(const Params& p, int bid, int nb, h16* lds) {
  unsigned char* ws = p.ws;
  const h16* x16 = (const h16*)(ws + OFF_X16);
  const h16* wg = (const h16*)(ws + OFF_WG);
  h16* G = (h16*)(ws + OFF_GATES);
  for (int u = bid; u < 128 * 32; u += nb) {
    const int m0 = (u >> 5) * 128, n0 = (u & 31) * 128;
    f16v acc[2][2]; acc_zero(acc);
    gemm_main<false>(x16, DM, nullptr, m0, wg, 1024, n0, 1024, lds, acc);
    gemm_epilogue(acc, m0, n0, [&](int m, int n, f4v v0, f4v v1) {
      f4v a, b;
#pragma unroll
      for (int i = 0; i < 4; ++i) { a[i] = sigmoid_(v0[i]); b[i] = sigmoid_(v1[i]); }
      st_h4(&G[(size_t)m * 4096 + n], a); st_h4(&G[(size_t)m * 4096 + n + 32], b);
    });
  }
}
DI void phase_merge(const Params& p, int bid, int nb, h16* lds) {
  unsigned char* ws = p.ws;
  const h16* Y = (const h16*)(ws + OFF_Y);
  const h16* wbr = (const h16*)(ws + OFF_WBR);
  const h16* G = (const h16*)(ws + OFF_GATES);
  h16* Mg = (h16*)(ws + OFF_MERGED);
  for (int u = bid; u < 128 * 8; u += nb) {
    const int m0 = (u >> 3) * 128, n0 = (u & 7) * 128;
    f16v macc[2][2]; acc_zero(macc);
#pragma unroll 1
    for (int b = 0; b < 4; ++b) {
      const int Kb = (b == 3) ? 512 : 256;
      f16v acc[2][2]; acc_zero(acc);
      gemm_main<false>(Y + b * 256, 1280, nullptr, m0, wbr + (size_t)b * 262144, Kb, n0, Kb, lds, acc);
      const int tid = otid(), lane = tid & 63, wv = tid >> 6, wm = wv >> 1, wn = wv & 1, h = lane >> 5;
#pragma unroll
      for (int i = 0; i < 2; ++i) {
        const int m = m0 + wm * 64 + i * 32 + (lane & 31);
#pragma unroll
        for (int g = 0; g < 4; ++g) {
          const int n = n0 + wn * 64 + 8 * g + 4 * h;
          const h4v g0 = *(const h4v*)&G[(size_t)m * 4096 + b * 1024 + n];
          const h4v g1 = *(const h4v*)&G[(size_t)m * 4096 + b * 1024 + n + 32];
#pragma unroll
          for (int e = 0; e < 4; ++e) {
            macc[i][0][4 * g + e] += (float)g0[e] * acc[i][0][4 * g + e];
            macc[i][1][4 * g + e] += (float)g1[e] * acc[i][1][4 * g + e];
          }
        }
      }
    }
    gemm_epilogue(macc, m0, n0, [&](int m, int n, f4v v0, f4v v1) {
      st_h4(&Mg[(size_t)m * DM + n], v0); st_h4(&Mg[(size_t)m * DM + n + 32], v1);
    });
  }
}
DI void phase_resid_gemm(const Params& p, const h16* A, int lda, const h16* W, int K, const float* xres, int bid, int nb, h16* lds) {
  float* out = p.out;
  for (int u = bid; u < 128 * 8; u += nb) {
    const int m0 = (u >> 3) * 128, n0 = (u & 7) * 128;
    f16v acc[2][2]; acc_zero(acc);
    gemm_main<false>(A, lda, nullptr, m0, W, K, n0, K, lds, acc);
    gemm_epilogue(acc, m0, n0, [&](int m, int n, f4v v0, f4v v1) {
      const f4v x0 = *(const f4v*)&xres[(size_t)m * DM + n], x1 = *(const f4v*)&xres[(size_t)m * DM + n + 32];
      *(f4v*)&out[(size_t)m * DM + n] = ALPHA * x0 + v0;
      *(f4v*)&out[(size_t)m * DM + n + 32] = ALPHA * x1 + v1;
    });
  }
}
DI void phase_ffn1_dense(const Params& p, int bid, int nb, h16* lds) {
  unsigned char* ws = p.ws;
  const h16* x16 = (const h16*)(ws + OFF_X16);
  const h16* w13 = (const h16*)(ws + OFF_WFF);
  h16* H = (h16*)(ws + OFF_H);
  for (int u = bid; u < 128 * 44; u += nb) {
    const int m0 = (u / 44) * 128, n0 = (u % 44) * 128;
    f16v acc[2][2]; acc_zero(acc);
    gemm_main<false>(x16, DM, nullptr, m0, w13, 1024, n0, 1024, lds, acc);
    gemm_epilogue(acc, m0, n0, [&](int m, int n, f4v v0, f4v v1) {
      f4v hq;
#pragma unroll
      for (int i = 0; i < 4; ++i) hq[i] = silu_(v0[i]) * v1[i];
      st_h4(&H[(size_t)m * 2816 + (n >> 6) * 32 + (n & 31)], hq);
    });
  }
}
DI void moe_prefix(const int* cnt, int (&pstart)[9]) {
  int s = 0;
#pragma unroll
  for (int e = 0; e < 8; ++e) { pstart[e] = s; s += (cnt[e] + 127) & ~127; }
  pstart[8] = s;
}
DI void phase_ffn1_moe(const Params& p, int bid, int nb, h16* lds) {
  unsigned char* ws = p.ws;
  const h16* x16 = (const h16*)(ws + OFF_X16);
  const h16* w13 = (const h16*)(ws + OFF_WFF);
  h16* H = (h16*)(ws + OFF_H);
  const int* st = (const int*)(ws + MOE_ST);
  int ps[9]; moe_prefix((const int*)(ws + MOE_CNT), ps);
  const int ntl = (ps[8] >> 7) * 22;
  for (int u = bid; u < ntl; u += nb) {
    const int mt = u / 22, m0 = mt * 128, n0 = (u % 22) * 128;
    int e = 0;
#pragma unroll
    for (int i = 1; i < 8; ++i) if (m0 >= ps[i]) e = i;
    f16v acc[2][2]; acc_zero(acc);
    gemm_main<true>(x16, DM, st, m0, w13 + (size_t)e * 2816 * 1024, 1024, n0, 1024, lds, acc);
    gemm_epilogue(acc, m0, n0, [&](int m, int n, f4v v0, f4v v1) {
      f4v hq;
#pragma unroll
      for (int i = 0; i < 4; ++i) hq[i] = silu_(v0[i]) * v1[i];
      st_h4(&H[(size_t)m * 1408 + (n >> 6) * 32 + (n & 31)], hq);
    });
  }
}
DI void phase_ffn2_moe(const Params& p, int bid, int nb, h16* lds) {
  unsigned char* ws = p.ws;
  const h16* H = (const h16*)(ws + OFF_H);
  const h16* w2 = (const h16*)(ws + OFF_WFF) + (size_t)8 * 2816 * 1024;
  h16* YB = (h16*)(ws + OFF_YB);
  const float* sg = (const float*)(ws + MOE_SG);
  int ps[9]; moe_prefix((const int*)(ws + MOE_CNT), ps);
  const int ntl = (ps[8] >> 7) * 8;
  for (int u = bid; u < ntl; u += nb) {
    const int mt = u >> 3, m0 = mt * 128, n0 = (u & 7) * 128;
    int e = 0;
#pragma unroll
    for (int i = 1; i < 8; ++i) if (m0 >= ps[i]) e = i;
    f16v acc[2][2]; acc_zero(acc);
    gemm_main<false>(H, 1408, nullptr, m0, w2 + (size_t)e * 1024 * 1408, 1408, n0, 1408, lds, acc);
    gemm_epilogue(acc, m0, n0, [&](int m, int n, f4v v0, f4v v1) {
      const float g = sg[m];
      st_h4(&YB[(size_t)m * DM + n], g * v0); st_h4(&YB[(size_t)m * DM + n + 32], g * v1);
    });
  }
}

DI void phase_ln(const Params& p, int l, int which, int bid, int nb) {
  unsigned char* ws = p.ws;
  const bool moe = (l & 1);
  const bool moe_in = moe && which == 2;
  const bool router = moe && which == 1;
  const float* lw = (which == 1 ? p.ln1_w : p.ln2_w) + l * DM;
  const float* lb = (which == 1 ? p.ln1_b : p.ln2_b) + l * DM;
  float* out = p.out;
  h16* x16 = (h16*)(ws + OFF_X16);
  const int tid_ = otid(); const int lane = tid_ & 63, wv = tid_ >> 6;
  for (int row = bid * 4 + wv; row < SEQ; row += nb * 4) {
    float v[16];
#pragma unroll
    for (int i = 0; i < 4; ++i) {
      const f4v t = *(const f4v*)&out[(size_t)row * DM + 256 * i + lane * 4];
      v[4 * i] = t[0]; v[4 * i + 1] = t[1]; v[4 * i + 2] = t[2]; v[4 * i + 3] = t[3];
    }
    if (moe_in) {
      const int* ts = (const int*)(ws + MOE_TS);
      const h16* YB = (const h16*)(ws + OFF_YB);
      const int s0 = ts[row * 2], s1 = ts[row * 2 + 1];
#pragma unroll
      for (int i = 0; i < 4; ++i) {
        const h4v a = *(const h4v*)&YB[(size_t)s0 * DM + 256 * i + lane * 4];
        const h4v b = *(const h4v*)&YB[(size_t)s1 * DM + 256 * i + lane * 4];
#pragma unroll
        for (int e = 0; e < 4; ++e) v[4 * i + e] = ALPHA * v[4 * i + e] + ((float)a[e] + (float)b[e]);
      }
    }
    float s = 0.f;
#pragma unroll
    for (int i = 0; i < 16; ++i) s += v[i];
    const float mu = wave_sum(s) * (1.f / 1024.f);
    float vs = 0.f;
#pragma unroll
    for (int i = 0; i < 16; ++i) { const float d = v[i] - mu; vs += d * d; }
    const float rstd = rsqrtf(wave_sum(vs) * (1.f / 1024.f) + 1e-5f);
#pragma unroll
    for (int i = 0; i < 4; ++i) {
      const int c = 256 * i + lane * 4;
      const f4v w4 = *(const f4v*)&lw[c], b4 = *(const f4v*)&lb[c];
      f4v y;
#pragma unroll
      for (int e = 0; e < 4; ++e) { y[e] = (v[4 * i + e] - mu) * rstd * w4[e] + b4[e]; v[4 * i + e] = y[e]; }
      *(f4v*)&out[(size_t)row * DM + c] = y;
      st_h4(&x16[(size_t)row * DM + c], y);
    }
    if (router) {
      const float* rw = p.moe_router + (size_t)(l >> 1) * DM * 8;
      float lg[8];
#pragma unroll
      for (int e = 0; e < 8; ++e) lg[e] = 0.f;
#pragma unroll
      for (int i = 0; i < 4; ++i)
#pragma unroll
        for (int k = 0; k < 4; ++k) {
          const int c = 256 * i + lane * 4 + k;
          const f4v r0 = *(const f4v*)&rw[(size_t)c * 8], r1 = *(const f4v*)&rw[(size_t)c * 8 + 4];
          const float xv = v[4 * i + k];
#pragma unroll
          for (int e = 0; e < 4; ++e) { lg[e] += xv * r0[e]; lg[4 + e] += xv * r1[e]; }
        }
#pragma unroll
      for (int e = 0; e < 8; ++e) lg[e] = wave_sum(lg[e]);
      if (lane == 0) {
        int i1 = 0; float b1 = lg[0];
#pragma unroll
        for (int e = 1; e < 8; ++e) if (lg[e] > b1) { b1 = lg[e]; i1 = e; }
        int i2 = -1; float b2 = -3.4e38f;
#pragma unroll
        for (int e = 0; e < 8; ++e) if (e != i1 && lg[e] > b2) { b2 = lg[e]; i2 = e; }
        const float g1 = 1.f / (1.f + __expf(b2 - b1)), g2 = 1.f - g1;
        int* cnt = (int*)(ws + MOE_CNT);
        int* te = (int*)(ws + MOE_TE); int* tp = (int*)(ws + MOE_TP); float* tg = (float*)(ws + MOE_TG);
        te[row * 2] = i1; te[row * 2 + 1] = i2;
        tp[row * 2] = atomicAdd(&cnt[i1], 1); tp[row * 2 + 1] = atomicAdd(&cnt[i2], 1);
        tg[row * 2] = g1; tg[row * 2 + 1] = g2;
      }
    }
  }
}
DI void phase_assign(const Params& p, int bid, int nb) {
  unsigned char* ws = p.ws;
  int ps[9]; moe_prefix((const int*)(ws + MOE_CNT), ps);
  const int* te = (const int*)(ws + MOE_TE); const int* tp = (const int*)(ws + MOE_TP); const float* tg = (const float*)(ws + MOE_TG);
  int* ts = (int*)(ws + MOE_TS); int* st = (int*)(ws + MOE_ST); float* sg = (float*)(ws + MOE_SG);
  for (int i = bid * 256 + otid(); i < 32768; i += nb * 256) {
    const int e = te[i];
    int base = 0;
#pragma unroll
    for (int k = 0; k < 8; ++k) if (e == k) base = ps[k];
    const int slot = base + tp[i];
    ts[i] = slot; st[slot] = i >> 1; sg[slot] = tg[i];
  }
}

__global__ void __launch_bounds__(256, 2) fwd_megakernel(Params p) {
  cg::grid_group grid = cg::this_grid();
  __shared__ __attribute__((aligned(16))) unsigned char smem[58368];
  h16* lds = (h16*)smem;
  const int bid = blockIdx.x, nb = gridDim.x;
  unsigned char* ws = p.ws;

  phase_init(p, bid, nb);
  phase_convert(p, 0, bid, nb, lds);
  grid.sync();
  for (int l = 0; l < 4; ++l) {
    phase_p1(p, l, bid, nb, smem);
    grid.sync();
    phase_m1(p, l, bid, nb, lds);
    grid.sync();
    phase_m2(p, l, bid, nb, lds);
    grid.sync();
    phase_m3(p, l, bid, nb, lds);
    grid.sync();
    phase_gates(p, bid, nb, lds);
    grid.sync();
    phase_merge(p, bid, nb, lds);
    grid.sync();
    phase_resid_gemm(p, (const h16*)(ws + OFF_MERGED), DM, (const h16*)(ws + OFF_WOUT), 1024, (l == 0) ? p.x : p.out, bid, nb, lds);
    grid.sync();
    phase_ln(p, l, 1, bid, nb);
    grid.sync();
    if (l & 1) {
      phase_assign(p, bid, nb);
      grid.sync();
      phase_ffn1_moe(p, bid, nb, lds);
      grid.sync();
      phase_ffn2_moe(p, bid, nb, lds);
      grid.sync();
    } else {
      phase_ffn1_dense(p, bid, nb, lds);
      grid.sync();
      phase_resid_gemm(p, (const h16*)(ws + OFF_H), 2816, (const h16*)(ws + OFF_WFF) + (size_t)5632 * 1024, 2816, p.out, bid, nb, lds);
      grid.sync();
    }
    phase_ln(p, l, 2, bid, nb);
    if (l + 1 < 4) { phase_convert(p, l + 1, bid, nb, lds); grid.sync(); }
  }
}

extern "C" void kernel_launch(void* const* d_in, const int* in_sizes, int n_in, void* d_out, int out_size, void* d_ws, size_t ws_size, hipStream_t stream) {
  static int grid_blocks = 0;
  if (!grid_blocks) {
    int dev = 0, cus = 0, per_cu = 0;
    hipGetDevice(&dev);
    hipDeviceGetAttribute(&cus, hipDeviceAttributeMultiprocessorCount, dev);
    hipOccupancyMaxActiveBlocksPerMultiprocessor(&per_cu, fwd_megakernel, 256, 0);
    if (per_cu > 2) per_cu = 2;
    if (per_cu < 1) per_cu = 1;
    grid_blocks = cus * per_cu;
    if (ws_size < WS_END) fprintf(stderr, "workspace too small: %zu < %zu\n", ws_size, (size_t)WS_END);
  }
  Params p{};
  const float* const* in = (const float* const*)d_in;
  p.x = in[0]; p.w_in = in[1]; p.a_gate_bias = in[2]; p.a_norm_w = in[3]; p.c_conv_w = in[4]; p.c_a_log = in[5]; p.c_dt_bias = in[6];
  p.c_norm_w = in[7]; p.d_sink = in[8]; p.w_br_a = in[9]; p.w_br_b = in[10]; p.w_br_c = in[11]; p.w_br_d = in[12]; p.w_out = in[13];
  p.ln1_w = in[14]; p.ln1_b = in[15]; p.ln2_w = in[16]; p.ln2_b = in[17]; p.ffn_w1 = in[18]; p.ffn_w3 = in[19]; p.ffn_w2 = in[20];
  p.moe_router = in[21]; p.moe_w1 = in[22]; p.moe_w3 = in[23]; p.moe_w2 = in[24];
  p.out = (float*)d_out; p.ws = (unsigned char*)d_ws;
  void* args[] = {&p};
  hipError_t e = hipLaunchCooperativeKernel((void*)fwd_megakernel, dim3(grid_blocks), dim3(256), args, 0, stream);
  if (e != hipSuccess) fprintf(stderr, "cooperative launch failed: %s (grid %d)\n", hipGetErrorString(e), grid_blocks);
}
```

```cpp
#include <hip/hip_runtime.h>
#include <hip/hip_cooperative_groups.h>
#include <cstdio>
namespace cg = cooperative_groups;

typedef _Float16 h16;
typedef h16 h8v __attribute__((ext_vector_type(8)));
typedef h16 h4v __attribute__((ext_vector_type(4)));
typedef float f4v __attribute__((ext_vector_type(4)));
typedef float f16v __attribute__((ext_vector_type(16)));
typedef unsigned int u4v __attribute__((ext_vector_type(4)));
#define DI __device__ __forceinline__

constexpr int SEQ = 16384, DM = 1024, NIN = 9248, NSM = 5120;
constexpr int LDH = 72;
constexpr float ALPHA = 1.6817928305074290f;
constexpr int NSLOT = 33792;
constexpr int MLD = 68;

constexpr size_t OFF_X16 = 0;
constexpr size_t OFF_WSM = OFF_X16 + (size_t)SEQ * DM * 2;
constexpr size_t OFF_WG = OFF_WSM + (size_t)NSM * 1024 * 2;
constexpr size_t OFF_WBR = OFF_WG + (size_t)4096 * 1024 * 2;
constexpr size_t OFF_WOUT = OFF_WBR + (size_t)1280 * 1024 * 2;
constexpr size_t OFF_WFF = OFF_WOUT + (size_t)1024 * 1024 * 2;
constexpr size_t OFF_PS = OFF_WFF + (size_t)69206016;
constexpr size_t OFF_PSCAL = OFF_PS + (size_t)SEQ * NSM * 2;
constexpr size_t OFF_Y = OFF_PSCAL + (size_t)SEQ * 32 * 4;
constexpr size_t OFF_MERGED = OFF_Y + (size_t)SEQ * 1280 * 2;
constexpr size_t OFF_ROPE = OFF_MERGED + (size_t)SEQ * DM * 2;
constexpr size_t OFF_SCA = OFF_ROPE + (size_t)SEQ * 32 * 4 * 2;
constexpr size_t OFF_SCAS = OFF_SCA + (size_t)2048 * 4160 * 4;
constexpr size_t OFF_CQKV = OFF_SCAS + (size_t)2048 * 4 * 4;
constexpr size_t OFF_CU = OFF_CQKV + (size_t)SEQ * 768 * 2;
constexpr size_t OFF_CW = OFF_CU + (size_t)2048 * 4096 * 4;
constexpr size_t OFF_CKD = OFF_CW + (size_t)2048 * 4096 * 2;
constexpr size_t OFF_CDL = OFF_CKD + (size_t)2048 * 4096 * 2;
constexpr size_t OFF_CS = OFF_CDL + (size_t)2048 * 4;
constexpr size_t OFF_CVN = OFF_CS + (size_t)2048 * 4096 * 2;
constexpr size_t OFF_OB = OFF_CVN + (size_t)2048 * 4096 * 2;
constexpr size_t OFF_MLB = OFF_OB + (size_t)3 * SEQ * 256 * 2;
constexpr size_t OFF_MOE = OFF_MLB + (size_t)3 * SEQ * 4 * 2 * 4;
constexpr size_t MOE_CNT = OFF_MOE;
constexpr size_t MOE_TE = MOE_CNT + 256;
constexpr size_t MOE_TP = MOE_TE + 32768 * 4;
constexpr size_t MOE_TG = MOE_TP + 32768 * 4;
constexpr size_t MOE_TS = MOE_TG + 32768 * 4;
constexpr size_t MOE_ST = MOE_TS + 32768 * 4;
constexpr size_t MOE_SG = MOE_ST + (size_t)NSLOT * 4;
constexpr size_t OFF_BAR = (MOE_SG + (size_t)NSLOT * 4 + 255) & ~(size_t)255;
constexpr size_t WS_END = OFF_BAR + 16384;
constexpr size_t OFF_GATES = OFF_PS;
constexpr size_t OFF_H = OFF_PS;
constexpr size_t OFF_YB = OFF_PS + (size_t)NSLOT * 1408 * 2;

struct Params {
  const float* x; const float* w_in; const float* a_gate_bias; const float* a_norm_w; const float* c_conv_w;
  const float* c_a_log; const float* c_dt_bias; const float* c_norm_w; const float* d_sink;
  const float* w_br_a; const float* w_br_b; const float* w_br_c; const float* w_br_d; const float* w_out;
  const float* ln1_w; const float* ln1_b; const float* ln2_w; const float* ln2_b;
  const float* ffn_w1; const float* ffn_w3; const float* ffn_w2;
  const float* moe_router; const float* moe_w1; const float* moe_w3; const float* moe_w2;
  float* out; unsigned char* ws;
};

DI int otid() { int t = threadIdx.x; asm volatile("" : "+v"(t)); return t; }
DI float sigmoid_(float x) { return 1.f / (1.f + __expf(-x)); }
DI float silu_(float x) { return x / (1.f + __expf(-x)); }
DI float softplus_(float x) { return x > 20.f ? x : log1pf(__expf(x)); }
DI float logsigmoid_(float x) { return fminf(x, 0.f) - log1pf(__expf(-fabsf(x))); }
DI f4v mfma16(h8v a, h8v b, f4v c) { return __builtin_amdgcn_mfma_f32_16x16x32_f16(a, b, c, 0, 0, 0); }
DI f16v mfma32(h8v a, h8v b, f16v c) { return __builtin_amdgcn_mfma_f32_32x32x16_f16(a, b, c, 0, 0, 0); }
DI float wave_incl_sum(float v, int lane) {
#pragma unroll
  for (int o = 1; o < 64; o <<= 1) { float t = __shfl_up(v, o); if (lane >= o) v += t; }
  return v;
}
DI float wave_incl_max(float v, int lane) {
#pragma unroll
  for (int o = 1; o < 64; o <<= 1) { float t = __shfl_up(v, o); if (lane >= o) v = fmaxf(v, t); }
  return v;
}
DI float wave_max(float v) {
#pragma unroll
  for (int o = 32; o >= 1; o >>= 1) v = fmaxf(v, __shfl_xor(v, o));
  return v;
}
DI float wave_sum(float v) {
#pragma unroll
  for (int o = 32; o >= 1; o >>= 1) v += __shfl_xor(v, o);
  return v;
}
DI float grp16_sum(float v) { v += __shfl_xor(v, 1); v += __shfl_xor(v, 2); v += __shfl_xor(v, 4); v += __shfl_xor(v, 8); return v; }
DI float grp16_max(float v) { v = fmaxf(v, __shfl_xor(v, 1)); v = fmaxf(v, __shfl_xor(v, 2)); v = fmaxf(v, __shfl_xor(v, 4)); v = fmaxf(v, __shfl_xor(v, 8)); return v; }

DI void mm64(const h16* A, const h16* B, f4v (&acc)[4], int w, int lane) {
  const int r = lane & 15, q = lane >> 4;
#pragma unroll
  for (int s = 0; s < 2; ++s) {
    h8v a = *(const h8v*)&A[(16 * w + r) * LDH + 32 * s + 8 * q];
#pragma unroll
    for (int nt = 0; nt < 4; ++nt) {
      h8v b = *(const h8v*)&B[(16 * nt + r) * LDH + 32 * s + 8 * q];
      acc[nt] = mfma16(a, b, acc[nt]);
    }
  }
}
DI h8v perm_frag(const h16* img, int row, int s, int q) {
  h4v lo = *(const h4v*)&img[row * LDH + 32 * s + 4 * q];
  h4v hi = *(const h4v*)&img[row * LDH + 32 * s + 16 + 4 * q];
  return __builtin_shufflevector(lo, hi, 0, 1, 2, 3, 4, 5, 6, 7);
}
DI h8v pack8(f4v a, f4v b) {
  h8v r;
  r[0] = (h16)a[0]; r[1] = (h16)a[1]; r[2] = (h16)a[2]; r[3] = (h16)a[3];
  r[4] = (h16)b[0]; r[5] = (h16)b[1]; r[6] = (h16)b[2]; r[7] = (h16)b[3];
  return r;
}
DI void st_h4(h16* p, f4v v) { h4v o; o[0] = (h16)v[0]; o[1] = (h16)v[1]; o[2] = (h16)v[2]; o[3] = (h16)v[3]; *(h4v*)p = o; }

DI void conv_unit(const float* __restrict__ src, int ld, int col0, int k0, h16* __restrict__ dst, int K, int n0, h16* lds) {
  const int t = otid();
  __syncthreads();
  {
    const int c = t & 31, kq = t >> 5;
#pragma unroll
    for (int i = 0; i < 8; ++i) {
      int kk = kq + 8 * i;
      lds[c * LDH + kk] = (h16)src[(size_t)(k0 + kk) * ld + col0 + c];
    }
  }
  __syncthreads();
  {
    const int c = t >> 3, ks = (t & 7) * 8;
    *(u4v*)&dst[(size_t)(n0 + c) * K + k0 + ks] = *(const u4v*)&lds[c * LDH + ks];
  }
}

DI int map_small(int n) {
  if (n < 1024) return 4096 + n;
  if (n < 3328) return 5136 + (n - 1024);
  if (n < 4352) return 7440 + (n - 3328);
  return 8480 + (n - 4352);
}

DI void phase_convert(const Params& p, int l, int bid, int nb, h16* lds) {
  unsigned char* ws = p.ws;
  const float* win = p.w_in + (size_t)l * 1024 * NIN;
  const int jj = l >> 1;
  const bool moe = (l & 1);
  const int nffn = moe ? 8 * 2112 : (2816 + 1408);
  const int total = 2560 + 2048 + 640 + 512 + nffn;
  for (int u = bid; u < total; u += nb) {
    int v = u;
    const float* src; int ld, col0, k0, K, n0; h16* dst;
    if (v < 2560) { n0 = (v >> 4) * 32; k0 = (v & 15) * 64; col0 = map_small(n0); src = win; ld = NIN; K = 1024; dst = (h16*)(ws + OFF_WSM); }
    else if ((v -= 2560) < 2048) { n0 = (v >> 4) * 32; k0 = (v & 15) * 64; col0 = n0; src = win; ld = NIN; K = 1024; dst = (h16*)(ws + OFF_WG); }
    else if ((v -= 2048) < 640) {
      int b, kt;
      if (v < 384) { b = v >> 7; v &= 127; kt = 4; } else { b = 3; v -= 384; kt = 8; }
      n0 = (v / kt) * 32; k0 = (v % kt) * 64; K = kt * 64;
      const float* base = (b == 0) ? p.w_br_a : (b == 1) ? p.w_br_b : (b == 2) ? p.w_br_c : p.w_br_d;
      src = base + (size_t)l * K * 1024; ld = 1024; col0 = n0; dst = (h16*)(ws + OFF_WBR) + (size_t)b * 262144;
    }
    else if ((v -= 640) < 512) { n0 = (v >> 4) * 32; k0 = (v & 15) * 64; col0 = n0; src = p.w_out + (size_t)l * 1024 * 1024; ld = 1024; K = 1024; dst = (h16*)(ws + OFF_WOUT); }
    else {
      v -= 512;
      if (!moe) {
        if (v < 2816) {
          int nbk = v >> 4; k0 = (v & 15) * 64; n0 = nbk * 32; col0 = (nbk >> 1) * 32;
          src = ((nbk & 1) ? p.ffn_w3 : p.ffn_w1) + (size_t)jj * 1024 * 2816; ld = 2816; K = 1024; dst = (h16*)(ws + OFF_WFF);
        } else {
          v -= 2816; n0 = (v / 44) * 32; k0 = (v % 44) * 64; col0 = n0; K = 2816;
          src = p.ffn_w2 + (size_t)jj * 2816 * 1024; ld = 1024; dst = (h16*)(ws + OFF_WFF) + (size_t)5632 * 1024;
        }
      } else {
        int e = v / 2112; v -= e * 2112;
        if (v < 1408) {
          int nbk = v >> 4; k0 = (v & 15) * 64; n0 = nbk * 32; col0 = (nbk >> 1) * 32;
          src = ((nbk & 1) ? p.moe_w3 : p.moe_w1) + (size_t)(jj * 8 + e) * 1024 * 1408; ld = 1408; K = 1024;
          dst = (h16*)(ws + OFF_WFF) + (size_t)e * 2816 * 1024;
        } else {
          v -= 1408; n0 = (v / 22) * 32; k0 = (v % 22) * 64; col0 = n0; K = 1408;
          src = p.moe_w2 + (size_t)(jj * 8 + e) * 1408 * 1024; ld = 1024;
          dst = (h16*)(ws + OFF_WFF) + (size_t)8 * 2816 * 1024 + (size_t)e * 1024 * 1408;
        }
      }
    }
    conv_unit(src, ld, col0, k0, dst, K, n0, lds);
  }
  if (moe) {
    int* cnt = (int*)(ws + MOE_CNT);
    int* st = (int*)(ws + MOE_ST);
    const int gt = bid * 256 + otid(), gs = nb * 256;
    if (gt < 64) cnt[gt] = 0;
    for (int i = gt; i < NSLOT; i += gs) st[i] = 0;
  }
}

DI void phase_init(const Params& p, int bid, int nb) {
  float* rc = (float*)(p.ws + OFF_ROPE);
  float* rs = rc + (size_t)SEQ * 32;
  const int gt = bid * 256 + otid(), gs = nb * 256;
  for (int i = gt; i < SEQ * 32; i += gs) {
    int pos = i >> 5, d = i & 31;
    float inv = (float)pow(10000.0, -(double)d / 32.0);
    float ang = (float)pos * inv;
    rc[i] = cosf(ang); rs[i] = sinf(ang);
  }
  h16* x16 = (h16*)(p.ws + OFF_X16);
  for (int i = gt; i < SEQ * DM / 4; i += gs) {
    float4 v = ((const float4*)p.x)[i];
    h4v o; o[0] = (h16)v.x; o[1] = (h16)v.y; o[2] = (h16)v.z; o[3] = (h16)v.w;
    *(h4v*)&x16[(size_t)i * 4] = o;
  }
}

template <bool GATHER>
DI void gemm_main(const h16* __restrict__ A, int lda, const int* __restrict__ idx, int m0,
                  const h16* __restrict__ B, int ldb, int n0, int K, h16* lds, f16v (&acc)[2][2]) {
  const int tid = otid(), lane = tid & 63, wv = tid >> 6, wm = wv >> 1, wn = wv & 1;
  h16* As = lds; h16* Bs = lds + 128 * LDH;
  const int lr = tid >> 1, lc = (tid & 1) * 32;
  const h16* ap = A + (size_t)(GATHER ? idx[m0 + lr] : (m0 + lr)) * lda + lc;
  const h16* bp = B + (size_t)(n0 + lr) * ldb + lc;
  u4v ra[4], rb[4];
#pragma unroll
  for (int i = 0; i < 4; ++i) { ra[i] = *(const u4v*)(ap + 8 * i); rb[i] = *(const u4v*)(bp + 8 * i); }
  const int nk = K >> 6;
  for (int kt = 0; kt < nk; ++kt) {
    __syncthreads();
#pragma unroll
    for (int i = 0; i < 4; ++i) { *(u4v*)&As[lr * LDH + lc + 8 * i] = ra[i]; *(u4v*)&Bs[lr * LDH + lc + 8 * i] = rb[i]; }
    __syncthreads();
    if (kt + 1 < nk) {
      ap += 64; bp += 64;
#pragma unroll
      for (int i = 0; i < 4; ++i) { ra[i] = *(const u4v*)(ap + 8 * i); rb[i] = *(const u4v*)(bp + 8 * i); }
    }
#pragma unroll
    for (int ks = 0; ks < 4; ++ks) {
      h8v af[2], bf[2];
#pragma unroll
      for (int i = 0; i < 2; ++i) af[i] = *(const h8v*)&As[(wm * 64 + i * 32 + (lane & 31)) * LDH + ks * 16 + 8 * (lane >> 5)];
#pragma unroll
      for (int j = 0; j < 2; ++j) bf[j] = *(const h8v*)&Bs[(wn * 64 + j * 32 + (lane & 31)) * LDH + ks * 16 + 8 * (lane >> 5)];
#pragma unroll
      for (int i = 0; i < 2; ++i)
#pragma unroll
        for (int j = 0; j < 2; ++j) acc[i][j] = mfma32(bf[j], af[i], acc[i][j]);
    }
  }
}
DI void acc_zero(f16v (&acc)[2][2]) {
#pragma unroll
  for (int i = 0; i < 2; ++i)
#pragma unroll
    for (int j = 0; j < 2; ++j)
#pragma unroll
      for (int r = 0; r < 16; ++r) acc[i][j][r] = 0.f;
}
template <class Epi>
DI void gemm_epilogue(f16v (&acc)[2][2], int m0, int n0, Epi epi) {
  const int tid = otid(), lane = tid & 63, wv = tid >> 6, wm = wv >> 1, wn = wv & 1, h = lane >> 5;
#pragma unroll
  for (int i = 0; i < 2; ++i) {
    const int m = m0 + wm * 64 + i * 32 + (lane & 31);
#pragma unroll
    for (int g = 0; g < 4; ++g) {
      const int n = n0 + wn * 64 + 8 * g + 4 * h;
      f4v v0 = {acc[i][0][4 * g], acc[i][0][4 * g + 1], acc[i][0][4 * g + 2], acc[i][0][4 * g + 3]};
      f4v v1 = {acc[i][1][4 * g], acc[i][1][4 * g + 1], acc[i][1][4 * g + 2], acc[i][1][4 * g + 3]};
      epi(m, n, v0, v1);
    }
  }
}

DI void scal_unit(const Params& p, int l, int unit, float* lds) {
  const float* xs = (l == 0) ? p.x : p.out;
  const float* win = p.w_in + (size_t)l * 1024 * NIN;
  float* ps = (float*)(p.ws + OFF_PSCAL);
  float* xt = lds;
  float* wt = lds + 64 * 65;
  const int t = otid(), tok = t >> 2, jg = t & 3;
  float acc[8];
#pragma unroll
  for (int i = 0; i < 8; ++i) acc[i] = 0.f;
  const int t0 = unit * 64;
  for (int k0 = 0; k0 < 1024; k0 += 64) {
    __syncthreads();
#pragma unroll
    for (int i = 0; i < 16; ++i) { int e = t + 256 * i; int r = e >> 6, c = e & 63; xt[r * 65 + c] = xs[(size_t)(t0 + r) * DM + k0 + c]; }
#pragma unroll
    for (int i = 0; i < 8; ++i) { int e = t + 256 * i; int kk = e >> 5, c = e & 31; int col = (c < 16) ? (5120 + c) : (8464 + (c - 16)); wt[kk * 32 + c] = win[(size_t)(k0 + kk) * NIN + col]; }
    __syncthreads();
#pragma unroll 8
    for (int kk = 0; kk < 64; ++kk) {
      float xv = xt[tok * 65 + kk];
#pragma unroll
      for (int i = 0; i < 8; ++i) acc[i] += xv * wt[kk * 32 + jg * 8 + i];
    }
  }
#pragma unroll
  for (int i = 0; i < 8; ++i) ps[(size_t)(t0 + tok) * 32 + jg * 8 + i] = acc[i];
}

DI void phase_p1(const Params& p, int l, int bid, int nb, unsigned char* smem) {
  unsigned char* ws = p.ws;
  const h16* x16 = (const h16*)(ws + OFF_X16);
  const h16* wsm = (const h16*)(ws + OFF_WSM);
  h16* ps = (h16*)(ws + OFF_PS);
  const float* rc = (const float*)(ws + OFF_ROPE);
  const float* rs = rc + (size_t)SEQ * 32;
  const int total = 256 + 128 * 40;
  for (int u = bid; u < total; u += nb) {
    if (u < 256) { scal_unit(p, l, u, (float*)smem); continue; }
    const int tl = u - 256, mt = tl / 40, nt = tl % 40, m0 = mt * 128, n0 = nt * 128;
    f16v acc[2][2]; acc_zero(acc);
    gemm_main<false>(x16, DM, nullptr, m0, wsm, 1024, n0, 1024, (h16*)smem, acc);
    gemm_epilogue(acc, m0, n0, [&](int m, int n, f4v v0, f4v v1) {
      const bool rope = (n >= 1024 && n < 2560) || (n >= 4352 && n < 4992);
      if (rope) {
        const int d = n & 31;
        f4v c = *(const f4v*)&rc[(size_t)m * 32 + d], s = *(const f4v*)&rs[(size_t)m * 32 + d];
        f4v o0 = v0 * c - v1 * s, o1 = v1 * c + v0 * s;
        v0 = o0; v1 = o1;
      }
      st_h4(&ps[(size_t)m * NSM + n], v0);
      st_h4(&ps[(size_t)m * NSM + n + 32], v1);
    });
  }
}

DI void img_store_nat(h16* img, int row, int seg, u4v a, u4v b) {
  *(u4v*)&img[row * LDH + 16 * seg] = a; *(u4v*)&img[row * LDH + 16 * seg + 8] = b;
}
DI void img_store_T(h16* img, int row, int seg, u4v a, u4v b) {
  const h16* pa = (const h16*)&a; const h16* pb = (const h16*)&b;
#pragma unroll
  for (int i = 0; i < 8; ++i) { img[(16 * seg + i) * LDH + row] = pa[i]; img[(16 * seg + 8 + i) * LDH + row] = pb[i]; }
}

template <int NKB>
DI void attn_unit(const Params& p, int l, int mode, int grp, int head, int r0, int dil, int i0, int sub_len, int W, h16* lds) {
  unsigned char* ws = p.ws;
  const h16* P = (const h16*)(ws + OFF_PS);
  h16* Qi = lds; h16* Ki = lds + 64 * LDH; h16* Vt = lds + 128 * LDH; h16* Pi = lds + 192 * LDH;
  const int tid = otid(), lane = tid & 63, w = tid >> 6, r = lane & 15, q = lane >> 4;
  const int lrow = tid >> 2, seg = tid & 3;
  int qcol, kcol, vcol;
  if (mode == 0) { qcol = 1024 + grp * 256 + head * 64; kcol = 1792 + grp * 256 + head * 64; vcol = 2560 + grp * 256 + head * 64; }
  else { qcol = 4352 + head * 64; kcol = 4864 + (head >> 2) * 64; vcol = 4992 + (head >> 2) * 64; }
  __syncthreads();
  {
    const size_t pos = (size_t)r0 + (size_t)dil * (i0 + lrow);
    const h16* g = P + pos * NSM + qcol + 16 * seg;
    img_store_nat(Qi, lrow, seg, *(const u4v*)g, *(const u4v*)(g + 8));
  }
  float mrow[4], lsum[4];
  f4v O[4];
  float m_init = -1e30f, l_init = 0.f;
  if (mode == 1) { m_init = p.d_sink[l * 8 + head]; l_init = 1.f; }
#pragma unroll
  for (int i = 0; i < 4; ++i) { mrow[i] = m_init; lsum[i] = l_init; O[i] = (f4v){0.f, 0.f, 0.f, 0.f}; }
  for (int kb = 0; kb < NKB; ++kb) {
    const int j0 = i0 - W + 64 * kb;
    if (j0 < 0 || j0 >= sub_len) continue;
    __syncthreads();
    {
      const size_t pos = (size_t)r0 + (size_t)dil * (j0 + lrow);
      const h16* gk = P + pos * NSM + kcol + 16 * seg;
      const h16* gv = P + pos * NSM + vcol + 16 * seg;
      img_store_nat(Ki, lrow, seg, *(const u4v*)gk, *(const u4v*)(gk + 8));
      img_store_T(Vt, lrow, seg, *(const u4v*)gv, *(const u4v*)(gv + 8));
    }
    __syncthreads();
    f4v S[4];
#pragma unroll
    for (int i = 0; i < 4; ++i) S[i] = (f4v){0.f, 0.f, 0.f, 0.f};
    mm64(Qi, Ki, S, w, lane);
    float mx[4], al[4], rsum[4];
    bool vm[4][4];
#pragma unroll
    for (int rg = 0; rg < 4; ++rg) {
      const int row = 16 * w + 4 * q + rg;
      float m_ = -1e30f;
#pragma unroll
      for (int nt = 0; nt < 4; ++nt) {
        const int key = 16 * nt + r;
        const int delta = row - key + W - 64 * kb;
        const bool ok = (delta >= -W) && (delta <= W);
        vm[nt][rg] = ok;
        float s = S[nt][rg] * 0.125f;
        S[nt][rg] = s;
        if (ok) m_ = fmaxf(m_, s);
      }
      mx[rg] = grp16_max(m_);
    }
#pragma unroll
    for (int rg = 0; rg < 4; ++rg) {
      const float mn = fmaxf(mrow[rg], mx[rg]);
      al[rg] = __expf(mrow[rg] - mn);
      mrow[rg] = mn;
      float rs_ = 0.f;
#pragma unroll
      for (int nt = 0; nt < 4; ++nt) {
        float pv = vm[nt][rg] ? __expf(S[nt][rg] - mn) : 0.f;
        rs_ += pv;
        Pi[(16 * w + 4 * q + rg) * LDH + 16 * nt + r] = (h16)pv;
      }
      rsum[rg] = grp16_sum(rs_);
      lsum[rg] = lsum[rg] * al[rg] + rsum[rg];
    }
#pragma unroll
    for (int et = 0; et < 4; ++et)
#pragma unroll
      for (int rg = 0; rg < 4; ++rg) O[et][rg] *= al[rg];
    __syncthreads();
    mm64(Pi, Vt, O, w, lane);
  }
#pragma unroll
  for (int rg = 0; rg < 4; ++rg) {
    const int row = 16 * w + 4 * q + rg;
    const size_t pos = (size_t)r0 + (size_t)dil * (i0 + row);
    const float inv = 1.f / lsum[rg];
    if (mode == 0) {
      h16* ob = (h16*)(ws + OFF_OB) + ((size_t)grp * SEQ + pos) * 256 + head * 64;
#pragma unroll
      for (int et = 0; et < 4; ++et) ob[16 * et + r] = (h16)(O[et][rg] * inv);
      if (r == 0) {
        float* ml = (float*)(ws + OFF_MLB) + (((size_t)grp * SEQ + pos) * 4 + head) * 2;
        ml[0] = mrow[rg]; ml[1] = lsum[rg];
      }
    } else {
      h16* y = (h16*)(ws + OFF_Y) + pos * 1280 + 768 + head * 64;
#pragma unroll
      for (int et = 0; et < 4; ++et) y[16 * et + r] = (h16)(O[et][rg] * inv);
    }
  }
}

DI void bcombine_unit(const Params& p, int unit) {
  unsigned char* ws = p.ws;
  const int gi = unit * 256 + otid();
  const int seg = gi & 7, head = (gi >> 3) & 3, pos = gi >> 5;
  const float* ml = (const float*)(ws + OFF_MLB);
  const h16* ob = (const h16*)(ws + OFF_OB);
  float m[3], lv[3];
#pragma unroll
  for (int g = 0; g < 3; ++g) { const float* q = ml + (((size_t)g * SEQ + pos) * 4 + head) * 2; m[g] = q[0]; lv[g] = q[1]; }
  const float M = fmaxf(m[0], fmaxf(m[1], m[2]));
  float wg[3], den = 0.f;
#pragma unroll
  for (int g = 0; g < 3; ++g) { wg[g] = __expf(m[g] - M) * lv[g]; den += wg[g]; }
  const float inv = 1.f / den;
  float o[8];
#pragma unroll
  for (int i = 0; i < 8; ++i) o[i] = 0.f;
#pragma unroll
  for (int g = 0; g < 3; ++g) {
    h8v v = *(const h8v*)&ob[((size_t)g * SEQ + pos) * 256 + head * 64 + seg * 8];
#pragma unroll
    for (int i = 0; i < 8; ++i) o[i] += wg[g] * (float)v[i];
  }
  h8v ov;
#pragma unroll
  for (int i = 0; i < 8; ++i) ov[i] = (h16)(o[i] * inv);
  *(h8v*)((h16*)(ws + OFF_Y) + (size_t)pos * 1280 + 256 + head * 64 + seg * 8) = ov;
}

DI void mlstm_a1_unit(const Params& p, int l, int head, int oc, h16* lds) {
  unsigned char* ws = p.ws;
  const h16* P = (const h16*)(ws + OFF_PS);
  const float* pscal = (const float*)(ws + OFF_PSCAL);
  float* sca = (float*)(ws + OFF_SCA);
  float* scas = (float*)(ws + OFF_SCAS);
  h16* Ks0 = lds; h16* Ks1 = lds + 64 * LDH; h16* Vt = lds + 128 * LDH;
  float* sw = (float*)(lds + 192 * LDH);
  const int tid = otid(), lane = tid & 63, w = tid >> 6, r = lane & 15, q = lane >> 4;
  __syncthreads();
  if (w < 2) {
    const int dir = w;
    const int rr = dir ? 63 - lane : lane;
    const size_t pos = (size_t)oc * 64 + rr;
    const float* gb = p.a_gate_bias + l * 16;
    const float ig = pscal[pos * 32 + dir * 8 + head] + gb[dir * 8 + head];
    const float lf = logsigmoid_(pscal[pos * 32 + dir * 8 + 4 + head] + gb[dir * 8 + 4 + head]);
    const float b = wave_incl_sum(lf, lane);
    const float blast = __shfl(b, 63);
    const float slog = blast - b + ig;
    const float mc = wave_max(slog);
    sw[dir * 64 + rr] = __expf(slog - mc) * 0.125f;
    if (lane == 0) {
      const int nloc = dir ? 255 - oc : oc;
      float* s4 = scas + ((size_t)(dir * 4 + head) * 256 + nloc) * 4;
      s4[0] = blast; s4[1] = mc;
    }
  }
  __syncthreads();
  {
    const int lrow = tid >> 2, seg = tid & 3;
    const size_t pos = (size_t)oc * 64 + lrow;
    const h16* gk = P + pos * NSM + 256 + head * 64 + 16 * seg;
    const h16* gv = P + pos * NSM + 512 + head * 64 + 16 * seg;
    h8v k0 = *(const h8v*)gk, k1 = *(const h8v*)(gk + 8);
    u4v v0 = *(const u4v*)gv, v1 = *(const u4v*)(gv + 8);
    const float s0 = sw[lrow], s1 = sw[64 + lrow];
#pragma unroll
    for (int i = 0; i < 8; ++i) {
      Ks0[(16 * seg + i) * LDH + lrow] = (h16)((float)k0[i] * s0);
      Ks0[(16 * seg + 8 + i) * LDH + lrow] = (h16)((float)k1[i] * s0);
      Ks1[(16 * seg + i) * LDH + lrow] = (h16)((float)k0[i] * s1);
      Ks1[(16 * seg + 8 + i) * LDH + lrow] = (h16)((float)k1[i] * s1);
    }
    img_store_T(Vt, lrow, seg, v0, v1);
  }
  __syncthreads();
#pragma unroll
  for (int dir = 0; dir < 2; ++dir) {
    const h16* Ks = dir ? Ks1 : Ks0;
    const int nloc = dir ? 255 - oc : oc;
    float* dst = sca + ((size_t)(dir * 4 + head) * 256 + nloc) * 4160;
    f4v acc[4];
#pragma unroll
    for (int i = 0; i < 4; ++i) acc[i] = (f4v){0.f, 0.f, 0.f, 0.f};
    mm64(Vt, Ks, acc, w, lane);
#pragma unroll
    for (int nt = 0; nt < 4; ++nt)
#pragma unroll
      for (int rg = 0; rg < 4; ++rg) dst[(16 * w + 4 * q + rg) * 64 + 16 * nt + r] = acc[nt][rg];
    if (w == dir) {
      float s = 0.f;
#pragma unroll 8
      for (int j = 0; j < 64; ++j) s += (float)Ks[lane * LDH + j];
      dst[4096 + lane] = s;
    }
  }
}

DI void mlstm_a2_unit(const Params& p, int unit) {
  unsigned char* ws = p.ws;
  float* sca = (float*)(ws + OFF_SCA);
  float* scas = (float*)(ws + OFF_SCAS);
  const int dh = unit / 17, sl = unit % 17;
  const int e = sl * 256 + otid();
  if (e >= 4160) return;
  float* base = sca + (size_t)dh * 256 * 4160 + e;
  float* s4 = scas + (size_t)dh * 256 * 4;
  float m = 0.f, c = 0.f;
  for (int n0 = 0; n0 < 256; n0 += 8) {
    float cc[8];
#pragma unroll
    for (int i = 0; i < 8; ++i) cc[i] = base[(size_t)(n0 + i) * 4160];
#pragma unroll
    for (int i = 0; i < 8; ++i) {
      const float bl = s4[(n0 + i) * 4], mc = s4[(n0 + i) * 4 + 1];
      const float mn = fmaxf(bl + m, mc);
      const float dec = __expf(bl + m - mn), gain = __expf(mc - mn);
      base[(size_t)(n0 + i) * 4160] = c;
      if (e == 0) s4[(n0 + i) * 4 + 2] = m;
      c = dec * c + gain * cc[i];
      m = mn;
    }
  }
}

DI void mlstm_a3_unit(const Params& p, int l, int head, int oc, h16* lds) {
  unsigned char* ws = p.ws;
  const h16* P = (const h16*)(ws + OFF_PS);
  const float* pscal = (const float*)(ws + OFF_PSCAL);
  const float* sca = (const float*)(ws + OFF_SCA);
  const float* scas = (const float*)(ws + OFF_SCAS);
  h16* Qi = lds; h16* Ki = lds + 64 * LDH; h16* Vt = lds + 128 * LDH; h16* Wi = lds + 192 * LDH; h16* Ci = lds + 256 * LDH;
  float* fl = (float*)(lds + 320 * LDH);
  float* rowterm = fl;
  float* colterm = fl + 128;
  float* ainter = fl + 256;
  float* emt = fl + 384;
  float* nvec = fl + 512;
  float* qn = fl + 576;
  const int tid = otid(), lane = tid & 63, w = tid >> 6, r = lane & 15, q = lane >> 4;
  const int lrow = tid >> 2, seg = tid & 3;
  __syncthreads();
  {
    const size_t pos = (size_t)oc * 64 + lrow;
    const h16* g = P + pos * NSM + head * 64 + 16 * seg;
    img_store_nat(Qi, lrow, seg, *(const u4v*)g, *(const u4v*)(g + 8));
    img_store_nat(Ki, lrow, seg, *(const u4v*)(g + 256), *(const u4v*)(g + 264));
    img_store_T(Vt, lrow, seg, *(const u4v*)(g + 512), *(const u4v*)(g + 520));
  }
  if (w < 2) {
    const int dir = w;
    const int rr = dir ? 63 - lane : lane;
    const size_t pos = (size_t)oc * 64 + rr;
    const int nloc = dir ? 255 - oc : oc;
    const float* gb = p.a_gate_bias + l * 16;
    const float ig = pscal[pos * 32 + dir * 8 + head] + gb[dir * 8 + head];
    const float lf = logsigmoid_(pscal[pos * 32 + dir * 8 + 4 + head] + gb[dir * 8 + 4 + head]);
    const float b = wave_incl_sum(lf, lane);
    const float u = ig - b;
    const float pm = wave_incl_max(u, lane);
    const float m_intra = b + pm;
    const float mprev = scas[((size_t)(dir * 4 + head) * 256 + nloc) * 4 + 2];
    const float mt = fmaxf(b + mprev, m_intra);
    rowterm[dir * 64 + rr] = b - mt;
    colterm[dir * 64 + rr] = u;
    ainter[dir * 64 + rr] = __expf(b + mprev - mt);
    emt[dir * 64 + rr] = __expf(-mt);
  }
  f4v hacc[4];
#pragma unroll
  for (int i = 0; i < 4; ++i) hacc[i] = (f4v){0.f, 0.f, 0.f, 0.f};
#pragma unroll 1
  for (int dir = 0; dir < 2; ++dir) {
    const int nloc = dir ? 255 - oc : oc;
    const float* src = sca + ((size_t)(dir * 4 + head) * 256 + nloc) * 4160;
    __syncthreads();
    {
      const float4* s4 = (const float4*)(src + lrow * 64 + 16 * seg);
      float4 a = s4[0], b = s4[1], c = s4[2], d = s4[3];
      h8v o0, o1;
      o0[0] = (h16)a.x; o0[1] = (h16)a.y; o0[2] = (h16)a.z; o0[3] = (h16)a.w; o0[4] = (h16)b.x; o0[5] = (h16)b.y; o0[6] = (h16)b.z; o0[7] = (h16)b.w;
      o1[0] = (h16)c.x; o1[1] = (h16)c.y; o1[2] = (h16)c.z; o1[3] = (h16)c.w; o1[4] = (h16)d.x; o1[5] = (h16)d.y; o1[6] = (h16)d.z; o1[7] = (h16)d.w;
      *(h8v*)&Ci[lrow * LDH + 16 * seg] = o0; *(h8v*)&Ci[lrow * LDH + 16 * seg + 8] = o1;
      if (tid < 64) nvec[tid] = src[4096 + tid];
    }
    __syncthreads();
    f4v S[4];
#pragma unroll
    for (int i = 0; i < 4; ++i) S[i] = (f4v){0.f, 0.f, 0.f, 0.f};
    mm64(Qi, Ki, S, w, lane);
    float dint[4];
#pragma unroll
    for (int rg = 0; rg < 4; ++rg) {
      const int t = 16 * w + 4 * q + rg;
      const float rt = rowterm[dir * 64 + t];
      float sum = 0.f;
#pragma unroll
      for (int nt = 0; nt < 4; ++nt) {
        const int s = 16 * nt + r;
        const bool ok = dir ? (s >= t) : (s <= t);
        const float wv = ok ? __expf(rt + colterm[dir * 64 + s]) * S[nt][rg] * 0.125f : 0.f;
        sum += wv;
        Wi[t * LDH + s] = (h16)wv;
      }
      dint[rg] = grp16_sum(sum);
    }
    {
      float s = 0.f;
#pragma unroll
      for (int i = 0; i < 16; ++i) s += (float)Qi[lrow * LDH + 16 * seg + i] * nvec[16 * seg + i];
      s += __shfl_xor(s, 1); s += __shfl_xor(s, 2);
      if (seg == 0) qn[lrow] = s;
    }
    __syncthreads();
    f4v a1[4], a2[4];
#pragma unroll
    for (int i = 0; i < 4; ++i) { a1[i] = (f4v){0.f, 0.f, 0.f, 0.f}; a2[i] = (f4v){0.f, 0.f, 0.f, 0.f}; }
    mm64(Wi, Vt, a1, w, lane);
    mm64(Qi, Ci, a2, w, lane);
#pragma unroll
    for (int rg = 0; rg < 4; ++rg) {
      const int t = 16 * w + 4 * q + rg;
      const float ai = ainter[dir * 64 + t];
      const float den = ai * qn[t] + dint[rg];
      const float dn = 1.f / fmaxf(fabsf(den), emt[dir * 64 + t]);
#pragma unroll
      for (int et = 0; et < 4; ++et) hacc[et][rg] += (a1[et][rg] + ai * a2[et][rg]) * dn;
    }
  }
  const float* nw = p.a_norm_w + l * 256 + head * 64;
#pragma unroll
  for (int rg = 0; rg < 4; ++rg) {
    const int t = 16 * w + 4 * q + rg;
    const size_t pos = (size_t)oc * 64 + t;
    float s = hacc[0][rg] + hacc[1][rg] + hacc[2][rg] + hacc[3][rg];
    const float mu = grp16_sum(s) * (1.f / 64.f);
    float vs = 0.f;
#pragma unroll
    for (int et = 0; et < 4; ++et) { float d = hacc[et][rg] - mu; vs += d * d; }
    const float var = grp16_sum(vs) * (1.f / 64.f);
    const float rstd = rsqrtf(var + 1e-5f);
    h16* y = (h16*)(ws + OFF_Y) + pos * 1280 + head * 64;
    const h16* ao = P + pos * NSM + 768 + head * 64;
#pragma unroll
    for (int et = 0; et < 4; ++et) {
      const int e = 16 * et + r;
      y[e] = (h16)((hacc[et][rg] - mu) * rstd * nw[e] * sigmoid_((float)ao[e]));
    }
  }
}

template <int DIR>
DI void dn_solve4(const float* M, const h16* Ki, const h16* Vi, const float* betal, const float* gcl, int half, int c, int pp, float (&x)[16]) {
  const h16* src = half ? (Ki + c) : (Vi + c);
#pragma unroll
  for (int k = 0; k < 16; ++k) x[k] = 0.f;
#pragma unroll
  for (int il = 0; il < 64; ++il) {
    const int ri = DIR ? 63 - il : il;
    float part = 0.f;
#pragma unroll
    for (int k = 0; k < (il + 3) / 4; ++k) {
      const int jl0 = 4 * k;
      float mv = DIR ? M[ri * MLD + 63 - jl0 - pp] : M[ri * MLD + jl0 + pp];
      if (jl0 + 3 >= il) mv = (jl0 + pp < il) ? mv : 0.f;
      part += mv * x[k];
    }
    part += __shfl_xor(part, 1); part += __shfl_xor(part, 2);
    const float e = half ? __expf(gcl[ri]) : 1.f;
    const float xi = betal[ri] * (float)src[ri * LDH] * e - part;
    if ((il & 3) == pp) x[il >> 2] = xi;
  }
}

DI void dn_c1_unit(const Params& p, int l, int head, int oc, h16* lds) {
  unsigned char* ws = p.ws;
  const h16* P = (const h16*)(ws + OFF_PS);
  const float* pscal = (const float*)(ws + OFF_PSCAL);
  h16* cq = (h16*)(ws + OFF_CQKV);
  h16* Ki = lds; h16* Vi = lds + 64 * LDH;
  float* M = (float*)(lds + 128 * LDH);
  float* betal = M + 64 * MLD;
  float* gcl = betal + 128;
  float* glast = gcl + 128;
  const int tid = otid(), lane = tid & 63, w = tid >> 6, r = lane & 15, q = lane >> 4;
  const int lrow = tid >> 2, seg = tid & 3;
  __syncthreads();
  {
    const int pos = oc * 64 + lrow;
    const float* cw = p.c_conv_w + (size_t)l * 5 * 768;
    float vq[16], vk[16], vv[16];
#pragma unroll
    for (int i = 0; i < 16; ++i) { vq[i] = 0.f; vk[i] = 0.f; vv[i] = 0.f; }
#pragma unroll
    for (int j = 0; j < 5; ++j) {
      const int pp = pos + j - 2;
      if (pp < 0 || pp >= SEQ) continue;
      const h16* g = P + (size_t)pp * NSM + 3328 + head * 64 + 16 * seg;
      h8v q0 = *(const h8v*)g, q1 = *(const h8v*)(g + 8);
      h8v k0 = *(const h8v*)(g + 256), k1 = *(const h8v*)(g + 264);
      h8v v0 = *(const h8v*)(g + 512), v1 = *(const h8v*)(g + 520);
      const float* wq = cw + j * 768 + head * 64 + 16 * seg;
#pragma unroll
      for (int i = 0; i < 8; ++i) {
        vq[i] += wq[i] * (float)q0[i]; vq[8 + i] += wq[8 + i] * (float)q1[i];
        vk[i] += wq[256 + i] * (float)k0[i]; vk[8 + i] += wq[264 + i] * (float)k1[i];
        vv[i] += wq[512 + i] * (float)v0[i]; vv[8 + i] += wq[520 + i] * (float)v1[i];
      }
    }
    float sq = 0.f, sk = 0.f;
#pragma unroll
    for (int i = 0; i < 16; ++i) { vq[i] = silu_(vq[i]); vk[i] = silu_(vk[i]); vv[i] = silu_(vv[i]); sq += vq[i] * vq[i]; sk += vk[i] * vk[i]; }
    sq += __shfl_xor(sq, 1); sq += __shfl_xor(sq, 2);
    sk += __shfl_xor(sk, 1); sk += __shfl_xor(sk, 2);
    const float rq = rsqrtf(sq + 1e-6f) * 0.125f, rk = rsqrtf(sk + 1e-6f);
    h8v oq0, oq1, ok0, ok1, ov0, ov1;
#pragma unroll
    for (int i = 0; i < 8; ++i) {
      oq0[i] = (h16)(vq[i] * rq); oq1[i] = (h16)(vq[8 + i] * rq);
      ok0[i] = (h16)(vk[i] * rk); ok1[i] = (h16)(vk[8 + i] * rk);
      ov0[i] = (h16)vv[i]; ov1[i] = (h16)vv[8 + i];
    }
    h16* o = cq + (size_t)pos * 768 + head * 64 + 16 * seg;
    *(h8v*)o = oq0; *(h8v*)(o + 8) = oq1;
    *(h8v*)(o + 256) = ok0; *(h8v*)(o + 264) = ok1;
    *(h8v*)(o + 512) = ov0; *(h8v*)(o + 520) = ov1;
    *(h8v*)&Ki[lrow * LDH + 16 * seg] = ok0; *(h8v*)&Ki[lrow * LDH + 16 * seg + 8] = ok1;
    *(h8v*)&Vi[lrow * LDH + 16 * seg] = ov0; *(h8v*)&Vi[lrow * LDH + 16 * seg + 8] = ov1;
  }
  if (w < 2) {
    const int dir = w;
    const int rr = dir ? 63 - lane : lane;
    const size_t pos = (size_t)oc * 64 + rr;
    const float beta = sigmoid_(pscal[pos * 32 + 16 + dir * 4 + head]);
    const float g = -__expf(p.c_a_log[l * 8 + dir * 4 + head]) * softplus_(pscal[pos * 32 + 24 + dir * 4 + head] + p.c_dt_bias[l * 8 + dir * 4 + head]);
    const float gc = wave_incl_sum(g, lane);
    const float gl = __shfl(gc, 63);
    betal[dir * 64 + rr] = beta; gcl[dir * 64 + rr] = gc;
    if (lane == 0) {
      glast[dir] = gl;
      const int nloc = dir ? 255 - oc : oc;
      ((float*)(ws + OFF_CDL))[(size_t)(dir * 4 + head) * 256 + nloc] = __expf(gl);
    }
  }
  __syncthreads();
  {
    f4v kk[4];
#pragma unroll
    for (int i = 0; i < 4; ++i) kk[i] = (f4v){0.f, 0.f, 0.f, 0.f};
    mm64(Ki, Ki, kk, w, lane);
#pragma unroll
    for (int nt = 0; nt < 4; ++nt)
#pragma unroll
      for (int rg = 0; rg < 4; ++rg) {
        const int i = 16 * w + 4 * q + rg, j = 16 * nt + r;
        float v = 0.f;
        if (j < i) v = betal[i] * kk[nt][rg] * __expf(gcl[i] - gcl[j]);
        else if (j > i) v = betal[64 + i] * kk[nt][rg] * __expf(gcl[64 + i] - gcl[64 + j]);
        M[i * MLD + j] = v;
      }
  }
  __syncthreads();
  {
    const int c = tid >> 2, pp = tid & 3;
#pragma unroll 1
    for (int dh2 = 0; dh2 < 4; ++dh2) {
      const int dir = dh2 >> 1, half = dh2 & 1;
      const int nloc = dir ? 255 - oc : oc;
      const size_t unit = (size_t)(dir * 4 + head) * 256 + nloc;
      float x[16];
      if (dir == 0) dn_solve4<0>(M, Ki, Vi, betal, gcl, half, c, pp, x);
      else dn_solve4<1>(M, Ki, Vi, betal + 64, gcl + 64, half, c, pp, x);
      if (half == 0) {
        float* ud = (float*)(ws + OFF_CU) + unit * 4096;
        const int slice = c >> 4, el = c & 15;
#pragma unroll
        for (int k = 0; k < 16; ++k) {
          const int il = 4 * k + pp;
          const int rr = dir ? 63 - il : il;
          ud[((slice * 4 + (rr >> 4)) * 64 + el + 16 * ((rr & 15) >> 2)) * 4 + (rr & 3)] = x[k];
        }
      } else {
        h16* wd = (h16*)(ws + OFF_CW) + unit * 4096;
        const int s = c >> 5, lq = (c & 15) >> 2, jjx = (c & 3) + 4 * ((c & 31) >> 4);
#pragma unroll
        for (int k = 0; k < 16; ++k) {
          const int il = 4 * k + pp;
          const int rr = dir ? 63 - il : il;
          wd[(((rr >> 4) * 2 + s) * 64 + (rr & 15) + 16 * lq) * 8 + jjx] = (h16)(-x[k]);
        }
      }
    }
  }
#pragma unroll
  for (int dir = 0; dir < 2; ++dir) {
    const int nloc = dir ? 255 - oc : oc;
    const size_t unit = (size_t)(dir * 4 + head) * 256 + nloc;
    h16* kd = (h16*)(ws + OFF_CKD) + unit * 4096;
    const float gl = glast[dir];
#pragma unroll
    for (int it = 0; it < 4; ++it) {
      const int e = tid + 256 * it;
      const int d = e & 63, rq = e >> 6;
      const int r0 = 4 * rq;
      h4v o;
#pragma unroll
      for (int i = 0; i < 4; ++i) o[i] = (h16)((float)Ki[(r0 + i) * LDH + d] * __expf(gl - gcl[dir * 64 + r0 + i]));
      const int tile = d >> 4, s = r0 >> 5, ln = (d & 15) + 16 * ((r0 & 15) >> 2), j4 = 4 * ((r0 & 31) >> 4);
      *(h4v*)&kd[((tile * 2 + s) * 64 + ln) * 8 + j4] = o;
    }
  }
}

DI void dn_c2_unit(const Params& p, int dh, int w) {
  unsigned char* ws = p.ws;
  const int tid = otid(), lane = tid & 63;
  if (tid >= 64) return;
  const h16* cw = (const h16*)(ws + OFF_CW) + (size_t)dh * 256 * 4096;
  const h16* ckd = (const h16*)(ws + OFF_CKD) + (size_t)dh * 256 * 4096;
  const float* cu = (const float*)(ws + OFF_CU) + (size_t)dh * 256 * 4096;
  const float* cdl = (const float*)(ws + OFF_CDL) + (size_t)dh * 256;
  h16* cs = (h16*)(ws + OFF_CS) + (size_t)dh * 256 * 4096;
  h16* cvn = (h16*)(ws + OFF_CVN) + (size_t)dh * 256 * 4096;
  f4v S[4];
#pragma unroll
  for (int i = 0; i < 4; ++i) S[i] = (f4v){0.f, 0.f, 0.f, 0.f};
  h8v wA[4][2], kA[4][2]; f4v uu[4]; float dl;
#pragma unroll
  for (int t = 0; t < 4; ++t) {
#pragma unroll
    for (int s = 0; s < 2; ++s) {
      wA[t][s] = *(const h8v*)&cw[((t * 2 + s) * 64 + lane) * 8];
      kA[t][s] = *(const h8v*)&ckd[((t * 2 + s) * 64 + lane) * 8];
    }
    uu[t] = *(const f4v*)&cu[((w * 4 + t) * 64 + lane) * 4];
  }
  dl = cdl[0];
  for (int n = 0; n < 256; ++n) {
    h8v wN[4][2], kN[4][2]; f4v uN[4]; float dlN = 0.f;
    const int nn = (n + 1 < 256) ? n + 1 : n;
    {
      const h16* cw1 = cw + (size_t)nn * 4096; const h16* ck1 = ckd + (size_t)nn * 4096; const float* cu1 = cu + (size_t)nn * 4096;
#pragma unroll
      for (int t = 0; t < 4; ++t) {
#pragma unroll
        for (int s = 0; s < 2; ++s) {
          wN[t][s] = *(const h8v*)&cw1[((t * 2 + s) * 64 + lane) * 8];
          kN[t][s] = *(const h8v*)&ck1[((t * 2 + s) * 64 + lane) * 8];
        }
        uN[t] = *(const f4v*)&cu1[((w * 4 + t) * 64 + lane) * 4];
      }
      dlN = cdl[nn];
    }
    h8v Sb[2];
    Sb[0] = pack8(S[0], S[1]); Sb[1] = pack8(S[2], S[3]);
    h16* cs1 = cs + (size_t)n * 4096; h16* cv1 = cvn + (size_t)n * 4096;
    *(h8v*)&cs1[((w * 2 + 0) * 64 + lane) * 8] = Sb[0];
    *(h8v*)&cs1[((w * 2 + 1) * 64 + lane) * 8] = Sb[1];
    f4v vn[4];
#pragma unroll
    for (int t = 0; t < 4; ++t) { vn[t] = uu[t]; vn[t] = mfma16(wA[t][0], Sb[0], vn[t]); vn[t] = mfma16(wA[t][1], Sb[1], vn[t]); }
    h8v Vb[2];
    Vb[0] = pack8(vn[0], vn[1]); Vb[1] = pack8(vn[2], vn[3]);
    *(h8v*)&cv1[((w * 2 + 0) * 64 + lane) * 8] = Vb[0];
    *(h8v*)&cv1[((w * 2 + 1) * 64 + lane) * 8] = Vb[1];
#pragma unroll
    for (int t = 0; t < 4; ++t) { S[t] *= dl; S[t] = mfma16(kA[t][0], Vb[0], S[t]); S[t] = mfma16(kA[t][1], Vb[1], S[t]); }
#pragma unroll
    for (int t = 0; t < 4; ++t) { wA[t][0] = wN[t][0]; wA[t][1] = wN[t][1]; kA[t][0] = kN[t][0]; kA[t][1] = kN[t][1]; uu[t] = uN[t]; }
    dl = dlN;
  }
}

DI void dn_c3_unit(const Params& p, int l, int head, int oc, h16* lds) {
  unsigned char* ws = p.ws;
  const h16* P = (const h16*)(ws + OFF_PS);
  const float* pscal = (const float*)(ws + OFF_PSCAL);
  const h16* cq = (const h16*)(ws + OFF_CQKV);
  h16* Qi = lds; h16* Ki = lds + 64 * LDH;
  h16* AT = lds + 128 * LDH;
  h16* QG = lds + 256 * LDH;
  float* gcl = (float*)(lds + 384 * LDH);
  float* Ol = (float*)lds;
  const int tid = otid(), lane = tid & 63, w = tid >> 6, r = lane & 15, q = lane >> 4;
  const int lrow = tid >> 2, seg = tid & 3;
  __syncthreads();
  {
    const size_t pos = (size_t)oc * 64 + lrow;
    const h16* g = cq + pos * 768 + head * 64 + 16 * seg;
    img_store_nat(Qi, lrow, seg, *(const u4v*)g, *(const u4v*)(g + 8));
    img_store_nat(Ki, lrow, seg, *(const u4v*)(g + 256), *(const u4v*)(g + 264));
  }
  if (w < 2) {
    const int dir = w;
    const int rr = dir ? 63 - lane : lane;
    const size_t pos = (size_t)oc * 64 + rr;
    const float g = -__expf(p.c_a_log[l * 8 + dir * 4 + head]) * softplus_(pscal[pos * 32 + 24 + dir * 4 + head] + p.c_dt_bias[l * 8 + dir * 4 + head]);
    gcl[dir * 64 + rr] = wave_incl_sum(g, lane);
  }
  __syncthreads();
  {
    f4v S[4];
#pragma unroll
    for (int i = 0; i < 4; ++i) S[i] = (f4v){0.f, 0.f, 0.f, 0.f};
    mm64(Qi, Ki, S, w, lane);
#pragma unroll
    for (int dir = 0; dir < 2; ++dir) {
#pragma unroll
      for (int nt = 0; nt < 4; ++nt)
#pragma unroll
        for (int rg = 0; rg < 4; ++rg) {
          const int i = 16 * w + 4 * q + rg, j = 16 * nt + r;
          const bool ok = dir ? (j >= i) : (j <= i);
          const float v = ok ? S[nt][rg] * __expf(gcl[dir * 64 + i] - gcl[dir * 64 + j]) : 0.f;
          AT[(dir * 64 + i) * LDH + j] = (h16)v;
        }
      const float eg = __expf(gcl[dir * 64 + lrow]);
#pragma unroll
      for (int i = 0; i < 16; ++i) QG[(dir * 64 + lrow) * LDH + 16 * seg + i] = (h16)((float)Qi[lrow * LDH + 16 * seg + i] * eg);
    }
  }
  __syncthreads();
  f4v o[4];
#pragma unroll
  for (int i = 0; i < 4; ++i) o[i] = (f4v){0.f, 0.f, 0.f, 0.f};
#pragma unroll
  for (int dir = 0; dir < 2; ++dir) {
    const int nloc = dir ? 255 - oc : oc;
    const size_t unit = (size_t)(dir * 4 + head) * 256 + nloc;
    const h16* cs = (const h16*)(ws + OFF_CS) + unit * 4096;
    const h16* cv = (const h16*)(ws + OFF_CVN) + unit * 4096;
#pragma unroll
    for (int s = 0; s < 2; ++s) {
      const h8v Sb = *(const h8v*)&cs[((w * 2 + s) * 64 + lane) * 8];
      const h8v Vb = *(const h8v*)&cv[((w * 2 + s) * 64 + lane) * 8];
#pragma unroll
      for (int it = 0; it < 4; ++it) {
        o[it] = mfma16(perm_frag(QG + dir * 64 * LDH, 16 * it + r, s, q), Sb, o[it]);
        o[it] = mfma16(perm_frag(AT + dir * 64 * LDH, 16 * it + r, s, q), Vb, o[it]);
      }
    }
  }
  __syncthreads();
#pragma unroll
  for (int it = 0; it < 4; ++it)
#pragma unroll
    for (int rg = 0; rg < 4; ++rg) Ol[(16 * it + 4 * q + rg) * 65 + 16 * w + r] = o[it][rg];
  __syncthreads();
  {
    const size_t pos = (size_t)oc * 64 + lrow;
    float v[16]; float ss = 0.f;
#pragma unroll
    for (int i = 0; i < 16; ++i) { v[i] = Ol[lrow * 65 + 16 * seg + i]; ss += v[i] * v[i]; }
    ss += __shfl_xor(ss, 1); ss += __shfl_xor(ss, 2);
    const float rms = rsqrtf(ss * (1.f / 64.f) + 1e-6f);
    const float* nw = p.c_norm_w + l * 64 + 16 * seg;
    const h16* cg_ = P + pos * NSM + 4096 + head * 64 + 16 * seg;
    h8v g0 = *(const h8v*)cg_, g1 = *(const h8v*)(cg_ + 8);
    h8v o0, o1;
#pragma unroll
    for (int i = 0; i < 8; ++i) {
      o0[i] = (h16)(v[i] * rms * nw[i] * silu_((float)g0[i]));
      o1[i] = (h16)(v[8 + i] * rms * nw[8 + i] * silu_((float)g1[i]));
    }
    h16* y = (h16*)(ws + OFF_Y) + pos * 1280 + 512 + head * 64 + 16 * seg;
    *(h8v*)y = o0; *(h8v*)(y + 8) = o1;
  }
}

DI void phase_m1(const Params& p, int l, int bid, int nb, h16* lds) {
  for (int u = bid; u < 2048; u += nb) {
    if (u < 1024) dn_c1_unit(p, l, u & 3, u >> 2, lds);
    else { const int v = u - 1024; mlstm_a1_unit(p, l, v & 3, v >> 2, lds); }
  }
}
DI void phase_m2(const Params& p, int l, int bid, int nb, h16* lds) {
  const int total = 32 + 136 + 2048 + 3072;
  for (int u = bid; u < total; u += nb) {
    int v = u;
    if (v < 32) { dn_c2_unit(p, v >> 2, v & 3); continue; }
    if ((v -= 32) < 136) { mlstm_a2_unit(p, v); continue; }
    if ((v -= 136) < 2048) { attn_unit<5>(p, l, 1, 0, v & 7, 0, 1, (v >> 3) * 64, SEQ, 128, lds); continue; }
    v -= 2048;
    const int grp = v >> 10, x = v & 1023, head = x & 3, tl = x >> 2;
    const int dil = (grp == 0) ? 1 : (grp == 1) ? 4 : 16;
    const int sub = SEQ / dil, tps = sub >> 6;
    const int res = tl / tps, ti = tl % tps;
    attn_unit<3>(p, l, 0, grp, head, res, dil, ti * 64, sub, 64, lds);
  }
}
DI void phase_m3(const Params& p, int l, int bid, int nb, h16* lds) {
  const int total = 1024 + 1024 + 2048;
  for (int u = bid; u < total; u += nb) {
    int v = u;
    if (v < 1024) { mlstm_a3_unit(p, l, v & 3, v >> 2, lds); continue; }
    if ((v -= 1024) < 1024) { dn_c3_unit(p, l, v & 3, v >> 2, lds); continue; }
    bcombine_unit(p, v - 1024);
  }
}

DI void phase_gates(const Params& p, int bid, int nb, h16* lds) {
  unsigned char* ws = p.ws;
  const h16* x16 = (const h16*)(ws + OFF_X16);
  const h16* wg = (const h16*)(ws + OFF_WG);
  h16* G = (h16*)(ws + OFF_GATES);
  for (int u = bid; u < 128 * 32; u += nb) {
    const int m0 = (u >> 5) * 128, n0 = (u & 31) * 128;
    f16v acc[2][2]; acc_zero(acc);
    gemm_main<false>(x16, DM, nullptr, m0, wg, 1024, n0, 1024, lds, acc);
    gemm_epilogue(acc, m0, n0, [&](int m, int n, f4v v0, f4v v1) {
      f4v a, b;
#pragma unroll
      for (int i = 0; i < 4; ++i) { a[i] = sigmoid_(v0[i]); b[i] = sigmoid_(v1[i]); }
      st_h4(&G[(size_t)m * 4096 + n], a); st_h4(&G[(size_t)m * 4096 + n + 32], b);
    });
  }
}
DI void phase_merge(const Params& p, int bid, int nb, h16* lds) {
  unsigned char* ws = p.ws;
  const h16* Y = (const h16*)(ws + OFF_Y);
  const h16* wbr = (const h16*)(ws + OFF_WBR);
  const h16* G = (const h16*)(ws + OFF_GATES);
  h16* Mg = (h16*)(ws + OFF_MERGED);
  for (int u = bid; u < 128 * 8; u += nb) {
    const int m0 = (u >> 3) * 128, n0 = (u & 7) * 128;
    f16v macc[2][2]; acc_zero(macc);
#pragma unroll 1
    for (int b = 0; b < 4; ++b) {
      const int Kb = (b == 3) ? 512 : 256;
      f16v acc[2][2]; acc_zero(acc);
      gemm_main<false>(Y + b * 256, 1280, nullptr, m0, wbr + (size_t)b * 262144, Kb, n0, Kb, lds, acc);
      const int tid = otid(), lane = tid & 63, wv = tid >> 6, wm = wv >> 1, wn = wv & 1, h = lane >> 5;
#pragma unroll
      for (int i = 0; i < 2; ++i) {
        const int m = m0 + wm * 64 + i * 32 + (lane & 31);
#pragma unroll
        for (int g = 0; g < 4; ++g) {
          const int n = n0 + wn * 64 + 8 * g + 4 * h;
          const h4v g0 = *(const h4v*)&G[(size_t)m * 4096 + b * 1024 + n];
          const h4v g1 = *(const h4v*)&G[(size_t)m * 4096 + b * 1024 + n + 32];
#pragma unroll
          for (int e = 0; e < 4; ++e) {
            macc[i][0][4 * g + e] += (float)g0[e] * acc[i][0][4 * g + e];
            macc[i][1][4 * g + e] += (float)g1[e] * acc[i][1][4 * g + e];
          }
        }
      }
    }
    gemm_epilogue(macc, m0, n0, [&](int m, int n, f4v v0, f4v v1) {
      st_h4(&Mg[(size_t)m * DM + n], v0); st_h4(&Mg[(size_t)m * DM + n + 32], v1);
    });
  }
}
DI void phase_resid_gemm(const Params& p, const h16* A, int lda, const h16* W, int K, const float* xres, int bid, int nb, h16* lds) {
  float* out = p.out;
  for (int u = bid; u < 128 * 8; u += nb) {
    const int m0 = (u >> 3) * 128, n0 = (u & 7) * 128;
    f16v acc[2][2]; acc_zero(acc);
    gemm_main<false>(A, lda, nullptr, m0, W, K, n0, K, lds, acc);
    gemm_epilogue(acc, m0, n0, [&](int m, int n, f4v v0, f4v v1) {
      const f4v x0 = *(const f4v*)&xres[(size_t)m * DM + n], x1 = *(const f4v*)&xres[(size_t)m * DM + n + 32];
      *(f4v*)&out[(size_t)m * DM + n] = ALPHA * x0 + v0;
      *(f4v*)&out[(size_t)m * DM + n + 32] = ALPHA * x1 + v1;
    });
  }
}
DI void phase_ffn1_dense(const Params& p, int bid, int nb, h16* lds) {
  unsigned char* ws = p.ws;
  const h16* x16 = (const h16*)(ws + OFF_X16);
  const h16* w13 = (const h16*)(ws + OFF_WFF);
  h16* H = (h16*)(ws + OFF_H);
  for (int u = bid; u < 128 * 44; u += nb) {
    const int m0 = (u / 44) * 128, n0 = (u % 44) * 128;
    f16v acc[2][2]; acc_zero(acc);
    gemm_main<false>(x16, DM, nullptr, m0, w13, 1024, n0, 1024, lds, acc);
    gemm_epilogue(acc, m0, n0, [&](int m, int n, f4v v0, f4v v1) {
      f4v hq;
#pragma unroll
      for (int i = 0; i < 4; ++i) hq[i] = silu_(v0[i]) * v1[i];
      st_h4(&H[(size_t)m * 2816 + (n >> 6) * 32 + (n & 31)], hq);
    });
  }
}
DI void moe_prefix(const int* cnt, int (&pstart)[9]) {
  int s = 0;
#pragma unroll
  for (int e = 0; e < 8; ++e) { pstart[e] = s; s += (cnt[e] + 127) & ~127; }
  pstart[8] = s;
}
DI void phase_ffn1_moe(const Params& p, int bid, int nb, h16* lds) {
  unsigned char* ws = p.ws;
  const h16* x16 = (const h16*)(ws + OFF_X16);
  const h16* w13 = (const h16*)(ws + OFF_WFF);
  h16* H = (h16*)(ws + OFF_H);
  const int* st = (const int*)(ws + MOE_ST);
  int ps[9]; moe_prefix((const int*)(ws + MOE_CNT), ps);
  const int ntl = (ps[8] >> 7) * 22;
  for (int u = bid; u < ntl; u += nb) {
    const int mt = u / 22, m0 = mt * 128, n0 = (u % 22) * 128;
    int e = 0;
#pragma unroll
    for (int i = 1; i < 8; ++i) if (m0 >= ps[i]) e = i;
    f16v acc[2][2]; acc_zero(acc);
    gemm_main<true>(x16, DM, st, m0, w13 + (size_t)e * 2816 * 1024, 1024, n0, 1024, lds, acc);
    gemm_epilogue(acc, m0, n0, [&](int m, int n, f4v v0, f4v v1) {
      f4v hq;
#pragma unroll
      for (int i = 0; i < 4; ++i) hq[i] = silu_(v0[i]) * v1[i];
      st_h4(&H[(size_t)m * 1408 + (n >> 6) * 32 + (n & 31)], hq);
    });
  }
}
DI void phase_ffn2_moe(const Params& p, int bid, int nb, h16* lds) {
  unsigned char* ws = p.ws;
  const h16* H = (const h16*)(ws + OFF_H);
  const h16* w2 = (const h16*)(ws + OFF_WFF) + (size_t)8 * 2816 * 1024;
  h16* YB = (h16*)(ws + OFF_YB);
  const float* sg = (const float*)(ws + MOE_SG);
  int ps[9]; moe_prefix((const int*)(ws + MOE_CNT), ps);
  const int ntl = (ps[8] >> 7) * 8;
  for (int u = bid; u < ntl; u += nb) {
    const int mt = u >> 3, m0 = mt * 128, n0 = (u & 7) * 128;
    int e = 0;
#pragma unroll
    for (int i = 1; i < 8; ++i) if (m0 >= ps[i]) e = i;
    f16v acc[2][2]; acc_zero(acc);
    gemm_main<false>(H, 1408, nullptr, m0, w2 + (size_t)e * 1024 * 1408, 1408, n0, 1408, lds, acc);
    gemm_epilogue(acc, m0, n0, [&](int m, int n, f4v v0, f4v v1) {
      const float g = sg[m];
      st_h4(&YB[(size_t)m * DM + n], g * v0); st_h4(&YB[(size_t)m * DM + n + 32], g * v1);
    });
  }
}

DI void phase_ln(const Params& p, int l, int which, int bid, int nb) {
  unsigned char* ws = p.ws;
  const bool moe = (l & 1);
  const bool moe_in = moe && which == 2;
  const bool router = moe && which == 1;
  const float* lw = (which == 1 ? p.ln1_w : p.ln2_w) + l * DM;
  const float* lb = (which == 1 ? p.ln1_b : p.ln2_b) + l * DM;
  float* out = p.out;
  h16* x16 = (h16*)(ws + OFF_X16);
  const int tid_ = otid(); const int lane = tid_ & 63, wv = tid_ >> 6;
  for (int row = bid * 4 + wv; row < SEQ; row += nb * 4) {
    float v[16];
#pragma unroll
    for (int i = 0; i < 4; ++i) {
      const f4v t = *(const f4v*)&out[(size_t)row * DM + 256 * i + lane * 4];
      v[4 * i] = t[0]; v[4 * i + 1] = t[1]; v[4 * i + 2] = t[2]; v[4 * i + 3] = t[3];
    }
    if (moe_in) {
      const int* ts = (const int*)(ws + MOE_TS);
      const h16* YB = (const h16*)(ws + OFF_YB);
      const int s0 = ts[row * 2], s1 = ts[row * 2 + 1];
#pragma unroll
      for (int i = 0; i < 4; ++i) {
        const h4v a = *(const h4v*)&YB[(size_t)s0 * DM + 256 * i + lane * 4];
        const h4v b = *(const h4v*)&YB[(size_t)s1 * DM + 256 * i + lane * 4];
#pragma unroll
        for (int e = 0; e < 4; ++e) v[4 * i + e] = ALPHA * v[4 * i + e] + ((float)a[e] + (float)b[e]);
      }
    }
    float s = 0.f;
#pragma unroll
    for (int i = 0; i < 16; ++i) s += v[i];
    const float mu = wave_sum(s) * (1.f / 1024.f);
    float vs = 0.f;
#pragma unroll
    for (int i = 0; i < 16; ++i) { const float d = v[i] - mu; vs += d * d; }
    const float rstd = rsqrtf(wave_sum(vs) * (1.f / 1024.f) + 1e-5f);
#pragma unroll
    for (int i = 0; i < 4; ++i) {
      const int c = 256 * i + lane * 4;
      const f4v w4 = *(const f4v*)&lw[c], b4 = *(const f4v*)&lb[c];
      f4v y;
#pragma unroll
      for (int e = 0; e < 4; ++e) { y[e] = (v[4 * i + e] - mu) * rstd * w4[e] + b4[e]; v[4 * i + e] = y[e]; }
      *(f4v*)&out[(size_t)row * DM + c] = y;
      st_h4(&x16[(size_t)row * DM + c], y);
    }
    if (router) {
      const float* rw = p.moe_router + (size_t)(l >> 1) * DM * 8;
      float lg[8];
#pragma unroll
      for (int e = 0; e < 8; ++e) lg[e] = 0.f;
#pragma unroll
      for (int i = 0; i < 4; ++i)
#pragma unroll
        for (int k = 0; k < 4; ++k) {
          const int c = 256 * i + lane * 4 + k;
          const f4v r0 = *(const f4v*)&rw[(size_t)c * 8], r1 = *(const f4v*)&rw[(size_t)c * 8 + 4];
          const float xv = v[4 * i + k];
#pragma unroll
          for (int e = 0; e < 4; ++e) { lg[e] += xv * r0[e]; lg[4 + e] += xv * r1[e]; }
        }
#pragma unroll
      for (int e = 0; e < 8; ++e) lg[e] = wave_sum(lg[e]);
      if (lane == 0) {
        int i1 = 0; float b1 = lg[0];
#pragma unroll
        for (int e = 1; e < 8; ++e) if (lg[e] > b1) { b1 = lg[e]; i1 = e; }
        int i2 = -1; float b2 = -3.4e38f;
#pragma unroll
        for (int e = 0; e < 8; ++e) if (e != i1 && lg[e] > b2) { b2 = lg[e]; i2 = e; }
        const float g1 = 1.f / (1.f + __expf(b2 - b1)), g2 = 1.f - g1;
        int* cnt = (int*)(ws + MOE_CNT);
        int* te = (int*)(ws + MOE_TE); int* tp = (int*)(ws + MOE_TP); float* tg = (float*)(ws + MOE_TG);
        te[row * 2] = i1; te[row * 2 + 1] = i2;
        tp[row * 2] = atomicAdd(&cnt[i1], 1); tp[row * 2 + 1] = atomicAdd(&cnt[i2], 1);
        tg[row * 2] = g1; tg[row * 2 + 1] = g2;
      }
    }
  }
}
DI void phase_assign(const Params& p, int bid, int nb) {
  unsigned char* ws = p.ws;
  int ps[9]; moe_prefix((const int*)(ws + MOE_CNT), ps);
  const int* te = (const int*)(ws + MOE_TE); const int* tp = (const int*)(ws + MOE_TP); const float* tg = (const float*)(ws + MOE_TG);
  int* ts = (int*)(ws + MOE_TS); int* st = (int*)(ws + MOE_ST); float* sg = (float*)(ws + MOE_SG);
  for (int i = bid * 256 + otid(); i < 32768; i += nb * 256) {
    const int e = te[i];
    int base = 0;
#pragma unroll
    for (int k = 0; k < 8; ++k) if (e == k) base = ps[k];
    const int slot = base + tp[i];
    ts[i] = slot; st[slot] = i >> 1; sg[slot] = tg[i];
  }
}


#define XB_TMO      128
#define XB_XCNT(j)  (256  + 64 * (j))
#define XB_XSUB(j)  (1280 + 64 * (j))
#define XB_XGEN(j)  (2304 + 64 * (j))
#define XB_TOP      3328
#define XB_TOPGEN   3392
#define XCD_BAR_WORDS 3456
#define XB_SPIN_CAP (1u << 22)
#define LAS __attribute__((address_space(3)))
DI unsigned xb_ld(unsigned* p) { return __hip_atomic_load(p, __ATOMIC_RELAXED, __HIP_MEMORY_SCOPE_AGENT); }
DI unsigned xb_add(unsigned* p, unsigned v) { return __hip_atomic_fetch_add(p, v, __ATOMIC_RELAXED, __HIP_MEMORY_SCOPE_AGENT); }
DI unsigned xb_xcc_id() { return (unsigned)__builtin_amdgcn_s_getreg((3 << 11) | 20) & 0xFu; }
#define XB_SPIN(cond, bar) do { unsigned _sp = 0; while (cond) { __builtin_amdgcn_s_sleep(1); \
    if ((++_sp & 255u) == 0u) { if (xb_ld(&(bar)[XB_TMO])) break; if (_sp > XB_SPIN_CAP) { atomicAdd(&(bar)[XB_TMO], 1u); break; } } } } while (0)
struct XcdBarrier { unsigned* bar; unsigned x; volatile LAS unsigned* st; };
DI XcdBarrier xcd_barrier_post(unsigned* bar, volatile LAS unsigned* st) {
  XcdBarrier b; b.bar = bar; b.x = xb_xcc_id(); b.st = st;
  if (threadIdx.x == 0) (void)xb_add(&bar[XB_XCNT(b.x)], 1u);
  return b;
}
DI void xcd_barrier_complete(unsigned* bar, unsigned x, unsigned& nloc, unsigned& nx) {
  const unsigned G = gridDim.x * gridDim.y * gridDim.z;
  unsigned sum, cnt, mine, sp = 0u;
  for (;;) {
    sum = 0u; cnt = 0u; mine = 0u;
#pragma unroll
    for (unsigned j = 0; j < 16; ++j) { const unsigned c = xb_ld(&bar[XB_XCNT(j)]); sum += c; cnt += (c > 0u) ? 1u : 0u; mine = (j == x) ? c : mine; }
    if (sum == G) break;
    __builtin_amdgcn_s_sleep(1);
    if ((++sp & 255u) == 0u) { if (xb_ld(&bar[XB_TMO])) break; if (sp > XB_SPIN_CAP) { atomicAdd(&bar[XB_TMO], 1u); break; } }
  }
  nloc = mine > 0u ? mine : 1u; nx = cnt > 0u ? cnt : 1u;
}
DI void xcd_barrier(const XcdBarrier& b) {
  asm volatile("s_waitcnt vmcnt(0)" ::: "memory");
  __syncthreads();
  if (threadIdx.x == 0) {
    unsigned* bar = b.bar;
    __builtin_amdgcn_s_waitcnt(0);
    unsigned nloc = b.st[0], nx = b.st[1];
    if (nloc == 0u) { xcd_barrier_complete(bar, b.x, nloc, nx); b.st[0] = nloc; b.st[1] = nx; }
    const unsigned old = xb_add(&bar[XB_XSUB(b.x)], 1u);
    const unsigned gen = old / nloc;
    if (old + 1u == (gen + 1u) * nloc) {
      __builtin_amdgcn_fence(__ATOMIC_RELEASE, "agent");
      asm volatile("s_waitcnt vmcnt(0)" ::: "memory");
      const unsigned og = xb_add(&bar[XB_TOP], 1u);
      const unsigned tg = og / nx;
      if (og + 1u == (tg + 1u) * nx) xb_add(&bar[XB_TOPGEN], 1u);
      else XB_SPIN(xb_ld(&bar[XB_TOPGEN]) == tg, bar);
      __builtin_amdgcn_fence(__ATOMIC_ACQUIRE, "agent");
      xb_add(&bar[XB_XGEN(b.x)], 1u);
      asm volatile("s_waitcnt vmcnt(0)" ::: "memory");
    } else {
      XB_SPIN(xb_ld(&bar[XB_XGEN(b.x)]) == gen, bar);
      __builtin_amdgcn_fence(__ATOMIC_ACQUIRE, "agent");
      asm volatile("s_waitcnt vmcnt(0)" ::: "memory");
    }
  }
  __syncthreads();
}

__global__ void __launch_bounds__(256, 2) fwd_megakernel(Params p) {
  cg::grid_group grid = cg::this_grid();
  __shared__ __attribute__((aligned(16))) unsigned char smem[58368];
  h16* lds = (h16*)smem;
  const int bid = blockIdx.x, nb = gridDim.x;
  unsigned char* ws = p.ws;
  __shared__ u4v xb_words;
  if (threadIdx.x == 0) xb_words = (u4v){0u, 0u, 0u, 0u};
  __syncthreads();
  XcdBarrier xb = xcd_barrier_post((unsigned*)(ws + OFF_BAR), (volatile LAS unsigned*)&xb_words);

  phase_init(p, bid, nb);
  phase_convert(p, 0, bid, nb, lds);
  grid.sync();
  for (int l = 0; l < 4; ++l) {
    phase_p1(p, l, bid, nb, smem);
    xcd_barrier(xb);
    phase_m1(p, l, bid, nb, lds);
    xcd_barrier(xb);
    phase_m2(p, l, bid, nb, lds);
    xcd_barrier(xb);
    phase_m3(p, l, bid, nb, lds);
    xcd_barrier(xb);
    phase_gates(p, bid, nb, lds);
    xcd_barrier(xb);
    phase_merge(p, bid, nb, lds);
    xcd_barrier(xb);
    phase_resid_gemm(p, (const h16*)(ws + OFF_MERGED), DM, (const h16*)(ws + OFF_WOUT), 1024, (l == 0) ? p.x : p.out, bid, nb, lds);
    xcd_barrier(xb);
    phase_ln(p, l, 1, bid, nb);
    xcd_barrier(xb);
    if (l & 1) {
      phase_assign(p, bid, nb);
      xcd_barrier(xb);
      phase_ffn1_moe(p, bid, nb, lds);
      xcd_barrier(xb);
      phase_ffn2_moe(p, bid, nb, lds);
      xcd_barrier(xb);
    } else {
      phase_ffn1_dense(p, bid, nb, lds);
      xcd_barrier(xb);
      phase_resid_gemm(p, (const h16*)(ws + OFF_H), 2816, (const h16*)(ws + OFF_WFF) + (size_t)5632 * 1024, 2816, p.out, bid, nb, lds);
      xcd_barrier(xb);
    }
    phase_ln(p, l, 2, bid, nb);
    if (l + 1 < 4) { phase_convert(p, l + 1, bid, nb, lds); xcd_barrier(xb); }
  }
}

extern "C" void kernel_launch(void* const* d_in, const int* in_sizes, int n_in, void* d_out, int out_size, void* d_ws, size_t ws_size, hipStream_t stream) {
  static int grid_blocks = 0;
  if (!grid_blocks) {
    int dev = 0, cus = 0, per_cu = 0;
    hipGetDevice(&dev);
    hipDeviceGetAttribute(&cus, hipDeviceAttributeMultiprocessorCount, dev);
    hipOccupancyMaxActiveBlocksPerMultiprocessor(&per_cu, fwd_megakernel, 256, 0);
    if (per_cu > 2) per_cu = 2;
    if (per_cu < 1) per_cu = 1;
    grid_blocks = cus * per_cu;
    if (ws_size < WS_END) fprintf(stderr, "workspace too small: %zu < %zu\n", ws_size, (size_t)WS_END);
  }
  Params p{};
  const float* const* in = (const float* const*)d_in;
  p.x = in[0]; p.w_in = in[1]; p.a_gate_bias = in[2]; p.a_norm_w = in[3]; p.c_conv_w = in[4]; p.c_a_log = in[5]; p.c_dt_bias = in[6];
  p.c_norm_w = in[7]; p.d_sink = in[8]; p.w_br_a = in[9]; p.w_br_b = in[10]; p.w_br_c = in[11]; p.w_br_d = in[12]; p.w_out = in[13];
  p.ln1_w = in[14]; p.ln1_b = in[15]; p.ln2_w = in[16]; p.ln2_b = in[17]; p.ffn_w1 = in[18]; p.ffn_w3 = in[19]; p.ffn_w2 = in[20];
  p.moe_router = in[21]; p.moe_w1 = in[22]; p.moe_w3 = in[23]; p.moe_w2 = in[24];
  p.out = (float*)d_out; p.ws = (unsigned char*)d_ws;
  void* args[] = {&p};
  hipMemsetAsync((unsigned char*)d_ws + OFF_BAR, 0, XCD_BAR_WORDS * 4, stream);
  hipError_t e = hipLaunchCooperativeKernel((void*)fwd_megakernel, dim3(grid_blocks), dim3(256), args, 0, stream);
  if (e != hipSuccess) fprintf(stderr, "cooperative launch failed: %s (grid %d)\n", hipGetErrorString(e), grid_blocks);
}
```

```cpp
#include <hip/hip_runtime.h>
#include <hip/hip_cooperative_groups.h>
#include <cstdio>
namespace cg = cooperative_groups;

typedef _Float16 h16;
typedef h16 h8v __attribute__((ext_vector_type(8)));
typedef h16 h4v __attribute__((ext_vector_type(4)));
typedef float f4v __attribute__((ext_vector_type(4)));
typedef float f16v __attribute__((ext_vector_type(16)));
typedef unsigned int u4v __attribute__((ext_vector_type(4)));
#define DI __device__ __forceinline__

constexpr int SEQ = 16384, DM = 1024, NIN = 9248, NSM = 5120;
constexpr int LDH = 72;
constexpr float ALPHA = 1.6817928305074290f;
constexpr int NSLOT = 33792;
constexpr int MLD = 68;

constexpr size_t OFF_X16 = 0;
constexpr size_t OFF_WSM = OFF_X16 + (size_t)SEQ * DM * 2;
constexpr size_t OFF_WG = OFF_WSM + (size_t)NSM * 1024 * 2;
constexpr size_t OFF_WBR = OFF_WG + (size_t)4096 * 1024 * 2;
constexpr size_t OFF_WOUT = OFF_WBR + (size_t)1280 * 1024 * 2;
constexpr size_t OFF_WFF = OFF_WOUT + (size_t)1024 * 1024 * 2;
constexpr size_t OFF_PS = OFF_WFF + (size_t)69206016;
constexpr size_t OFF_PSCAL = OFF_PS + (size_t)SEQ * NSM * 2;
constexpr size_t OFF_Y = OFF_PSCAL + (size_t)SEQ * 32 * 4;
constexpr size_t OFF_MERGED = OFF_Y + (size_t)SEQ * 1280 * 2;
constexpr size_t OFF_ROPE = OFF_MERGED + (size_t)SEQ * DM * 2;
constexpr size_t OFF_SCA = OFF_ROPE + (size_t)SEQ * 32 * 4 * 2;
constexpr size_t OFF_SCAS = OFF_SCA + (size_t)2048 * 4160 * 4;
constexpr size_t OFF_CQKV = OFF_SCAS + (size_t)2048 * 4 * 4;
constexpr size_t OFF_CU = OFF_CQKV + (size_t)SEQ * 768 * 2;
constexpr size_t OFF_CW = OFF_CU + (size_t)2048 * 4096 * 4;
constexpr size_t OFF_CKD = OFF_CW + (size_t)2048 * 4096 * 2;
constexpr size_t OFF_CDL = OFF_CKD + (size_t)2048 * 4096 * 2;
constexpr size_t OFF_CS = OFF_CDL + (size_t)2048 * 4;
constexpr size_t OFF_CVN = OFF_CS + (size_t)2048 * 4096 * 2;
constexpr size_t OFF_OB = OFF_CVN + (size_t)2048 * 4096 * 2;
constexpr size_t OFF_MLB = OFF_OB + (size_t)3 * SEQ * 256 * 2;
constexpr size_t OFF_MOE = OFF_MLB + (size_t)3 * SEQ * 4 * 2 * 4;
constexpr size_t MOE_CNT = OFF_MOE;
constexpr size_t MOE_TE = MOE_CNT + 256;
constexpr size_t MOE_TP = MOE_TE + 32768 * 4;
constexpr size_t MOE_TG = MOE_TP + 32768 * 4;
constexpr size_t MOE_TS = MOE_TG + 32768 * 4;
constexpr size_t MOE_ST = MOE_TS + 32768 * 4;
constexpr size_t MOE_SG = MOE_ST + (size_t)NSLOT * 4;
constexpr size_t OFF_BAR = (MOE_SG + (size_t)NSLOT * 4 + 255) & ~(size_t)255;
constexpr size_t WS_END = OFF_BAR + 16384;
constexpr size_t OFF_GATES = OFF_PS;
constexpr size_t OFF_H = OFF_PS;
constexpr size_t OFF_YB = OFF_PS + (size_t)NSLOT * 1408 * 2;

struct Params {
  const float* x; const float* w_in; const float* a_gate_bias; const float* a_norm_w; const float* c_conv_w;
  const float* c_a_log; const float* c_dt_bias; const float* c_norm_w; const float* d_sink;
  const float* w_br_a; const float* w_br_b; const float* w_br_c; const float* w_br_d; const float* w_out;
  const float* ln1_w; const float* ln1_b; const float* ln2_w; const float* ln2_b;
  const float* ffn_w1; const float* ffn_w3; const float* ffn_w2;
  const float* moe_router; const float* moe_w1; const float* moe_w3; const float* moe_w2;
  float* out; unsigned char* ws;
};

DI int otid() { int t = threadIdx.x; asm volatile("" : "+v"(t)); return t; }
DI float sigmoid_(float x) { return 1.f / (1.f + __expf(-x)); }
DI float silu_(float x) { return x / (1.f + __expf(-x)); }
DI float softplus_(float x) { return x > 20.f ? x : log1pf(__expf(x)); }
DI float logsigmoid_(float x) { return fminf(x, 0.f) - log1pf(__expf(-fabsf(x))); }
DI f4v mfma16(h8v a, h8v b, f4v c) { return __builtin_amdgcn_mfma_f32_16x16x32_f16(a, b, c, 0, 0, 0); }
DI f16v mfma32(h8v a, h8v b, f16v c) { return __builtin_amdgcn_mfma_f32_32x32x16_f16(a, b, c, 0, 0, 0); }
DI float wave_incl_sum(float v, int lane) {
#pragma unroll
  for (int o = 1; o < 64; o <<= 1) { float t = __shfl_up(v, o); if (lane >= o) v += t; }
  return v;
}
DI float wave_incl_max(float v, int lane) {
#pragma unroll
  for (int o = 1; o < 64; o <<= 1) { float t = __shfl_up(v, o); if (lane >= o) v = fmaxf(v, t); }
  return v;
}
DI float wave_max(float v) {
#pragma unroll
  for (int o = 32; o >= 1; o >>= 1) v = fmaxf(v, __shfl_xor(v, o));
  return v;
}
DI float wave_sum(float v) {
#pragma unroll
  for (int o = 32; o >= 1; o >>= 1) v += __shfl_xor(v, o);
  return v;
}
DI float grp16_sum(float v) { v += __shfl_xor(v, 1); v += __shfl_xor(v, 2); v += __shfl_xor(v, 4); v += __shfl_xor(v, 8); return v; }
DI float grp16_max(float v) { v = fmaxf(v, __shfl_xor(v, 1)); v = fmaxf(v, __shfl_xor(v, 2)); v = fmaxf(v, __shfl_xor(v, 4)); v = fmaxf(v, __shfl_xor(v, 8)); return v; }

DI void mm64(const h16* A, const h16* B, f4v (&acc)[4], int w, int lane) {
  const int r = lane & 15, q = lane >> 4;
#pragma unroll
  for (int s = 0; s < 2; ++s) {
    h8v a = *(const h8v*)&A[(16 * w + r) * LDH + 32 * s + 8 * q];
#pragma unroll
    for (int nt = 0; nt < 4; ++nt) {
      h8v b = *(const h8v*)&B[(16 * nt + r) * LDH + 32 * s + 8 * q];
      acc[nt] = mfma16(a, b, acc[nt]);
    }
  }
}
DI h8v perm_frag(const h16* img, int row, int s, int q) {
  h4v lo = *(const h4v*)&img[row * LDH + 32 * s + 4 * q];
  h4v hi = *(const h4v*)&img[row * LDH + 32 * s + 16 + 4 * q];
  return __builtin_shufflevector(lo, hi, 0, 1, 2, 3, 4, 5, 6, 7);
}
DI h8v pack8(f4v a, f4v b) {
  h8v r;
  r[0] = (h16)a[0]; r[1] = (h16)a[1]; r[2] = (h16)a[2]; r[3] = (h16)a[3];
  r[4] = (h16)b[0]; r[5] = (h16)b[1]; r[6] = (h16)b[2]; r[7] = (h16)b[3];
  return r;
}
DI void st_h4(h16* p, f4v v) { h4v o; o[0] = (h16)v[0]; o[1] = (h16)v[1]; o[2] = (h16)v[2]; o[3] = (h16)v[3]; *(h4v*)p = o; }

DI void conv_unit(const float* __restrict__ src, int ld, int col0, int k0, h16* __restrict__ dst, int K, int n0, h16* lds) {
  const int t = otid();
  __syncthreads();
  {
    const int c = t & 31, kq = t >> 5;
#pragma unroll
    for (int i = 0; i < 8; ++i) {
      int kk = kq + 8 * i;
      lds[c * LDH + kk] = (h16)src[(size_t)(k0 + kk) * ld + col0 + c];
    }
  }
  __syncthreads();
  {
    const int c = t >> 3, ks = (t & 7) * 8;
    *(u4v*)&dst[(size_t)(n0 + c) * K + k0 + ks] = *(const u4v*)&lds[c * LDH + ks];
  }
}

DI int map_small(int n) {
  if (n < 1024) return 4096 + n;
  if (n < 3328) return 5136 + (n - 1024);
  if (n < 4352) return 7440 + (n - 3328);
  return 8480 + (n - 4352);
}

DI void phase_convert(const Params& p, int l, int bid, int nb, h16* lds) {
  unsigned char* ws = p.ws;
  const float* win = p.w_in + (size_t)l * 1024 * NIN;
  const int jj = l >> 1;
  const bool moe = (l & 1);
  const int nffn = moe ? 8 * 2112 : (2816 + 1408);
  const int total = 2560 + 2048 + 640 + 512 + nffn;
  for (int u = bid; u < total; u += nb) {
    int v = u;
    const float* src; int ld, col0, k0, K, n0; h16* dst;
    if (v < 2560) { n0 = (v >> 4) * 32; k0 = (v & 15) * 64; col0 = map_small(n0); src = win; ld = NIN; K = 1024; dst = (h16*)(ws + OFF_WSM); }
    else if ((v -= 2560) < 2048) { n0 = (v >> 4) * 32; k0 = (v & 15) * 64; col0 = n0; src = win; ld = NIN; K = 1024; dst = (h16*)(ws + OFF_WG); }
    else if ((v -= 2048) < 640) {
      int b, kt;
      if (v < 384) { b = v >> 7; v &= 127; kt = 4; } else { b = 3; v -= 384; kt = 8; }
      n0 = (v / kt) * 32; k0 = (v % kt) * 64; K = kt * 64;
      const float* base = (b == 0) ? p.w_br_a : (b == 1) ? p.w_br_b : (b == 2) ? p.w_br_c : p.w_br_d;
      src = base + (size_t)l * K * 1024; ld = 1024; col0 = n0; dst = (h16*)(ws + OFF_WBR) + (size_t)b * 262144;
    }
    else if ((v -= 640) < 512) { n0 = (v >> 4) * 32; k0 = (v & 15) * 64; col0 = n0; src = p.w_out + (size_t)l * 1024 * 1024; ld = 1024; K = 1024; dst = (h16*)(ws + OFF_WOUT); }
    else {
      v -= 512;
      if (!moe) {
        if (v < 2816) {
          int nbk = v >> 4; k0 = (v & 15) * 64; n0 = nbk * 32; col0 = (nbk >> 1) * 32;
          src = ((nbk & 1) ? p.ffn_w3 : p.ffn_w1) + (size_t)jj * 1024 * 2816; ld = 2816; K = 1024; dst = (h16*)(ws + OFF_WFF);
        } else {
          v -= 2816; n0 = (v / 44) * 32; k0 = (v % 44) * 64; col0 = n0; K = 2816;
          src = p.ffn_w2 + (size_t)jj * 2816 * 1024; ld = 1024; dst = (h16*)(ws + OFF_WFF) + (size_t)5632 * 1024;
        }
      } else {
        int e = v / 2112; v -= e * 2112;
        if (v < 1408) {
          int nbk = v >> 4; k0 = (v & 15) * 64; n0 = nbk * 32; col0 = (nbk >> 1) * 32;
          src = ((nbk & 1) ? p.moe_w3 : p.moe_w1) + (size_t)(jj * 8 + e) * 1024 * 1408; ld = 1408; K = 1024;
          dst = (h16*)(ws + OFF_WFF) + (size_t)e * 2816 * 1024;
        } else {
          v -= 1408; n0 = (v / 22) * 32; k0 = (v % 22) * 64; col0 = n0; K = 1408;
          src = p.moe_w2 + (size_t)(jj * 8 + e) * 1408 * 1024; ld = 1024;
          dst = (h16*)(ws + OFF_WFF) + (size_t)8 * 2816 * 1024 + (size_t)e * 1024 * 1408;
        }
      }
    }
    conv_unit(src, ld, col0, k0, dst, K, n0, lds);
  }
  if (moe) {
    int* cnt = (int*)(ws + MOE_CNT);
    int* st = (int*)(ws + MOE_ST);
    const int gt = bid * 256 + otid(), gs = nb * 256;
    if (gt < 64) cnt[gt] = 0;
    for (int i = gt; i < NSLOT; i += gs) st[i] = 0;
  }
}

DI void phase_init(const Params& p, int bid, int nb) {
  float* rc = (float*)(p.ws + OFF_ROPE);
  float* rs = rc + (size_t)SEQ * 32;
  const int gt = bid * 256 + otid(), gs = nb * 256;
  for (int i = gt; i < SEQ * 32; i += gs) {
    int pos = i >> 5, d = i & 31;
    float inv = (float)pow(10000.0, -(double)d / 32.0);
    float ang = (float)pos * inv;
    rc[i] = cosf(ang); rs[i] = sinf(ang);
  }
  h16* x16 = (h16*)(p.ws + OFF_X16);
  for (int i = gt; i < SEQ * DM / 4; i += gs) {
    float4 v = ((const float4*)p.x)[i];
    h4v o; o[0] = (h16)v.x; o[1] = (h16)v.y; o[2] = (h16)v.z; o[3] = (h16)v.w;
    *(h4v*)&x16[(size_t)i * 4] = o;
  }
}

template <bool GATHER>
DI void gemm_main(const h16* __restrict__ A, int lda, const int* __restrict__ idx, int m0,
                  const h16* __restrict__ B, int ldb, int n0, int K, h16* lds, f16v (&acc)[2][2]) {
  const int tid = otid(), lane = tid & 63, wv = tid >> 6, wm = wv >> 1, wn = wv & 1;
  h16* As = lds; h16* Bs = lds + 128 * LDH;
  const int lr = tid >> 1, lc = (tid & 1) * 32;
  const h16* ap = A + (size_t)(GATHER ? idx[m0 + lr] : (m0 + lr)) * lda + lc;
  const h16* bp = B + (size_t)(n0 + lr) * ldb + lc;
  u4v ra[2][4], rb[2][4];
  const int nk = K >> 6;
#pragma unroll
  for (int i = 0; i < 4; ++i) { ra[0][i] = *(const u4v*)(ap + 8 * i); rb[0][i] = *(const u4v*)(bp + 8 * i); }
#pragma unroll
  for (int i = 0; i < 4; ++i) { ra[1][i] = *(const u4v*)(ap + 64 + 8 * i); rb[1][i] = *(const u4v*)(bp + 64 + 8 * i); }
  ap += 128; bp += 128;
  for (int kt = 0; kt < nk; kt += 2) {
#pragma unroll
    for (int st = 0; st < 2; ++st) {
      __syncthreads();
#pragma unroll
      for (int i = 0; i < 4; ++i) { *(u4v*)&As[lr * LDH + lc + 8 * i] = ra[st][i]; *(u4v*)&Bs[lr * LDH + lc + 8 * i] = rb[st][i]; }
      __syncthreads();
      if (kt + st + 2 < nk) {
#pragma unroll
        for (int i = 0; i < 4; ++i) { ra[st][i] = *(const u4v*)(ap + 8 * i); rb[st][i] = *(const u4v*)(bp + 8 * i); }
        ap += 64; bp += 64;
      }
#pragma unroll
      for (int ks = 0; ks < 4; ++ks) {
        h8v af[2], bf[2];
#pragma unroll
        for (int i = 0; i < 2; ++i) af[i] = *(const h8v*)&As[(wm * 64 + i * 32 + (lane & 31)) * LDH + ks * 16 + 8 * (lane >> 5)];
#pragma unroll
        for (int j = 0; j < 2; ++j) bf[j] = *(const h8v*)&Bs[(wn * 64 + j * 32 + (lane & 31)) * LDH + ks * 16 + 8 * (lane >> 5)];
#pragma unroll
        for (int i = 0; i < 2; ++i)
#pragma unroll
          for (int j = 0; j < 2; ++j) acc[i][j] = mfma32(bf[j], af[i], acc[i][j]);
      }
    }
  }
}
template <bool GATHER>
DI void gemm_main1(const h16* __restrict__ A, int lda, const int* __restrict__ idx, int m0,
                  const h16* __restrict__ B, int ldb, int n0, int K, h16* lds, f16v (&acc)[2][2]) {
  const int tid = otid(), lane = tid & 63, wv = tid >> 6, wm = wv >> 1, wn = wv & 1;
  h16* As = lds; h16* Bs = lds + 128 * LDH;
  const int lr = tid >> 1, lc = (tid & 1) * 32;
  const h16* ap = A + (size_t)(GATHER ? idx[m0 + lr] : (m0 + lr)) * lda + lc;
  const h16* bp = B + (size_t)(n0 + lr) * ldb + lc;
  u4v ra[4], rb[4];
#pragma unroll
  for (int i = 0; i < 4; ++i) { ra[i] = *(const u4v*)(ap + 8 * i); rb[i] = *(const u4v*)(bp + 8 * i); }
  const int nk = K >> 6;
  for (int kt = 0; kt < nk; ++kt) {
    __syncthreads();
#pragma unroll
    for (int i = 0; i < 4; ++i) { *(u4v*)&As[lr * LDH + lc + 8 * i] = ra[i]; *(u4v*)&Bs[lr * LDH + lc + 8 * i] = rb[i]; }
    __syncthreads();
    if (kt + 1 < nk) {
      ap += 64; bp += 64;
#pragma unroll
      for (int i = 0; i < 4; ++i) { ra[i] = *(const u4v*)(ap + 8 * i); rb[i] = *(const u4v*)(bp + 8 * i); }
    }
#pragma unroll
    for (int ks = 0; ks < 4; ++ks) {
      h8v af[2], bf[2];
#pragma unroll
      for (int i = 0; i < 2; ++i) af[i] = *(const h8v*)&As[(wm * 64 + i * 32 + (lane & 31)) * LDH + ks * 16 + 8 * (lane >> 5)];
#pragma unroll
      for (int j = 0; j < 2; ++j) bf[j] = *(const h8v*)&Bs[(wn * 64 + j * 32 + (lane & 31)) * LDH + ks * 16 + 8 * (lane >> 5)];
#pragma unroll
      for (int i = 0; i < 2; ++i)
#pragma unroll
        for (int j = 0; j < 2; ++j) acc[i][j] = mfma32(bf[j], af[i], acc[i][j]);
    }
  }
}
DI void acc_zero(f16v (&acc)[2][2]) {
#pragma unroll
  for (int i = 0; i < 2; ++i)
#pragma unroll
    for (int j = 0; j < 2; ++j)
#pragma unroll
      for (int r = 0; r < 16; ++r) acc[i][j][r] = 0.f;
}
template <class Epi>
DI void gemm_epilogue(f16v (&acc)[2][2], int m0, int n0, Epi epi) {
  const int tid = otid(), lane = tid & 63, wv = tid >> 6, wm = wv >> 1, wn = wv & 1, h = lane >> 5;
#pragma unroll
  for (int i = 0; i < 2; ++i) {
    const int m = m0 + wm * 64 + i * 32 + (lane & 31);
#pragma unroll
    for (int g = 0; g < 4; ++g) {
      const int n = n0 + wn * 64 + 8 * g + 4 * h;
      f4v v0 = {acc[i][0][4 * g], acc[i][0][4 * g + 1], acc[i][0][4 * g + 2], acc[i][0][4 * g + 3]};
      f4v v1 = {acc[i][1][4 * g], acc[i][1][4 * g + 1], acc[i][1][4 * g + 2], acc[i][1][4 * g + 3]};
      epi(m, n, v0, v1);
    }
  }
}

DI void scal_unit(const Params& p, int l, int unit, float* lds) {
  const float* xs = (l == 0) ? p.x : p.out;
  const float* win = p.w_in + (size_t)l * 1024 * NIN;
  float* ps = (float*)(p.ws + OFF_PSCAL);
  float* xt = lds;
  float* wt = lds + 64 * 68;
  const int t = otid(), lane = t & 63, w = t >> 6, r = lane & 15, q = lane >> 4;
  f4v acc[2];
  acc[0] = (f4v){0.f, 0.f, 0.f, 0.f}; acc[1] = (f4v){0.f, 0.f, 0.f, 0.f};
  const int t0 = unit * 64;
  for (int k0 = 0; k0 < 1024; k0 += 64) {
    __syncthreads();
#pragma unroll
    for (int i = 0; i < 4; ++i) { int e = t + 256 * i; int rr = e >> 4, c4 = (e & 15) * 4; *(f4v*)&xt[rr * 68 + c4] = *(const f4v*)&xs[(size_t)(t0 + rr) * DM + k0 + c4]; }
#pragma unroll
    for (int i = 0; i < 8; ++i) { int e = t + 256 * i; int kk = e >> 5, c = e & 31; int col = (c < 16) ? (5120 + c) : (8464 + (c - 16)); wt[kk * 32 + c] = win[(size_t)(k0 + kk) * NIN + col]; }
    __syncthreads();
#pragma unroll
    for (int ks = 0; ks < 16; ++ks) {
      const float a = xt[(16 * w + r) * 68 + ks * 4 + q];
      const float b0 = wt[(ks * 4 + q) * 32 + r], b1 = wt[(ks * 4 + q) * 32 + 16 + r];
      acc[0] = __builtin_amdgcn_mfma_f32_16x16x4f32(a, b0, acc[0], 0, 0, 0);
      acc[1] = __builtin_amdgcn_mfma_f32_16x16x4f32(a, b1, acc[1], 0, 0, 0);
    }
  }
#pragma unroll
  for (int nt = 0; nt < 2; ++nt)
#pragma unroll
    for (int rg = 0; rg < 4; ++rg) ps[(size_t)(t0 + 16 * w + 4 * q + rg) * 32 + 16 * nt + r] = acc[nt][rg];
}

DI void phase_p1(const Params& p, int l, int bid, int nb, unsigned char* smem) {
  unsigned char* ws = p.ws;
  const h16* x16 = (const h16*)(ws + OFF_X16);
  const h16* wsm = (const h16*)(ws + OFF_WSM);
  h16* ps = (h16*)(ws + OFF_PS);
  const float* rc = (const float*)(ws + OFF_ROPE);
  const float* rs = rc + (size_t)SEQ * 32;
  const int total = 256 + 128 * 40;
  for (int u = bid; u < total; u += nb) {
    if (u < 256) { scal_unit(p, l, u, (float*)smem); continue; }
    const int tl = u - 256, mt = tl / 40, nt = tl % 40, m0 = mt * 128, n0 = nt * 128;
    f16v acc[2][2]; acc_zero(acc);
    gemm_main<false>(x16, DM, nullptr, m0, wsm, 1024, n0, 1024, (h16*)smem, acc);
    gemm_epilogue(acc, m0, n0, [&](int m, int n, f4v v0, f4v v1) {
      const bool rope = (n >= 1024 && n < 2560) || (n >= 4352 && n < 4992);
      if (rope) {
        const int d = n & 31;
        f4v c = *(const f4v*)&rc[(size_t)m * 32 + d], s = *(const f4v*)&rs[(size_t)m * 32 + d];
        f4v o0 = v0 * c - v1 * s, o1 = v1 * c + v0 * s;
        v0 = o0; v1 = o1;
      }
      st_h4(&ps[(size_t)m * NSM + n], v0);
      st_h4(&ps[(size_t)m * NSM + n + 32], v1);
    });
  }
}

DI void img_store_nat(h16* img, int row, int seg, u4v a, u4v b) {
  *(u4v*)&img[row * LDH + 16 * seg] = a; *(u4v*)&img[row * LDH + 16 * seg + 8] = b;
}
DI void img_store_T(h16* img, int row, int seg, u4v a, u4v b) {
  const h16* pa = (const h16*)&a; const h16* pb = (const h16*)&b;
#pragma unroll
  for (int i = 0; i < 8; ++i) { img[(16 * seg + i) * LDH + row] = pa[i]; img[(16 * seg + 8 + i) * LDH + row] = pb[i]; }
}

template <int NKB>
DI void attn_unit(const Params& p, int l, int mode, int grp, int head, int r0, int dil, int i0, int sub_len, int W, h16* lds) {
  unsigned char* ws = p.ws;
  const h16* P = (const h16*)(ws + OFF_PS);
  h16* Qi = lds; h16* Ki = lds + 64 * LDH; h16* Vt = lds + 128 * LDH; h16* Pi = lds + 192 * LDH;
  const int tid = otid(), lane = tid & 63, w = tid >> 6, r = lane & 15, q = lane >> 4;
  const int lrow = tid >> 2, seg = tid & 3;
  int qcol, kcol, vcol;
  if (mode == 0) { qcol = 1024 + grp * 256 + head * 64; kcol = 1792 + grp * 256 + head * 64; vcol = 2560 + grp * 256 + head * 64; }
  else { qcol = 4352 + head * 64; kcol = 4864 + (head >> 2) * 64; vcol = 4992 + (head >> 2) * 64; }
  __syncthreads();
  {
    const size_t pos = (size_t)r0 + (size_t)dil * (i0 + lrow);
    const h16* g = P + pos * NSM + qcol + 16 * seg;
    img_store_nat(Qi, lrow, seg, *(const u4v*)g, *(const u4v*)(g + 8));
  }
  float mrow[4], lsum[4];
  f4v O[4];
  float m_init = -1e30f, l_init = 0.f;
  if (mode == 1) { m_init = p.d_sink[l * 8 + head]; l_init = 1.f; }
#pragma unroll
  for (int i = 0; i < 4; ++i) { mrow[i] = m_init; lsum[i] = l_init; O[i] = (f4v){0.f, 0.f, 0.f, 0.f}; }
  for (int kb = 0; kb < NKB; ++kb) {
    const int j0 = i0 - W + 64 * kb;
    if (j0 < 0 || j0 >= sub_len) continue;
    __syncthreads();
    {
      const size_t pos = (size_t)r0 + (size_t)dil * (j0 + lrow);
      const h16* gk = P + pos * NSM + kcol + 16 * seg;
      const h16* gv = P + pos * NSM + vcol + 16 * seg;
      img_store_nat(Ki, lrow, seg, *(const u4v*)gk, *(const u4v*)(gk + 8));
      img_store_T(Vt, lrow, seg, *(const u4v*)gv, *(const u4v*)(gv + 8));
    }
    __syncthreads();
    f4v S[4];
#pragma unroll
    for (int i = 0; i < 4; ++i) S[i] = (f4v){0.f, 0.f, 0.f, 0.f};
    mm64(Qi, Ki, S, w, lane);
    float mx[4], al[4], rsum[4];
    bool vm[4][4];
#pragma unroll
    for (int rg = 0; rg < 4; ++rg) {
      const int row = 16 * w + 4 * q + rg;
      float m_ = -1e30f;
#pragma unroll
      for (int nt = 0; nt < 4; ++nt) {
        const int key = 16 * nt + r;
        const int delta = row - key + W - 64 * kb;
        const bool ok = (delta >= -W) && (delta <= W);
        vm[nt][rg] = ok;
        float s = S[nt][rg] * 0.125f;
        S[nt][rg] = s;
        if (ok) m_ = fmaxf(m_, s);
      }
      mx[rg] = grp16_max(m_);
    }
#pragma unroll
    for (int rg = 0; rg < 4; ++rg) {
      const float mn = fmaxf(mrow[rg], mx[rg]);
      al[rg] = __expf(mrow[rg] - mn);
      mrow[rg] = mn;
      float rs_ = 0.f;
#pragma unroll
      for (int nt = 0; nt < 4; ++nt) {
        float pv = vm[nt][rg] ? __expf(S[nt][rg] - mn) : 0.f;
        rs_ += pv;
        Pi[(16 * w + 4 * q + rg) * LDH + 16 * nt + r] = (h16)pv;
      }
      rsum[rg] = grp16_sum(rs_);
      lsum[rg] = lsum[rg] * al[rg] + rsum[rg];
    }
#pragma unroll
    for (int et = 0; et < 4; ++et)
#pragma unroll
      for (int rg = 0; rg < 4; ++rg) O[et][rg] *= al[rg];
    __syncthreads();
    mm64(Pi, Vt, O, w, lane);
  }
#pragma unroll
  for (int rg = 0; rg < 4; ++rg) {
    const int row = 16 * w + 4 * q + rg;
    const size_t pos = (size_t)r0 + (size_t)dil * (i0 + row);
    const float inv = 1.f / lsum[rg];
    if (mode == 0) {
      h16* ob = (h16*)(ws + OFF_OB) + ((size_t)grp * SEQ + pos) * 256 + head * 64;
#pragma unroll
      for (int et = 0; et < 4; ++et) ob[16 * et + r] = (h16)(O[et][rg] * inv);
      if (r == 0) {
        float* ml = (float*)(ws + OFF_MLB) + (((size_t)grp * SEQ + pos) * 4 + head) * 2;
        ml[0] = mrow[rg]; ml[1] = lsum[rg];
      }
    } else {
      h16* y = (h16*)(ws + OFF_Y) + pos * 1280 + 768 + head * 64;
#pragma unroll
      for (int et = 0; et < 4; ++et) y[16 * et + r] = (h16)(O[et][rg] * inv);
    }
  }
}

DI void bcombine_unit(const Params& p, int unit) {
  unsigned char* ws = p.ws;
  const int gi = unit * 256 + otid();
  const int seg = gi & 7, head = (gi >> 3) & 3, pos = gi >> 5;
  const float* ml = (const float*)(ws + OFF_MLB);
  const h16* ob = (const h16*)(ws + OFF_OB);
  float m[3], lv[3];
#pragma unroll
  for (int g = 0; g < 3; ++g) { const float* q = ml + (((size_t)g * SEQ + pos) * 4 + head) * 2; m[g] = q[0]; lv[g] = q[1]; }
  const float M = fmaxf(m[0], fmaxf(m[1], m[2]));
  float wg[3], den = 0.f;
#pragma unroll
  for (int g = 0; g < 3; ++g) { wg[g] = __expf(m[g] - M) * lv[g]; den += wg[g]; }
  const float inv = 1.f / den;
  float o[8];
#pragma unroll
  for (int i = 0; i < 8; ++i) o[i] = 0.f;
#pragma unroll
  for (int g = 0; g < 3; ++g) {
    h8v v = *(const h8v*)&ob[((size_t)g * SEQ + pos) * 256 + head * 64 + seg * 8];
#pragma unroll
    for (int i = 0; i < 8; ++i) o[i] += wg[g] * (float)v[i];
  }
  h8v ov;
#pragma unroll
  for (int i = 0; i < 8; ++i) ov[i] = (h16)(o[i] * inv);
  *(h8v*)((h16*)(ws + OFF_Y) + (size_t)pos * 1280 + 256 + head * 64 + seg * 8) = ov;
}

DI void mlstm_a1_unit(const Params& p, int l, int head, int oc, h16* lds) {
  unsigned char* ws = p.ws;
  const h16* P = (const h16*)(ws + OFF_PS);
  const float* pscal = (const float*)(ws + OFF_PSCAL);
  float* sca = (float*)(ws + OFF_SCA);
  float* scas = (float*)(ws + OFF_SCAS);
  h16* Ks0 = lds; h16* Ks1 = lds + 64 * LDH; h16* Vt = lds + 128 * LDH;
  float* sw = (float*)(lds + 192 * LDH);
  const int tid = otid(), lane = tid & 63, w = tid >> 6, r = lane & 15, q = lane >> 4;
  __syncthreads();
  if (w < 2) {
    const int dir = w;
    const int rr = dir ? 63 - lane : lane;
    const size_t pos = (size_t)oc * 64 + rr;
    const float* gb = p.a_gate_bias + l * 16;
    const float ig = pscal[pos * 32 + dir * 8 + head] + gb[dir * 8 + head];
    const float lf = logsigmoid_(pscal[pos * 32 + dir * 8 + 4 + head] + gb[dir * 8 + 4 + head]);
    const float b = wave_incl_sum(lf, lane);
    const float blast = __shfl(b, 63);
    const float slog = blast - b + ig;
    const float mc = wave_max(slog);
    sw[dir * 64 + rr] = __expf(slog - mc) * 0.125f;
    if (lane == 0) {
      const int nloc = dir ? 255 - oc : oc;
      float* s4 = scas + ((size_t)(dir * 4 + head) * 256 + nloc) * 4;
      s4[0] = blast; s4[1] = mc;
    }
  }
  __syncthreads();
  {
    const int lrow = tid >> 2, seg = tid & 3;
    const size_t pos = (size_t)oc * 64 + lrow;
    const h16* gk = P + pos * NSM + 256 + head * 64 + 16 * seg;
    const h16* gv = P + pos * NSM + 512 + head * 64 + 16 * seg;
    h8v k0 = *(const h8v*)gk, k1 = *(const h8v*)(gk + 8);
    u4v v0 = *(const u4v*)gv, v1 = *(const u4v*)(gv + 8);
    const float s0 = sw[lrow], s1 = sw[64 + lrow];
#pragma unroll
    for (int i = 0; i < 8; ++i) {
      Ks0[(16 * seg + i) * LDH + lrow] = (h16)((float)k0[i] * s0);
      Ks0[(16 * seg + 8 + i) * LDH + lrow] = (h16)((float)k1[i] * s0);
      Ks1[(16 * seg + i) * LDH + lrow] = (h16)((float)k0[i] * s1);
      Ks1[(16 * seg + 8 + i) * LDH + lrow] = (h16)((float)k1[i] * s1);
    }
    img_store_T(Vt, lrow, seg, v0, v1);
  }
  __syncthreads();
#pragma unroll
  for (int dir = 0; dir < 2; ++dir) {
    const h16* Ks = dir ? Ks1 : Ks0;
    const int nloc = dir ? 255 - oc : oc;
    float* dst = sca + ((size_t)(dir * 4 + head) * 256 + nloc) * 4160;
    f4v acc[4];
#pragma unroll
    for (int i = 0; i < 4; ++i) acc[i] = (f4v){0.f, 0.f, 0.f, 0.f};
    mm64(Vt, Ks, acc, w, lane);
#pragma unroll
    for (int nt = 0; nt < 4; ++nt)
#pragma unroll
      for (int rg = 0; rg < 4; ++rg) dst[(16 * w + 4 * q + rg) * 64 + 16 * nt + r] = acc[nt][rg];
    if (w == dir) {
      float s = 0.f;
#pragma unroll 8
      for (int j = 0; j < 64; ++j) s += (float)Ks[lane * LDH + j];
      dst[4096 + lane] = s;
    }
  }
}

DI void mlstm_a2_unit(const Params& p, int unit) {
  unsigned char* ws = p.ws;
  float* sca = (float*)(ws + OFF_SCA);
  float* scas = (float*)(ws + OFF_SCAS);
  const int dh = unit / 17, sl = unit % 17;
  const int e = sl * 256 + otid();
  if (e >= 4160) return;
  float* base = sca + (size_t)dh * 256 * 4160 + e;
  float* s4 = scas + (size_t)dh * 256 * 4;
  float m = 0.f, c = 0.f;
  for (int n0 = 0; n0 < 256; n0 += 8) {
    float cc[8];
#pragma unroll
    for (int i = 0; i < 8; ++i) cc[i] = base[(size_t)(n0 + i) * 4160];
#pragma unroll
    for (int i = 0; i < 8; ++i) {
      const float bl = s4[(n0 + i) * 4], mc = s4[(n0 + i) * 4 + 1];
      const float mn = fmaxf(bl + m, mc);
      const float dec = __expf(bl + m - mn), gain = __expf(mc - mn);
      base[(size_t)(n0 + i) * 4160] = c;
      if (e == 0) s4[(n0 + i) * 4 + 2] = m;
      c = dec * c + gain * cc[i];
      m = mn;
    }
  }
}

DI void mlstm_a3_unit(const Params& p, int l, int head, int oc, h16* lds) {
  unsigned char* ws = p.ws;
  const h16* P = (const h16*)(ws + OFF_PS);
  const float* pscal = (const float*)(ws + OFF_PSCAL);
  const float* sca = (const float*)(ws + OFF_SCA);
  const float* scas = (const float*)(ws + OFF_SCAS);
  h16* Qi = lds; h16* Ki = lds + 64 * LDH; h16* Vt = lds + 128 * LDH; h16* Wi = lds + 192 * LDH; h16* Ci = lds + 256 * LDH;
  float* fl = (float*)(lds + 320 * LDH);
  float* rowterm = fl;
  float* colterm = fl + 128;
  float* ainter = fl + 256;
  float* emt = fl + 384;
  float* nvec = fl + 512;
  float* qn = fl + 576;
  const int tid = otid(), lane = tid & 63, w = tid >> 6, r = lane & 15, q = lane >> 4;
  const int lrow = tid >> 2, seg = tid & 3;
  __syncthreads();
  {
    const size_t pos = (size_t)oc * 64 + lrow;
    const h16* g = P + pos * NSM + head * 64 + 16 * seg;
    img_store_nat(Qi, lrow, seg, *(const u4v*)g, *(const u4v*)(g + 8));
    img_store_nat(Ki, lrow, seg, *(const u4v*)(g + 256), *(const u4v*)(g + 264));
    img_store_T(Vt, lrow, seg, *(const u4v*)(g + 512), *(const u4v*)(g + 520));
  }
  if (w < 2) {
    const int dir = w;
    const int rr = dir ? 63 - lane : lane;
    const size_t pos = (size_t)oc * 64 + rr;
    const int nloc = dir ? 255 - oc : oc;
    const float* gb = p.a_gate_bias + l * 16;
    const float ig = pscal[pos * 32 + dir * 8 + head] + gb[dir * 8 + head];
    const float lf = logsigmoid_(pscal[pos * 32 + dir * 8 + 4 + head] + gb[dir * 8 + 4 + head]);
    const float b = wave_incl_sum(lf, lane);
    const float u = ig - b;
    const float pm = wave_incl_max(u, lane);
    const float m_intra = b + pm;
    const float mprev = scas[((size_t)(dir * 4 + head) * 256 + nloc) * 4 + 2];
    const float mt = fmaxf(b + mprev, m_intra);
    rowterm[dir * 64 + rr] = b - mt;
    colterm[dir * 64 + rr] = u;
    ainter[dir * 64 + rr] = __expf(b + mprev - mt);
    emt[dir * 64 + rr] = __expf(-mt);
  }
  f4v hacc[4];
#pragma unroll
  for (int i = 0; i < 4; ++i) hacc[i] = (f4v){0.f, 0.f, 0.f, 0.f};
#pragma unroll 1
  for (int dir = 0; dir < 2; ++dir) {
    const int nloc = dir ? 255 - oc : oc;
    const float* src = sca + ((size_t)(dir * 4 + head) * 256 + nloc) * 4160;
    __syncthreads();
    {
      const float4* s4 = (const float4*)(src + lrow * 64 + 16 * seg);
      float4 a = s4[0], b = s4[1], c = s4[2], d = s4[3];
      h8v o0, o1;
      o0[0] = (h16)a.x; o0[1] = (h16)a.y; o0[2] = (h16)a.z; o0[3] = (h16)a.w; o0[4] = (h16)b.x; o0[5] = (h16)b.y; o0[6] = (h16)b.z; o0[7] = (h16)b.w;
      o1[0] = (h16)c.x; o1[1] = (h16)c.y; o1[2] = (h16)c.z; o1[3] = (h16)c.w; o1[4] = (h16)d.x; o1[5] = (h16)d.y; o1[6] = (h16)d.z; o1[7] = (h16)d.w;
      *(h8v*)&Ci[lrow * LDH + 16 * seg] = o0; *(h8v*)&Ci[lrow * LDH + 16 * seg + 8] = o1;
      if (tid < 64) nvec[tid] = src[4096 + tid];
    }
    __syncthreads();
    f4v S[4];
#pragma unroll
    for (int i = 0; i < 4; ++i) S[i] = (f4v){0.f, 0.f, 0.f, 0.f};
    mm64(Qi, Ki, S, w, lane);
    float dint[4];
#pragma unroll
    for (int rg = 0; rg < 4; ++rg) {
      const int t = 16 * w + 4 * q + rg;
      const float rt = rowterm[dir * 64 + t];
      float sum = 0.f;
#pragma unroll
      for (int nt = 0; nt < 4; ++nt) {
        const int s = 16 * nt + r;
        const bool ok = dir ? (s >= t) : (s <= t);
        const float wv = ok ? __expf(rt + colterm[dir * 64 + s]) * S[nt][rg] * 0.125f : 0.f;
        sum += wv;
        Wi[t * LDH + s] = (h16)wv;
      }
      dint[rg] = grp16_sum(sum);
    }
    {
      float s = 0.f;
#pragma unroll
      for (int i = 0; i < 16; ++i) s += (float)Qi[lrow * LDH + 16 * seg + i] * nvec[16 * seg + i];
      s += __shfl_xor(s, 1); s += __shfl_xor(s, 2);
      if (seg == 0) qn[lrow] = s;
    }
    __syncthreads();
    f4v a1[4], a2[4];
#pragma unroll
    for (int i = 0; i < 4; ++i) { a1[i] = (f4v){0.f, 0.f, 0.f, 0.f}; a2[i] = (f4v){0.f, 0.f, 0.f, 0.f}; }
    mm64(Wi, Vt, a1, w, lane);
    mm64(Qi, Ci, a2, w, lane);
#pragma unroll
    for (int rg = 0; rg < 4; ++rg) {
      const int t = 16 * w + 4 * q + rg;
      const float ai = ainter[dir * 64 + t];
      const float den = ai * qn[t] + dint[rg];
      const float dn = 1.f / fmaxf(fabsf(den), emt[dir * 64 + t]);
#pragma unroll
      for (int et = 0; et < 4; ++et) hacc[et][rg] += (a1[et][rg] + ai * a2[et][rg]) * dn;
    }
  }
  const float* nw = p.a_norm_w + l * 256 + head * 64;
#pragma unroll
  for (int rg = 0; rg < 4; ++rg) {
    const int t = 16 * w + 4 * q + rg;
    const size_t pos = (size_t)oc * 64 + t;
    float s = hacc[0][rg] + hacc[1][rg] + hacc[2][rg] + hacc[3][rg];
    const float mu = grp16_sum(s) * (1.f / 64.f);
    float vs = 0.f;
#pragma unroll
    for (int et = 0; et < 4; ++et) { float d = hacc[et][rg] - mu; vs += d * d; }
    const float var = grp16_sum(vs) * (1.f / 64.f);
    const float rstd = rsqrtf(var + 1e-5f);
    h16* y = (h16*)(ws + OFF_Y) + pos * 1280 + head * 64;
    const h16* ao = P + pos * NSM + 768 + head * 64;
#pragma unroll
    for (int et = 0; et < 4; ++et) {
      const int e = 16 * et + r;
      y[e] = (h16)((hacc[et][rg] - mu) * rstd * nw[e] * sigmoid_((float)ao[e]));
    }
  }
}

template <int DIR>
DI void dn_solve4(const float* M, const h16* Ki, const h16* Vi, const float* betal, const float* gcl, int half, int c, int pp, float (&x)[16]) {
  const h16* src = half ? (Ki + c) : (Vi + c);
#pragma unroll
  for (int k = 0; k < 16; ++k) x[k] = 0.f;
#pragma unroll
  for (int il = 0; il < 64; ++il) {
    const int ri = DIR ? 63 - il : il;
    float part = 0.f;
#pragma unroll
    for (int k = 0; k < (il + 3) / 4; ++k) {
      const int jl0 = 4 * k;
      float mv = DIR ? M[ri * MLD + 63 - jl0 - pp] : M[ri * MLD + jl0 + pp];
      if (jl0 + 3 >= il) mv = (jl0 + pp < il) ? mv : 0.f;
      part += mv * x[k];
    }
    part += __shfl_xor(part, 1); part += __shfl_xor(part, 2);
    const float e = half ? __expf(gcl[ri]) : 1.f;
    const float xi = betal[ri] * (float)src[ri * LDH] * e - part;
    if ((il & 3) == pp) x[il >> 2] = xi;
  }
}

DI void dn_c1_unit(const Params& p, int l, int head, int oc, h16* lds) {
  unsigned char* ws = p.ws;
  const h16* P = (const h16*)(ws + OFF_PS);
  const float* pscal = (const float*)(ws + OFF_PSCAL);
  h16* cq = (h16*)(ws + OFF_CQKV);
  h16* Ki = lds; h16* Vi = lds + 64 * LDH;
  float* M = (float*)(lds + 128 * LDH);
  float* betal = M + 64 * MLD;
  float* gcl = betal + 128;
  float* glast = gcl + 128;
  const int tid = otid(), lane = tid & 63, w = tid >> 6, r = lane & 15, q = lane >> 4;
  const int lrow = tid >> 2, seg = tid & 3;
  __syncthreads();
  {
    const int pos = oc * 64 + lrow;
    const float* cw = p.c_conv_w + (size_t)l * 5 * 768;
    float vq[16], vk[16], vv[16];
#pragma unroll
    for (int i = 0; i < 16; ++i) { vq[i] = 0.f; vk[i] = 0.f; vv[i] = 0.f; }
#pragma unroll
    for (int j = 0; j < 5; ++j) {
      const int pp = pos + j - 2;
      if (pp < 0 || pp >= SEQ) continue;
      const h16* g = P + (size_t)pp * NSM + 3328 + head * 64 + 16 * seg;
      h8v q0 = *(const h8v*)g, q1 = *(const h8v*)(g + 8);
      h8v k0 = *(const h8v*)(g + 256), k1 = *(const h8v*)(g + 264);
      h8v v0 = *(const h8v*)(g + 512), v1 = *(const h8v*)(g + 520);
      const float* wq = cw + j * 768 + head * 64 + 16 * seg;
#pragma unroll
      for (int i = 0; i < 8; ++i) {
        vq[i] += wq[i] * (float)q0[i]; vq[8 + i] += wq[8 + i] * (float)q1[i];
        vk[i] += wq[256 + i] * (float)k0[i]; vk[8 + i] += wq[264 + i] * (float)k1[i];
        vv[i] += wq[512 + i] * (float)v0[i]; vv[8 + i] += wq[520 + i] * (float)v1[i];
      }
    }
    float sq = 0.f, sk = 0.f;
#pragma unroll
    for (int i = 0; i < 16; ++i) { vq[i] = silu_(vq[i]); vk[i] = silu_(vk[i]); vv[i] = silu_(vv[i]); sq += vq[i] * vq[i]; sk += vk[i] * vk[i]; }
    sq += __shfl_xor(sq, 1); sq += __shfl_xor(sq, 2);
    sk += __shfl_xor(sk, 1); sk += __shfl_xor(sk, 2);
    const float rq = rsqrtf(sq + 1e-6f) * 0.125f, rk = rsqrtf(sk + 1e-6f);
    h8v oq0, oq1, ok0, ok1, ov0, ov1;
#pragma unroll
    for (int i = 0; i < 8; ++i) {
      oq0[i] = (h16)(vq[i] * rq); oq1[i] = (h16)(vq[8 + i] * rq);
      ok0[i] = (h16)(vk[i] * rk); ok1[i] = (h16)(vk[8 + i] * rk);
      ov0[i] = (h16)vv[i]; ov1[i] = (h16)vv[8 + i];
    }
    h16* o = cq + (size_t)pos * 768 + head * 64 + 16 * seg;
    *(h8v*)o = oq0; *(h8v*)(o + 8) = oq1;
    *(h8v*)(o + 256) = ok0; *(h8v*)(o + 264) = ok1;
    *(h8v*)(o + 512) = ov0; *(h8v*)(o + 520) = ov1;
    *(h8v*)&Ki[lrow * LDH + 16 * seg] = ok0; *(h8v*)&Ki[lrow * LDH + 16 * seg + 8] = ok1;
    *(h8v*)&Vi[lrow * LDH + 16 * seg] = ov0; *(h8v*)&Vi[lrow * LDH + 16 * seg + 8] = ov1;
  }
  if (w < 2) {
    const int dir = w;
    const int rr = dir ? 63 - lane : lane;
    const size_t pos = (size_t)oc * 64 + rr;
    const float beta = sigmoid_(pscal[pos * 32 + 16 + dir * 4 + head]);
    const float g = -__expf(p.c_a_log[l * 8 + dir * 4 + head]) * softplus_(pscal[pos * 32 + 24 + dir * 4 + head] + p.c_dt_bias[l * 8 + dir * 4 + head]);
    const float gc = wave_incl_sum(g, lane);
    const float gl = __shfl(gc, 63);
    betal[dir * 64 + rr] = beta; gcl[dir * 64 + rr] = gc;
    if (lane == 0) {
      glast[dir] = gl;
      const int nloc = dir ? 255 - oc : oc;
      ((float*)(ws + OFF_CDL))[(size_t)(dir * 4 + head) * 256 + nloc] = __expf(gl);
    }
  }
  __syncthreads();
  {
    f4v kk[4];
#pragma unroll
    for (int i = 0; i < 4; ++i) kk[i] = (f4v){0.f, 0.f, 0.f, 0.f};
    mm64(Ki, Ki, kk, w, lane);
#pragma unroll
    for (int nt = 0; nt < 4; ++nt)
#pragma unroll
      for (int rg = 0; rg < 4; ++rg) {
        const int i = 16 * w + 4 * q + rg, j = 16 * nt + r;
        float v = 0.f;
        if (j < i) v = betal[i] * kk[nt][rg] * __expf(gcl[i] - gcl[j]);
        else if (j > i) v = betal[64 + i] * kk[nt][rg] * __expf(gcl[64 + i] - gcl[64 + j]);
        M[i * MLD + j] = v;
      }
  }
  __syncthreads();
  {
    const int c = tid >> 2, pp = tid & 3;
#pragma unroll 1
    for (int dh2 = 0; dh2 < 4; ++dh2) {
      const int dir = dh2 >> 1, half = dh2 & 1;
      const int nloc = dir ? 255 - oc : oc;
      const size_t unit = (size_t)(dir * 4 + head) * 256 + nloc;
      float x[16];
      if (dir == 0) dn_solve4<0>(M, Ki, Vi, betal, gcl, half, c, pp, x);
      else dn_solve4<1>(M, Ki, Vi, betal + 64, gcl + 64, half, c, pp, x);
      if (half == 0) {
        float* ud = (float*)(ws + OFF_CU) + unit * 4096;
        const int slice = c >> 4, el = c & 15;
#pragma unroll
        for (int k = 0; k < 16; ++k) {
          const int il = 4 * k + pp;
          const int rr = dir ? 63 - il : il;
          ud[((slice * 4 + (rr >> 4)) * 64 + el + 16 * ((rr & 15) >> 2)) * 4 + (rr & 3)] = x[k];
        }
      } else {
        h16* wd = (h16*)(ws + OFF_CW) + unit * 4096;
        const int s = c >> 5, lq = (c & 15) >> 2, jjx = (c & 3) + 4 * ((c & 31) >> 4);
#pragma unroll
        for (int k = 0; k < 16; ++k) {
          const int il = 4 * k + pp;
          const int rr = dir ? 63 - il : il;
          wd[(((rr >> 4) * 2 + s) * 64 + (rr & 15) + 16 * lq) * 8 + jjx] = (h16)(-x[k]);
        }
      }
    }
  }
#pragma unroll
  for (int dir = 0; dir < 2; ++dir) {
    const int nloc = dir ? 255 - oc : oc;
    const size_t unit = (size_t)(dir * 4 + head) * 256 + nloc;
    h16* kd = (h16*)(ws + OFF_CKD) + unit * 4096;
    const float gl = glast[dir];
#pragma unroll
    for (int it = 0; it < 4; ++it) {
      const int e = tid + 256 * it;
      const int d = e & 63, rq = e >> 6;
      const int r0 = 4 * rq;
      h4v o;
#pragma unroll
      for (int i = 0; i < 4; ++i) o[i] = (h16)((float)Ki[(r0 + i) * LDH + d] * __expf(gl - gcl[dir * 64 + r0 + i]));
      const int tile = d >> 4, s = r0 >> 5, ln = (d & 15) + 16 * ((r0 & 15) >> 2), j4 = 4 * ((r0 & 31) >> 4);
      *(h4v*)&kd[((tile * 2 + s) * 64 + ln) * 8 + j4] = o;
    }
  }
}

DI void dn_c2_unit(const Params& p, int dh, int w) {
  unsigned char* ws = p.ws;
  const int tid = otid(), lane = tid & 63;
  if (tid >= 64) return;
  const h16* cw = (const h16*)(ws + OFF_CW) + (size_t)dh * 256 * 4096;
  const h16* ckd = (const h16*)(ws + OFF_CKD) + (size_t)dh * 256 * 4096;
  const float* cu = (const float*)(ws + OFF_CU) + (size_t)dh * 256 * 4096;
  const float* cdl = (const float*)(ws + OFF_CDL) + (size_t)dh * 256;
  h16* cs = (h16*)(ws + OFF_CS) + (size_t)dh * 256 * 4096;
  h16* cvn = (h16*)(ws + OFF_CVN) + (size_t)dh * 256 * 4096;
  f4v S[4];
#pragma unroll
  for (int i = 0; i < 4; ++i) S[i] = (f4v){0.f, 0.f, 0.f, 0.f};
  h8v wA[4][2], kA[4][2]; f4v uu[4]; float dl;
#pragma unroll
  for (int t = 0; t < 4; ++t) {
#pragma unroll
    for (int s = 0; s < 2; ++s) {
      wA[t][s] = *(const h8v*)&cw[((t * 2 + s) * 64 + lane) * 8];
      kA[t][s] = *(const h8v*)&ckd[((t * 2 + s) * 64 + lane) * 8];
    }
    uu[t] = *(const f4v*)&cu[((w * 4 + t) * 64 + lane) * 4];
  }
  dl = cdl[0];
  for (int n = 0; n < 256; ++n) {
    h8v wN[4][2], kN[4][2]; f4v uN[4]; float dlN = 0.f;
    const int nn = (n + 1 < 256) ? n + 1 : n;
    {
      const h16* cw1 = cw + (size_t)nn * 4096; const h16* ck1 = ckd + (size_t)nn * 4096; const float* cu1 = cu + (size_t)nn * 4096;
#pragma unroll
      for (int t = 0; t < 4; ++t) {
#pragma unroll
        for (int s = 0; s < 2; ++s) {
          wN[t][s] = *(const h8v*)&cw1[((t * 2 + s) * 64 + lane) * 8];
          kN[t][s] = *(const h8v*)&ck1[((t * 2 + s) * 64 + lane) * 8];
        }
        uN[t] = *(const f4v*)&cu1[((w * 4 + t) * 64 + lane) * 4];
      }
      dlN = cdl[nn];
    }
    h8v Sb[2];
    Sb[0] = pack8(S[0], S[1]); Sb[1] = pack8(S[2], S[3]);
    h16* cs1 = cs + (size_t)n * 4096; h16* cv1 = cvn + (size_t)n * 4096;
    *(h8v*)&cs1[((w * 2 + 0) * 64 + lane) * 8] = Sb[0];
    *(h8v*)&cs1[((w * 2 + 1) * 64 + lane) * 8] = Sb[1];
    f4v vn[4];
#pragma unroll
    for (int t = 0; t < 4; ++t) { vn[t] = uu[t]; vn[t] = mfma16(wA[t][0], Sb[0], vn[t]); vn[t] = mfma16(wA[t][1], Sb[1], vn[t]); }
    h8v Vb[2];
    Vb[0] = pack8(vn[0], vn[1]); Vb[1] = pack8(vn[2], vn[3]);
    *(h8v*)&cv1[((w * 2 + 0) * 64 + lane) * 8] = Vb[0];
    *(h8v*)&cv1[((w * 2 + 1) * 64 + lane) * 8] = Vb[1];
#pragma unroll
    for (int t = 0; t < 4; ++t) { S[t] *= dl; S[t] = mfma16(kA[t][0], Vb[0], S[t]); S[t] = mfma16(kA[t][1], Vb[1], S[t]); }
#pragma unroll
    for (int t = 0; t < 4; ++t) { wA[t][0] = wN[t][0]; wA[t][1] = wN[t][1]; kA[t][0] = kN[t][0]; kA[t][1] = kN[t][1]; uu[t] = uN[t]; }
    dl = dlN;
  }
}

DI void dn_c3_unit(const Params& p, int l, int head, int oc, h16* lds) {
  unsigned char* ws = p.ws;
  const h16* P = (const h16*)(ws + OFF_PS);
  const float* pscal = (const float*)(ws + OFF_PSCAL);
  const h16* cq = (const h16*)(ws + OFF_CQKV);
  h16* Qi = lds; h16* Ki = lds + 64 * LDH;
  h16* AT = lds + 128 * LDH;
  h16* QG = lds + 256 * LDH;
  float* gcl = (float*)(lds + 384 * LDH);
  float* Ol = (float*)lds;
  const int tid = otid(), lane = tid & 63, w = tid >> 6, r = lane & 15, q = lane >> 4;
  const int lrow = tid >> 2, seg = tid & 3;
  __syncthreads();
  {
    const size_t pos = (size_t)oc * 64 + lrow;
    const h16* g = cq + pos * 768 + head * 64 + 16 * seg;
    img_store_nat(Qi, lrow, seg, *(const u4v*)g, *(const u4v*)(g + 8));
    img_store_nat(Ki, lrow, seg, *(const u4v*)(g + 256), *(const u4v*)(g + 264));
  }
  if (w < 2) {
    const int dir = w;
    const int rr = dir ? 63 - lane : lane;
    const size_t pos = (size_t)oc * 64 + rr;
    const float g = -__expf(p.c_a_log[l * 8 + dir * 4 + head]) * softplus_(pscal[pos * 32 + 24 + dir * 4 + head] + p.c_dt_bias[l * 8 + dir * 4 + head]);
    gcl[dir * 64 + rr] = wave_incl_sum(g, lane);
  }
  __syncthreads();
  {
    f4v S[4];
#pragma unroll
    for (int i = 0; i < 4; ++i) S[i] = (f4v){0.f, 0.f, 0.f, 0.f};
    mm64(Qi, Ki, S, w, lane);
#pragma unroll
    for (int dir = 0; dir < 2; ++dir) {
#pragma unroll
      for (int nt = 0; nt < 4; ++nt)
#pragma unroll
        for (int rg = 0; rg < 4; ++rg) {
          const int i = 16 * w + 4 * q + rg, j = 16 * nt + r;
          const bool ok = dir ? (j >= i) : (j <= i);
          const float v = ok ? S[nt][rg] * __expf(gcl[dir * 64 + i] - gcl[dir * 64 + j]) : 0.f;
          AT[(dir * 64 + i) * LDH + j] = (h16)v;
        }
      const float eg = __expf(gcl[dir * 64 + lrow]);
#pragma unroll
      for (int i = 0; i < 16; ++i) QG[(dir * 64 + lrow) * LDH + 16 * seg + i] = (h16)((float)Qi[lrow * LDH + 16 * seg + i] * eg);
    }
  }
  __syncthreads();
  f4v o[4];
#pragma unroll
  for (int i = 0; i < 4; ++i) o[i] = (f4v){0.f, 0.f, 0.f, 0.f};
#pragma unroll
  for (int dir = 0; dir < 2; ++dir) {
    const int nloc = dir ? 255 - oc : oc;
    const size_t unit = (size_t)(dir * 4 + head) * 256 + nloc;
    const h16* cs = (const h16*)(ws + OFF_CS) + unit * 4096;
    const h16* cv = (const h16*)(ws + OFF_CVN) + unit * 4096;
#pragma unroll
    for (int s = 0; s < 2; ++s) {
      const h8v Sb = *(const h8v*)&cs[((w * 2 + s) * 64 + lane) * 8];
      const h8v Vb = *(const h8v*)&cv[((w * 2 + s) * 64 + lane) * 8];
#pragma unroll
      for (int it = 0; it < 4; ++it) {
        o[it] = mfma16(perm_frag(QG + dir * 64 * LDH, 16 * it + r, s, q), Sb, o[it]);
        o[it] = mfma16(perm_frag(AT + dir * 64 * LDH, 16 * it + r, s, q), Vb, o[it]);
      }
    }
  }
  __syncthreads();
#pragma unroll
  for (int it = 0; it < 4; ++it)
#pragma unroll
    for (int rg = 0; rg < 4; ++rg) Ol[(16 * it + 4 * q + rg) * 65 + 16 * w + r] = o[it][rg];
  __syncthreads();
  {
    const size_t pos = (size_t)oc * 64 + lrow;
    float v[16]; float ss = 0.f;
#pragma unroll
    for (int i = 0; i < 16; ++i) { v[i] = Ol[lrow * 65 + 16 * seg + i]; ss += v[i] * v[i]; }
    ss += __shfl_xor(ss, 1); ss += __shfl_xor(ss, 2);
    const float rms = rsqrtf(ss * (1.f / 64.f) + 1e-6f);
    const float* nw = p.c_norm_w + l * 64 + 16 * seg;
    const h16* cg_ = P + pos * NSM + 4096 + head * 64 + 16 * seg;
    h8v g0 = *(const h8v*)cg_, g1 = *(const h8v*)(cg_ + 8);
    h8v o0, o1;
#pragma unroll
    for (int i = 0; i < 8; ++i) {
      o0[i] = (h16)(v[i] * rms * nw[i] * silu_((float)g0[i]));
      o1[i] = (h16)(v[8 + i] * rms * nw[8 + i] * silu_((float)g1[i]));
    }
    h16* y = (h16*)(ws + OFF_Y) + pos * 1280 + 512 + head * 64 + 16 * seg;
    *(h8v*)y = o0; *(h8v*)(y + 8) = o1;
  }
}

DI void phase_m1(const Params& p, int l, int bid, int nb, h16* lds) {
  for (int u = bid; u < 2048; u += nb) {
    if (u < 1024) dn_c1_unit(p, l, u & 3, u >> 2, lds);
    else { const int v = u - 1024; mlstm_a1_unit(p, l, v & 3, v >> 2, lds); }
  }
}
DI void phase_m2(const Params& p, int l, int bid, int nb, h16* lds) {
  const int total = 32 + 136 + 2048 + 3072;
  for (int u = bid; u < total; u += nb) {
    int v = u;
    if (v < 32) { dn_c2_unit(p, v >> 2, v & 3); continue; }
    if ((v -= 32) < 136) { mlstm_a2_unit(p, v); continue; }
    if ((v -= 136) < 2048) { attn_unit<5>(p, l, 1, 0, v & 7, 0, 1, (v >> 3) * 64, SEQ, 128, lds); continue; }
    v -= 2048;
    const int grp = v >> 10, x = v & 1023, head = x & 3, tl = x >> 2;
    const int dil = (grp == 0) ? 1 : (grp == 1) ? 4 : 16;
    const int sub = SEQ / dil, tps = sub >> 6;
    const int res = tl / tps, ti = tl % tps;
    attn_unit<3>(p, l, 0, grp, head, res, dil, ti * 64, sub, 64, lds);
  }
}
DI void phase_m3(const Params& p, int l, int bid, int nb, h16* lds) {
  const int total = 1024 + 1024 + 2048;
  for (int u = bid; u < total; u += nb) {
    int v = u;
    if (v < 1024) { mlstm_a3_unit(p, l, v & 3, v >> 2, lds); continue; }
    if ((v -= 1024) < 1024) { dn_c3_unit(p, l, v & 3, v >> 2, lds); continue; }
    bcombine_unit(p, v - 1024);
  }
}

DI void phase_gates(const Params& p, int bid, int nb, h16* lds) {
  unsigned char* ws = p.ws;
  const h16* x16 = (const h16*)(ws + OFF_X16);
  const h16* wg = (const h16*)(ws + OFF_WG);
  h16* G = (h16*)(ws + OFF_GATES);
  for (int u = bid; u < 128 * 32; u += nb) {
    const int m0 = (u >> 5) * 128, n0 = (u & 31) * 128;
    f16v acc[2][2]; acc_zero(acc);
    gemm_main<false>(x16, DM, nullptr, m0, wg, 1024, n0, 1024, lds, acc);
    gemm_epilogue(acc, m0, n0, [&](int m, int n, f4v v0, f4v v1) {
      f4v a, b;
#pragma unroll
      for (int i = 0; i < 4; ++i) { a[i] = sigmoid_(v0[i]); b[i] = sigmoid_(v1[i]); }
      st_h4(&G[(size_t)m * 4096 + n], a); st_h4(&G[(size_t)m * 4096 + n + 32], b);
    });
  }
}
DI void phase_merge(const Params& p, int bid, int nb, h16* lds) {
  unsigned char* ws = p.ws;
  const h16* Y = (const h16*)(ws + OFF_Y);
  const h16* wbr = (const h16*)(ws + OFF_WBR);
  const h16* G = (const h16*)(ws + OFF_GATES);
  h16* Mg = (h16*)(ws + OFF_MERGED);
  for (int u = bid; u < 128 * 8; u += nb) {
    const int m0 = (u >> 3) * 128, n0 = (u & 7) * 128;
    f16v macc[2][2]; acc_zero(macc);
#pragma unroll 1
    for (int b = 0; b < 4; ++b) {
      const int Kb = (b == 3) ? 512 : 256;
      f16v acc[2][2]; acc_zero(acc);
      gemm_main1<false>(Y + b * 256, 1280, nullptr, m0, wbr + (size_t)b * 262144, Kb, n0, Kb, lds, acc);
      const int tid = otid(), lane = tid & 63, wv = tid >> 6, wm = wv >> 1, wn = wv & 1, h = lane >> 5;
#pragma unroll
      for (int i = 0; i < 2; ++i) {
        const int m = m0 + wm * 64 + i * 32 + (lane & 31);
#pragma unroll
        for (int g = 0; g < 4; ++g) {
          const int n = n0 + wn * 64 + 8 * g + 4 * h;
          const h4v g0 = *(const h4v*)&G[(size_t)m * 4096 + b * 1024 + n];
          const h4v g1 = *(const h4v*)&G[(size_t)m * 4096 + b * 1024 + n + 32];
#pragma unroll
          for (int e = 0; e < 4; ++e) {
            macc[i][0][4 * g + e] += (float)g0[e] * acc[i][0][4 * g + e];
            macc[i][1][4 * g + e] += (float)g1[e] * acc[i][1][4 * g + e];
          }
        }
      }
    }
    gemm_epilogue(macc, m0, n0, [&](int m, int n, f4v v0, f4v v1) {
      st_h4(&Mg[(size_t)m * DM + n], v0); st_h4(&Mg[(size_t)m * DM + n + 32], v1);
    });
  }
}
DI void phase_resid_gemm(const Params& p, const h16* A, int lda, const h16* W, int K, const float* xres, int bid, int nb, h16* lds) {
  float* out = p.out;
  for (int u = bid; u < 128 * 8; u += nb) {
    const int m0 = (u >> 3) * 128, n0 = (u & 7) * 128;
    f16v acc[2][2]; acc_zero(acc);
    gemm_main<false>(A, lda, nullptr, m0, W, K, n0, K, lds, acc);
    gemm_epilogue(acc, m0, n0, [&](int m, int n, f4v v0, f4v v1) {
      const f4v x0 = *(const f4v*)&xres[(size_t)m * DM + n], x1 = *(const f4v*)&xres[(size_t)m * DM + n + 32];
      *(f4v*)&out[(size_t)m * DM + n] = ALPHA * x0 + v0;
      *(f4v*)&out[(size_t)m * DM + n + 32] = ALPHA * x1 + v1;
    });
  }
}
DI void phase_ffn1_dense(const Params& p, int bid, int nb, h16* lds) {
  unsigned char* ws = p.ws;
  const h16* x16 = (const h16*)(ws + OFF_X16);
  const h16* w13 = (const h16*)(ws + OFF_WFF);
  h16* H = (h16*)(ws + OFF_H);
  for (int u = bid; u < 128 * 44; u += nb) {
    const int m0 = (u / 44) * 128, n0 = (u % 44) * 128;
    f16v acc[2][2]; acc_zero(acc);
    gemm_main<false>(x16, DM, nullptr, m0, w13, 1024, n0, 1024, lds, acc);
    gemm_epilogue(acc, m0, n0, [&](int m, int n, f4v v0, f4v v1) {
      f4v hq;
#pragma unroll
      for (int i = 0; i < 4; ++i) hq[i] = silu_(v0[i]) * v1[i];
      st_h4(&H[(size_t)m * 2816 + (n >> 6) * 32 + (n & 31)], hq);
    });
  }
}
DI void moe_prefix(const int* cnt, int (&pstart)[9]) {
  int s = 0;
#pragma unroll
  for (int e = 0; e < 8; ++e) { pstart[e] = s; s += (cnt[e] + 127) & ~127; }
  pstart[8] = s;
}
DI void phase_ffn1_moe(const Params& p, int bid, int nb, h16* lds) {
  unsigned char* ws = p.ws;
  const h16* x16 = (const h16*)(ws + OFF_X16);
  const h16* w13 = (const h16*)(ws + OFF_WFF);
  h16* H = (h16*)(ws + OFF_H);
  const int* st = (const int*)(ws + MOE_ST);
  int ps[9]; moe_prefix((const int*)(ws + MOE_CNT), ps);
  const int ntl = (ps[8] >> 7) * 22;
  for (int u = bid; u < ntl; u += nb) {
    const int mt = u / 22, m0 = mt * 128, n0 = (u % 22) * 128;
    int e = 0;
#pragma unroll
    for (int i = 1; i < 8; ++i) if (m0 >= ps[i]) e = i;
    f16v acc[2][2]; acc_zero(acc);
    gemm_main<true>(x16, DM, st, m0, w13 + (size_t)e * 2816 * 1024, 1024, n0, 1024, lds, acc);
    gemm_epilogue(acc, m0, n0, [&](int m, int n, f4v v0, f4v v1) {
      f4v hq;
#pragma unroll
      for (int i = 0; i < 4; ++i) hq[i] = silu_(v0[i]) * v1[i];
      st_h4(&H[(size_t)m * 1408 + (n >> 6) * 32 + (n & 31)], hq);
    });
  }
}
DI void phase_ffn2_moe(const Params& p, int bid, int nb, h16* lds) {
  unsigned char* ws = p.ws;
  const h16* H = (const h16*)(ws + OFF_H);
  const h16* w2 = (const h16*)(ws + OFF_WFF) + (size_t)8 * 2816 * 1024;
  h16* YB = (h16*)(ws + OFF_YB);
  const float* sg = (const float*)(ws + MOE_SG);
  int ps[9]; moe_prefix((const int*)(ws + MOE_CNT), ps);
  const int ntl = (ps[8] >> 7) * 8;
  for (int u = bid; u < ntl; u += nb) {
    const int mt = u >> 3, m0 = mt * 128, n0 = (u & 7) * 128;
    int e = 0;
#pragma unroll
    for (int i = 1; i < 8; ++i) if (m0 >= ps[i]) e = i;
    f16v acc[2][2]; acc_zero(acc);
    gemm_main<false>(H, 1408, nullptr, m0, w2 + (size_t)e * 1024 * 1408, 1408, n0, 1408, lds, acc);
    gemm_epilogue(acc, m0, n0, [&](int m, int n, f4v v0, f4v v1) {
      const float g = sg[m];
      st_h4(&YB[(size_t)m * DM + n], g * v0); st_h4(&YB[(size_t)m * DM + n + 32], g * v1);
    });
  }
}

DI void phase_ln(const Params& p, int l, int which, int bid, int nb) {
  unsigned char* ws = p.ws;
  const bool moe = (l & 1);
  const bool moe_in = moe && which == 2;
  const bool router = moe && which == 1;
  const float* lw = (which == 1 ? p.ln1_w : p.ln2_w) + l * DM;
  const float* lb = (which == 1 ? p.ln1_b : p.ln2_b) + l * DM;
  float* out = p.out;
  h16* x16 = (h16*)(ws + OFF_X16);
  const int tid_ = otid(); const int lane = tid_ & 63, wv = tid_ >> 6;
  for (int row = bid * 4 + wv; row < SEQ; row += nb * 4) {
    float v[16];
#pragma unroll
    for (int i = 0; i < 4; ++i) {
      const f4v t = *(const f4v*)&out[(size_t)row * DM + 256 * i + lane * 4];
      v[4 * i] = t[0]; v[4 * i + 1] = t[1]; v[4 * i + 2] = t[2]; v[4 * i + 3] = t[3];
    }
    if (moe_in) {
      const int* ts = (const int*)(ws + MOE_TS);
      const h16* YB = (const h16*)(ws + OFF_YB);
      const int s0 = ts[row * 2], s1 = ts[row * 2 + 1];
#pragma unroll
      for (int i = 0; i < 4; ++i) {
        const h4v a = *(const h4v*)&YB[(size_t)s0 * DM + 256 * i + lane * 4];
        const h4v b = *(const h4v*)&YB[(size_t)s1 * DM + 256 * i + lane * 4];
#pragma unroll
        for (int e = 0; e < 4; ++e) v[4 * i + e] = ALPHA * v[4 * i + e] + ((float)a[e] + (float)b[e]);
      }
    }
    float s = 0.f;
#pragma unroll
    for (int i = 0; i < 16; ++i) s += v[i];
    const float mu = wave_sum(s) * (1.f / 1024.f);
    float vs = 0.f;
#pragma unroll
    for (int i = 0; i < 16; ++i) { const float d = v[i] - mu; vs += d * d; }
    const float rstd = rsqrtf(wave_sum(vs) * (1.f / 1024.f) + 1e-5f);
#pragma unroll
    for (int i = 0; i < 4; ++i) {
      const int c = 256 * i + lane * 4;
      const f4v w4 = *(const f4v*)&lw[c], b4 = *(const f4v*)&lb[c];
      f4v y;
#pragma unroll
      for (int e = 0; e < 4; ++e) { y[e] = (v[4 * i + e] - mu) * rstd * w4[e] + b4[e]; v[4 * i + e] = y[e]; }
      *(f4v*)&out[(size_t)row * DM + c] = y;
      st_h4(&x16[(size_t)row * DM + c], y);
    }
    if (router) {
      const float* rw = p.moe_router + (size_t)(l >> 1) * DM * 8;
      float lg[8];
#pragma unroll
      for (int e = 0; e < 8; ++e) lg[e] = 0.f;
#pragma unroll
      for (int i = 0; i < 4; ++i)
#pragma unroll
        for (int k = 0; k < 4; ++k) {
          const int c = 256 * i + lane * 4 + k;
          const f4v r0 = *(const f4v*)&rw[(size_t)c * 8], r1 = *(const f4v*)&rw[(size_t)c * 8 + 4];
          const float xv = v[4 * i + k];
#pragma unroll
          for (int e = 0; e < 4; ++e) { lg[e] += xv * r0[e]; lg[4 + e] += xv * r1[e]; }
        }
#pragma unroll
      for (int e = 0; e < 8; ++e) lg[e] = wave_sum(lg[e]);
      if (lane == 0) {
        int i1 = 0; float b1 = lg[0];
#pragma unroll
        for (int e = 1; e < 8; ++e) if (lg[e] > b1) { b1 = lg[e]; i1 = e; }
        int i2 = -1; float b2 = -3.4e38f;
#pragma unroll
        for (int e = 0; e < 8; ++e) if (e != i1 && lg[e] > b2) { b2 = lg[e]; i2 = e; }
        const float g1 = 1.f / (1.f + __expf(b2 - b1)), g2 = 1.f - g1;
        int* cnt = (int*)(ws + MOE_CNT);
        int* te = (int*)(ws + MOE_TE); int* tp = (int*)(ws + MOE_TP); float* tg = (float*)(ws + MOE_TG);
        te[row * 2] = i1; te[row * 2 + 1] = i2;
        tp[row * 2] = atomicAdd(&cnt[i1], 1); tp[row * 2 + 1] = atomicAdd(&cnt[i2], 1);
        tg[row * 2] = g1; tg[row * 2 + 1] = g2;
      }
    }
  }
}
DI void phase_assign(const Params& p, int bid, int nb) {
  unsigned char* ws = p.ws;
  int ps[9]; moe_prefix((const int*)(ws + MOE_CNT), ps);
  const int* te = (const int*)(ws + MOE_TE); const int* tp = (const int*)(ws + MOE_TP); const float* tg = (const float*)(ws + MOE_TG);
  int* ts = (int*)(ws + MOE_TS); int* st = (int*)(ws + MOE_ST); float* sg = (float*)(ws + MOE_SG);
  for (int i = bid * 256 + otid(); i < 32768; i += nb * 256) {
    const int e = te[i];
    int base = 0;
#pragma unroll
    for (int k = 0; k < 8; ++k) if (e == k) base = ps[k];
    const int slot = base + tp[i];
    ts[i] = slot; st[slot] = i >> 1; sg[slot] = tg[i];
  }
}


#define XB_TMO      128
#define XB_XCNT(j)  (256  + 64 * (j))
#define XB_XSUB(j)  (1280 + 64 * (j))
#define XB_XGEN(j)  (2304 + 64 * (j))
#define XB_TOP      3328
#define XB_TOPGEN   3392
#define XCD_BAR_WORDS 3456
#define XB_SPIN_CAP (1u << 22)
#define LAS __attribute__((address_space(3)))
DI unsigned xb_ld(unsigned* p) { return __hip_atomic_load(p, __ATOMIC_RELAXED, __HIP_MEMORY_SCOPE_AGENT); }
DI unsigned xb_add(unsigned* p, unsigned v) { return __hip_atomic_fetch_add(p, v, __ATOMIC_RELAXED, __HIP_MEMORY_SCOPE_AGENT); }
DI unsigned xb_xcc_id() { return (unsigned)__builtin_amdgcn_s_getreg((3 << 11) | 20) & 0xFu; }
#define XB_SPIN(cond, bar) do { unsigned _sp = 0; while (cond) { __builtin_amdgcn_s_sleep(1); \
    if ((++_sp & 255u) == 0u) { if (xb_ld(&(bar)[XB_TMO])) break; if (_sp > XB_SPIN_CAP) { atomicAdd(&(bar)[XB_TMO], 1u); break; } } } } while (0)
struct XcdBarrier { unsigned* bar; unsigned x; volatile LAS unsigned* st; };
DI XcdBarrier xcd_barrier_post(unsigned* bar, volatile LAS unsigned* st) {
  XcdBarrier b; b.bar = bar; b.x = xb_xcc_id(); b.st = st;
  if (threadIdx.x == 0) (void)xb_add(&bar[XB_XCNT(b.x)], 1u);
  return b;
}
DI void xcd_barrier_complete(unsigned* bar, unsigned x, unsigned& nloc, unsigned& nx) {
  const unsigned G = gridDim.x * gridDim.y * gridDim.z;
  unsigned sum, cnt, mine, sp = 0u;
  for (;;) {
    sum = 0u; cnt = 0u; mine = 0u;
#pragma unroll
    for (unsigned j = 0; j < 16; ++j) { const unsigned c = xb_ld(&bar[XB_XCNT(j)]); sum += c; cnt += (c > 0u) ? 1u : 0u; mine = (j == x) ? c : mine; }
    if (sum == G) break;
    __builtin_amdgcn_s_sleep(1);
    if ((++sp & 255u) == 0u) { if (xb_ld(&bar[XB_TMO])) break; if (sp > XB_SPIN_CAP) { atomicAdd(&bar[XB_TMO], 1u); break; } }
  }
  nloc = mine > 0u ? mine : 1u; nx = cnt > 0u ? cnt : 1u;
}
DI void xcd_barrier(const XcdBarrier& b) {
  asm volatile("s_waitcnt vmcnt(0)" ::: "memory");
  __syncthreads();
  if (threadIdx.x == 0) {
    unsigned* bar = b.bar;
    __builtin_amdgcn_s_waitcnt(0);
    unsigned nloc = b.st[0], nx = b.st[1];
    if (nloc == 0u) { xcd_barrier_complete(bar, b.x, nloc, nx); b.st[0] = nloc; b.st[1] = nx; }
    const unsigned old = xb_add(&bar[XB_XSUB(b.x)], 1u);
    const unsigned gen = old / nloc;
    if (old + 1u == (gen + 1u) * nloc) {
      __builtin_amdgcn_fence(__ATOMIC_RELEASE, "agent");
      asm volatile("s_waitcnt vmcnt(0)" ::: "memory");
      const unsigned og = xb_add(&bar[XB_TOP], 1u);
      const unsigned tg = og / nx;
      if (og + 1u == (tg + 1u) * nx) xb_add(&bar[XB_TOPGEN], 1u);
      else XB_SPIN(xb_ld(&bar[XB_TOPGEN]) == tg, bar);
      __builtin_amdgcn_fence(__ATOMIC_ACQUIRE, "agent");
      xb_add(&bar[XB_XGEN(b.x)], 1u);
      asm volatile("s_waitcnt vmcnt(0)" ::: "memory");
    } else {
      XB_SPIN(xb_ld(&bar[XB_XGEN(b.x)]) == gen, bar);
      __builtin_amdgcn_fence(__ATOMIC_ACQUIRE, "agent");
      asm volatile("s_waitcnt vmcnt(0)" ::: "memory");
    }
  }
  __syncthreads();
}

__global__ void __launch_bounds__(256, 2) fwd_megakernel(Params p) {
  cg::grid_group grid = cg::this_grid();
  __shared__ __attribute__((aligned(16))) unsigned char smem[58368];
  h16* lds = (h16*)smem;
  const int bid = blockIdx.x, nb = gridDim.x;
  unsigned char* ws = p.ws;
  __shared__ u4v xb_words;
  if (threadIdx.x == 0) xb_words = (u4v){0u, 0u, 0u, 0u};
  __syncthreads();
  XcdBarrier xb = xcd_barrier_post((unsigned*)(ws + OFF_BAR), (volatile LAS unsigned*)&xb_words);

  phase_init(p, bid, nb);
  phase_convert(p, 0, bid, nb, lds);
  grid.sync();
  for (int l = 0; l < 4; ++l) {
    phase_p1(p, l, bid, nb, smem);
    xcd_barrier(xb);
    phase_m1(p, l, bid, nb, lds);
    xcd_barrier(xb);
    phase_m2(p, l, bid, nb, lds);
    xcd_barrier(xb);
    phase_m3(p, l, bid, nb, lds);
    xcd_barrier(xb);
    phase_gates(p, bid, nb, lds);
    xcd_barrier(xb);
    phase_merge(p, bid, nb, lds);
    xcd_barrier(xb);
    phase_resid_gemm(p, (const h16*)(ws + OFF_MERGED), DM, (const h16*)(ws + OFF_WOUT), 1024, (l == 0) ? p.x : p.out, bid, nb, lds);
    xcd_barrier(xb);
    phase_ln(p, l, 1, bid, nb);
    xcd_barrier(xb);
    if (l & 1) {
      phase_assign(p, bid, nb);
      xcd_barrier(xb);
      phase_ffn1_moe(p, bid, nb, lds);
      xcd_barrier(xb);
      phase_ffn2_moe(p, bid, nb, lds);
      xcd_barrier(xb);
    } else {
      phase_ffn1_dense(p, bid, nb, lds);
      xcd_barrier(xb);
      phase_resid_gemm(p, (const h16*)(ws + OFF_H), 2816, (const h16*)(ws + OFF_WFF) + (size_t)5632 * 1024, 2816, p.out, bid, nb, lds);
      xcd_barrier(xb);
    }
    phase_ln(p, l, 2, bid, nb);
    if (l + 1 < 4) { phase_convert(p, l + 1, bid, nb, lds); xcd_barrier(xb); }
  }
}

extern "C" void kernel_launch(void* const* d_in, const int* in_sizes, int n_in, void* d_out, int out_size, void* d_ws, size_t ws_size, hipStream_t stream) {
  static int grid_blocks = 0;
  if (!grid_blocks) {
    int dev = 0, cus = 0, per_cu = 0;
    hipGetDevice(&dev);
    hipDeviceGetAttribute(&cus, hipDeviceAttributeMultiprocessorCount, dev);
    hipOccupancyMaxActiveBlocksPerMultiprocessor(&per_cu, fwd_megakernel, 256, 0);
    if (per_cu > 2) per_cu = 2;
    if (per_cu < 1) per_cu = 1;
    grid_blocks = cus * per_cu;
    if (ws_size < WS_END) fprintf(stderr, "workspace too small: %zu < %zu\n", ws_size, (size_t)WS_END);
  }
  Params p{};
  const float* const* in = (const float* const*)d_in;
  p.x = in[0]; p.w_in = in[1]; p.a_gate_bias = in[2]; p.a_norm_w = in[3]; p.c_conv_w = in[4]; p.c_a_log = in[5]; p.c_dt_bias = in[6];
  p.c_norm_w = in[7]; p.d_sink = in[8]; p.w_br_a = in[9]; p.w_br_b = in[10]; p.w_br_c = in[11]; p.w_br_d = in[12]; p.w_out = in[13];
  p.ln1_w = in[14]; p.ln1_b = in[15]; p.ln2_w = in[16]; p.ln2_b = in[17]; p.ffn_w1 = in[18]; p.ffn_w3 = in[19]; p.ffn_w2 = in[20];
  p.moe_router = in[21]; p.moe_w1 = in[22]; p.moe_w3 = in[23]; p.moe_w2 = in[24];
  p.out = (float*)d_out; p.ws = (unsigned char*)d_ws;
  void* args[] = {&p};
  hipMemsetAsync((unsigned char*)d_ws + OFF_BAR, 0, XCD_BAR_WORDS * 4, stream);
  hipError_t e = hipLaunchCooperativeKernel((void*)fwd_megakernel, dim3(grid_blocks), dim3(256), args, 0, stream);
  if (e != hipSuccess) fprintf(stderr, "cooperative launch failed: %s (grid %d)\n", hipGetErrorString(e), grid_blocks);
}
```

```cpp
#include <hip/hip_runtime.h>
#include <hip/hip_cooperative_groups.h>
#include <cstdio>
namespace cg = cooperative_groups;

typedef _Float16 h16;
typedef h16 h8v __attribute__((ext_vector_type(8)));
typedef h16 h4v __attribute__((ext_vector_type(4)));
typedef float f4v __attribute__((ext_vector_type(4)));
typedef float f16v __attribute__((ext_vector_type(16)));
typedef unsigned int u4v __attribute__((ext_vector_type(4)));
#define DI __device__ __forceinline__

constexpr int SEQ = 16384, DM = 1024, NIN = 9248, NSM = 5120;
constexpr int LDH = 72;
constexpr float ALPHA = 1.6817928305074290f;
constexpr int NSLOT = 34816;
constexpr int HALF_LDS = 58368;
constexpr int LDS_BYTES = 147456;
constexpr int MLD = 68;

constexpr size_t OFF_X16 = 0;
constexpr size_t OFF_WSM = OFF_X16 + (size_t)SEQ * DM * 2;
constexpr size_t OFF_WG = OFF_WSM + (size_t)NSM * 1024 * 2;
constexpr size_t OFF_WBR = OFF_WG + (size_t)4096 * 1024 * 2;
constexpr size_t OFF_WOUT = OFF_WBR + (size_t)1280 * 1024 * 2;
constexpr size_t OFF_WFF = OFF_WOUT + (size_t)1024 * 1024 * 2;
constexpr size_t OFF_PS = OFF_WFF + (size_t)69206016;
constexpr size_t OFF_PSCAL = OFF_PS + (size_t)SEQ * NSM * 2;
constexpr size_t OFF_Y = OFF_PSCAL + (size_t)SEQ * 32 * 4;
constexpr size_t OFF_MERGED = OFF_Y + (size_t)SEQ * 1280 * 2;
constexpr size_t OFF_ROPE = OFF_MERGED + (size_t)SEQ * DM * 2;
constexpr size_t OFF_SCA = OFF_ROPE + (size_t)SEQ * 32 * 4 * 2;
constexpr size_t OFF_SCAS = OFF_SCA + (size_t)2048 * 4160 * 4;
constexpr size_t OFF_CQKV = OFF_SCAS + (size_t)2048 * 4 * 4;
constexpr size_t OFF_CU = OFF_CQKV + (size_t)SEQ * 768 * 2;
constexpr size_t OFF_CW = OFF_CU + (size_t)2048 * 4096 * 4;
constexpr size_t OFF_CKD = OFF_CW + (size_t)2048 * 4096 * 2;
constexpr size_t OFF_CDL = OFF_CKD + (size_t)2048 * 4096 * 2;
constexpr size_t OFF_CS = OFF_CDL + (size_t)2048 * 4;
constexpr size_t OFF_CVN = OFF_CS + (size_t)2048 * 4096 * 2;
constexpr size_t OFF_OB = OFF_CVN + (size_t)2048 * 4096 * 2;
constexpr size_t OFF_MLB = OFF_OB + (size_t)3 * SEQ * 256 * 2;
constexpr size_t OFF_MOE = OFF_MLB + (size_t)3 * SEQ * 4 * 2 * 4;
constexpr size_t MOE_CNT = OFF_MOE;
constexpr size_t MOE_TE = MOE_CNT + 256;
constexpr size_t MOE_TP = MOE_TE + 32768 * 4;
constexpr size_t MOE_TG = MOE_TP + 32768 * 4;
constexpr size_t MOE_TS = MOE_TG + 32768 * 4;
constexpr size_t MOE_ST = MOE_TS + 32768 * 4;
constexpr size_t MOE_SG = MOE_ST + (size_t)NSLOT * 4;
constexpr size_t OFF_BAR = (MOE_SG + (size_t)NSLOT * 4 + 255) & ~(size_t)255;
constexpr size_t WS_END = OFF_BAR + 16384;
constexpr size_t OFF_GATES = OFF_PS;
constexpr size_t OFF_H = OFF_PS;
constexpr size_t OFF_YB = OFF_Y;

struct Params {
  const float* x; const float* w_in; const float* a_gate_bias; const float* a_norm_w; const float* c_conv_w;
  const float* c_a_log; const float* c_dt_bias; const float* c_norm_w; const float* d_sink;
  const float* w_br_a; const float* w_br_b; const float* w_br_c; const float* w_br_d; const float* w_out;
  const float* ln1_w; const float* ln1_b; const float* ln2_w; const float* ln2_b;
  const float* ffn_w1; const float* ffn_w3; const float* ffn_w2;
  const float* moe_router; const float* moe_w1; const float* moe_w3; const float* moe_w2;
  float* out; unsigned char* ws;
};

DI int otid() { int t = threadIdx.x & 255; asm volatile("" : "+v"(t)); return t; }
DI int otid512() { int t = threadIdx.x; asm volatile("" : "+v"(t)); return t; }
DI float sigmoid_(float x) { return 1.f / (1.f + __expf(-x)); }
DI float silu_(float x) { return x / (1.f + __expf(-x)); }
DI float softplus_(float x) { return x > 20.f ? x : log1pf(__expf(x)); }
DI float logsigmoid_(float x) { return fminf(x, 0.f) - log1pf(__expf(-fabsf(x))); }
DI f4v mfma16(h8v a, h8v b, f4v c) { return __builtin_amdgcn_mfma_f32_16x16x32_f16(a, b, c, 0, 0, 0); }
DI f16v mfma32(h8v a, h8v b, f16v c) { return __builtin_amdgcn_mfma_f32_32x32x16_f16(a, b, c, 0, 0, 0); }
DI float wave_incl_sum(float v, int lane) {
#pragma unroll
  for (int o = 1; o < 64; o <<= 1) { float t = __shfl_up(v, o); if (lane >= o) v += t; }
  return v;
}
DI float wave_incl_max(float v, int lane) {
#pragma unroll
  for (int o = 1; o < 64; o <<= 1) { float t = __shfl_up(v, o); if (lane >= o) v = fmaxf(v, t); }
  return v;
}
DI float wave_max(float v) {
#pragma unroll
  for (int o = 32; o >= 1; o >>= 1) v = fmaxf(v, __shfl_xor(v, o));
  return v;
}
DI float wave_sum(float v) {
#pragma unroll
  for (int o = 32; o >= 1; o >>= 1) v += __shfl_xor(v, o);
  return v;
}
DI float grp16_sum(float v) { v += __shfl_xor(v, 1); v += __shfl_xor(v, 2); v += __shfl_xor(v, 4); v += __shfl_xor(v, 8); return v; }
DI float grp16_max(float v) { v = fmaxf(v, __shfl_xor(v, 1)); v = fmaxf(v, __shfl_xor(v, 2)); v = fmaxf(v, __shfl_xor(v, 4)); v = fmaxf(v, __shfl_xor(v, 8)); return v; }

DI void mm64(const h16* A, const h16* B, f4v (&acc)[4], int w, int lane) {
  const int r = lane & 15, q = lane >> 4;
#pragma unroll
  for (int s = 0; s < 2; ++s) {
    h8v a = *(const h8v*)&A[(16 * w + r) * LDH + 32 * s + 8 * q];
#pragma unroll
    for (int nt = 0; nt < 4; ++nt) {
      h8v b = *(const h8v*)&B[(16 * nt + r) * LDH + 32 * s + 8 * q];
      acc[nt] = mfma16(a, b, acc[nt]);
    }
  }
}
DI h8v perm_frag(const h16* img, int row, int s, int q) {
  h4v lo = *(const h4v*)&img[row * LDH + 32 * s + 4 * q];
  h4v hi = *(const h4v*)&img[row * LDH + 32 * s + 16 + 4 * q];
  return __builtin_shufflevector(lo, hi, 0, 1, 2, 3, 4, 5, 6, 7);
}
DI h8v pack8(f4v a, f4v b) {
  h8v r;
  r[0] = (h16)a[0]; r[1] = (h16)a[1]; r[2] = (h16)a[2]; r[3] = (h16)a[3];
  r[4] = (h16)b[0]; r[5] = (h16)b[1]; r[6] = (h16)b[2]; r[7] = (h16)b[3];
  return r;
}
DI void st_h4(h16* p, f4v v) { h4v o; o[0] = (h16)v[0]; o[1] = (h16)v[1]; o[2] = (h16)v[2]; o[3] = (h16)v[3]; *(h4v*)p = o; }

DI void conv_unit(const float* __restrict__ src, int ld, int col0, int k0, h16* __restrict__ dst, int K, int n0, h16* lds) {
  const int t = otid();
  __syncthreads();
  {
    const int c = t & 31, kq = t >> 5;
#pragma unroll
    for (int i = 0; i < 8; ++i) {
      int kk = kq + 8 * i;
      lds[c * LDH + kk] = (h16)src[(size_t)(k0 + kk) * ld + col0 + c];
    }
  }
  __syncthreads();
  {
    const int c = t >> 3, ks = (t & 7) * 8;
    *(u4v*)&dst[(size_t)(n0 + c) * K + k0 + ks] = *(const u4v*)&lds[c * LDH + ks];
  }
}

DI int map_small(int n) {
  if (n < 1024) return 4096 + n;
  if (n < 3328) return 5136 + (n - 1024);
  if (n < 4352) return 7440 + (n - 3328);
  return 8480 + (n - 4352);
}

DI void phase_convert(const Params& p, int l, int bid, int nb, h16* lds) {
  unsigned char* ws = p.ws;
  const float* win = p.w_in + (size_t)l * 1024 * NIN;
  const int jj = l >> 1;
  const bool moe = (l & 1);
  const int nffn = moe ? 8 * 2112 : (2816 + 1408);
  const int total = 2560 + 2048 + 640 + 512 + nffn;
  for (int u = bid; u < total; u += nb) {
    int v = u;
    const float* src; int ld, col0, k0, K, n0; h16* dst;
    if (v < 2560) { n0 = (v >> 4) * 32; k0 = (v & 15) * 64; col0 = map_small(n0); src = win; ld = NIN; K = 1024; dst = (h16*)(ws + OFF_WSM); }
    else if ((v -= 2560) < 2048) { n0 = (v >> 4) * 32; k0 = (v & 15) * 64; col0 = n0; src = win; ld = NIN; K = 1024; dst = (h16*)(ws + OFF_WG); }
    else if ((v -= 2048) < 640) {
      int b, kt;
      if (v < 384) { b = v >> 7; v &= 127; kt = 4; } else { b = 3; v -= 384; kt = 8; }
      n0 = (v / kt) * 32; k0 = (v % kt) * 64; K = kt * 64;
      const float* base = (b == 0) ? p.w_br_a : (b == 1) ? p.w_br_b : (b == 2) ? p.w_br_c : p.w_br_d;
      src = base + (size_t)l * K * 1024; ld = 1024; col0 = n0; dst = (h16*)(ws + OFF_WBR) + (size_t)b * 262144;
    }
    else if ((v -= 640) < 512) { n0 = (v >> 4) * 32; k0 = (v & 15) * 64; col0 = n0; src = p.w_out + (size_t)l * 1024 * 1024; ld = 1024; K = 1024; dst = (h16*)(ws + OFF_WOUT); }
    else {
      v -= 512;
      if (!moe) {
        if (v < 2816) {
          int nbk = v >> 4; k0 = (v & 15) * 64; n0 = nbk * 32; col0 = (nbk >> 1) * 32;
          src = ((nbk & 1) ? p.ffn_w3 : p.ffn_w1) + (size_t)jj * 1024 * 2816; ld = 2816; K = 1024; dst = (h16*)(ws + OFF_WFF);
        } else {
          v -= 2816; n0 = (v / 44) * 32; k0 = (v % 44) * 64; col0 = n0; K = 2816;
          src = p.ffn_w2 + (size_t)jj * 2816 * 1024; ld = 1024; dst = (h16*)(ws + OFF_WFF) + (size_t)5632 * 1024;
        }
      } else {
        int e = v / 2112; v -= e * 2112;
        if (v < 1408) {
          int nbk = v >> 4; k0 = (v & 15) * 64; n0 = nbk * 32; col0 = (nbk >> 1) * 32;
          src = ((nbk & 1) ? p.moe_w3 : p.moe_w1) + (size_t)(jj * 8 + e) * 1024 * 1408; ld = 1408; K = 1024;
          dst = (h16*)(ws + OFF_WFF) + (size_t)e * 2816 * 1024;
        } else {
          v -= 1408; n0 = (v / 22) * 32; k0 = (v % 22) * 64; col0 = n0; K = 1408;
          src = p.moe_w2 + (size_t)(jj * 8 + e) * 1408 * 1024; ld = 1024;
          dst = (h16*)(ws + OFF_WFF) + (size_t)8 * 2816 * 1024 + (size_t)e * 1024 * 1408;
        }
      }
    }
    conv_unit(src, ld, col0, k0, dst, K, n0, lds);
  }
  if (moe) {
    int* cnt = (int*)(ws + MOE_CNT);
    int* st = (int*)(ws + MOE_ST);
    const int gt = bid * 256 + otid(), gs = nb * 256;
    if (gt < 64) cnt[gt] = 0;
    for (int i = gt; i < NSLOT; i += gs) st[i] = 0;
  }
}

DI void phase_init(const Params& p, int bid, int nb) {
  float* rc = (float*)(p.ws + OFF_ROPE);
  float* rs = rc + (size_t)SEQ * 32;
  const int gt = bid * 256 + otid(), gs = nb * 256;
  for (int i = gt; i < SEQ * 32; i += gs) {
    int pos = i >> 5, d = i & 31;
    float inv = (float)pow(10000.0, -(double)d / 32.0);
    float ang = (float)pos * inv;
    rc[i] = cosf(ang); rs[i] = sinf(ang);
  }
  h16* x16 = (h16*)(p.ws + OFF_X16);
  for (int i = gt; i < SEQ * DM / 4; i += gs) {
    float4 v = ((const float4*)p.x)[i];
    h4v o; o[0] = (h16)v.x; o[1] = (h16)v.y; o[2] = (h16)v.z; o[3] = (h16)v.w;
    *(h4v*)&x16[(size_t)i * 4] = o;
  }
}

template <bool GATHER>
DI void gemm_main(const h16* __restrict__ A, int lda, const int* __restrict__ idx, int m0,
                  const h16* __restrict__ B, int ldb, int n0, int K, h16* lds, f16v (&acc)[2][2]) {
  const int tid = otid(), lane = tid & 63, wv = tid >> 6, wm = wv >> 1, wn = wv & 1;
  h16* As = lds; h16* Bs = lds + 128 * LDH;
  const int lr = tid >> 1, lc = (tid & 1) * 32;
  const h16* ap = A + (size_t)(GATHER ? idx[m0 + lr] : (m0 + lr)) * lda + lc;
  const h16* bp = B + (size_t)(n0 + lr) * ldb + lc;
  u4v ra[4], rb[4];
#pragma unroll
  for (int i = 0; i < 4; ++i) { ra[i] = *(const u4v*)(ap + 8 * i); rb[i] = *(const u4v*)(bp + 8 * i); }
  const int nk = K >> 6;
  for (int kt = 0; kt < nk; ++kt) {
    __syncthreads();
#pragma unroll
    for (int i = 0; i < 4; ++i) { *(u4v*)&As[lr * LDH + lc + 8 * i] = ra[i]; *(u4v*)&Bs[lr * LDH + lc + 8 * i] = rb[i]; }
    __syncthreads();
    if (kt + 1 < nk) {
      ap += 64; bp += 64;
#pragma unroll
      for (int i = 0; i < 4; ++i) { ra[i] = *(const u4v*)(ap + 8 * i); rb[i] = *(const u4v*)(bp + 8 * i); }
    }
#pragma unroll
    for (int ks = 0; ks < 4; ++ks) {
      h8v af[2], bf[2];
#pragma unroll
      for (int i = 0; i < 2; ++i) af[i] = *(const h8v*)&As[(wm * 64 + i * 32 + (lane & 31)) * LDH + ks * 16 + 8 * (lane >> 5)];
#pragma unroll
      for (int j = 0; j < 2; ++j) bf[j] = *(const h8v*)&Bs[(wn * 64 + j * 32 + (lane & 31)) * LDH + ks * 16 + 8 * (lane >> 5)];
#pragma unroll
      for (int i = 0; i < 2; ++i)
#pragma unroll
        for (int j = 0; j < 2; ++j) acc[i][j] = mfma32(bf[j], af[i], acc[i][j]);
    }
  }
}
DI void acc_zero(f16v (&acc)[2][2]) {
#pragma unroll
  for (int i = 0; i < 2; ++i)
#pragma unroll
    for (int j = 0; j < 2; ++j)
#pragma unroll
      for (int r = 0; r < 16; ++r) acc[i][j][r] = 0.f;
}
template <class Epi>
DI void gemm_epilogue(f16v (&acc)[2][2], int m0, int n0, Epi epi) {
  const int tid = otid(), lane = tid & 63, wv = tid >> 6, wm = wv >> 1, wn = wv & 1, h = lane >> 5;
#pragma unroll
  for (int i = 0; i < 2; ++i) {
    const int m = m0 + wm * 64 + i * 32 + (lane & 31);
#pragma unroll
    for (int g = 0; g < 4; ++g) {
      const int n = n0 + wn * 64 + 8 * g + 4 * h;
      f4v v0 = {acc[i][0][4 * g], acc[i][0][4 * g + 1], acc[i][0][4 * g + 2], acc[i][0][4 * g + 3]};
      f4v v1 = {acc[i][1][4 * g], acc[i][1][4 * g + 1], acc[i][1][4 * g + 2], acc[i][1][4 * g + 3]};
      epi(m, n, v0, v1);
    }
  }
}


template <bool GATHER>
DI void gemm256_main(const h16* __restrict__ A, int lda, const int* __restrict__ idx, int m0,
                     const h16* __restrict__ B, int ldb, int n0, int K, h16* lds, f16v (&acc)[4][2]) {
  const int tid = otid512(), lane = tid & 63, wv = tid >> 6, wm = wv >> 2, wn = wv & 3;
  const int lr = tid >> 1, lc = (tid & 1) * 32;
  unsigned ao = (unsigned)(GATHER ? idx[m0 + lr] : (m0 + lr)) * (unsigned)lda + lc;
  unsigned bo = (unsigned)(n0 + lr) * (unsigned)ldb + lc;
  const h16* ap = A; const h16* bp = B;
#define AP_ (ap + ao)
#define BP_ (bp + bo)
  u4v ra[4], rb[4];
  const int nk = K >> 6;
  __syncthreads();
#pragma unroll
  for (int i = 0; i < 4; ++i) { ra[i] = *(const u4v*)(AP_ + 8 * i); rb[i] = *(const u4v*)(BP_ + 8 * i); }
  ao += 64; bo += 64;
#pragma unroll
  for (int i = 0; i < 4; ++i) { *(u4v*)&lds[lr * LDH + lc + 8 * i] = ra[i]; *(u4v*)&lds[(256 + lr) * LDH + lc + 8 * i] = rb[i]; }
#pragma unroll
  for (int i = 0; i < 4; ++i) { ra[i] = *(const u4v*)(AP_ + 8 * i); rb[i] = *(const u4v*)(BP_ + 8 * i); }
  ao += 64; bo += 64;
  __syncthreads();
  for (int kt = 0; kt < nk; ++kt) {
    const h16* As = lds + (kt & 1) * (512 * LDH);
    const h16* Bs = As + 256 * LDH;
    h16* Wn = lds + ((kt & 1) ^ 1) * (512 * LDH);
    if (kt + 1 < nk) {
#pragma unroll
      for (int i = 0; i < 4; ++i) { *(u4v*)&Wn[lr * LDH + lc + 8 * i] = ra[i]; *(u4v*)&Wn[(256 + lr) * LDH + lc + 8 * i] = rb[i]; }
    }
    if (kt + 2 < nk) {
#pragma unroll
      for (int i = 0; i < 4; ++i) { ra[i] = *(const u4v*)(AP_ + 8 * i); rb[i] = *(const u4v*)(BP_ + 8 * i); }
      ao += 64; bo += 64;
    }
#pragma unroll 2
    for (int ks = 0; ks < 4; ++ks) {
      h8v af[4], bf[2];
#pragma unroll
      for (int i = 0; i < 4; ++i) af[i] = *(const h8v*)&As[(wm * 128 + i * 32 + (lane & 31)) * LDH + ks * 16 + 8 * (lane >> 5)];
#pragma unroll
      for (int j = 0; j < 2; ++j) bf[j] = *(const h8v*)&Bs[(wn * 64 + j * 32 + (lane & 31)) * LDH + ks * 16 + 8 * (lane >> 5)];
#pragma unroll
      for (int i = 0; i < 4; ++i)
#pragma unroll
        for (int j = 0; j < 2; ++j) acc[i][j] = mfma32(bf[j], af[i], acc[i][j]);
    }
    __syncthreads();
  }
}
DI void acc256_zero(f16v (&acc)[4][2]) {
#pragma unroll
  for (int i = 0; i < 4; ++i)
#pragma unroll
    for (int j = 0; j < 2; ++j)
#pragma unroll
      for (int r = 0; r < 16; ++r) acc[i][j][r] = 0.f;
}
template <class Epi>
DI void gemm256_epilogue(f16v (&acc)[4][2], int m0, int n0, Epi epi) {
  const int tid = otid512(), lane = tid & 63, wv = tid >> 6, wm = wv >> 2, wn = wv & 3, h = lane >> 5;
#pragma unroll
  for (int i = 0; i < 4; ++i) {
    const int m = m0 + wm * 128 + i * 32 + (lane & 31);
#pragma unroll
    for (int g = 0; g < 4; ++g) {
      const int n = n0 + wn * 64 + 8 * g + 4 * h;
      f4v v0 = {acc[i][0][4 * g], acc[i][0][4 * g + 1], acc[i][0][4 * g + 2], acc[i][0][4 * g + 3]};
      f4v v1 = {acc[i][1][4 * g], acc[i][1][4 * g + 1], acc[i][1][4 * g + 2], acc[i][1][4 * g + 3]};
      epi(m, n, v0, v1);
    }
  }
}

DI void scal_unit(const Params& p, int l, int unit, float* lds) {
  const float* xs = (l == 0) ? p.x : p.out;
  const float* win = p.w_in + (size_t)l * 1024 * NIN;
  float* ps = (float*)(p.ws + OFF_PSCAL);
  float* xt = lds;
  float* wt = lds + 64 * 68;
  const int t = otid(), lane = t & 63, w = t >> 6, r = lane & 15, q = lane >> 4;
  f4v acc[2];
  acc[0] = (f4v){0.f, 0.f, 0.f, 0.f}; acc[1] = (f4v){0.f, 0.f, 0.f, 0.f};
  const int t0 = unit * 64;
  for (int k0 = 0; k0 < 1024; k0 += 64) {
    __syncthreads();
#pragma unroll
    for (int i = 0; i < 4; ++i) { int e = t + 256 * i; int rr = e >> 4, c4 = (e & 15) * 4; *(f4v*)&xt[rr * 68 + c4] = *(const f4v*)&xs[(size_t)(t0 + rr) * DM + k0 + c4]; }
#pragma unroll
    for (int i = 0; i < 8; ++i) { int e = t + 256 * i; int kk = e >> 5, c = e & 31; int col = (c < 16) ? (5120 + c) : (8464 + (c - 16)); wt[kk * 32 + c] = win[(size_t)(k0 + kk) * NIN + col]; }
    __syncthreads();
#pragma unroll
    for (int ks = 0; ks < 16; ++ks) {
      const float a = xt[(16 * w + r) * 68 + ks * 4 + q];
      const float b0 = wt[(ks * 4 + q) * 32 + r], b1 = wt[(ks * 4 + q) * 32 + 16 + r];
      acc[0] = __builtin_amdgcn_mfma_f32_16x16x4f32(a, b0, acc[0], 0, 0, 0);
      acc[1] = __builtin_amdgcn_mfma_f32_16x16x4f32(a, b1, acc[1], 0, 0, 0);
    }
  }
#pragma unroll
  for (int nt = 0; nt < 2; ++nt)
#pragma unroll
    for (int rg = 0; rg < 4; ++rg) ps[(size_t)(t0 + 16 * w + 4 * q + rg) * 32 + 16 * nt + r] = acc[nt][rg];
}

DI void phase_p1(const Params& p, int l, int bid, int nb, int vb, int vnb, unsigned char* smem, unsigned char* smem_half) {
  unsigned char* ws = p.ws;
  const h16* x16 = (const h16*)(ws + OFF_X16);
  const h16* wsm = (const h16*)(ws + OFF_WSM);
  h16* ps = (h16*)(ws + OFF_PS);
  const float* rc = (const float*)(ws + OFF_ROPE);
  const float* rs = rc + (size_t)SEQ * 32;
  for (int u = vb; u < 256; u += vnb) scal_unit(p, l, u, (float*)smem_half);
  for (int u = bid; u < 64 * 20; u += nb) {
    const int m0 = (u / 20) * 256, n0 = (u % 20) * 256;
    f16v acc[4][2]; acc256_zero(acc);
    gemm256_main<false>(x16, DM, nullptr, m0, wsm, 1024, n0, 1024, (h16*)smem, acc);
    gemm256_epilogue(acc, m0, n0, [&](int m, int n, f4v v0, f4v v1) {
      const bool rope = (n >= 1024 && n < 2560) || (n >= 4352 && n < 4992);
      if (rope) {
        const int d = n & 31;
        f4v c = *(const f4v*)&rc[(size_t)m * 32 + d], s = *(const f4v*)&rs[(size_t)m * 32 + d];
        f4v o0 = v0 * c - v1 * s, o1 = v1 * c + v0 * s;
        v0 = o0; v1 = o1;
      }
      st_h4(&ps[(size_t)m * NSM + n], v0);
      st_h4(&ps[(size_t)m * NSM + n + 32], v1);
    });
  }
}

DI void img_store_nat(h16* img, int row, int seg, u4v a, u4v b) {
  *(u4v*)&img[row * LDH + 16 * seg] = a; *(u4v*)&img[row * LDH + 16 * seg + 8] = b;
}
DI void img_store_T(h16* img, int row, int seg, u4v a, u4v b) {
  const h16* pa = (const h16*)&a; const h16* pb = (const h16*)&b;
#pragma unroll
  for (int i = 0; i < 8; ++i) { img[(16 * seg + i) * LDH + row] = pa[i]; img[(16 * seg + 8 + i) * LDH + row] = pb[i]; }
}

template <int NKB>
DI void attn_unit(const Params& p, int l, int mode, int grp, int head, int r0, int dil, int i0, int sub_len, int W, h16* lds) {
  unsigned char* ws = p.ws;
  const h16* P = (const h16*)(ws + OFF_PS);
  h16* Qi = lds; h16* Ki = lds + 64 * LDH; h16* Vt = lds + 128 * LDH; h16* Pi = lds + 192 * LDH;
  const int tid = otid(), lane = tid & 63, w = tid >> 6, r = lane & 15, q = lane >> 4;
  const int lrow = tid >> 2, seg = tid & 3;
  int qcol, kcol, vcol;
  if (mode == 0) { qcol = 1024 + grp * 256 + head * 64; kcol = 1792 + grp * 256 + head * 64; vcol = 2560 + grp * 256 + head * 64; }
  else { qcol = 4352 + head * 64; kcol = 4864 + (head >> 2) * 64; vcol = 4992 + (head >> 2) * 64; }
  __syncthreads();
  {
    const size_t pos = (size_t)r0 + (size_t)dil * (i0 + lrow);
    const h16* g = P + pos * NSM + qcol + 16 * seg;
    img_store_nat(Qi, lrow, seg, *(const u4v*)g, *(const u4v*)(g + 8));
  }
  float mrow[4], lsum[4];
  f4v O[4];
  float m_init = -1e30f, l_init = 0.f;
  if (mode == 1) { m_init = p.d_sink[l * 8 + head]; l_init = 1.f; }
#pragma unroll
  for (int i = 0; i < 4; ++i) { mrow[i] = m_init; lsum[i] = l_init; O[i] = (f4v){0.f, 0.f, 0.f, 0.f}; }
  for (int kb = 0; kb < NKB; ++kb) {
    const int j0 = i0 - W + 64 * kb;
    const bool inr = (j0 >= 0) && (j0 < sub_len);
    const int j0c = inr ? j0 : i0;
    __syncthreads();
    {
      const size_t pos = (size_t)r0 + (size_t)dil * (j0c + lrow);
      const h16* gk = P + pos * NSM + kcol + 16 * seg;
      const h16* gv = P + pos * NSM + vcol + 16 * seg;
      img_store_nat(Ki, lrow, seg, *(const u4v*)gk, *(const u4v*)(gk + 8));
      img_store_T(Vt, lrow, seg, *(const u4v*)gv, *(const u4v*)(gv + 8));
    }
    __syncthreads();
    f4v S[4];
#pragma unroll
    for (int i = 0; i < 4; ++i) S[i] = (f4v){0.f, 0.f, 0.f, 0.f};
    mm64(Qi, Ki, S, w, lane);
    float mx[4], al[4], rsum[4];
    bool vm[4][4];
#pragma unroll
    for (int rg = 0; rg < 4; ++rg) {
      const int row = 16 * w + 4 * q + rg;
      float m_ = -1e30f;
#pragma unroll
      for (int nt = 0; nt < 4; ++nt) {
        const int key = 16 * nt + r;
        const int delta = row - key + W - 64 * kb;
        const bool ok = inr && (delta >= -W) && (delta <= W);
        vm[nt][rg] = ok;
        float s = S[nt][rg] * 0.125f;
        S[nt][rg] = s;
        if (ok) m_ = fmaxf(m_, s);
      }
      mx[rg] = grp16_max(m_);
    }
#pragma unroll
    for (int rg = 0; rg < 4; ++rg) {
      const float mn = fmaxf(mrow[rg], mx[rg]);
      al[rg] = __expf(mrow[rg] - mn);
      mrow[rg] = mn;
      float rs_ = 0.f;
#pragma unroll
      for (int nt = 0; nt < 4; ++nt) {
        float pv = vm[nt][rg] ? __expf(S[nt][rg] - mn) : 0.f;
        rs_ += pv;
        Pi[(16 * w + 4 * q + rg) * LDH + 16 * nt + r] = (h16)pv;
      }
      rsum[rg] = grp16_sum(rs_);
      lsum[rg] = lsum[rg] * al[rg] + rsum[rg];
    }
#pragma unroll
    for (int et = 0; et < 4; ++et)
#pragma unroll
      for (int rg = 0; rg < 4; ++rg) O[et][rg] *= al[rg];
    __syncthreads();
    mm64(Pi, Vt, O, w, lane);
  }
#pragma unroll
  for (int rg = 0; rg < 4; ++rg) {
    const int row = 16 * w + 4 * q + rg;
    const size_t pos = (size_t)r0 + (size_t)dil * (i0 + row);
    const float inv = 1.f / lsum[rg];
    if (mode == 0) {
      h16* ob = (h16*)(ws + OFF_OB) + ((size_t)grp * SEQ + pos) * 256 + head * 64;
#pragma unroll
      for (int et = 0; et < 4; ++et) ob[16 * et + r] = (h16)(O[et][rg] * inv);
      if (r == 0) {
        float* ml = (float*)(ws + OFF_MLB) + (((size_t)grp * SEQ + pos) * 4 + head) * 2;
        ml[0] = mrow[rg]; ml[1] = lsum[rg];
      }
    } else {
      h16* y = (h16*)(ws + OFF_Y) + pos * 1280 + 768 + head * 64;
#pragma unroll
      for (int et = 0; et < 4; ++et) y[16 * et + r] = (h16)(O[et][rg] * inv);
    }
  }
}

DI void bcombine_unit(const Params& p, int unit) {
  unsigned char* ws = p.ws;
  const int gi = unit * 256 + otid();
  const int seg = gi & 7, head = (gi >> 3) & 3, pos = gi >> 5;
  const float* ml = (const float*)(ws + OFF_MLB);
  const h16* ob = (const h16*)(ws + OFF_OB);
  float m[3], lv[3];
#pragma unroll
  for (int g = 0; g < 3; ++g) { const float* q = ml + (((size_t)g * SEQ + pos) * 4 + head) * 2; m[g] = q[0]; lv[g] = q[1]; }
  const float M = fmaxf(m[0], fmaxf(m[1], m[2]));
  float wg[3], den = 0.f;
#pragma unroll
  for (int g = 0; g < 3; ++g) { wg[g] = __expf(m[g] - M) * lv[g]; den += wg[g]; }
  const float inv = 1.f / den;
  float o[8];
#pragma unroll
  for (int i = 0; i < 8; ++i) o[i] = 0.f;
#pragma unroll
  for (int g = 0; g < 3; ++g) {
    h8v v = *(const h8v*)&ob[((size_t)g * SEQ + pos) * 256 + head * 64 + seg * 8];
#pragma unroll
    for (int i = 0; i < 8; ++i) o[i] += wg[g] * (float)v[i];
  }
  h8v ov;
#pragma unroll
  for (int i = 0; i < 8; ++i) ov[i] = (h16)(o[i] * inv);
  *(h8v*)((h16*)(ws + OFF_Y) + (size_t)pos * 1280 + 256 + head * 64 + seg * 8) = ov;
}

DI void mlstm_a1_unit(const Params& p, int l, int head, int oc, h16* lds) {
  unsigned char* ws = p.ws;
  const h16* P = (const h16*)(ws + OFF_PS);
  const float* pscal = (const float*)(ws + OFF_PSCAL);
  float* sca = (float*)(ws + OFF_SCA);
  float* scas = (float*)(ws + OFF_SCAS);
  h16* Ks0 = lds; h16* Ks1 = lds + 64 * LDH; h16* Vt = lds + 128 * LDH;
  float* sw = (float*)(lds + 192 * LDH);
  const int tid = otid(), lane = tid & 63, w = tid >> 6, r = lane & 15, q = lane >> 4;
  __syncthreads();
  if (w < 2) {
    const int dir = w;
    const int rr = dir ? 63 - lane : lane;
    const size_t pos = (size_t)oc * 64 + rr;
    const float* gb = p.a_gate_bias + l * 16;
    const float ig = pscal[pos * 32 + dir * 8 + head] + gb[dir * 8 + head];
    const float lf = logsigmoid_(pscal[pos * 32 + dir * 8 + 4 + head] + gb[dir * 8 + 4 + head]);
    const float b = wave_incl_sum(lf, lane);
    const float blast = __shfl(b, 63);
    const float slog = blast - b + ig;
    const float mc = wave_max(slog);
    sw[dir * 64 + rr] = __expf(slog - mc) * 0.125f;
    if (lane == 0) {
      const int nloc = dir ? 255 - oc : oc;
      float* s4 = scas + ((size_t)(dir * 4 + head) * 256 + nloc) * 4;
      s4[0] = blast; s4[1] = mc;
    }
  }
  __syncthreads();
  {
    const int lrow = tid >> 2, seg = tid & 3;
    const size_t pos = (size_t)oc * 64 + lrow;
    const h16* gk = P + pos * NSM + 256 + head * 64 + 16 * seg;
    const h16* gv = P + pos * NSM + 512 + head * 64 + 16 * seg;
    h8v k0 = *(const h8v*)gk, k1 = *(const h8v*)(gk + 8);
    u4v v0 = *(const u4v*)gv, v1 = *(const u4v*)(gv + 8);
    const float s0 = sw[lrow], s1 = sw[64 + lrow];
#pragma unroll
    for (int i = 0; i < 8; ++i) {
      Ks0[(16 * seg + i) * LDH + lrow] = (h16)((float)k0[i] * s0);
      Ks0[(16 * seg + 8 + i) * LDH + lrow] = (h16)((float)k1[i] * s0);
      Ks1[(16 * seg + i) * LDH + lrow] = (h16)((float)k0[i] * s1);
      Ks1[(16 * seg + 8 + i) * LDH + lrow] = (h16)((float)k1[i] * s1);
    }
    img_store_T(Vt, lrow, seg, v0, v1);
  }
  __syncthreads();
#pragma unroll
  for (int dir = 0; dir < 2; ++dir) {
    const h16* Ks = dir ? Ks1 : Ks0;
    const int nloc = dir ? 255 - oc : oc;
    float* dst = sca + ((size_t)(dir * 4 + head) * 256 + nloc) * 4160;
    f4v acc[4];
#pragma unroll
    for (int i = 0; i < 4; ++i) acc[i] = (f4v){0.f, 0.f, 0.f, 0.f};
    mm64(Vt, Ks, acc, w, lane);
#pragma unroll
    for (int nt = 0; nt < 4; ++nt)
#pragma unroll
      for (int rg = 0; rg < 4; ++rg) dst[(16 * w + 4 * q + rg) * 64 + 16 * nt + r] = acc[nt][rg];
    if (w == dir) {
      float s = 0.f;
#pragma unroll 8
      for (int j = 0; j < 64; ++j) s += (float)Ks[lane * LDH + j];
      dst[4096 + lane] = s;
    }
  }
}

DI void mlstm_a2_unit(const Params& p, int unit) {
  unsigned char* ws = p.ws;
  float* sca = (float*)(ws + OFF_SCA);
  float* scas = (float*)(ws + OFF_SCAS);
  const int dh = unit / 17, sl = unit % 17;
  const int e = sl * 256 + otid();
  if (e >= 4160) return;
  float* base = sca + (size_t)dh * 256 * 4160 + e;
  float* s4 = scas + (size_t)dh * 256 * 4;
  float m = 0.f, c = 0.f;
  for (int n0 = 0; n0 < 256; n0 += 8) {
    float cc[8];
#pragma unroll
    for (int i = 0; i < 8; ++i) cc[i] = base[(size_t)(n0 + i) * 4160];
#pragma unroll
    for (int i = 0; i < 8; ++i) {
      const float bl = s4[(n0 + i) * 4], mc = s4[(n0 + i) * 4 + 1];
      const float mn = fmaxf(bl + m, mc);
      const float dec = __expf(bl + m - mn), gain = __expf(mc - mn);
      base[(size_t)(n0 + i) * 4160] = c;
      if (e == 0) s4[(n0 + i) * 4 + 2] = m;
      c = dec * c + gain * cc[i];
      m = mn;
    }
  }
}

DI void mlstm_a3_unit(const Params& p, int l, int head, int oc, h16* lds) {
  unsigned char* ws = p.ws;
  const h16* P = (const h16*)(ws + OFF_PS);
  const float* pscal = (const float*)(ws + OFF_PSCAL);
  const float* sca = (const float*)(ws + OFF_SCA);
  const float* scas = (const float*)(ws + OFF_SCAS);
  h16* Qi = lds; h16* Ki = lds + 64 * LDH; h16* Vt = lds + 128 * LDH; h16* Wi = lds + 192 * LDH; h16* Ci = lds + 256 * LDH;
  float* fl = (float*)(lds + 320 * LDH);
  float* rowterm = fl;
  float* colterm = fl + 128;
  float* ainter = fl + 256;
  float* emt = fl + 384;
  float* nvec = fl + 512;
  float* qn = fl + 576;
  const int tid = otid(), lane = tid & 63, w = tid >> 6, r = lane & 15, q = lane >> 4;
  const int lrow = tid >> 2, seg = tid & 3;
  __syncthreads();
  {
    const size_t pos = (size_t)oc * 64 + lrow;
    const h16* g = P + pos * NSM + head * 64 + 16 * seg;
    img_store_nat(Qi, lrow, seg, *(const u4v*)g, *(const u4v*)(g + 8));
    img_store_nat(Ki, lrow, seg, *(const u4v*)(g + 256), *(const u4v*)(g + 264));
    img_store_T(Vt, lrow, seg, *(const u4v*)(g + 512), *(const u4v*)(g + 520));
  }
  if (w < 2) {
    const int dir = w;
    const int rr = dir ? 63 - lane : lane;
    const size_t pos = (size_t)oc * 64 + rr;
    const int nloc = dir ? 255 - oc : oc;
    const float* gb = p.a_gate_bias + l * 16;
    const float ig = pscal[pos * 32 + dir * 8 + head] + gb[dir * 8 + head];
    const float lf = logsigmoid_(pscal[pos * 32 + dir * 8 + 4 + head] + gb[dir * 8 + 4 + head]);
    const float b = wave_incl_sum(lf, lane);
    const float u = ig - b;
    const float pm = wave_incl_max(u, lane);
    const float m_intra = b + pm;
    const float mprev = scas[((size_t)(dir * 4 + head) * 256 + nloc) * 4 + 2];
    const float mt = fmaxf(b + mprev, m_intra);
    rowterm[dir * 64 + rr] = b - mt;
    colterm[dir * 64 + rr] = u;
    ainter[dir * 64 + rr] = __expf(b + mprev - mt);
    emt[dir * 64 + rr] = __expf(-mt);
  }
  f4v hacc[4];
#pragma unroll
  for (int i = 0; i < 4; ++i) hacc[i] = (f4v){0.f, 0.f, 0.f, 0.f};
#pragma unroll 1
  for (int dir = 0; dir < 2; ++dir) {
    const int nloc = dir ? 255 - oc : oc;
    const float* src = sca + ((size_t)(dir * 4 + head) * 256 + nloc) * 4160;
    __syncthreads();
    {
      const float4* s4 = (const float4*)(src + lrow * 64 + 16 * seg);
      float4 a = s4[0], b = s4[1], c = s4[2], d = s4[3];
      h8v o0, o1;
      o0[0] = (h16)a.x; o0[1] = (h16)a.y; o0[2] = (h16)a.z; o0[3] = (h16)a.w; o0[4] = (h16)b.x; o0[5] = (h16)b.y; o0[6] = (h16)b.z; o0[7] = (h16)b.w;
      o1[0] = (h16)c.x; o1[1] = (h16)c.y; o1[2] = (h16)c.z; o1[3] = (h16)c.w; o1[4] = (h16)d.x; o1[5] = (h16)d.y; o1[6] = (h16)d.z; o1[7] = (h16)d.w;
      *(h8v*)&Ci[lrow * LDH + 16 * seg] = o0; *(h8v*)&Ci[lrow * LDH + 16 * seg + 8] = o1;
      if (tid < 64) nvec[tid] = src[4096 + tid];
    }
    __syncthreads();
    f4v S[4];
#pragma unroll
    for (int i = 0; i < 4; ++i) S[i] = (f4v){0.f, 0.f, 0.f, 0.f};
    mm64(Qi, Ki, S, w, lane);
    float dint[4];
#pragma unroll
    for (int rg = 0; rg < 4; ++rg) {
      const int t = 16 * w + 4 * q + rg;
      const float rt = rowterm[dir * 64 + t];
      float sum = 0.f;
#pragma unroll
      for (int nt = 0; nt < 4; ++nt) {
        const int s = 16 * nt + r;
        const bool ok = dir ? (s >= t) : (s <= t);
        const float wv = ok ? __expf(rt + colterm[dir * 64 + s]) * S[nt][rg] * 0.125f : 0.f;
        sum += wv;
        Wi[t * LDH + s] = (h16)wv;
      }
      dint[rg] = grp16_sum(sum);
    }
    {
      float s = 0.f;
#pragma unroll
      for (int i = 0; i < 16; ++i) s += (float)Qi[lrow * LDH + 16 * seg + i] * nvec[16 * seg + i];
      s += __shfl_xor(s, 1); s += __shfl_xor(s, 2);
      if (seg == 0) qn[lrow] = s;
    }
    __syncthreads();
    f4v a1[4], a2[4];
#pragma unroll
    for (int i = 0; i < 4; ++i) { a1[i] = (f4v){0.f, 0.f, 0.f, 0.f}; a2[i] = (f4v){0.f, 0.f, 0.f, 0.f}; }
    mm64(Wi, Vt, a1, w, lane);
    mm64(Qi, Ci, a2, w, lane);
#pragma unroll
    for (int rg = 0; rg < 4; ++rg) {
      const int t = 16 * w + 4 * q + rg;
      const float ai = ainter[dir * 64 + t];
      const float den = ai * qn[t] + dint[rg];
      const float dn = 1.f / fmaxf(fabsf(den), emt[dir * 64 + t]);
#pragma unroll
      for (int et = 0; et < 4; ++et) hacc[et][rg] += (a1[et][rg] + ai * a2[et][rg]) * dn;
    }
  }
  const float* nw = p.a_norm_w + l * 256 + head * 64;
#pragma unroll
  for (int rg = 0; rg < 4; ++rg) {
    const int t = 16 * w + 4 * q + rg;
    const size_t pos = (size_t)oc * 64 + t;
    float s = hacc[0][rg] + hacc[1][rg] + hacc[2][rg] + hacc[3][rg];
    const float mu = grp16_sum(s) * (1.f / 64.f);
    float vs = 0.f;
#pragma unroll
    for (int et = 0; et < 4; ++et) { float d = hacc[et][rg] - mu; vs += d * d; }
    const float var = grp16_sum(vs) * (1.f / 64.f);
    const float rstd = rsqrtf(var + 1e-5f);
    h16* y = (h16*)(ws + OFF_Y) + pos * 1280 + head * 64;
    const h16* ao = P + pos * NSM + 768 + head * 64;
#pragma unroll
    for (int et = 0; et < 4; ++et) {
      const int e = 16 * et + r;
      y[e] = (h16)((hacc[et][rg] - mu) * rstd * nw[e] * sigmoid_((float)ao[e]));
    }
  }
}

template <int DIR>
DI void dn_solve4(const float* M, const h16* Ki, const h16* Vi, const float* betal, const float* gcl, int half, int c, int pp, float (&x)[16]) {
  const h16* src = half ? (Ki + c) : (Vi + c);
#pragma unroll
  for (int k = 0; k < 16; ++k) x[k] = 0.f;
#pragma unroll
  for (int il = 0; il < 64; ++il) {
    const int ri = DIR ? 63 - il : il;
    float part = 0.f;
#pragma unroll
    for (int k = 0; k < (il + 3) / 4; ++k) {
      const int jl0 = 4 * k;
      float mv = DIR ? M[ri * MLD + 63 - jl0 - pp] : M[ri * MLD + jl0 + pp];
      if (jl0 + 3 >= il) mv = (jl0 + pp < il) ? mv : 0.f;
      part += mv * x[k];
    }
    part += __shfl_xor(part, 1); part += __shfl_xor(part, 2);
    const float e = half ? __expf(gcl[ri]) : 1.f;
    const float xi = betal[ri] * (float)src[ri * LDH] * e - part;
    if ((il & 3) == pp) x[il >> 2] = xi;
  }
}

DI void dn_c1_unit(const Params& p, int l, int head, int oc, h16* lds) {
  unsigned char* ws = p.ws;
  const h16* P = (const h16*)(ws + OFF_PS);
  const float* pscal = (const float*)(ws + OFF_PSCAL);
  h16* cq = (h16*)(ws + OFF_CQKV);
  h16* Ki = lds; h16* Vi = lds + 64 * LDH;
  float* M = (float*)(lds + 128 * LDH);
  float* betal = M + 64 * MLD;
  float* gcl = betal + 128;
  float* glast = gcl + 128;
  const int tid = otid(), lane = tid & 63, w = tid >> 6, r = lane & 15, q = lane >> 4;
  const int lrow = tid >> 2, seg = tid & 3;
  __syncthreads();
  {
    const int pos = oc * 64 + lrow;
    const float* cw = p.c_conv_w + (size_t)l * 5 * 768;
    float vq[16], vk[16], vv[16];
#pragma unroll
    for (int i = 0; i < 16; ++i) { vq[i] = 0.f; vk[i] = 0.f; vv[i] = 0.f; }
#pragma unroll
    for (int j = 0; j < 5; ++j) {
      const int pp = pos + j - 2;
      if (pp < 0 || pp >= SEQ) continue;
      const h16* g = P + (size_t)pp * NSM + 3328 + head * 64 + 16 * seg;
      h8v q0 = *(const h8v*)g, q1 = *(const h8v*)(g + 8);
      h8v k0 = *(const h8v*)(g + 256), k1 = *(const h8v*)(g + 264);
      h8v v0 = *(const h8v*)(g + 512), v1 = *(const h8v*)(g + 520);
      const float* wq = cw + j * 768 + head * 64 + 16 * seg;
#pragma unroll
      for (int i = 0; i < 8; ++i) {
        vq[i] += wq[i] * (float)q0[i]; vq[8 + i] += wq[8 + i] * (float)q1[i];
        vk[i] += wq[256 + i] * (float)k0[i]; vk[8 + i] += wq[264 + i] * (float)k1[i];
        vv[i] += wq[512 + i] * (float)v0[i]; vv[8 + i] += wq[520 + i] * (float)v1[i];
      }
    }
    float sq = 0.f, sk = 0.f;
#pragma unroll
    for (int i = 0; i < 16; ++i) { vq[i] = silu_(vq[i]); vk[i] = silu_(vk[i]); vv[i] = silu_(vv[i]); sq += vq[i] * vq[i]; sk += vk[i] * vk[i]; }
    sq += __shfl_xor(sq, 1); sq += __shfl_xor(sq, 2);
    sk += __shfl_xor(sk, 1); sk += __shfl_xor(sk, 2);
    const float rq = rsqrtf(sq + 1e-6f) * 0.125f, rk = rsqrtf(sk + 1e-6f);
    h8v oq0, oq1, ok0, ok1, ov0, ov1;
#pragma unroll
    for (int i = 0; i < 8; ++i) {
      oq0[i] = (h16)(vq[i] * rq); oq1[i] = (h16)(vq[8 + i] * rq);
      ok0[i] = (h16)(vk[i] * rk); ok1[i] = (h16)(vk[8 + i] * rk);
      ov0[i] = (h16)vv[i]; ov1[i] = (h16)vv[8 + i];
    }
    h16* o = cq + (size_t)pos * 768 + head * 64 + 16 * seg;
    *(h8v*)o = oq0; *(h8v*)(o + 8) = oq1;
    *(h8v*)(o + 256) = ok0; *(h8v*)(o + 264) = ok1;
    *(h8v*)(o + 512) = ov0; *(h8v*)(o + 520) = ov1;
    *(h8v*)&Ki[lrow * LDH + 16 * seg] = ok0; *(h8v*)&Ki[lrow * LDH + 16 * seg + 8] = ok1;
    *(h8v*)&Vi[lrow * LDH + 16 * seg] = ov0; *(h8v*)&Vi[lrow * LDH + 16 * seg + 8] = ov1;
  }
  if (w < 2) {
    const int dir = w;
    const int rr = dir ? 63 - lane : lane;
    const size_t pos = (size_t)oc * 64 + rr;
    const float beta = sigmoid_(pscal[pos * 32 + 16 + dir * 4 + head]);
    const float g = -__expf(p.c_a_log[l * 8 + dir * 4 + head]) * softplus_(pscal[pos * 32 + 24 + dir * 4 + head] + p.c_dt_bias[l * 8 + dir * 4 + head]);
    const float gc = wave_incl_sum(g, lane);
    const float gl = __shfl(gc, 63);
    betal[dir * 64 + rr] = beta; gcl[dir * 64 + rr] = gc;
    if (lane == 0) {
      glast[dir] = gl;
      const int nloc = dir ? 255 - oc : oc;
      ((float*)(ws + OFF_CDL))[(size_t)(dir * 4 + head) * 256 + nloc] = __expf(gl);
    }
  }
  __syncthreads();
  {
    f4v kk[4];
#pragma unroll
    for (int i = 0; i < 4; ++i) kk[i] = (f4v){0.f, 0.f, 0.f, 0.f};
    mm64(Ki, Ki, kk, w, lane);
#pragma unroll
    for (int nt = 0; nt < 4; ++nt)
#pragma unroll
      for (int rg = 0; rg < 4; ++rg) {
        const int i = 16 * w + 4 * q + rg, j = 16 * nt + r;
        float v = 0.f;
        if (j < i) v = betal[i] * kk[nt][rg] * __expf(gcl[i] - gcl[j]);
        else if (j > i) v = betal[64 + i] * kk[nt][rg] * __expf(gcl[64 + i] - gcl[64 + j]);
        M[i * MLD + j] = v;
      }
  }
  __syncthreads();
  {
    const int c = tid >> 2, pp = tid & 3;
#pragma unroll 1
    for (int dh2 = 0; dh2 < 4; ++dh2) {
      const int dir = dh2 >> 1, half = dh2 & 1;
      const int nloc = dir ? 255 - oc : oc;
      const size_t unit = (size_t)(dir * 4 + head) * 256 + nloc;
      float x[16];
      if (dir == 0) dn_solve4<0>(M, Ki, Vi, betal, gcl, half, c, pp, x);
      else dn_solve4<1>(M, Ki, Vi, betal + 64, gcl + 64, half, c, pp, x);
      if (half == 0) {
        float* ud = (float*)(ws + OFF_CU) + unit * 4096;
        const int slice = c >> 4, el = c & 15;
#pragma unroll
        for (int k = 0; k < 16; ++k) {
          const int il = 4 * k + pp;
          const int rr = dir ? 63 - il : il;
          ud[((slice * 4 + (rr >> 4)) * 64 + el + 16 * ((rr & 15) >> 2)) * 4 + (rr & 3)] = x[k];
        }
      } else {
        h16* wd = (h16*)(ws + OFF_CW) + unit * 4096;
        const int s = c >> 5, lq = (c & 15) >> 2, jjx = (c & 3) + 4 * ((c & 31) >> 4);
#pragma unroll
        for (int k = 0; k < 16; ++k) {
          const int il = 4 * k + pp;
          const int rr = dir ? 63 - il : il;
          wd[(((rr >> 4) * 2 + s) * 64 + (rr & 15) + 16 * lq) * 8 + jjx] = (h16)(-x[k]);
        }
      }
    }
  }
#pragma unroll
  for (int dir = 0; dir < 2; ++dir) {
    const int nloc = dir ? 255 - oc : oc;
    const size_t unit = (size_t)(dir * 4 + head) * 256 + nloc;
    h16* kd = (h16*)(ws + OFF_CKD) + unit * 4096;
    const float gl = glast[dir];
#pragma unroll
    for (int it = 0; it < 4; ++it) {
      const int e = tid + 256 * it;
      const int d = e & 63, rq = e >> 6;
      const int r0 = 4 * rq;
      h4v o;
#pragma unroll
      for (int i = 0; i < 4; ++i) o[i] = (h16)((float)Ki[(r0 + i) * LDH + d] * __expf(gl - gcl[dir * 64 + r0 + i]));
      const int tile = d >> 4, s = r0 >> 5, ln = (d & 15) + 16 * ((r0 & 15) >> 2), j4 = 4 * ((r0 & 31) >> 4);
      *(h4v*)&kd[((tile * 2 + s) * 64 + ln) * 8 + j4] = o;
    }
  }
}

DI void dn_c2_unit(const Params& p, int dh, int w) {
  unsigned char* ws = p.ws;
  const int tid = otid(), lane = tid & 63;
  if (tid >= 64) return;
  const h16* cw = (const h16*)(ws + OFF_CW) + (size_t)dh * 256 * 4096;
  const h16* ckd = (const h16*)(ws + OFF_CKD) + (size_t)dh * 256 * 4096;
  const float* cu = (const float*)(ws + OFF_CU) + (size_t)dh * 256 * 4096;
  const float* cdl = (const float*)(ws + OFF_CDL) + (size_t)dh * 256;
  h16* cs = (h16*)(ws + OFF_CS) + (size_t)dh * 256 * 4096;
  h16* cvn = (h16*)(ws + OFF_CVN) + (size_t)dh * 256 * 4096;
  f4v S[4];
#pragma unroll
  for (int i = 0; i < 4; ++i) S[i] = (f4v){0.f, 0.f, 0.f, 0.f};
  h8v wA[4][2], kA[4][2]; f4v uu[4]; float dl;
#pragma unroll
  for (int t = 0; t < 4; ++t) {
#pragma unroll
    for (int s = 0; s < 2; ++s) {
      wA[t][s] = *(const h8v*)&cw[((t * 2 + s) * 64 + lane) * 8];
      kA[t][s] = *(const h8v*)&ckd[((t * 2 + s) * 64 + lane) * 8];
    }
    uu[t] = *(const f4v*)&cu[((w * 4 + t) * 64 + lane) * 4];
  }
  dl = cdl[0];
  for (int n = 0; n < 256; ++n) {
    h8v wN[4][2], kN[4][2]; f4v uN[4]; float dlN = 0.f;
    const int nn = (n + 1 < 256) ? n + 1 : n;
    {
      const h16* cw1 = cw + (size_t)nn * 4096; const h16* ck1 = ckd + (size_t)nn * 4096; const float* cu1 = cu + (size_t)nn * 4096;
#pragma unroll
      for (int t = 0; t < 4; ++t) {
#pragma unroll
        for (int s = 0; s < 2; ++s) {
          wN[t][s] = *(const h8v*)&cw1[((t * 2 + s) * 64 + lane) * 8];
          kN[t][s] = *(const h8v*)&ck1[((t * 2 + s) * 64 + lane) * 8];
        }
        uN[t] = *(const f4v*)&cu1[((w * 4 + t) * 64 + lane) * 4];
      }
      dlN = cdl[nn];
    }
    h8v Sb[2];
    Sb[0] = pack8(S[0], S[1]); Sb[1] = pack8(S[2], S[3]);
    h16* cs1 = cs + (size_t)n * 4096; h16* cv1 = cvn + (size_t)n * 4096;
    *(h8v*)&cs1[((w * 2 + 0) * 64 + lane) * 8] = Sb[0];
    *(h8v*)&cs1[((w * 2 + 1) * 64 + lane) * 8] = Sb[1];
    f4v vn[4];
#pragma unroll
    for (int t = 0; t < 4; ++t) { vn[t] = uu[t]; vn[t] = mfma16(wA[t][0], Sb[0], vn[t]); vn[t] = mfma16(wA[t][1], Sb[1], vn[t]); }
    h8v Vb[2];
    Vb[0] = pack8(vn[0], vn[1]); Vb[1] = pack8(vn[2], vn[3]);
    *(h8v*)&cv1[((w * 2 + 0) * 64 + lane) * 8] = Vb[0];
    *(h8v*)&cv1[((w * 2 + 1) * 64 + lane) * 8] = Vb[1];
#pragma unroll
    for (int t = 0; t < 4; ++t) { S[t] *= dl; S[t] = mfma16(kA[t][0], Vb[0], S[t]); S[t] = mfma16(kA[t][1], Vb[1], S[t]); }
#pragma unroll
    for (int t = 0; t < 4; ++t) { wA[t][0] = wN[t][0]; wA[t][1] = wN[t][1]; kA[t][0] = kN[t][0]; kA[t][1] = kN[t][1]; uu[t] = uN[t]; }
    dl = dlN;
  }
}

DI void dn_c3_unit(const Params& p, int l, int head, int oc, h16* lds) {
  unsigned char* ws = p.ws;
  const h16* P = (const h16*)(ws + OFF_PS);
  const float* pscal = (const float*)(ws + OFF_PSCAL);
  const h16* cq = (const h16*)(ws + OFF_CQKV);
  h16* Qi = lds; h16* Ki = lds + 64 * LDH;
  h16* AT = lds + 128 * LDH;
  h16* QG = lds + 256 * LDH;
  float* gcl = (float*)(lds + 384 * LDH);
  float* Ol = (float*)lds;
  const int tid = otid(), lane = tid & 63, w = tid >> 6, r = lane & 15, q = lane >> 4;
  const int lrow = tid >> 2, seg = tid & 3;
  __syncthreads();
  {
    const size_t pos = (size_t)oc * 64 + lrow;
    const h16* g = cq + pos * 768 + head * 64 + 16 * seg;
    img_store_nat(Qi, lrow, seg, *(const u4v*)g, *(const u4v*)(g + 8));
    img_store_nat(Ki, lrow, seg, *(const u4v*)(g + 256), *(const u4v*)(g + 264));
  }
  if (w < 2) {
    const int dir = w;
    const int rr = dir ? 63 - lane : lane;
    const size_t pos = (size_t)oc * 64 + rr;
    const float g = -__expf(p.c_a_log[l * 8 + dir * 4 + head]) * softplus_(pscal[pos * 32 + 24 + dir * 4 + head] + p.c_dt_bias[l * 8 + dir * 4 + head]);
    gcl[dir * 64 + rr] = wave_incl_sum(g, lane);
  }
  __syncthreads();
  {
    f4v S[4];
#pragma unroll
    for (int i = 0; i < 4; ++i) S[i] = (f4v){0.f, 0.f, 0.f, 0.f};
    mm64(Qi, Ki, S, w, lane);
#pragma unroll
    for (int dir = 0; dir < 2; ++dir) {
#pragma unroll
      for (int nt = 0; nt < 4; ++nt)
#pragma unroll
        for (int rg = 0; rg < 4; ++rg) {
          const int i = 16 * w + 4 * q + rg, j = 16 * nt + r;
          const bool ok = dir ? (j >= i) : (j <= i);
          const float v = ok ? S[nt][rg] * __expf(gcl[dir * 64 + i] - gcl[dir * 64 + j]) : 0.f;
          AT[(dir * 64 + i) * LDH + j] = (h16)v;
        }
      const float eg = __expf(gcl[dir * 64 + lrow]);
#pragma unroll
      for (int i = 0; i < 16; ++i) QG[(dir * 64 + lrow) * LDH + 16 * seg + i] = (h16)((float)Qi[lrow * LDH + 16 * seg + i] * eg);
    }
  }
  __syncthreads();
  f4v o[4];
#pragma unroll
  for (int i = 0; i < 4; ++i) o[i] = (f4v){0.f, 0.f, 0.f, 0.f};
#pragma unroll
  for (int dir = 0; dir < 2; ++dir) {
    const int nloc = dir ? 255 - oc : oc;
    const size_t unit = (size_t)(dir * 4 + head) * 256 + nloc;
    const h16* cs = (const h16*)(ws + OFF_CS) + unit * 4096;
    const h16* cv = (const h16*)(ws + OFF_CVN) + unit * 4096;
#pragma unroll
    for (int s = 0; s < 2; ++s) {
      const h8v Sb = *(const h8v*)&cs[((w * 2 + s) * 64 + lane) * 8];
      const h8v Vb = *(const h8v*)&cv[((w * 2 + s) * 64 + lane) * 8];
#pragma unroll
      for (int it = 0; it < 4; ++it) {
        o[it] = mfma16(perm_frag(QG + dir * 64 * LDH, 16 * it + r, s, q), Sb, o[it]);
        o[it] = mfma16(perm_frag(AT + dir * 64 * LDH, 16 * it + r, s, q), Vb, o[it]);
      }
    }
  }
  __syncthreads();
#pragma unroll
  for (int it = 0; it < 4; ++it)
#pragma unroll
    for (int rg = 0; rg < 4; ++rg) Ol[(16 * it + 4 * q + rg) * 65 + 16 * w + r] = o[it][rg];
  __syncthreads();
  {
    const size_t pos = (size_t)oc * 64 + lrow;
    float v[16]; float ss = 0.f;
#pragma unroll
    for (int i = 0; i < 16; ++i) { v[i] = Ol[lrow * 65 + 16 * seg + i]; ss += v[i] * v[i]; }
    ss += __shfl_xor(ss, 1); ss += __shfl_xor(ss, 2);
    const float rms = rsqrtf(ss * (1.f / 64.f) + 1e-6f);
    const float* nw = p.c_norm_w + l * 64 + 16 * seg;
    const h16* cg_ = P + pos * NSM + 4096 + head * 64 + 16 * seg;
    h8v g0 = *(const h8v*)cg_, g1 = *(const h8v*)(cg_ + 8);
    h8v o0, o1;
#pragma unroll
    for (int i = 0; i < 8; ++i) {
      o0[i] = (h16)(v[i] * rms * nw[i] * silu_((float)g0[i]));
      o1[i] = (h16)(v[8 + i] * rms * nw[8 + i] * silu_((float)g1[i]));
    }
    h16* y = (h16*)(ws + OFF_Y) + pos * 1280 + 512 + head * 64 + 16 * seg;
    *(h8v*)y = o0; *(h8v*)(y + 8) = o1;
  }
}

DI void phase_m1(const Params& p, int l, int bid, int nb, h16* lds) {
  for (int u = bid; u < 2048; u += nb) {
    if (u < 1024) dn_c1_unit(p, l, u & 3, u >> 2, lds);
    else { const int v = u - 1024; mlstm_a1_unit(p, l, v & 3, v >> 2, lds); }
  }
}
DI void phase_m2(const Params& p, int l, int bid, int nb, h16* lds) {
  const int total = 32 + 136 + 2048 + 3072;
  for (int u = bid; u < total; u += nb) {
    int v = u;
    if (v < 32) { dn_c2_unit(p, v >> 2, v & 3); continue; }
    if ((v -= 32) < 136) { mlstm_a2_unit(p, v); continue; }
    if ((v -= 136) < 2048) { attn_unit<5>(p, l, 1, 0, v & 7, 0, 1, (v >> 3) * 64, SEQ, 128, lds); continue; }
    v -= 2048;
    const int grp = v >> 10, x = v & 1023, head = x & 3, tl = x >> 2;
    const int dil = (grp == 0) ? 1 : (grp == 1) ? 4 : 16;
    const int sub = SEQ / dil, tps = sub >> 6;
    const int res = tl / tps, ti = tl % tps;
    attn_unit<3>(p, l, 0, grp, head, res, dil, ti * 64, sub, 64, lds);
  }
}
DI void phase_m3(const Params& p, int l, int bid, int nb, h16* lds) {
  const int total = 1024 + 1024 + 2048;
  for (int u = bid; u < total; u += nb) {
    int v = u;
    if (v < 1024) { mlstm_a3_unit(p, l, v & 3, v >> 2, lds); continue; }
    if ((v -= 1024) < 1024) { dn_c3_unit(p, l, v & 3, v >> 2, lds); continue; }
    bcombine_unit(p, v - 1024);
  }
}

DI void phase_gates(const Params& p, int bid, int nb, h16* lds) {
  unsigned char* ws = p.ws;
  const h16* x16 = (const h16*)(ws + OFF_X16);
  const h16* wg = (const h16*)(ws + OFF_WG);
  h16* G = (h16*)(ws + OFF_GATES);
  for (int u = bid; u < 64 * 16; u += nb) {
    const int m0 = (u >> 4) * 256, n0 = (u & 15) * 256;
    f16v acc[4][2]; acc256_zero(acc);
    gemm256_main<false>(x16, DM, nullptr, m0, wg, 1024, n0, 1024, lds, acc);
    gemm256_epilogue(acc, m0, n0, [&](int m, int n, f4v v0, f4v v1) {
      f4v a, b;
#pragma unroll
      for (int i = 0; i < 4; ++i) { a[i] = sigmoid_(v0[i]); b[i] = sigmoid_(v1[i]); }
      st_h4(&G[(size_t)m * 4096 + n], a); st_h4(&G[(size_t)m * 4096 + n + 32], b);
    });
  }
}
DI void phase_merge(const Params& p, int bid, int nb, h16* lds) {
  unsigned char* ws = p.ws;
  const h16* Y = (const h16*)(ws + OFF_Y);
  const h16* wbr = (const h16*)(ws + OFF_WBR);
  const h16* G = (const h16*)(ws + OFF_GATES);
  h16* Mg = (h16*)(ws + OFF_MERGED);
  for (int u = bid; u < 128 * 8; u += nb) {
    const int m0 = (u >> 3) * 128, n0 = (u & 7) * 128;
    f16v macc[2][2]; acc_zero(macc);
#pragma unroll 1
    for (int b = 0; b < 4; ++b) {
      const int Kb = (b == 3) ? 512 : 256;
      f16v acc[2][2]; acc_zero(acc);
      gemm_main<false>(Y + b * 256, 1280, nullptr, m0, wbr + (size_t)b * 262144, Kb, n0, Kb, lds, acc);
      const int tid = otid(), lane = tid & 63, wv = tid >> 6, wm = wv >> 1, wn = wv & 1, h = lane >> 5;
#pragma unroll
      for (int i = 0; i < 2; ++i) {
        const int m = m0 + wm * 64 + i * 32 + (lane & 31);
#pragma unroll
        for (int g = 0; g < 4; ++g) {
          const int n = n0 + wn * 64 + 8 * g + 4 * h;
          const h4v g0 = *(const h4v*)&G[(size_t)m * 4096 + b * 1024 + n];
          const h4v g1 = *(const h4v*)&G[(size_t)m * 4096 + b * 1024 + n + 32];
#pragma unroll
          for (int e = 0; e < 4; ++e) {
            macc[i][0][4 * g + e] += (float)g0[e] * acc[i][0][4 * g + e];
            macc[i][1][4 * g + e] += (float)g1[e] * acc[i][1][4 * g + e];
          }
        }
      }
    }
    gemm_epilogue(macc, m0, n0, [&](int m, int n, f4v v0, f4v v1) {
      st_h4(&Mg[(size_t)m * DM + n], v0); st_h4(&Mg[(size_t)m * DM + n + 32], v1);
    });
  }
}
DI void phase_resid_gemm(const Params& p, const h16* A, int lda, const h16* W, int K, const float* xres, int bid, int nb, h16* lds) {
  float* out = p.out;
  for (int u = bid; u < 64 * 4; u += nb) {
    const int m0 = (u >> 2) * 256, n0 = (u & 3) * 256;
    f16v acc[4][2]; acc256_zero(acc);
    gemm256_main<false>(A, lda, nullptr, m0, W, K, n0, K, lds, acc);
    gemm256_epilogue(acc, m0, n0, [&](int m, int n, f4v v0, f4v v1) {
      const f4v x0 = *(const f4v*)&xres[(size_t)m * DM + n], x1 = *(const f4v*)&xres[(size_t)m * DM + n + 32];
      *(f4v*)&out[(size_t)m * DM + n] = ALPHA * x0 + v0;
      *(f4v*)&out[(size_t)m * DM + n + 32] = ALPHA * x1 + v1;
    });
  }
}
DI void phase_ffn1_dense(const Params& p, int bid, int nb, h16* lds) {
  unsigned char* ws = p.ws;
  const h16* x16 = (const h16*)(ws + OFF_X16);
  const h16* w13 = (const h16*)(ws + OFF_WFF);
  h16* H = (h16*)(ws + OFF_H);
  for (int u = bid; u < 64 * 22; u += nb) {
    const int m0 = (u / 22) * 256, n0 = (u % 22) * 256;
    f16v acc[4][2]; acc256_zero(acc);
    gemm256_main<false>(x16, DM, nullptr, m0, w13, 1024, n0, 1024, lds, acc);
    gemm256_epilogue(acc, m0, n0, [&](int m, int n, f4v v0, f4v v1) {
      f4v hq;
#pragma unroll
      for (int i = 0; i < 4; ++i) hq[i] = silu_(v0[i]) * v1[i];
      st_h4(&H[(size_t)m * 2816 + (n >> 6) * 32 + (n & 31)], hq);
    });
  }
}
DI void moe_prefix(const int* cnt, int (&pstart)[9]) {
  int s = 0;
#pragma unroll
  for (int e = 0; e < 8; ++e) { pstart[e] = s; s += (cnt[e] + 255) & ~255; }
  pstart[8] = s;
}
DI void phase_ffn1_moe(const Params& p, int bid, int nb, h16* lds) {
  unsigned char* ws = p.ws;
  const h16* x16 = (const h16*)(ws + OFF_X16);
  const h16* w13 = (const h16*)(ws + OFF_WFF);
  h16* H = (h16*)(ws + OFF_H);
  const int* st = (const int*)(ws + MOE_ST);
  int ps[9]; moe_prefix((const int*)(ws + MOE_CNT), ps);
  const int ntl = (ps[8] >> 8) * 11;
  for (int u = bid; u < ntl; u += nb) {
    const int mt = u / 11, m0 = mt * 256, n0 = (u % 11) * 256;
    int e = 0;
#pragma unroll
    for (int i = 1; i < 8; ++i) if (m0 >= ps[i]) e = i;
    f16v acc[4][2]; acc256_zero(acc);
    gemm256_main<true>(x16, DM, st, m0, w13 + (size_t)e * 2816 * 1024, 1024, n0, 1024, lds, acc);
    gemm256_epilogue(acc, m0, n0, [&](int m, int n, f4v v0, f4v v1) {
      f4v hq;
#pragma unroll
      for (int i = 0; i < 4; ++i) hq[i] = silu_(v0[i]) * v1[i];
      st_h4(&H[(size_t)m * 1408 + (n >> 6) * 32 + (n & 31)], hq);
    });
  }
}
DI void phase_ffn2_moe(const Params& p, int bid, int nb, h16* lds) {
  unsigned char* ws = p.ws;
  const h16* H = (const h16*)(ws + OFF_H);
  const h16* w2 = (const h16*)(ws + OFF_WFF) + (size_t)8 * 2816 * 1024;
  h16* YB = (h16*)(ws + OFF_YB);
  const float* sg = (const float*)(ws + MOE_SG);
  int ps[9]; moe_prefix((const int*)(ws + MOE_CNT), ps);
  const int ntl = (ps[8] >> 8) * 4;
  for (int u = bid; u < ntl; u += nb) {
    const int mt = u >> 2, m0 = mt * 256, n0 = (u & 3) * 256;
    int e = 0;
#pragma unroll
    for (int i = 1; i < 8; ++i) if (m0 >= ps[i]) e = i;
    f16v acc[4][2]; acc256_zero(acc);
    gemm256_main<false>(H, 1408, nullptr, m0, w2 + (size_t)e * 1024 * 1408, 1408, n0, 1408, lds, acc);
    gemm256_epilogue(acc, m0, n0, [&](int m, int n, f4v v0, f4v v1) {
      const float g = sg[m];
      st_h4(&YB[(size_t)m * DM + n], g * v0); st_h4(&YB[(size_t)m * DM + n + 32], g * v1);
    });
  }
}

DI void phase_ln(const Params& p, int l, int which, int bid, int nb) {
  unsigned char* ws = p.ws;
  const bool moe = (l & 1);
  const bool moe_in = moe && which == 2;
  const bool router = moe && which == 1;
  const float* lw = (which == 1 ? p.ln1_w : p.ln2_w) + l * DM;
  const float* lb = (which == 1 ? p.ln1_b : p.ln2_b) + l * DM;
  float* out = p.out;
  h16* x16 = (h16*)(ws + OFF_X16);
  const int tid_ = otid(); const int lane = tid_ & 63, wv = tid_ >> 6;
  for (int row = bid * 4 + wv; row < SEQ; row += nb * 4) {
    float v[16];
#pragma unroll
    for (int i = 0; i < 4; ++i) {
      const f4v t = *(const f4v*)&out[(size_t)row * DM + 256 * i + lane * 4];
      v[4 * i] = t[0]; v[4 * i + 1] = t[1]; v[4 * i + 2] = t[2]; v[4 * i + 3] = t[3];
    }
    if (moe_in) {
      const int* ts = (const int*)(ws + MOE_TS);
      const h16* YB = (const h16*)(ws + OFF_YB);
      const int s0 = ts[row * 2], s1 = ts[row * 2 + 1];
#pragma unroll
      for (int i = 0; i < 4; ++i) {
        const h4v a = *(const h4v*)&YB[(size_t)s0 * DM + 256 * i + lane * 4];
        const h4v b = *(const h4v*)&YB[(size_t)s1 * DM + 256 * i + lane * 4];
#pragma unroll
        for (int e = 0; e < 4; ++e) v[4 * i + e] = ALPHA * v[4 * i + e] + ((float)a[e] + (float)b[e]);
      }
    }
    float s = 0.f;
#pragma unroll
    for (int i = 0; i < 16; ++i) s += v[i];
    const float mu = wave_sum(s) * (1.f / 1024.f);
    float vs = 0.f;
#pragma unroll
    for (int i = 0; i < 16; ++i) { const float d = v[i] - mu; vs += d * d; }
    const float rstd = rsqrtf(wave_sum(vs) * (1.f / 1024.f) + 1e-5f);
#pragma unroll
    for (int i = 0; i < 4; ++i) {
      const int c = 256 * i + lane * 4;
      const f4v w4 = *(const f4v*)&lw[c], b4 = *(const f4v*)&lb[c];
      f4v y;
#pragma unroll
      for (int e = 0; e < 4; ++e) { y[e] = (v[4 * i + e] - mu) * rstd * w4[e] + b4[e]; v[4 * i + e] = y[e]; }
      *(f4v*)&out[(size_t)row * DM + c] = y;
      st_h4(&x16[(size_t)row * DM + c], y);
    }
    if (router) {
      const float* rw = p.moe_router + (size_t)(l >> 1) * DM * 8;
      float lg[8];
#pragma unroll
      for (int e = 0; e < 8; ++e) lg[e] = 0.f;
#pragma unroll
      for (int i = 0; i < 4; ++i)
#pragma unroll
        for (int k = 0; k < 4; ++k) {
          const int c = 256 * i + lane * 4 + k;
          const f4v r0 = *(const f4v*)&rw[(size_t)c * 8], r1 = *(const f4v*)&rw[(size_t)c * 8 + 4];
          const float xv = v[4 * i + k];
#pragma unroll
          for (int e = 0; e < 4; ++e) { lg[e] += xv * r0[e]; lg[4 + e] += xv * r1[e]; }
        }
#pragma unroll
      for (int e = 0; e < 8; ++e) lg[e] = wave_sum(lg[e]);
      if (lane == 0) {
        int i1 = 0; float b1 = lg[0];
#pragma unroll
        for (int e = 1; e < 8; ++e) if (lg[e] > b1) { b1 = lg[e]; i1 = e; }
        int i2 = -1; float b2 = -3.4e38f;
#pragma unroll
        for (int e = 0; e < 8; ++e) if (e != i1 && lg[e] > b2) { b2 = lg[e]; i2 = e; }
        const float g1 = 1.f / (1.f + __expf(b2 - b1)), g2 = 1.f - g1;
        int* cnt = (int*)(ws + MOE_CNT);
        int* te = (int*)(ws + MOE_TE); int* tp = (int*)(ws + MOE_TP); float* tg = (float*)(ws + MOE_TG);
        te[row * 2] = i1; te[row * 2 + 1] = i2;
        tp[row * 2] = atomicAdd(&cnt[i1], 1); tp[row * 2 + 1] = atomicAdd(&cnt[i2], 1);
        tg[row * 2] = g1; tg[row * 2 + 1] = g2;
      }
    }
  }
}
DI void phase_assign(const Params& p, int bid, int nb) {
  unsigned char* ws = p.ws;
  int ps[9]; moe_prefix((const int*)(ws + MOE_CNT), ps);
  const int* te = (const int*)(ws + MOE_TE); const int* tp = (const int*)(ws + MOE_TP); const float* tg = (const float*)(ws + MOE_TG);
  int* ts = (int*)(ws + MOE_TS); int* st = (int*)(ws + MOE_ST); float* sg = (float*)(ws + MOE_SG);
  for (int i = bid * 256 + otid(); i < 32768; i += nb * 256) {
    const int e = te[i];
    int base = 0;
#pragma unroll
    for (int k = 0; k < 8; ++k) if (e == k) base = ps[k];
    const int slot = base + tp[i];
    ts[i] = slot; st[slot] = i >> 1; sg[slot] = tg[i];
  }
}


#define XB_TMO      128
#define XB_XCNT(j)  (256  + 64 * (j))
#define XB_XSUB(j)  (1280 + 64 * (j))
#define XB_XGEN(j)  (2304 + 64 * (j))
#define XB_TOP      3328
#define XB_TOPGEN   3392
#define XCD_BAR_WORDS 3456
#define XB_SPIN_CAP (1u << 22)
#define LAS __attribute__((address_space(3)))
DI unsigned xb_ld(unsigned* p) { return __hip_atomic_load(p, __ATOMIC_RELAXED, __HIP_MEMORY_SCOPE_AGENT); }
DI unsigned xb_add(unsigned* p, unsigned v) { return __hip_atomic_fetch_add(p, v, __ATOMIC_RELAXED, __HIP_MEMORY_SCOPE_AGENT); }
DI unsigned xb_xcc_id() { return (unsigned)__builtin_amdgcn_s_getreg((3 << 11) | 20) & 0xFu; }
#define XB_SPIN(cond, bar) do { unsigned _sp = 0; while (cond) { __builtin_amdgcn_s_sleep(1); \
    if ((++_sp & 255u) == 0u) { if (xb_ld(&(bar)[XB_TMO])) break; if (_sp > XB_SPIN_CAP) { atomicAdd(&(bar)[XB_TMO], 1u); break; } } } } while (0)
struct XcdBarrier { unsigned* bar; unsigned x; volatile LAS unsigned* st; };
DI XcdBarrier xcd_barrier_post(unsigned* bar, volatile LAS unsigned* st) {
  XcdBarrier b; b.bar = bar; b.x = xb_xcc_id(); b.st = st;
  if (threadIdx.x == 0) (void)xb_add(&bar[XB_XCNT(b.x)], 1u);
  return b;
}
DI void xcd_barrier_complete(unsigned* bar, unsigned x, unsigned& nloc, unsigned& nx) {
  const unsigned G = gridDim.x * gridDim.y * gridDim.z;
  unsigned sum, cnt, mine, sp = 0u;
  for (;;) {
    sum = 0u; cnt = 0u; mine = 0u;
#pragma unroll
    for (unsigned j = 0; j < 16; ++j) { const unsigned c = xb_ld(&bar[XB_XCNT(j)]); sum += c; cnt += (c > 0u) ? 1u : 0u; mine = (j == x) ? c : mine; }
    if (sum == G) break;
    __builtin_amdgcn_s_sleep(1);
    if ((++sp & 255u) == 0u) { if (xb_ld(&bar[XB_TMO])) break; if (sp > XB_SPIN_CAP) { atomicAdd(&bar[XB_TMO], 1u); break; } }
  }
  nloc = mine > 0u ? mine : 1u; nx = cnt > 0u ? cnt : 1u;
}
DI void xcd_barrier(const XcdBarrier& b) {
  asm volatile("s_waitcnt vmcnt(0)" ::: "memory");
  __syncthreads();
  if (threadIdx.x == 0) {
    unsigned* bar = b.bar;
    __builtin_amdgcn_s_waitcnt(0);
    unsigned nloc = b.st[0], nx = b.st[1];
    if (nloc == 0u) { xcd_barrier_complete(bar, b.x, nloc, nx); b.st[0] = nloc; b.st[1] = nx; }
    const unsigned old = xb_add(&bar[XB_XSUB(b.x)], 1u);
    const unsigned gen = old / nloc;
    if (old + 1u == (gen + 1u) * nloc) {
      __builtin_amdgcn_fence(__ATOMIC_RELEASE, "agent");
      asm volatile("s_waitcnt vmcnt(0)" ::: "memory");
      const unsigned og = xb_add(&bar[XB_TOP], 1u);
      const unsigned tg = og / nx;
      if (og + 1u == (tg + 1u) * nx) xb_add(&bar[XB_TOPGEN], 1u);
      else XB_SPIN(xb_ld(&bar[XB_TOPGEN]) == tg, bar);
      __builtin_amdgcn_fence(__ATOMIC_ACQUIRE, "agent");
      xb_add(&bar[XB_XGEN(b.x)], 1u);
      asm volatile("s_waitcnt vmcnt(0)" ::: "memory");
    } else {
      XB_SPIN(xb_ld(&bar[XB_XGEN(b.x)]) == gen, bar);
      __builtin_amdgcn_fence(__ATOMIC_ACQUIRE, "agent");
      asm volatile("s_waitcnt vmcnt(0)" ::: "memory");
    }
  }
  __syncthreads();
}

extern __shared__ __attribute__((aligned(16))) unsigned char smem_dyn[];
__global__ void __launch_bounds__(512) fwd_megakernel(Params p) {
  cg::grid_group grid = cg::this_grid();
  unsigned char* smem = smem_dyn;
  const int half = threadIdx.x >> 8;
  unsigned char* smem_half = smem_dyn + half * HALF_LDS;
  h16* lds = (h16*)smem;
  h16* ldh = (h16*)smem_half;
  const int bid = blockIdx.x, nb = gridDim.x;
  const int vb = bid * 2 + half, vnb = nb * 2;
  unsigned char* ws = p.ws;
  __shared__ u4v xb_words;
  if (threadIdx.x == 0) xb_words = (u4v){0u, 0u, 0u, 0u};
  __syncthreads();
  XcdBarrier xb = xcd_barrier_post((unsigned*)(ws + OFF_BAR), (volatile LAS unsigned*)&xb_words);

  phase_init(p, vb, vnb);
  phase_convert(p, 0, vb, vnb, ldh);
  grid.sync();
  for (int l = 0; l < 4; ++l) {
    phase_p1(p, l, bid, nb, vb, vnb, smem, smem_half);
    xcd_barrier(xb);
    phase_m1(p, l, vb, vnb, ldh);
    xcd_barrier(xb);
    phase_m2(p, l, vb, vnb, ldh);
    xcd_barrier(xb);
    phase_m3(p, l, vb, vnb, ldh);
    xcd_barrier(xb);
    phase_gates(p, bid, nb, lds);
    xcd_barrier(xb);
    phase_merge(p, vb, vnb, ldh);
    xcd_barrier(xb);
    phase_resid_gemm(p, (const h16*)(ws + OFF_MERGED), DM, (const h16*)(ws + OFF_WOUT), 1024, (l == 0) ? p.x : p.out, bid, nb, lds);
    xcd_barrier(xb);
    phase_ln(p, l, 1, vb, vnb);
    xcd_barrier(xb);
    if (l & 1) {
      phase_assign(p, vb, vnb);
      xcd_barrier(xb);
      phase_ffn1_moe(p, bid, nb, lds);
      xcd_barrier(xb);
      phase_ffn2_moe(p, bid, nb, lds);
      xcd_barrier(xb);
    } else {
      phase_ffn1_dense(p, bid, nb, lds);
      xcd_barrier(xb);
      phase_resid_gemm(p, (const h16*)(ws + OFF_H), 2816, (const h16*)(ws + OFF_WFF) + (size_t)5632 * 1024, 2816, p.out, bid, nb, lds);
      xcd_barrier(xb);
    }
    phase_ln(p, l, 2, vb, vnb);
    if (l + 1 < 4) { phase_convert(p, l + 1, vb, vnb, ldh); xcd_barrier(xb); }
  }
}

extern "C" void kernel_launch(void* const* d_in, const int* in_sizes, int n_in, void* d_out, int out_size, void* d_ws, size_t ws_size, hipStream_t stream) {
  static int grid_blocks = 0;
  if (!grid_blocks) {
    int dev = 0, cus = 0, per_cu = 0;
    hipGetDevice(&dev);
    hipDeviceGetAttribute(&cus, hipDeviceAttributeMultiprocessorCount, dev);
    hipFuncSetAttribute((const void*)fwd_megakernel, hipFuncAttributeMaxDynamicSharedMemorySize, LDS_BYTES);
    hipOccupancyMaxActiveBlocksPerMultiprocessor(&per_cu, fwd_megakernel, 512, LDS_BYTES);
    if (per_cu > 1) per_cu = 1;
    if (per_cu < 1) per_cu = 1;
    grid_blocks = cus * per_cu;
    if (ws_size < WS_END) fprintf(stderr, "workspace too small: %zu < %zu\n", ws_size, (size_t)WS_END);
  }
  Params p{};
  const float* const* in = (const float* const*)d_in;
  p.x = in[0]; p.w_in = in[1]; p.a_gate_bias = in[2]; p.a_norm_w = in[3]; p.c_conv_w = in[4]; p.c_a_log = in[5]; p.c_dt_bias = in[6];
  p.c_norm_w = in[7]; p.d_sink = in[8]; p.w_br_a = in[9]; p.w_br_b = in[10]; p.w_br_c = in[11]; p.w_br_d = in[12]; p.w_out = in[13];
  p.ln1_w = in[14]; p.ln1_b = in[15]; p.ln2_w = in[16]; p.ln2_b = in[17]; p.ffn_w1 = in[18]; p.ffn_w3 = in[19]; p.ffn_w2 = in[20];
  p.moe_router = in[21]; p.moe_w1 = in[22]; p.moe_w3 = in[23]; p.moe_w2 = in[24];
  p.out = (float*)d_out; p.ws = (unsigned char*)d_ws;
  void* args[] = {&p};
  hipMemsetAsync((unsigned char*)d_ws + OFF_BAR, 0, XCD_BAR_WORDS * 4, stream);
  hipError_t e = hipLaunchCooperativeKernel((void*)fwd_megakernel, dim3(grid_blocks), dim3(512), args, LDS_BYTES, stream);
  if (e != hipSuccess) fprintf(stderr, "cooperative launch failed: %s (grid %d)\n", hipGetErrorString(e), grid_blocks);
}
```

```cpp
#include <hip/hip_runtime.h>
#include <hip/hip_cooperative_groups.h>
#include <cstdio>
namespace cg = cooperative_groups;

typedef _Float16 h16;
typedef h16 h8v __attribute__((ext_vector_type(8)));
typedef h16 h4v __attribute__((ext_vector_type(4)));
typedef float f4v __attribute__((ext_vector_type(4)));
typedef float f16v __attribute__((ext_vector_type(16)));
typedef unsigned int u4v __attribute__((ext_vector_type(4)));
#define DI __device__ __forceinline__

constexpr int SEQ = 16384, DM = 1024, NIN = 9248, NSM = 5120;
constexpr int LDH = 72;
constexpr float ALPHA = 1.6817928305074290f;
constexpr int NSLOT = 34816;
constexpr int HALF_LDS = 58368;
constexpr int LDS_BYTES = 147456;
constexpr int MLD = 68;

constexpr size_t OFF_X16 = 0;
constexpr size_t OFF_WSM = OFF_X16 + (size_t)SEQ * DM * 2;
constexpr size_t OFF_WG = OFF_WSM + (size_t)NSM * 1024 * 2;
constexpr size_t OFF_WBR = OFF_WG + (size_t)4096 * 1024 * 2;
constexpr size_t OFF_WOUT = OFF_WBR + (size_t)1280 * 1024 * 2;
constexpr size_t OFF_WFF = OFF_WOUT + (size_t)1024 * 1024 * 2;
constexpr size_t OFF_PS = OFF_WFF + (size_t)69206016;
constexpr size_t OFF_PSCAL = OFF_PS + (size_t)SEQ * NSM * 2;
constexpr size_t OFF_Y = OFF_PSCAL + (size_t)SEQ * 32 * 4;
constexpr size_t OFF_MERGED = OFF_Y + (size_t)SEQ * 1280 * 2;
constexpr size_t OFF_ROPE = OFF_MERGED + (size_t)SEQ * DM * 2;
constexpr size_t OFF_SCA = OFF_ROPE + (size_t)SEQ * 32 * 4 * 2;
constexpr size_t OFF_SCAS = OFF_SCA + (size_t)2048 * 4160 * 4;
constexpr size_t OFF_CQKV = OFF_SCAS + (size_t)2048 * 4 * 4;
constexpr size_t OFF_CU = OFF_CQKV + (size_t)SEQ * 768 * 2;
constexpr size_t OFF_CW = OFF_CU + (size_t)2048 * 4096 * 4;
constexpr size_t OFF_CKD = OFF_CW + (size_t)2048 * 4096 * 2;
constexpr size_t OFF_CDL = OFF_CKD + (size_t)2048 * 4096 * 2;
constexpr size_t OFF_CS = OFF_CDL + (size_t)2048 * 4;
constexpr size_t OFF_CVN = OFF_CS + (size_t)2048 * 4096 * 2;
constexpr size_t OFF_OB = OFF_CVN + (size_t)2048 * 4096 * 2;
constexpr size_t OFF_MLB = OFF_OB + (size_t)3 * SEQ * 256 * 2;
constexpr size_t OFF_MOE = OFF_MLB + (size_t)3 * SEQ * 4 * 2 * 4;
constexpr size_t MOE_CNT = OFF_MOE;
constexpr size_t MOE_TE = MOE_CNT + 256;
constexpr size_t MOE_TP = MOE_TE + 32768 * 4;
constexpr size_t MOE_TG = MOE_TP + 32768 * 4;
constexpr size_t MOE_TS = MOE_TG + 32768 * 4;
constexpr size_t MOE_ST = MOE_TS + 32768 * 4;
constexpr size_t MOE_SG = MOE_ST + (size_t)NSLOT * 4;
constexpr size_t OFF_BAR = (MOE_SG + (size_t)NSLOT * 4 + 255) & ~(size_t)255;
constexpr size_t WS_END = OFF_BAR + 16384;
constexpr size_t OFF_GATES = OFF_PS;
constexpr size_t OFF_H = OFF_PS;
constexpr size_t OFF_YB = OFF_Y;

struct Params {
  const float* x; const float* w_in; const float* a_gate_bias; const float* a_norm_w; const float* c_conv_w;
  const float* c_a_log; const float* c_dt_bias; const float* c_norm_w; const float* d_sink;
  const float* w_br_a; const float* w_br_b; const float* w_br_c; const float* w_br_d; const float* w_out;
  const float* ln1_w; const float* ln1_b; const float* ln2_w; const float* ln2_b;
  const float* ffn_w1; const float* ffn_w3; const float* ffn_w2;
  const float* moe_router; const float* moe_w1; const float* moe_w3; const float* moe_w2;
  float* out; unsigned char* ws;
};

DI int otid() { int t = threadIdx.x & 255; asm volatile("" : "+v"(t)); return t; }
DI int otid512() { int t = threadIdx.x; asm volatile("" : "+v"(t)); return t; }
DI float sigmoid_(float x) { return 1.f / (1.f + __expf(-x)); }
DI float silu_(float x) { return x / (1.f + __expf(-x)); }
DI float softplus_(float x) { return x > 20.f ? x : log1pf(__expf(x)); }
DI float logsigmoid_(float x) { return fminf(x, 0.f) - log1pf(__expf(-fabsf(x))); }
DI f4v mfma16(h8v a, h8v b, f4v c) { return __builtin_amdgcn_mfma_f32_16x16x32_f16(a, b, c, 0, 0, 0); }
DI f16v mfma32(h8v a, h8v b, f16v c) { return __builtin_amdgcn_mfma_f32_32x32x16_f16(a, b, c, 0, 0, 0); }
DI float wave_incl_sum(float v, int lane) {
#pragma unroll
  for (int o = 1; o < 64; o <<= 1) { float t = __shfl_up(v, o); if (lane >= o) v += t; }
  return v;
}
DI float wave_incl_max(float v, int lane) {
#pragma unroll
  for (int o = 1; o < 64; o <<= 1) { float t = __shfl_up(v, o); if (lane >= o) v = fmaxf(v, t); }
  return v;
}
DI float wave_max(float v) {
#pragma unroll
  for (int o = 32; o >= 1; o >>= 1) v = fmaxf(v, __shfl_xor(v, o));
  return v;
}
DI float wave_sum(float v) {
#pragma unroll
  for (int o = 32; o >= 1; o >>= 1) v += __shfl_xor(v, o);
  return v;
}
DI float grp16_sum(float v) { v += __shfl_xor(v, 1); v += __shfl_xor(v, 2); v += __shfl_xor(v, 4); v += __shfl_xor(v, 8); return v; }
DI float grp16_max(float v) { v = fmaxf(v, __shfl_xor(v, 1)); v = fmaxf(v, __shfl_xor(v, 2)); v = fmaxf(v, __shfl_xor(v, 4)); v = fmaxf(v, __shfl_xor(v, 8)); return v; }

DI void mm64(const h16* A, const h16* B, f4v (&acc)[4], int w, int lane) {
  const int r = lane & 15, q = lane >> 4;
#pragma unroll
  for (int s = 0; s < 2; ++s) {
    h8v a = *(const h8v*)&A[(16 * w + r) * LDH + 32 * s + 8 * q];
#pragma unroll
    for (int nt = 0; nt < 4; ++nt) {
      h8v b = *(const h8v*)&B[(16 * nt + r) * LDH + 32 * s + 8 * q];
      acc[nt] = mfma16(a, b, acc[nt]);
    }
  }
}
DI h8v perm_frag(const h16* img, int row, int s, int q) {
  h4v lo = *(const h4v*)&img[row * LDH + 32 * s + 4 * q];
  h4v hi = *(const h4v*)&img[row * LDH + 32 * s + 16 + 4 * q];
  return __builtin_shufflevector(lo, hi, 0, 1, 2, 3, 4, 5, 6, 7);
}
DI h8v pack8(f4v a, f4v b) {
  h8v r;
  r[0] = (h16)a[0]; r[1] = (h16)a[1]; r[2] = (h16)a[2]; r[3] = (h16)a[3];
  r[4] = (h16)b[0]; r[5] = (h16)b[1]; r[6] = (h16)b[2]; r[7] = (h16)b[3];
  return r;
}
DI void st_h4(h16* p, f4v v) { h4v o; o[0] = (h16)v[0]; o[1] = (h16)v[1]; o[2] = (h16)v[2]; o[3] = (h16)v[3]; *(h4v*)p = o; }

DI void conv_unit(const float* __restrict__ src, int ld, int col0, int k0, h16* __restrict__ dst, int K, int n0, h16* lds) {
  const int t = otid();
  __syncthreads();
  {
    const int c = t & 31, kq = t >> 5;
#pragma unroll
    for (int i = 0; i < 8; ++i) {
      int kk = kq + 8 * i;
      lds[c * LDH + kk] = (h16)src[(size_t)(k0 + kk) * ld + col0 + c];
    }
  }
  __syncthreads();
  {
    const int c = t >> 3, ks = (t & 7) * 8;
    *(u4v*)&dst[(size_t)(n0 + c) * K + k0 + ks] = *(const u4v*)&lds[c * LDH + ks];
  }
}

DI int map_small(int n) {
  if (n < 1024) return 4096 + n;
  if (n < 3328) return 5136 + (n - 1024);
  if (n < 4352) return 7440 + (n - 3328);
  return 8480 + (n - 4352);
}

DI void phase_convert(const Params& p, int l, int bid, int nb, h16* lds) {
  asm volatile("" : "+v"(bid));
  unsigned char* ws = p.ws;
  const float* win = p.w_in + (size_t)l * 1024 * NIN;
  const int jj = l >> 1;
  const bool moe = (l & 1);
  const int nffn = moe ? 8 * 2112 : (2816 + 1408);
  const int total = 2560 + 2048 + 640 + 512 + nffn;
  for (int u = bid; u < total; u += nb) {
    int v = u;
    const float* src; int ld, col0, k0, K, n0; h16* dst;
    if (v < 2560) { n0 = (v >> 4) * 32; k0 = (v & 15) * 64; col0 = map_small(n0); src = win; ld = NIN; K = 1024; dst = (h16*)(ws + OFF_WSM); }
    else if ((v -= 2560) < 2048) { n0 = (v >> 4) * 32; k0 = (v & 15) * 64; col0 = n0; src = win; ld = NIN; K = 1024; dst = (h16*)(ws + OFF_WG); }
    else if ((v -= 2048) < 640) {
      int b, kt;
      if (v < 384) { b = v >> 7; v &= 127; kt = 4; } else { b = 3; v -= 384; kt = 8; }
      n0 = (v / kt) * 32; k0 = (v % kt) * 64; K = kt * 64;
      const float* base = (b == 0) ? p.w_br_a : (b == 1) ? p.w_br_b : (b == 2) ? p.w_br_c : p.w_br_d;
      src = base + (size_t)l * K * 1024; ld = 1024; col0 = n0; dst = (h16*)(ws + OFF_WBR) + (size_t)b * 262144;
    }
    else if ((v -= 640) < 512) { n0 = (v >> 4) * 32; k0 = (v & 15) * 64; col0 = n0; src = p.w_out + (size_t)l * 1024 * 1024; ld = 1024; K = 1024; dst = (h16*)(ws + OFF_WOUT); }
    else {
      v -= 512;
      if (!moe) {
        if (v < 2816) {
          int nbk = v >> 4; k0 = (v & 15) * 64; n0 = nbk * 32; col0 = (nbk >> 1) * 32;
          src = ((nbk & 1) ? p.ffn_w3 : p.ffn_w1) + (size_t)jj * 1024 * 2816; ld = 2816; K = 1024; dst = (h16*)(ws + OFF_WFF);
        } else {
          v -= 2816; n0 = (v / 44) * 32; k0 = (v % 44) * 64; col0 = n0; K = 2816;
          src = p.ffn_w2 + (size_t)jj * 2816 * 1024; ld = 1024; dst = (h16*)(ws + OFF_WFF) + (size_t)5632 * 1024;
        }
      } else {
        int e = v / 2112; v -= e * 2112;
        if (v < 1408) {
          int nbk = v >> 4; k0 = (v & 15) * 64; n0 = nbk * 32; col0 = (nbk >> 1) * 32;
          src = ((nbk & 1) ? p.moe_w3 : p.moe_w1) + (size_t)(jj * 8 + e) * 1024 * 1408; ld = 1408; K = 1024;
          dst = (h16*)(ws + OFF_WFF) + (size_t)e * 2816 * 1024;
        } else {
          v -= 1408; n0 = (v / 22) * 32; k0 = (v % 22) * 64; col0 = n0; K = 1408;
          src = p.moe_w2 + (size_t)(jj * 8 + e) * 1408 * 1024; ld = 1024;
          dst = (h16*)(ws + OFF_WFF) + (size_t)8 * 2816 * 1024 + (size_t)e * 1024 * 1408;
        }
      }
    }
    conv_unit(src, ld, col0, k0, dst, K, n0, lds);
  }
  if (moe) {
    int* cnt = (int*)(ws + MOE_CNT);
    int* st = (int*)(ws + MOE_ST);
    const int gt = bid * 256 + otid(), gs = nb * 256;
    if (gt < 64) cnt[gt] = 0;
    #pragma unroll 1
    for (int i = gt; i < NSLOT; i += gs) st[i] = 0;
  }
}

DI void phase_init(const Params& p, int bid, int nb) {
  asm volatile("" : "+v"(bid));
  float* rc = (float*)(p.ws + OFF_ROPE);
  float* rs = rc + (size_t)SEQ * 32;
  const int gt = bid * 256 + otid(), gs = nb * 256;
  #pragma unroll 1
  for (int i = gt; i < SEQ * 32; i += gs) {
    int pos = i >> 5, d = i & 31;
    float inv = (float)pow(10000.0, -(double)d / 32.0);
    float ang = (float)pos * inv;
    rc[i] = cosf(ang); rs[i] = sinf(ang);
  }
  h16* x16 = (h16*)(p.ws + OFF_X16);
  #pragma unroll 1
  for (int i = gt; i < SEQ * DM / 4; i += gs) {
    float4 v = ((const float4*)p.x)[i];
    h4v o; o[0] = (h16)v.x; o[1] = (h16)v.y; o[2] = (h16)v.z; o[3] = (h16)v.w;
    *(h4v*)&x16[(size_t)i * 4] = o;
  }
}

template <bool GATHER>
DI void gemm_main(const h16* __restrict__ A, int lda, const int* __restrict__ idx, int m0,
                  const h16* __restrict__ B, int ldb, int n0, int K, h16* lds, f16v (&acc)[2][2]) {
  const int tid = otid(), lane = tid & 63, wv = tid >> 6, wm = wv >> 1, wn = wv & 1;
  h16* As = lds; h16* Bs = lds + 128 * LDH;
  const int lr = tid >> 1, lc = (tid & 1) * 32;
  const h16* ap = A + (size_t)(GATHER ? idx[m0 + lr] : (m0 + lr)) * lda + lc;
  const h16* bp = B + (size_t)(n0 + lr) * ldb + lc;
  u4v ra[4], rb[4];
#pragma unroll
  for (int i = 0; i < 4; ++i) { ra[i] = *(const u4v*)(ap + 8 * i); rb[i] = *(const u4v*)(bp + 8 * i); }
  const int nk = K >> 6;
  for (int kt = 0; kt < nk; ++kt) {
    __syncthreads();
#pragma unroll
    for (int i = 0; i < 4; ++i) { *(u4v*)&As[lr * LDH + lc + 8 * i] = ra[i]; *(u4v*)&Bs[lr * LDH + lc + 8 * i] = rb[i]; }
    __syncthreads();
    if (kt + 1 < nk) {
      ap += 64; bp += 64;
#pragma unroll
      for (int i = 0; i < 4; ++i) { ra[i] = *(const u4v*)(ap + 8 * i); rb[i] = *(const u4v*)(bp + 8 * i); }
    }
#pragma unroll
    for (int ks = 0; ks < 4; ++ks) {
      h8v af[2], bf[2];
#pragma unroll
      for (int i = 0; i < 2; ++i) af[i] = *(const h8v*)&As[(wm * 64 + i * 32 + (lane & 31)) * LDH + ks * 16 + 8 * (lane >> 5)];
#pragma unroll
      for (int j = 0; j < 2; ++j) bf[j] = *(const h8v*)&Bs[(wn * 64 + j * 32 + (lane & 31)) * LDH + ks * 16 + 8 * (lane >> 5)];
#pragma unroll
      for (int i = 0; i < 2; ++i)
#pragma unroll
        for (int j = 0; j < 2; ++j) acc[i][j] = mfma32(bf[j], af[i], acc[i][j]);
    }
  }
}
DI void acc_zero(f16v (&acc)[2][2]) {
#pragma unroll
  for (int i = 0; i < 2; ++i)
#pragma unroll
    for (int j = 0; j < 2; ++j)
#pragma unroll
      for (int r = 0; r < 16; ++r) acc[i][j][r] = 0.f;
}
template <class Epi>
DI void gemm_epilogue(f16v (&acc)[2][2], int m0, int n0, Epi epi) {
  const int tid = otid(), lane = tid & 63, wv = tid >> 6, wm = wv >> 1, wn = wv & 1, h = lane >> 5;
#pragma unroll
  for (int i = 0; i < 2; ++i) {
    const int m = m0 + wm * 64 + i * 32 + (lane & 31);
#pragma unroll
    for (int g = 0; g < 4; ++g) {
      const int n = n0 + wn * 64 + 8 * g + 4 * h;
      f4v v0 = {acc[i][0][4 * g], acc[i][0][4 * g + 1], acc[i][0][4 * g + 2], acc[i][0][4 * g + 3]};
      f4v v1 = {acc[i][1][4 * g], acc[i][1][4 * g + 1], acc[i][1][4 * g + 2], acc[i][1][4 * g + 3]};
      epi(m, n, v0, v1);
    }
  }
}


template <bool GATHER>
DI void gemm256_main(const h16* __restrict__ A, int lda, const int* __restrict__ idx, int m0,
                     const h16* __restrict__ B, int ldb, int n0, int K, h16* lds, f16v (&acc)[4][2]) {
  const int tid = otid512(), lane = tid & 63, wv = tid >> 6, wm = wv >> 2, wn = wv & 3;
  const int lr = tid >> 1, lc = (tid & 1) * 32;
  unsigned ao = (unsigned)(GATHER ? idx[m0 + lr] : (m0 + lr)) * (unsigned)lda + lc;
  unsigned bo = (unsigned)(n0 + lr) * (unsigned)ldb + lc;
  const h16* ap = A; const h16* bp = B;
#define AP_ (ap + ao)
#define BP_ (bp + bo)
  u4v ra[4], rb[4];
  const int nk = K >> 6;
  __syncthreads();
#pragma unroll
  for (int i = 0; i < 4; ++i) { ra[i] = *(const u4v*)(AP_ + 8 * i); rb[i] = *(const u4v*)(BP_ + 8 * i); }
  ao += 64; bo += 64;
#pragma unroll
  for (int i = 0; i < 4; ++i) { *(u4v*)&lds[lr * LDH + lc + 8 * i] = ra[i]; *(u4v*)&lds[(256 + lr) * LDH + lc + 8 * i] = rb[i]; }
#pragma unroll
  for (int i = 0; i < 4; ++i) { ra[i] = *(const u4v*)(AP_ + 8 * i); rb[i] = *(const u4v*)(BP_ + 8 * i); }
  ao += 64; bo += 64;
  __syncthreads();
  for (int kt = 0; kt < nk; ++kt) {
    const h16* As = lds + (kt & 1) * (512 * LDH);
    const h16* Bs = As + 256 * LDH;
    h16* Wn = lds + ((kt & 1) ^ 1) * (512 * LDH);
    if (kt + 1 < nk) {
#pragma unroll
      for (int i = 0; i < 4; ++i) { *(u4v*)&Wn[lr * LDH + lc + 8 * i] = ra[i]; *(u4v*)&Wn[(256 + lr) * LDH + lc + 8 * i] = rb[i]; }
    }
    if (kt + 2 < nk) {
#pragma unroll
      for (int i = 0; i < 4; ++i) { ra[i] = *(const u4v*)(AP_ + 8 * i); rb[i] = *(const u4v*)(BP_ + 8 * i); }
      ao += 64; bo += 64;
    }
#pragma unroll
    for (int ks = 0; ks < 4; ++ks) {
      h8v af[4], bf[2];
#pragma unroll
      for (int i = 0; i < 4; ++i) af[i] = *(const h8v*)&As[(wm * 128 + i * 32 + (lane & 31)) * LDH + ks * 16 + 8 * (lane >> 5)];
#pragma unroll
      for (int j = 0; j < 2; ++j) bf[j] = *(const h8v*)&Bs[(wn * 64 + j * 32 + (lane & 31)) * LDH + ks * 16 + 8 * (lane >> 5)];
#pragma unroll
      for (int i = 0; i < 4; ++i)
#pragma unroll
        for (int j = 0; j < 2; ++j) acc[i][j] = mfma32(bf[j], af[i], acc[i][j]);
    }
    __syncthreads();
  }
}
DI void acc256_zero(f16v (&acc)[4][2]) {
#pragma unroll
  for (int i = 0; i < 4; ++i)
#pragma unroll
    for (int j = 0; j < 2; ++j)
#pragma unroll
      for (int r = 0; r < 16; ++r) acc[i][j][r] = 0.f;
}
template <class Epi>
DI void gemm256_epilogue(f16v (&acc)[4][2], int m0, int n0, Epi epi) {
  const int tid = otid512(), lane = tid & 63, wv = tid >> 6, wm = wv >> 2, wn = wv & 3, h = lane >> 5;
#pragma unroll
  for (int i = 0; i < 4; ++i) {
    const int m = m0 + wm * 128 + i * 32 + (lane & 31);
#pragma unroll
    for (int g = 0; g < 4; ++g) {
      const int n = n0 + wn * 64 + 8 * g + 4 * h;
      f4v v0 = {acc[i][0][4 * g], acc[i][0][4 * g + 1], acc[i][0][4 * g + 2], acc[i][0][4 * g + 3]};
      f4v v1 = {acc[i][1][4 * g], acc[i][1][4 * g + 1], acc[i][1][4 * g + 2], acc[i][1][4 * g + 3]};
      epi(m, n, v0, v1);
    }
  }
}

DI void scal_unit(const Params& p, int l, int unit, float* lds) {
  const float* xs = (l == 0) ? p.x : p.out;
  const float* win = p.w_in + (size_t)l * 1024 * NIN;
  float* ps = (float*)(p.ws + OFF_PSCAL);
  float* xt = lds;
  float* wt = lds + 64 * 68;
  const int t = otid(), lane = t & 63, w = t >> 6, r = lane & 15, q = lane >> 4;
  f4v acc[2];
  acc[0] = (f4v){0.f, 0.f, 0.f, 0.f}; acc[1] = (f4v){0.f, 0.f, 0.f, 0.f};
  const int t0 = unit * 64;
  for (int k0 = 0; k0 < 1024; k0 += 64) {
    __syncthreads();
#pragma unroll
    for (int i = 0; i < 4; ++i) { int e = t + 256 * i; int rr = e >> 4, c4 = (e & 15) * 4; *(f4v*)&xt[rr * 68 + c4] = *(const f4v*)&xs[(size_t)(t0 + rr) * DM + k0 + c4]; }
#pragma unroll
    for (int i = 0; i < 8; ++i) { int e = t + 256 * i; int kk = e >> 5, c = e & 31; int col = (c < 16) ? (5120 + c) : (8464 + (c - 16)); wt[kk * 32 + c] = win[(size_t)(k0 + kk) * NIN + col]; }
    __syncthreads();
#pragma unroll
    for (int ks = 0; ks < 16; ++ks) {
      const float a = xt[(16 * w + r) * 68 + ks * 4 + q];
      const float b0 = wt[(ks * 4 + q) * 32 + r], b1 = wt[(ks * 4 + q) * 32 + 16 + r];
      acc[0] = __builtin_amdgcn_mfma_f32_16x16x4f32(a, b0, acc[0], 0, 0, 0);
      acc[1] = __builtin_amdgcn_mfma_f32_16x16x4f32(a, b1, acc[1], 0, 0, 0);
    }
  }
#pragma unroll
  for (int nt = 0; nt < 2; ++nt)
#pragma unroll
    for (int rg = 0; rg < 4; ++rg) ps[(size_t)(t0 + 16 * w + 4 * q + rg) * 32 + 16 * nt + r] = acc[nt][rg];
}

DI void phase_p1(const Params& p, int l, int bid, int nb, int vb, int vnb, unsigned char* smem, unsigned char* smem_half) {
  asm volatile("" : "+v"(vb));
  unsigned char* ws = p.ws;
  const h16* x16 = (const h16*)(ws + OFF_X16);
  const h16* wsm = (const h16*)(ws + OFF_WSM);
  h16* ps = (h16*)(ws + OFF_PS);
  const float* rc = (const float*)(ws + OFF_ROPE);
  const float* rs = rc + (size_t)SEQ * 32;
  for (int u = vb; u < 256; u += vnb) scal_unit(p, l, u, (float*)smem_half);
  for (int u = bid; u < 64 * 20; u += nb) {
    const int m0 = (u / 20) * 256, n0 = (u % 20) * 256;
    f16v acc[4][2]; acc256_zero(acc);
    gemm256_main<false>(x16, DM, nullptr, m0, wsm, 1024, n0, 1024, (h16*)smem, acc);
    gemm256_epilogue(acc, m0, n0, [&](int m, int n, f4v v0, f4v v1) {
      const bool rope = (n >= 1024 && n < 2560) || (n >= 4352 && n < 4992);
      if (rope) {
        const int d = n & 31;
        f4v c = *(const f4v*)&rc[(size_t)m * 32 + d], s = *(const f4v*)&rs[(size_t)m * 32 + d];
        f4v o0 = v0 * c - v1 * s, o1 = v1 * c + v0 * s;
        v0 = o0; v1 = o1;
      }
      st_h4(&ps[(size_t)m * NSM + n], v0);
      st_h4(&ps[(size_t)m * NSM + n + 32], v1);
    });
  }
}

DI void img_store_nat(h16* img, int row, int seg, u4v a, u4v b) {
  *(u4v*)&img[row * LDH + 16 * seg] = a; *(u4v*)&img[row * LDH + 16 * seg + 8] = b;
}
DI void img_store_T(h16* img, int row, int seg, u4v a, u4v b) {
  const h16* pa = (const h16*)&a; const h16* pb = (const h16*)&b;
#pragma unroll
  for (int i = 0; i < 8; ++i) { img[(16 * seg + i) * LDH + row] = pa[i]; img[(16 * seg + 8 + i) * LDH + row] = pb[i]; }
}

template <int NKB>
DI void attn_unit(const Params& p, int l, int mode, int grp, int head, int r0, int dil, int i0, int sub_len, int W, h16* lds) {
  unsigned char* ws = p.ws;
  const h16* P = (const h16*)(ws + OFF_PS);
  h16* Qi = lds; h16* Ki = lds + 64 * LDH; h16* Vt = lds + 128 * LDH; h16* Pi = lds + 192 * LDH;
  const int tid = otid(), lane = tid & 63, w = tid >> 6, r = lane & 15, q = lane >> 4;
  const int lrow = tid >> 2, seg = tid & 3;
  int qcol, kcol, vcol;
  if (mode == 0) { qcol = 1024 + grp * 256 + head * 64; kcol = 1792 + grp * 256 + head * 64; vcol = 2560 + grp * 256 + head * 64; }
  else { qcol = 4352 + head * 64; kcol = 4864 + (head >> 2) * 64; vcol = 4992 + (head >> 2) * 64; }
  __syncthreads();
  {
    const size_t pos = (size_t)r0 + (size_t)dil * (i0 + lrow);
    const h16* g = P + pos * NSM + qcol + 16 * seg;
    img_store_nat(Qi, lrow, seg, *(const u4v*)g, *(const u4v*)(g + 8));
  }
  float mrow[4], lsum[4];
  f4v O[4];
  float m_init = -1e30f, l_init = 0.f;
  if (mode == 1) { m_init = p.d_sink[l * 8 + head]; l_init = 1.f; }
#pragma unroll
  for (int i = 0; i < 4; ++i) { mrow[i] = m_init; lsum[i] = l_init; O[i] = (f4v){0.f, 0.f, 0.f, 0.f}; }
  for (int kb = 0; kb < NKB; ++kb) {
    const int j0 = i0 - W + 64 * kb;
    const bool inr = (j0 >= 0) && (j0 < sub_len);
    const int j0c = inr ? j0 : i0;
    __syncthreads();
    {
      const size_t pos = (size_t)r0 + (size_t)dil * (j0c + lrow);
      const h16* gk = P + pos * NSM + kcol + 16 * seg;
      const h16* gv = P + pos * NSM + vcol + 16 * seg;
      img_store_nat(Ki, lrow, seg, *(const u4v*)gk, *(const u4v*)(gk + 8));
      img_store_T(Vt, lrow, seg, *(const u4v*)gv, *(const u4v*)(gv + 8));
    }
    __syncthreads();
    f4v S[4];
#pragma unroll
    for (int i = 0; i < 4; ++i) S[i] = (f4v){0.f, 0.f, 0.f, 0.f};
    mm64(Qi, Ki, S, w, lane);
    float mx[4], al[4], rsum[4];
    bool vm[4][4];
#pragma unroll
    for (int rg = 0; rg < 4; ++rg) {
      const int row = 16 * w + 4 * q + rg;
      float m_ = -1e30f;
#pragma unroll
      for (int nt = 0; nt < 4; ++nt) {
        const int key = 16 * nt + r;
        const int delta = row - key + W - 64 * kb;
        const bool ok = inr && (delta >= -W) && (delta <= W);
        vm[nt][rg] = ok;
        float s = S[nt][rg] * 0.125f;
        S[nt][rg] = s;
        if (ok) m_ = fmaxf(m_, s);
      }
      mx[rg] = grp16_max(m_);
    }
#pragma unroll
    for (int rg = 0; rg < 4; ++rg) {
      const float mn = fmaxf(mrow[rg], mx[rg]);
      al[rg] = __expf(mrow[rg] - mn);
      mrow[rg] = mn;
      float rs_ = 0.f;
#pragma unroll
      for (int nt = 0; nt < 4; ++nt) {
        float pv = vm[nt][rg] ? __expf(S[nt][rg] - mn) : 0.f;
        rs_ += pv;
        Pi[(16 * w + 4 * q + rg) * LDH + 16 * nt + r] = (h16)pv;
      }
      rsum[rg] = grp16_sum(rs_);
      lsum[rg] = lsum[rg] * al[rg] + rsum[rg];
    }
#pragma unroll
    for (int et = 0; et < 4; ++et)
#pragma unroll
      for (int rg = 0; rg < 4; ++rg) O[et][rg] *= al[rg];
    __syncthreads();
    mm64(Pi, Vt, O, w, lane);
  }
#pragma unroll
  for (int rg = 0; rg < 4; ++rg) {
    const int row = 16 * w + 4 * q + rg;
    const size_t pos = (size_t)r0 + (size_t)dil * (i0 + row);
    const float inv = 1.f / lsum[rg];
    if (mode == 0) {
      h16* ob = (h16*)(ws + OFF_OB) + ((size_t)grp * SEQ + pos) * 256 + head * 64;
#pragma unroll
      for (int et = 0; et < 4; ++et) ob[16 * et + r] = (h16)(O[et][rg] * inv);
      if (r == 0) {
        float* ml = (float*)(ws + OFF_MLB) + (((size_t)grp * SEQ + pos) * 4 + head) * 2;
        ml[0] = mrow[rg]; ml[1] = lsum[rg];
      }
    } else {
      h16* y = (h16*)(ws + OFF_Y) + pos * 1280 + 768 + head * 64;
#pragma unroll
      for (int et = 0; et < 4; ++et) y[16 * et + r] = (h16)(O[et][rg] * inv);
    }
  }
}

DI void bcombine_unit(const Params& p, int unit) {
  unsigned char* ws = p.ws;
  const int gi = unit * 256 + otid();
  const int seg = gi & 7, head = (gi >> 3) & 3, pos = gi >> 5;
  const float* ml = (const float*)(ws + OFF_MLB);
  const h16* ob = (const h16*)(ws + OFF_OB);
  float m[3], lv[3];
#pragma unroll
  for (int g = 0; g < 3; ++g) { const float* q = ml + (((size_t)g * SEQ + pos) * 4 + head) * 2; m[g] = q[0]; lv[g] = q[1]; }
  const float M = fmaxf(m[0], fmaxf(m[1], m[2]));
  float wg[3], den = 0.f;
#pragma unroll
  for (int g = 0; g < 3; ++g) { wg[g] = __expf(m[g] - M) * lv[g]; den += wg[g]; }
  const float inv = 1.f / den;
  float o[8];
#pragma unroll
  for (int i = 0; i < 8; ++i) o[i] = 0.f;
#pragma unroll
  for (int g = 0; g < 3; ++g) {
    h8v v = *(const h8v*)&ob[((size_t)g * SEQ + pos) * 256 + head * 64 + seg * 8];
#pragma unroll
    for (int i = 0; i < 8; ++i) o[i] += wg[g] * (float)v[i];
  }
  h8v ov;
#pragma unroll
  for (int i = 0; i < 8; ++i) ov[i] = (h16)(o[i] * inv);
  *(h8v*)((h16*)(ws + OFF_Y) + (size_t)pos * 1280 + 256 + head * 64 + seg * 8) = ov;
}

DI void mlstm_a1_unit(const Params& p, int l, int head, int oc, h16* lds) {
  unsigned char* ws = p.ws;
  const h16* P = (const h16*)(ws + OFF_PS);
  const float* pscal = (const float*)(ws + OFF_PSCAL);
  float* sca = (float*)(ws + OFF_SCA);
  float* scas = (float*)(ws + OFF_SCAS);
  h16* Ks0 = lds; h16* Ks1 = lds + 64 * LDH; h16* Vt = lds + 128 * LDH;
  float* sw = (float*)(lds + 192 * LDH);
  const int tid = otid(), lane = tid & 63, w = tid >> 6, r = lane & 15, q = lane >> 4;
  __syncthreads();
  if (w < 2) {
    const int dir = w;
    const int rr = dir ? 63 - lane : lane;
    const size_t pos = (size_t)oc * 64 + rr;
    const float* gb = p.a_gate_bias + l * 16;
    const float ig = pscal[pos * 32 + dir * 8 + head] + gb[dir * 8 + head];
    const float lf = logsigmoid_(pscal[pos * 32 + dir * 8 + 4 + head] + gb[dir * 8 + 4 + head]);
    const float b = wave_incl_sum(lf, lane);
    const float blast = __shfl(b, 63);
    const float slog = blast - b + ig;
    const float mc = wave_max(slog);
    sw[dir * 64 + rr] = __expf(slog - mc) * 0.125f;
    if (lane == 0) {
      const int nloc = dir ? 255 - oc : oc;
      float* s4 = scas + ((size_t)(dir * 4 + head) * 256 + nloc) * 4;
      s4[0] = blast; s4[1] = mc;
    }
  }
  __syncthreads();
  {
    const int lrow = tid >> 2, seg = tid & 3;
    const size_t pos = (size_t)oc * 64 + lrow;
    const h16* gk = P + pos * NSM + 256 + head * 64 + 16 * seg;
    const h16* gv = P + pos * NSM + 512 + head * 64 + 16 * seg;
    h8v k0 = *(const h8v*)gk, k1 = *(const h8v*)(gk + 8);
    u4v v0 = *(const u4v*)gv, v1 = *(const u4v*)(gv + 8);
    const float s0 = sw[lrow], s1 = sw[64 + lrow];
#pragma unroll
    for (int i = 0; i < 8; ++i) {
      Ks0[(16 * seg + i) * LDH + lrow] = (h16)((float)k0[i] * s0);
      Ks0[(16 * seg + 8 + i) * LDH + lrow] = (h16)((float)k1[i] * s0);
      Ks1[(16 * seg + i) * LDH + lrow] = (h16)((float)k0[i] * s1);
      Ks1[(16 * seg + 8 + i) * LDH + lrow] = (h16)((float)k1[i] * s1);
    }
    img_store_T(Vt, lrow, seg, v0, v1);
  }
  __syncthreads();
#pragma unroll
  for (int dir = 0; dir < 2; ++dir) {
    const h16* Ks = dir ? Ks1 : Ks0;
    const int nloc = dir ? 255 - oc : oc;
    float* dst = sca + ((size_t)(dir * 4 + head) * 256 + nloc) * 4160;
    f4v acc[4];
#pragma unroll
    for (int i = 0; i < 4; ++i) acc[i] = (f4v){0.f, 0.f, 0.f, 0.f};
    mm64(Vt, Ks, acc, w, lane);
#pragma unroll
    for (int nt = 0; nt < 4; ++nt)
#pragma unroll
      for (int rg = 0; rg < 4; ++rg) dst[(16 * w + 4 * q + rg) * 64 + 16 * nt + r] = acc[nt][rg];
    if (w == dir) {
      float s = 0.f;
#pragma unroll 8
      for (int j = 0; j < 64; ++j) s += (float)Ks[lane * LDH + j];
      dst[4096 + lane] = s;
    }
  }
}

DI void mlstm_a2_unit(const Params& p, int unit) {
  unsigned char* ws = p.ws;
  float* sca = (float*)(ws + OFF_SCA);
  float* scas = (float*)(ws + OFF_SCAS);
  const int dh = unit / 17, sl = unit % 17;
  const int e = sl * 256 + otid();
  if (e >= 4160) return;
  float* base = sca + (size_t)dh * 256 * 4160 + e;
  float* s4 = scas + (size_t)dh * 256 * 4;
  float m = 0.f, c = 0.f;
  for (int n0 = 0; n0 < 256; n0 += 8) {
    float cc[8];
#pragma unroll
    for (int i = 0; i < 8; ++i) cc[i] = base[(size_t)(n0 + i) * 4160];
#pragma unroll
    for (int i = 0; i < 8; ++i) {
      const float bl = s4[(n0 + i) * 4], mc = s4[(n0 + i) * 4 + 1];
      const float mn = fmaxf(bl + m, mc);
      const float dec = __expf(bl + m - mn), gain = __expf(mc - mn);
      base[(size_t)(n0 + i) * 4160] = c;
      if (e == 0) s4[(n0 + i) * 4 + 2] = m;
      c = dec * c + gain * cc[i];
      m = mn;
    }
  }
}

DI void mlstm_a3_unit(const Params& p, int l, int head, int oc, h16* lds) {
  unsigned char* ws = p.ws;
  const h16* P = (const h16*)(ws + OFF_PS);
  const float* pscal = (const float*)(ws + OFF_PSCAL);
  const float* sca = (const float*)(ws + OFF_SCA);
  const float* scas = (const float*)(ws + OFF_SCAS);
  h16* Qi = lds; h16* Ki = lds + 64 * LDH; h16* Vt = lds + 128 * LDH; h16* Wi = lds + 192 * LDH; h16* Ci = lds + 256 * LDH;
  float* fl = (float*)(lds + 320 * LDH);
  float* rowterm = fl;
  float* colterm = fl + 128;
  float* ainter = fl + 256;
  float* emt = fl + 384;
  float* nvec = fl + 512;
  float* qn = fl + 576;
  const int tid = otid(), lane = tid & 63, w = tid >> 6, r = lane & 15, q = lane >> 4;
  const int lrow = tid >> 2, seg = tid & 3;
  __syncthreads();
  {
    const size_t pos = (size_t)oc * 64 + lrow;
    const h16* g = P + pos * NSM + head * 64 + 16 * seg;
    img_store_nat(Qi, lrow, seg, *(const u4v*)g, *(const u4v*)(g + 8));
    img_store_nat(Ki, lrow, seg, *(const u4v*)(g + 256), *(const u4v*)(g + 264));
    img_store_T(Vt, lrow, seg, *(const u4v*)(g + 512), *(const u4v*)(g + 520));
  }
  if (w < 2) {
    const int dir = w;
    const int rr = dir ? 63 - lane : lane;
    const size_t pos = (size_t)oc * 64 + rr;
    const int nloc = dir ? 255 - oc : oc;
    const float* gb = p.a_gate_bias + l * 16;
    const float ig = pscal[pos * 32 + dir * 8 + head] + gb[dir * 8 + head];
    const float lf = logsigmoid_(pscal[pos * 32 + dir * 8 + 4 + head] + gb[dir * 8 + 4 + head]);
    const float b = wave_incl_sum(lf, lane);
    const float u = ig - b;
    const float pm = wave_incl_max(u, lane);
    const float m_intra = b + pm;
    const float mprev = scas[((size_t)(dir * 4 + head) * 256 + nloc) * 4 + 2];
    const float mt = fmaxf(b + mprev, m_intra);
    rowterm[dir * 64 + rr] = b - mt;
    colterm[dir * 64 + rr] = u;
    ainter[dir * 64 + rr] = __expf(b + mprev - mt);
    emt[dir * 64 + rr] = __expf(-mt);
  }
  f4v hacc[4];
#pragma unroll
  for (int i = 0; i < 4; ++i) hacc[i] = (f4v){0.f, 0.f, 0.f, 0.f};
#pragma unroll 1
  for (int dir = 0; dir < 2; ++dir) {
    const int nloc = dir ? 255 - oc : oc;
    const float* src = sca + ((size_t)(dir * 4 + head) * 256 + nloc) * 4160;
    __syncthreads();
    {
      const float4* s4 = (const float4*)(src + lrow * 64 + 16 * seg);
      float4 a = s4[0], b = s4[1], c = s4[2], d = s4[3];
      h8v o0, o1;
      o0[0] = (h16)a.x; o0[1] = (h16)a.y; o0[2] = (h16)a.z; o0[3] = (h16)a.w; o0[4] = (h16)b.x; o0[5] = (h16)b.y; o0[6] = (h16)b.z; o0[7] = (h16)b.w;
      o1[0] = (h16)c.x; o1[1] = (h16)c.y; o1[2] = (h16)c.z; o1[3] = (h16)c.w; o1[4] = (h16)d.x; o1[5] = (h16)d.y; o1[6] = (h16)d.z; o1[7] = (h16)d.w;
      *(h8v*)&Ci[lrow * LDH + 16 * seg] = o0; *(h8v*)&Ci[lrow * LDH + 16 * seg + 8] = o1;
      if (tid < 64) nvec[tid] = src[4096 + tid];
    }
    __syncthreads();
    f4v S[4];
#pragma unroll
    for (int i = 0; i < 4; ++i) S[i] = (f4v){0.f, 0.f, 0.f, 0.f};
    mm64(Qi, Ki, S, w, lane);
    float dint[4];
#pragma unroll
    for (int rg = 0; rg < 4; ++rg) {
      const int t = 16 * w + 4 * q + rg;
      const float rt = rowterm[dir * 64 + t];
      float sum = 0.f;
#pragma unroll
      for (int nt = 0; nt < 4; ++nt) {
        const int s = 16 * nt + r;
        const bool ok = dir ? (s >= t) : (s <= t);
        const float wv = ok ? __expf(rt + colterm[dir * 64 + s]) * S[nt][rg] * 0.125f : 0.f;
        sum += wv;
        Wi[t * LDH + s] = (h16)wv;
      }
      dint[rg] = grp16_sum(sum);
    }
    {
      float s = 0.f;
#pragma unroll
      for (int i = 0; i < 16; ++i) s += (float)Qi[lrow * LDH + 16 * seg + i] * nvec[16 * seg + i];
      s += __shfl_xor(s, 1); s += __shfl_xor(s, 2);
      if (seg == 0) qn[lrow] = s;
    }
    __syncthreads();
    f4v a1[4], a2[4];
#pragma unroll
    for (int i = 0; i < 4; ++i) { a1[i] = (f4v){0.f, 0.f, 0.f, 0.f}; a2[i] = (f4v){0.f, 0.f, 0.f, 0.f}; }
    mm64(Wi, Vt, a1, w, lane);
    mm64(Qi, Ci, a2, w, lane);
#pragma unroll
    for (int rg = 0; rg < 4; ++rg) {
      const int t = 16 * w + 4 * q + rg;
      const float ai = ainter[dir * 64 + t];
      const float den = ai * qn[t] + dint[rg];
      const float dn = 1.f / fmaxf(fabsf(den), emt[dir * 64 + t]);
#pragma unroll
      for (int et = 0; et < 4; ++et) hacc[et][rg] += (a1[et][rg] + ai * a2[et][rg]) * dn;
    }
  }
  const float* nw = p.a_norm_w + l * 256 + head * 64;
#pragma unroll
  for (int rg = 0; rg < 4; ++rg) {
    const int t = 16 * w + 4 * q + rg;
    const size_t pos = (size_t)oc * 64 + t;
    float s = hacc[0][rg] + hacc[1][rg] + hacc[2][rg] + hacc[3][rg];
    const float mu = grp16_sum(s) * (1.f / 64.f);
    float vs = 0.f;
#pragma unroll
    for (int et = 0; et < 4; ++et) { float d = hacc[et][rg] - mu; vs += d * d; }
    const float var = grp16_sum(vs) * (1.f / 64.f);
    const float rstd = rsqrtf(var + 1e-5f);
    h16* y = (h16*)(ws + OFF_Y) + pos * 1280 + head * 64;
    const h16* ao = P + pos * NSM + 768 + head * 64;
#pragma unroll
    for (int et = 0; et < 4; ++et) {
      const int e = 16 * et + r;
      y[e] = (h16)((hacc[et][rg] - mu) * rstd * nw[e] * sigmoid_((float)ao[e]));
    }
  }
}

template <int DIR>
DI void dn_solve4(const float* M, const h16* Ki, const h16* Vi, const float* betal, const float* gcl, int half, int c, int pp, float (&x)[16]) {
  const h16* src = half ? (Ki + c) : (Vi + c);
#pragma unroll
  for (int k = 0; k < 16; ++k) x[k] = 0.f;
#pragma unroll
  for (int il = 0; il < 64; ++il) {
    const int ri = DIR ? 63 - il : il;
    float part = 0.f;
#pragma unroll
    for (int k = 0; k < (il + 3) / 4; ++k) {
      const int jl0 = 4 * k;
      float mv = DIR ? M[ri * MLD + 63 - jl0 - pp] : M[ri * MLD + jl0 + pp];
      if (jl0 + 3 >= il) mv = (jl0 + pp < il) ? mv : 0.f;
      part += mv * x[k];
    }
    part += __shfl_xor(part, 1); part += __shfl_xor(part, 2);
    const float e = half ? __expf(gcl[ri]) : 1.f;
    const float xi = betal[ri] * (float)src[ri * LDH] * e - part;
    if ((il & 3) == pp) x[il >> 2] = xi;
  }
}

DI void dn_c1_unit(const Params& p, int l, int head, int oc, h16* lds) {
  unsigned char* ws = p.ws;
  const h16* P = (const h16*)(ws + OFF_PS);
  const float* pscal = (const float*)(ws + OFF_PSCAL);
  h16* cq = (h16*)(ws + OFF_CQKV);
  h16* Ki = lds; h16* Vi = lds + 64 * LDH;
  float* M = (float*)(lds + 128 * LDH);
  float* betal = M + 64 * MLD;
  float* gcl = betal + 128;
  float* glast = gcl + 128;
  const int tid = otid(), lane = tid & 63, w = tid >> 6, r = lane & 15, q = lane >> 4;
  const int lrow = tid >> 2, seg = tid & 3;
  __syncthreads();
  {
    const int pos = oc * 64 + lrow;
    const float* cw = p.c_conv_w + (size_t)l * 5 * 768;
    float vq[16], vk[16], vv[16];
#pragma unroll
    for (int i = 0; i < 16; ++i) { vq[i] = 0.f; vk[i] = 0.f; vv[i] = 0.f; }
#pragma unroll
    for (int j = 0; j < 5; ++j) {
      const int pp = pos + j - 2;
      if (pp < 0 || pp >= SEQ) continue;
      const h16* g = P + (size_t)pp * NSM + 3328 + head * 64 + 16 * seg;
      h8v q0 = *(const h8v*)g, q1 = *(const h8v*)(g + 8);
      h8v k0 = *(const h8v*)(g + 256), k1 = *(const h8v*)(g + 264);
      h8v v0 = *(const h8v*)(g + 512), v1 = *(const h8v*)(g + 520);
      const float* wq = cw + j * 768 + head * 64 + 16 * seg;
#pragma unroll
      for (int i = 0; i < 8; ++i) {
        vq[i] += wq[i] * (float)q0[i]; vq[8 + i] += wq[8 + i] * (float)q1[i];
        vk[i] += wq[256 + i] * (float)k0[i]; vk[8 + i] += wq[264 + i] * (float)k1[i];
        vv[i] += wq[512 + i] * (float)v0[i]; vv[8 + i] += wq[520 + i] * (float)v1[i];
      }
    }
    float sq = 0.f, sk = 0.f;
#pragma unroll
    for (int i = 0; i < 16; ++i) { vq[i] = silu_(vq[i]); vk[i] = silu_(vk[i]); vv[i] = silu_(vv[i]); sq += vq[i] * vq[i]; sk += vk[i] * vk[i]; }
    sq += __shfl_xor(sq, 1); sq += __shfl_xor(sq, 2);
    sk += __shfl_xor(sk, 1); sk += __shfl_xor(sk, 2);
    const float rq = rsqrtf(sq + 1e-6f) * 0.125f, rk = rsqrtf(sk + 1e-6f);
    h8v oq0, oq1, ok0, ok1, ov0, ov1;
#pragma unroll
    for (int i = 0; i < 8; ++i) {
      oq0[i] = (h16)(vq[i] * rq); oq1[i] = (h16)(vq[8 + i] * rq);
      ok0[i] = (h16)(vk[i] * rk); ok1[i] = (h16)(vk[8 + i] * rk);
      ov0[i] = (h16)vv[i]; ov1[i] = (h16)vv[8 + i];
    }
    h16* o = cq + (size_t)pos * 768 + head * 64 + 16 * seg;
    *(h8v*)o = oq0; *(h8v*)(o + 8) = oq1;
    *(h8v*)(o + 256) = ok0; *(h8v*)(o + 264) = ok1;
    *(h8v*)(o + 512) = ov0; *(h8v*)(o + 520) = ov1;
    *(h8v*)&Ki[lrow * LDH + 16 * seg] = ok0; *(h8v*)&Ki[lrow * LDH + 16 * seg + 8] = ok1;
    *(h8v*)&Vi[lrow * LDH + 16 * seg] = ov0; *(h8v*)&Vi[lrow * LDH + 16 * seg + 8] = ov1;
  }
  if (w < 2) {
    const int dir = w;
    const int rr = dir ? 63 - lane : lane;
    const size_t pos = (size_t)oc * 64 + rr;
    const float beta = sigmoid_(pscal[pos * 32 + 16 + dir * 4 + head]);
    const float g = -__expf(p.c_a_log[l * 8 + dir * 4 + head]) * softplus_(pscal[pos * 32 + 24 + dir * 4 + head] + p.c_dt_bias[l * 8 + dir * 4 + head]);
    const float gc = wave_incl_sum(g, lane);
    const float gl = __shfl(gc, 63);
    betal[dir * 64 + rr] = beta; gcl[dir * 64 + rr] = gc;
    if (lane == 0) {
      glast[dir] = gl;
      const int nloc = dir ? 255 - oc : oc;
      ((float*)(ws + OFF_CDL))[(size_t)(dir * 4 + head) * 256 + nloc] = __expf(gl);
    }
  }
  __syncthreads();
  {
    f4v kk[4];
#pragma unroll
    for (int i = 0; i < 4; ++i) kk[i] = (f4v){0.f, 0.f, 0.f, 0.f};
    mm64(Ki, Ki, kk, w, lane);
#pragma unroll
    for (int nt = 0; nt < 4; ++nt)
#pragma unroll
      for (int rg = 0; rg < 4; ++rg) {
        const int i = 16 * w + 4 * q + rg, j = 16 * nt + r;
        float v = 0.f;
        if (j < i) v = betal[i] * kk[nt][rg] * __expf(gcl[i] - gcl[j]);
        else if (j > i) v = betal[64 + i] * kk[nt][rg] * __expf(gcl[64 + i] - gcl[64 + j]);
        M[i * MLD + j] = v;
      }
  }
  __syncthreads();
  {
    const int c = tid >> 2, pp = tid & 3;
#pragma unroll 1
    for (int dh2 = 0; dh2 < 4; ++dh2) {
      const int dir = dh2 >> 1, half = dh2 & 1;
      const int nloc = dir ? 255 - oc : oc;
      const size_t unit = (size_t)(dir * 4 + head) * 256 + nloc;
      float x[16];
      if (dir == 0) dn_solve4<0>(M, Ki, Vi, betal, gcl, half, c, pp, x);
      else dn_solve4<1>(M, Ki, Vi, betal + 64, gcl + 64, half, c, pp, x);
      if (half == 0) {
        float* ud = (float*)(ws + OFF_CU) + unit * 4096;
        const int slice = c >> 4, el = c & 15;
#pragma unroll
        for (int k = 0; k < 16; ++k) {
          const int il = 4 * k + pp;
          const int rr = dir ? 63 - il : il;
          ud[((slice * 4 + (rr >> 4)) * 64 + el + 16 * ((rr & 15) >> 2)) * 4 + (rr & 3)] = x[k];
        }
      } else {
        h16* wd = (h16*)(ws + OFF_CW) + unit * 4096;
        const int s = c >> 5, lq = (c & 15) >> 2, jjx = (c & 3) + 4 * ((c & 31) >> 4);
#pragma unroll
        for (int k = 0; k < 16; ++k) {
          const int il = 4 * k + pp;
          const int rr = dir ? 63 - il : il;
          wd[(((rr >> 4) * 2 + s) * 64 + (rr & 15) + 16 * lq) * 8 + jjx] = (h16)(-x[k]);
        }
      }
    }
  }
#pragma unroll
  for (int dir = 0; dir < 2; ++dir) {
    const int nloc = dir ? 255 - oc : oc;
    const size_t unit = (size_t)(dir * 4 + head) * 256 + nloc;
    h16* kd = (h16*)(ws + OFF_CKD) + unit * 4096;
    const float gl = glast[dir];
#pragma unroll
    for (int it = 0; it < 4; ++it) {
      const int e = tid + 256 * it;
      const int d = e & 63, rq = e >> 6;
      const int r0 = 4 * rq;
      h4v o;
#pragma unroll
      for (int i = 0; i < 4; ++i) o[i] = (h16)((float)Ki[(r0 + i) * LDH + d] * __expf(gl - gcl[dir * 64 + r0 + i]));
      const int tile = d >> 4, s = r0 >> 5, ln = (d & 15) + 16 * ((r0 & 15) >> 2), j4 = 4 * ((r0 & 31) >> 4);
      *(h4v*)&kd[((tile * 2 + s) * 64 + ln) * 8 + j4] = o;
    }
  }
}

DI void dn_c2_unit(const Params& p, int dh, int w) {
  unsigned char* ws = p.ws;
  const int tid = otid(), lane = tid & 63;
  if (tid >= 64) return;
  const h16* cw = (const h16*)(ws + OFF_CW) + (size_t)dh * 256 * 4096;
  const h16* ckd = (const h16*)(ws + OFF_CKD) + (size_t)dh * 256 * 4096;
  const float* cu = (const float*)(ws + OFF_CU) + (size_t)dh * 256 * 4096;
  const float* cdl = (const float*)(ws + OFF_CDL) + (size_t)dh * 256;
  h16* cs = (h16*)(ws + OFF_CS) + (size_t)dh * 256 * 4096;
  h16* cvn = (h16*)(ws + OFF_CVN) + (size_t)dh * 256 * 4096;
  f4v S[4];
#pragma unroll
  for (int i = 0; i < 4; ++i) S[i] = (f4v){0.f, 0.f, 0.f, 0.f};
  h8v wA[4][2], kA[4][2]; f4v uu[4]; float dl;
#pragma unroll
  for (int t = 0; t < 4; ++t) {
#pragma unroll
    for (int s = 0; s < 2; ++s) {
      wA[t][s] = *(const h8v*)&cw[((t * 2 + s) * 64 + lane) * 8];
      kA[t][s] = *(const h8v*)&ckd[((t * 2 + s) * 64 + lane) * 8];
    }
    uu[t] = *(const f4v*)&cu[((w * 4 + t) * 64 + lane) * 4];
  }
  dl = cdl[0];
  for (int n = 0; n < 256; ++n) {
    h8v wN[4][2], kN[4][2]; f4v uN[4]; float dlN = 0.f;
    const int nn = (n + 1 < 256) ? n + 1 : n;
    {
      const h16* cw1 = cw + (size_t)nn * 4096; const h16* ck1 = ckd + (size_t)nn * 4096; const float* cu1 = cu + (size_t)nn * 4096;
#pragma unroll
      for (int t = 0; t < 4; ++t) {
#pragma unroll
        for (int s = 0; s < 2; ++s) {
          wN[t][s] = *(const h8v*)&cw1[((t * 2 + s) * 64 + lane) * 8];
          kN[t][s] = *(const h8v*)&ck1[((t * 2 + s) * 64 + lane) * 8];
        }
        uN[t] = *(const f4v*)&cu1[((w * 4 + t) * 64 + lane) * 4];
      }
      dlN = cdl[nn];
    }
    h8v Sb[2];
    Sb[0] = pack8(S[0], S[1]); Sb[1] = pack8(S[2], S[3]);
    h16* cs1 = cs + (size_t)n * 4096; h16* cv1 = cvn + (size_t)n * 4096;
    *(h8v*)&cs1[((w * 2 + 0) * 64 + lane) * 8] = Sb[0];
    *(h8v*)&cs1[((w * 2 + 1) * 64 + lane) * 8] = Sb[1];
    f4v vn[4];
#pragma unroll
    for (int t = 0; t < 4; ++t) { vn[t] = uu[t]; vn[t] = mfma16(wA[t][0], Sb[0], vn[t]); vn[t] = mfma16(wA[t][1], Sb[1], vn[t]); }
    h8v Vb[2];
    Vb[0] = pack8(vn[0], vn[1]); Vb[1] = pack8(vn[2], vn[3]);
    *(h8v*)&cv1[((w * 2 + 0) * 64 + lane) * 8] = Vb[0];
    *(h8v*)&cv1[((w * 2 + 1) * 64 + lane) * 8] = Vb[1];
#pragma unroll
    for (int t = 0; t < 4; ++t) { S[t] *= dl; S[t] = mfma16(kA[t][0], Vb[0], S[t]); S[t] = mfma16(kA[t][1], Vb[1], S[t]); }
#pragma unroll
    for (int t = 0; t < 4; ++t) { wA[t][0] = wN[t][0]; wA[t][1] = wN[t][1]; kA[t][0] = kN[t][0]; kA[t][1] = kN[t][1]; uu[t] = uN[t]; }
    dl = dlN;
  }
}

DI void dn_c3_unit(const Params& p, int l, int head, int oc, h16* lds) {
  unsigned char* ws = p.ws;
  const h16* P = (const h16*)(ws + OFF_PS);
  const float* pscal = (const float*)(ws + OFF_PSCAL);
  const h16* cq = (const h16*)(ws + OFF_CQKV);
  h16* Qi = lds; h16* Ki = lds + 64 * LDH;
  h16* AT = lds + 128 * LDH;
  h16* QG = lds + 256 * LDH;
  float* gcl = (float*)(lds + 384 * LDH);
  float* Ol = (float*)lds;
  const int tid = otid(), lane = tid & 63, w = tid >> 6, r = lane & 15, q = lane >> 4;
  const int lrow = tid >> 2, seg = tid & 3;
  __syncthreads();
  {
    const size_t pos = (size_t)oc * 64 + lrow;
    const h16* g = cq + pos * 768 + head * 64 + 16 * seg;
    img_store_nat(Qi, lrow, seg, *(const u4v*)g, *(const u4v*)(g + 8));
    img_store_nat(Ki, lrow, seg, *(const u4v*)(g + 256), *(const u4v*)(g + 264));
  }
  if (w < 2) {
    const int dir = w;
    const int rr = dir ? 63 - lane : lane;
    const size_t pos = (size_t)oc * 64 + rr;
    const float g = -__expf(p.c_a_log[l * 8 + dir * 4 + head]) * softplus_(pscal[pos * 32 + 24 + dir * 4 + head] + p.c_dt_bias[l * 8 + dir * 4 + head]);
    gcl[dir * 64 + rr] = wave_incl_sum(g, lane);
  }
  __syncthreads();
  {
    f4v S[4];
#pragma unroll
    for (int i = 0; i < 4; ++i) S[i] = (f4v){0.f, 0.f, 0.f, 0.f};
    mm64(Qi, Ki, S, w, lane);
#pragma unroll
    for (int dir = 0; dir < 2; ++dir) {
#pragma unroll
      for (int nt = 0; nt < 4; ++nt)
#pragma unroll
        for (int rg = 0; rg < 4; ++rg) {
          const int i = 16 * w + 4 * q + rg, j = 16 * nt + r;
          const bool ok = dir ? (j >= i) : (j <= i);
          const float v = ok ? S[nt][rg] * __expf(gcl[dir * 64 + i] - gcl[dir * 64 + j]) : 0.f;
          AT[(dir * 64 + i) * LDH + j] = (h16)v;
        }
      const float eg = __expf(gcl[dir * 64 + lrow]);
#pragma unroll
      for (int i = 0; i < 16; ++i) QG[(dir * 64 + lrow) * LDH + 16 * seg + i] = (h16)((float)Qi[lrow * LDH + 16 * seg + i] * eg);
    }
  }
  __syncthreads();
  f4v o[4];
#pragma unroll
  for (int i = 0; i < 4; ++i) o[i] = (f4v){0.f, 0.f, 0.f, 0.f};
#pragma unroll
  for (int dir = 0; dir < 2; ++dir) {
    const int nloc = dir ? 255 - oc : oc;
    const size_t unit = (size_t)(dir * 4 + head) * 256 + nloc;
    const h16* cs = (const h16*)(ws + OFF_CS) + unit * 4096;
    const h16* cv = (const h16*)(ws + OFF_CVN) + unit * 4096;
#pragma unroll
    for (int s = 0; s < 2; ++s) {
      const h8v Sb = *(const h8v*)&cs[((w * 2 + s) * 64 + lane) * 8];
      const h8v Vb = *(const h8v*)&cv[((w * 2 + s) * 64 + lane) * 8];
#pragma unroll
      for (int it = 0; it < 4; ++it) {
        o[it] = mfma16(perm_frag(QG + dir * 64 * LDH, 16 * it + r, s, q), Sb, o[it]);
        o[it] = mfma16(perm_frag(AT + dir * 64 * LDH, 16 * it + r, s, q), Vb, o[it]);
      }
    }
  }
  __syncthreads();
#pragma unroll
  for (int it = 0; it < 4; ++it)
#pragma unroll
    for (int rg = 0; rg < 4; ++rg) Ol[(16 * it + 4 * q + rg) * 65 + 16 * w + r] = o[it][rg];
  __syncthreads();
  {
    const size_t pos = (size_t)oc * 64 + lrow;
    float v[16]; float ss = 0.f;
#pragma unroll
    for (int i = 0; i < 16; ++i) { v[i] = Ol[lrow * 65 + 16 * seg + i]; ss += v[i] * v[i]; }
    ss += __shfl_xor(ss, 1); ss += __shfl_xor(ss, 2);
    const float rms = rsqrtf(ss * (1.f / 64.f) + 1e-6f);
    const float* nw = p.c_norm_w + l * 64 + 16 * seg;
    const h16* cg_ = P + pos * NSM + 4096 + head * 64 + 16 * seg;
    h8v g0 = *(const h8v*)cg_, g1 = *(const h8v*)(cg_ + 8);
    h8v o0, o1;
#pragma unroll
    for (int i = 0; i < 8; ++i) {
      o0[i] = (h16)(v[i] * rms * nw[i] * silu_((float)g0[i]));
      o1[i] = (h16)(v[8 + i] * rms * nw[8 + i] * silu_((float)g1[i]));
    }
    h16* y = (h16*)(ws + OFF_Y) + pos * 1280 + 512 + head * 64 + 16 * seg;
    *(h8v*)y = o0; *(h8v*)(y + 8) = o1;
  }
}

DI void phase_m1(const Params& p, int l, int bid, int nb, h16* lds) {
  asm volatile("" : "+v"(bid));
  for (int u = bid; u < 2048; u += nb) {
    if (u < 1024) dn_c1_unit(p, l, u & 3, u >> 2, lds);
    else { const int v = u - 1024; mlstm_a1_unit(p, l, v & 3, v >> 2, lds); }
  }
}
DI void phase_m2(const Params& p, int l, int bid, int nb, h16* lds) {
  asm volatile("" : "+v"(bid));
  const int total = 32 + 136 + 2048 + 3072;
  for (int u = bid; u < total; u += nb) {
    int v = u;
    if (v < 32) { dn_c2_unit(p, v >> 2, v & 3); continue; }
    if ((v -= 32) < 136) { mlstm_a2_unit(p, v); continue; }
    if ((v -= 136) < 2048) { attn_unit<5>(p, l, 1, 0, v & 7, 0, 1, (v >> 3) * 64, SEQ, 128, lds); continue; }
    v -= 2048;
    const int grp = v >> 10, x = v & 1023, head = x & 3, tl = x >> 2;
    const int dil = (grp == 0) ? 1 : (grp == 1) ? 4 : 16;
    const int sub = SEQ / dil, tps = sub >> 6;
    const int res = tl / tps, ti = tl % tps;
    attn_unit<3>(p, l, 0, grp, head, res, dil, ti * 64, sub, 64, lds);
  }
}
DI void phase_m3(const Params& p, int l, int bid, int nb, h16* lds) {
  asm volatile("" : "+v"(bid));
  const int total = 1024 + 1024 + 2048;
  for (int u = bid; u < total; u += nb) {
    int v = u;
    if (v < 1024) { mlstm_a3_unit(p, l, v & 3, v >> 2, lds); continue; }
    if ((v -= 1024) < 1024) { dn_c3_unit(p, l, v & 3, v >> 2, lds); continue; }
    bcombine_unit(p, v - 1024);
  }
}

DI void phase_gates(const Params& p, int bid, int nb, h16* lds) {
  unsigned char* ws = p.ws;
  const h16* x16 = (const h16*)(ws + OFF_X16);
  const h16* wg = (const h16*)(ws + OFF_WG);
  h16* G = (h16*)(ws + OFF_GATES);
  for (int u = bid; u < 64 * 16; u += nb) {
    const int m0 = (u >> 4) * 256, n0 = (u & 15) * 256;
    f16v acc[4][2]; acc256_zero(acc);
    gemm256_main<false>(x16, DM, nullptr, m0, wg, 1024, n0, 1024, lds, acc);
    gemm256_epilogue(acc, m0, n0, [&](int m, int n, f4v v0, f4v v1) {
      f4v a, b;
#pragma unroll
      for (int i = 0; i < 4; ++i) { a[i] = sigmoid_(v0[i]); b[i] = sigmoid_(v1[i]); }
      st_h4(&G[(size_t)m * 4096 + n], a); st_h4(&G[(size_t)m * 4096 + n + 32], b);
    });
  }
}
DI void phase_merge(const Params& p, int bid, int nb, h16* lds) {
  asm volatile("" : "+v"(bid));
  unsigned char* ws = p.ws;
  const h16* Y = (const h16*)(ws + OFF_Y);
  const h16* wbr = (const h16*)(ws + OFF_WBR);
  const h16* G = (const h16*)(ws + OFF_GATES);
  h16* Mg = (h16*)(ws + OFF_MERGED);
  for (int u = bid; u < 128 * 8; u += nb) {
    const int m0 = (u >> 3) * 128, n0 = (u & 7) * 128;
    f16v macc[2][2]; acc_zero(macc);
#pragma unroll 1
    for (int b = 0; b < 4; ++b) {
      const int Kb = (b == 3) ? 512 : 256;
      f16v acc[2][2]; acc_zero(acc);
      gemm_main<false>(Y + b * 256, 1280, nullptr, m0, wbr + (size_t)b * 262144, Kb, n0, Kb, lds, acc);
      const int tid = otid(), lane = tid & 63, wv = tid >> 6, wm = wv >> 1, wn = wv & 1, h = lane >> 5;
#pragma unroll
      for (int i = 0; i < 2; ++i) {
        const int m = m0 + wm * 64 + i * 32 + (lane & 31);
#pragma unroll
        for (int g = 0; g < 4; ++g) {
          const int n = n0 + wn * 64 + 8 * g + 4 * h;
          const h4v g0 = *(const h4v*)&G[(size_t)m * 4096 + b * 1024 + n];
          const h4v g1 = *(const h4v*)&G[(size_t)m * 4096 + b * 1024 + n + 32];
#pragma unroll
          for (int e = 0; e < 4; ++e) {
            macc[i][0][4 * g + e] += (float)g0[e] * acc[i][0][4 * g + e];
            macc[i][1][4 * g + e] += (float)g1[e] * acc[i][1][4 * g + e];
          }
        }
      }
    }
    gemm_epilogue(macc, m0, n0, [&](int m, int n, f4v v0, f4v v1) {
      st_h4(&Mg[(size_t)m * DM + n], v0); st_h4(&Mg[(size_t)m * DM + n + 32], v1);
    });
  }
}
DI void phase_resid_gemm(const Params& p, const h16* A, int lda, const h16* W, int K, const float* xres, int bid, int nb, h16* lds) {
  float* out = p.out;
  for (int u = bid; u < 64 * 4; u += nb) {
    const int m0 = (u >> 2) * 256, n0 = (u & 3) * 256;
    f16v acc[4][2]; acc256_zero(acc);
    gemm256_main<false>(A, lda, nullptr, m0, W, K, n0, K, lds, acc);
    gemm256_epilogue(acc, m0, n0, [&](int m, int n, f4v v0, f4v v1) {
      const f4v x0 = *(const f4v*)&xres[(size_t)m * DM + n], x1 = *(const f4v*)&xres[(size_t)m * DM + n + 32];
      *(f4v*)&out[(size_t)m * DM + n] = ALPHA * x0 + v0;
      *(f4v*)&out[(size_t)m * DM + n + 32] = ALPHA * x1 + v1;
    });
  }
}
DI void phase_ffn1_dense(const Params& p, int bid, int nb, h16* lds) {
  unsigned char* ws = p.ws;
  const h16* x16 = (const h16*)(ws + OFF_X16);
  const h16* w13 = (const h16*)(ws + OFF_WFF);
  h16* H = (h16*)(ws + OFF_H);
  for (int u = bid; u < 64 * 22; u += nb) {
    const int m0 = (u / 22) * 256, n0 = (u % 22) * 256;
    f16v acc[4][2]; acc256_zero(acc);
    gemm256_main<false>(x16, DM, nullptr, m0, w13, 1024, n0, 1024, lds, acc);
    gemm256_epilogue(acc, m0, n0, [&](int m, int n, f4v v0, f4v v1) {
      f4v hq;
#pragma unroll
      for (int i = 0; i < 4; ++i) hq[i] = silu_(v0[i]) * v1[i];
      st_h4(&H[(size_t)m * 2816 + (n >> 6) * 32 + (n & 31)], hq);
    });
  }
}
DI void moe_prefix(const int* cnt, int (&pstart)[9]) {
  int s = 0;
#pragma unroll
  for (int e = 0; e < 8; ++e) { pstart[e] = s; s += (cnt[e] + 255) & ~255; }
  pstart[8] = s;
}
DI void phase_ffn1_moe(const Params& p, int bid, int nb, h16* lds) {
  unsigned char* ws = p.ws;
  const h16* x16 = (const h16*)(ws + OFF_X16);
  const h16* w13 = (const h16*)(ws + OFF_WFF);
  h16* H = (h16*)(ws + OFF_H);
  const int* st = (const int*)(ws + MOE_ST);
  int ps[9]; moe_prefix((const int*)(ws + MOE_CNT), ps);
  const int ntl = (ps[8] >> 8) * 11;
  for (int u = bid; u < ntl; u += nb) {
    const int mt = u / 11, m0 = mt * 256, n0 = (u % 11) * 256;
    int e = 0;
#pragma unroll
    for (int i = 1; i < 8; ++i) if (m0 >= ps[i]) e = i;
    f16v acc[4][2]; acc256_zero(acc);
    gemm256_main<true>(x16, DM, st, m0, w13 + (size_t)e * 2816 * 1024, 1024, n0, 1024, lds, acc);
    gemm256_epilogue(acc, m0, n0, [&](int m, int n, f4v v0, f4v v1) {
      f4v hq;
#pragma unroll
      for (int i = 0; i < 4; ++i) hq[i] = silu_(v0[i]) * v1[i];
      st_h4(&H[(size_t)m * 1408 + (n >> 6) * 32 + (n & 31)], hq);
    });
  }
}
DI void phase_ffn2_moe(const Params& p, int bid, int nb, h16* lds) {
  unsigned char* ws = p.ws;
  const h16* H = (const h16*)(ws + OFF_H);
  const h16* w2 = (const h16*)(ws + OFF_WFF) + (size_t)8 * 2816 * 1024;
  h16* YB = (h16*)(ws + OFF_YB);
  const float* sg = (const float*)(ws + MOE_SG);
  int ps[9]; moe_prefix((const int*)(ws + MOE_CNT), ps);
  const int ntl = (ps[8] >> 8) * 4;
  for (int u = bid; u < ntl; u += nb) {
    const int mt = u >> 2, m0 = mt * 256, n0 = (u & 3) * 256;
    int e = 0;
#pragma unroll
    for (int i = 1; i < 8; ++i) if (m0 >= ps[i]) e = i;
    f16v acc[4][2]; acc256_zero(acc);
    gemm256_main<false>(H, 1408, nullptr, m0, w2 + (size_t)e * 1024 * 1408, 1408, n0, 1408, lds, acc);
    gemm256_epilogue(acc, m0, n0, [&](int m, int n, f4v v0, f4v v1) {
      const float g = sg[m];
      st_h4(&YB[(size_t)m * DM + n], g * v0); st_h4(&YB[(size_t)m * DM + n + 32], g * v1);
    });
  }
}

DI void phase_ln(const Params& p, int l, int which, int bid, int nb) {
  asm volatile("" : "+v"(bid));
  unsigned char* ws = p.ws;
  const bool moe = (l & 1);
  const bool moe_in = moe && which == 2;
  const bool router = moe && which == 1;
  const float* lw = (which == 1 ? p.ln1_w : p.ln2_w) + l * DM;
  const float* lb = (which == 1 ? p.ln1_b : p.ln2_b) + l * DM;
  float* out = p.out;
  h16* x16 = (h16*)(ws + OFF_X16);
  const int tid_ = otid(); const int lane = tid_ & 63, wv = tid_ >> 6;
  for (int row = bid * 4 + wv; row < SEQ; row += nb * 4) {
    float v[16];
#pragma unroll
    for (int i = 0; i < 4; ++i) {
      const f4v t = *(const f4v*)&out[(size_t)row * DM + 256 * i + lane * 4];
      v[4 * i] = t[0]; v[4 * i + 1] = t[1]; v[4 * i + 2] = t[2]; v[4 * i + 3] = t[3];
    }
    if (moe_in) {
      const int* ts = (const int*)(ws + MOE_TS);
      const h16* YB = (const h16*)(ws + OFF_YB);
      const int s0 = ts[row * 2], s1 = ts[row * 2 + 1];
#pragma unroll
      for (int i = 0; i < 4; ++i) {
        const h4v a = *(const h4v*)&YB[(size_t)s0 * DM + 256 * i + lane * 4];
        const h4v b = *(const h4v*)&YB[(size_t)s1 * DM + 256 * i + lane * 4];
#pragma unroll
        for (int e = 0; e < 4; ++e) v[4 * i + e] = ALPHA * v[4 * i + e] + ((float)a[e] + (float)b[e]);
      }
    }
    float s = 0.f;
#pragma unroll
    for (int i = 0; i < 16; ++i) s += v[i];
    const float mu = wave_sum(s) * (1.f / 1024.f);
    float vs = 0.f;
#pragma unroll
    for (int i = 0; i < 16; ++i) { const float d = v[i] - mu; vs += d * d; }
    const float rstd = rsqrtf(wave_sum(vs) * (1.f / 1024.f) + 1e-5f);
#pragma unroll
    for (int i = 0; i < 4; ++i) {
      const int c = 256 * i + lane * 4;
      const f4v w4 = *(const f4v*)&lw[c], b4 = *(const f4v*)&lb[c];
      f4v y;
#pragma unroll
      for (int e = 0; e < 4; ++e) { y[e] = (v[4 * i + e] - mu) * rstd * w4[e] + b4[e]; v[4 * i + e] = y[e]; }
      *(f4v*)&out[(size_t)row * DM + c] = y;
      st_h4(&x16[(size_t)row * DM + c], y);
    }
    if (router) {
      const float* rw = p.moe_router + (size_t)(l >> 1) * DM * 8;
      float lg[8];
#pragma unroll
      for (int e = 0; e < 8; ++e) lg[e] = 0.f;
#pragma unroll
      for (int i = 0; i < 4; ++i)
#pragma unroll
        for (int k = 0; k < 4; ++k) {
          const int c = 256 * i + lane * 4 + k;
          const f4v r0 = *(const f4v*)&rw[(size_t)c * 8], r1 = *(const f4v*)&rw[(size_t)c * 8 + 4];
          const float xv = v[4 * i + k];
#pragma unroll
          for (int e = 0; e < 4; ++e) { lg[e] += xv * r0[e]; lg[4 + e] += xv * r1[e]; }
        }
#pragma unroll
      for (int e = 0; e < 8; ++e) lg[e] = wave_sum(lg[e]);
      if (lane == 0) {
        int i1 = 0; float b1 = lg[0];
#pragma unroll
        for (int e = 1; e < 8; ++e) if (lg[e] > b1) { b1 = lg[e]; i1 = e; }
        int i2 = -1; float b2 = -3.4e38f;
#pragma unroll
        for (int e = 0; e < 8; ++e) if (e != i1 && lg[e] > b2) { b2 = lg[e]; i2 = e; }
        const float g1 = 1.f / (1.f + __expf(b2 - b1)), g2 = 1.f - g1;
        int* cnt = (int*)(ws + MOE_CNT);
        int* te = (int*)(ws + MOE_TE); int* tp = (int*)(ws + MOE_TP); float* tg = (float*)(ws + MOE_TG);
        te[row * 2] = i1; te[row * 2 + 1] = i2;
        tp[row * 2] = atomicAdd(&cnt[i1], 1); tp[row * 2 + 1] = atomicAdd(&cnt[i2], 1);
        tg[row * 2] = g1; tg[row * 2 + 1] = g2;
      }
    }
  }
}
DI void phase_assign(const Params& p, int bid, int nb) {
  asm volatile("" : "+v"(bid));
  unsigned char* ws = p.ws;
  int ps[9]; moe_prefix((const int*)(ws + MOE_CNT), ps);
  const int* te = (const int*)(ws + MOE_TE); const int* tp = (const int*)(ws + MOE_TP); const float* tg = (const float*)(ws + MOE_TG);
  int* ts = (int*)(ws + MOE_TS); int* st = (int*)(ws + MOE_ST); float* sg = (float*)(ws + MOE_SG);
  #pragma unroll 1
  for (int i = bid * 256 + otid(); i < 32768; i += nb * 256) {
    const int e = te[i];
    int base = 0;
#pragma unroll
    for (int k = 0; k < 8; ++k) if (e == k) base = ps[k];
    const int slot = base + tp[i];
    ts[i] = slot; st[slot] = i >> 1; sg[slot] = tg[i];
  }
}


#define XB_TMO      128
#define XB_XCNT(j)  (256  + 64 * (j))
#define XB_XSUB(j)  (1280 + 64 * (j))
#define XB_XGEN(j)  (2304 + 64 * (j))
#define XB_TOP      3328
#define XB_TOPGEN   3392
#define XCD_BAR_WORDS 3456
#define XB_SPIN_CAP (1u << 22)
#define LAS __attribute__((address_space(3)))
DI unsigned xb_ld(unsigned* p) { return __hip_atomic_load(p, __ATOMIC_RELAXED, __HIP_MEMORY_SCOPE_AGENT); }
DI unsigned xb_add(unsigned* p, unsigned v) { return __hip_atomic_fetch_add(p, v, __ATOMIC_RELAXED, __HIP_MEMORY_SCOPE_AGENT); }
DI unsigned xb_xcc_id() { return (unsigned)__builtin_amdgcn_s_getreg((3 << 11) | 20) & 0xFu; }
#define XB_SPIN(cond, bar) do { unsigned _sp = 0; while (cond) { __builtin_amdgcn_s_sleep(1); \
    if ((++_sp & 255u) == 0u) { if (xb_ld(&(bar)[XB_TMO])) break; if (_sp > XB_SPIN_CAP) { atomicAdd(&(bar)[XB_TMO], 1u); break; } } } } while (0)
struct XcdBarrier { unsigned* bar; unsigned x; volatile LAS unsigned* st; };
DI XcdBarrier xcd_barrier_post(unsigned* bar, volatile LAS unsigned* st) {
  XcdBarrier b; b.bar = bar; b.x = xb_xcc_id(); b.st = st;
  if (threadIdx.x == 0) (void)xb_add(&bar[XB_XCNT(b.x)], 1u);
  return b;
}
DI void xcd_barrier_complete(unsigned* bar, unsigned x, unsigned& nloc, unsigned& nx) {
  const unsigned G = gridDim.x * gridDim.y * gridDim.z;
  unsigned sum, cnt, mine, sp = 0u;
  for (;;) {
    sum = 0u; cnt = 0u; mine = 0u;
#pragma unroll
    for (unsigned j = 0; j < 16; ++j) { const unsigned c = xb_ld(&bar[XB_XCNT(j)]); sum += c; cnt += (c > 0u) ? 1u : 0u; mine = (j == x) ? c : mine; }
    if (sum == G) break;
    __builtin_amdgcn_s_sleep(1);
    if ((++sp & 255u) == 0u) { if (xb_ld(&bar[XB_TMO])) break; if (sp > XB_SPIN_CAP) { atomicAdd(&bar[XB_TMO], 1u); break; } }
  }
  nloc = mine > 0u ? mine : 1u; nx = cnt > 0u ? cnt : 1u;
}
DI void xcd_barrier(const XcdBarrier& b) {
  asm volatile("s_waitcnt vmcnt(0)" ::: "memory");
  __syncthreads();
  if (threadIdx.x == 0) {
    unsigned* bar = b.bar;
    __builtin_amdgcn_s_waitcnt(0);
    unsigned nloc = b.st[0], nx = b.st[1];
    if (nloc == 0u) { xcd_barrier_complete(bar, b.x, nloc, nx); b.st[0] = nloc; b.st[1] = nx; }
    const unsigned old = xb_add(&bar[XB_XSUB(b.x)], 1u);
    const unsigned gen = old / nloc;
    if (old + 1u == (gen + 1u) * nloc) {
      __builtin_amdgcn_fence(__ATOMIC_RELEASE, "agent");
      asm volatile("s_waitcnt vmcnt(0)" ::: "memory");
      const unsigned og = xb_add(&bar[XB_TOP], 1u);
      const unsigned tg = og / nx;
      if (og + 1u == (tg + 1u) * nx) xb_add(&bar[XB_TOPGEN], 1u);
      else XB_SPIN(xb_ld(&bar[XB_TOPGEN]) == tg, bar);
      __builtin_amdgcn_fence(__ATOMIC_ACQUIRE, "agent");
      xb_add(&bar[XB_XGEN(b.x)], 1u);
      asm volatile("s_waitcnt vmcnt(0)" ::: "memory");
    } else {
      XB_SPIN(xb_ld(&bar[XB_XGEN(b.x)]) == gen, bar);
      __builtin_amdgcn_fence(__ATOMIC_ACQUIRE, "agent");
      asm volatile("s_waitcnt vmcnt(0)" ::: "memory");
    }
  }
  __syncthreads();
}

extern __shared__ __attribute__((aligned(16))) unsigned char smem_dyn[];
__global__ void __launch_bounds__(512) fwd_megakernel(Params p) {
  cg::grid_group grid = cg::this_grid();
  unsigned char* smem = smem_dyn;
  const int half = threadIdx.x >> 8;
  unsigned char* smem_half = smem_dyn + half * HALF_LDS;
  h16* lds = (h16*)smem;
  h16* ldh = (h16*)smem_half;
  const int bid = blockIdx.x, nb = gridDim.x;
  const int vb = bid * 2 + half, vnb = nb * 2;
  unsigned char* ws = p.ws;
  __shared__ u4v xb_words;
  if (threadIdx.x == 0) xb_words = (u4v){0u, 0u, 0u, 0u};
  __syncthreads();
  XcdBarrier xb = xcd_barrier_post((unsigned*)(ws + OFF_BAR), (volatile LAS unsigned*)&xb_words);

  phase_init(p, vb, vnb);
  phase_convert(p, 0, vb, vnb, ldh);
  grid.sync();
  for (int l = 0; l < 4; ++l) {
    phase_p1(p, l, bid, nb, vb, vnb, smem, smem_half);
    xcd_barrier(xb);
    phase_m1(p, l, vb, vnb, ldh);
    xcd_barrier(xb);
    phase_m2(p, l, vb, vnb, ldh);
    xcd_barrier(xb);
    phase_m3(p, l, vb, vnb, ldh);
    xcd_barrier(xb);
    phase_gates(p, bid, nb, lds);
    xcd_barrier(xb);
    phase_merge(p, vb, vnb, ldh);
    xcd_barrier(xb);
    phase_resid_gemm(p, (const h16*)(ws + OFF_MERGED), DM, (const h16*)(ws + OFF_WOUT), 1024, (l == 0) ? p.x : p.out, bid, nb, lds);
    xcd_barrier(xb);
    phase_ln(p, l, 1, vb, vnb);
    xcd_barrier(xb);
    if (l & 1) {
      phase_assign(p, vb, vnb);
      xcd_barrier(xb);
      phase_ffn1_moe(p, bid, nb, lds);
      xcd_barrier(xb);
      phase_ffn2_moe(p, bid, nb, lds);
      xcd_barrier(xb);
    } else {
      phase_ffn1_dense(p, bid, nb, lds);
      xcd_barrier(xb);
      phase_resid_gemm(p, (const h16*)(ws + OFF_H), 2816, (const h16*)(ws + OFF_WFF) + (size_t)5632 * 1024, 2816, p.out, bid, nb, lds);
      xcd_barrier(xb);
    }
    phase_ln(p, l, 2, vb, vnb);
    if (l + 1 < 4) { phase_convert(p, l + 1, vb, vnb, ldh); xcd_barrier(xb); }
  }
}

extern "C" void kernel_launch(void* const* d_in, const int* in_sizes, int n_in, void* d_out, int out_size, void* d_ws, size_t ws_size, hipStream_t stream) {
  static int grid_blocks = 0;
  if (!grid_blocks) {
    int dev = 0, cus = 0, per_cu = 0;
    hipGetDevice(&dev);
    hipDeviceGetAttribute(&cus, hipDeviceAttributeMultiprocessorCount, dev);
    hipFuncSetAttribute((const void*)fwd_megakernel, hipFuncAttributeMaxDynamicSharedMemorySize, LDS_BYTES);
    hipOccupancyMaxActiveBlocksPerMultiprocessor(&per_cu, fwd_megakernel, 512, LDS_BYTES);
    if (per_cu > 1) per_cu = 1;
    if (per_cu < 1) per_cu = 1;
    grid_blocks = cus * per_cu;
    if (ws_size < WS_END) fprintf(stderr, "workspace too small: %zu < %zu\n", ws_size, (size_t)WS_END);
  }
  Params p{};
  const float* const* in = (const float* const*)d_in;
  p.x = in[0]; p.w_in = in[1]; p.a_gate_bias = in[2]; p.a_norm_w = in[3]; p.c_conv_w = in[4]; p.c_a_log = in[5]; p.c_dt_bias = in[6];
  p.c_norm_w = in[7]; p.d_sink = in[8]; p.w_br_a = in[9]; p.w_br_b = in[10]; p.w_br_c = in[11]; p.w_br_d = in[12]; p.w_out = in[13];
  p.ln1_w = in[14]; p.ln1_b = in[15]; p.ln2_w = in[16]; p.ln2_b = in[17]; p.ffn_w1 = in[18]; p.ffn_w3 = in[19]; p.ffn_w2 = in[20];
  p.moe_router = in[21]; p.moe_w1 = in[22]; p.moe_w3 = in[23]; p.moe_w2 = in[24];
  p.out = (float*)d_out; p.ws = (unsigned char*)d_ws;
  void* args[] = {&p};
  hipMemsetAsync((unsigned char*)d_ws + OFF_BAR, 0, XCD_BAR_WORDS * 4, stream);
  hipError_t e = hipLaunchCooperativeKernel((void*)fwd_megakernel, dim3(grid_blocks), dim3(512), args, LDS_BYTES, stream);
  if (e != hipSuccess) fprintf(stderr, "cooperative launch failed: %s (grid %d)\n", hipGetErrorString(e), grid_blocks);
}
```

```cpp
#include <hip/hip_runtime.h>
#include <hip/hip_cooperative_groups.h>
#include <cstdio>
namespace cg = cooperative_groups;

typedef _Float16 h16;
typedef h16 h8v __attribute__((ext_vector_type(8)));
typedef h16 h4v __attribute__((ext_vector_type(4)));
typedef float f4v __attribute__((ext_vector_type(4)));
typedef float f16v __attribute__((ext_vector_type(16)));
typedef unsigned int u4v __attribute__((ext_vector_type(4)));
#define DI __device__ __forceinline__

constexpr int SEQ = 16384, DM = 1024, NIN = 9248, NSM = 5120;
constexpr int LDH = 72;
constexpr float ALPHA = 1.6817928305074290f;
constexpr int NSLOT = 34816;
constexpr int HALF_LDS = 58368;
constexpr int LDS_BYTES = 147456;
constexpr int MLD = 68;

constexpr size_t OFF_X16 = 0;
constexpr size_t OFF_WSM = OFF_X16 + (size_t)SEQ * DM * 2;
constexpr size_t OFF_WG = OFF_WSM + (size_t)NSM * 1024 * 2;
constexpr size_t OFF_WBR = OFF_WG + (size_t)4096 * 1024 * 2;
constexpr size_t OFF_WOUT = OFF_WBR + (size_t)1280 * 1024 * 2;
constexpr size_t OFF_WFF = OFF_WOUT + (size_t)1024 * 1024 * 2;
constexpr size_t OFF_PS = OFF_WFF + (size_t)69206016;
constexpr size_t OFF_PSCAL = OFF_PS + (size_t)SEQ * NSM * 2;
constexpr size_t OFF_Y = OFF_PSCAL + (size_t)SEQ * 32 * 4;
constexpr size_t OFF_MERGED = OFF_Y + (size_t)SEQ * 1280 * 2;
constexpr size_t OFF_ROPE = OFF_MERGED + (size_t)SEQ * DM * 2;
constexpr size_t OFF_SCA = OFF_ROPE + (size_t)SEQ * 32 * 4 * 2;
constexpr size_t OFF_SCAS = OFF_SCA + (size_t)2048 * 4160 * 4;
constexpr size_t OFF_CQKV = OFF_SCAS + (size_t)2048 * 4 * 4;
constexpr size_t OFF_CU = OFF_CQKV + (size_t)SEQ * 768 * 2;
constexpr size_t OFF_CW = OFF_CU + (size_t)2048 * 4096 * 4;
constexpr size_t OFF_CKD = OFF_CW + (size_t)2048 * 4096 * 2;
constexpr size_t OFF_CDL = OFF_CKD + (size_t)2048 * 4096 * 2;
constexpr size_t OFF_CS = OFF_CDL + (size_t)2048 * 4;
constexpr size_t OFF_CVN = OFF_CS + (size_t)2048 * 4096 * 2;
constexpr size_t OFF_OB = OFF_CVN + (size_t)2048 * 4096 * 2;
constexpr size_t OFF_MLB = OFF_OB + (size_t)3 * SEQ * 256 * 2;
constexpr size_t OFF_MOE = OFF_MLB + (size_t)3 * SEQ * 4 * 2 * 4;
constexpr size_t MOE_CNT = OFF_MOE;
constexpr size_t MOE_TE = MOE_CNT + 256;
constexpr size_t MOE_TP = MOE_TE + 32768 * 4;
constexpr size_t MOE_TG = MOE_TP + 32768 * 4;
constexpr size_t MOE_TS = MOE_TG + 32768 * 4;
constexpr size_t MOE_ST = MOE_TS + 32768 * 4;
constexpr size_t MOE_SG = MOE_ST + (size_t)NSLOT * 4;
constexpr size_t OFF_BAR = (MOE_SG + (size_t)NSLOT * 4 + 255) & ~(size_t)255;
constexpr size_t WS_END = OFF_BAR + 16384;
constexpr size_t OFF_GATES = OFF_PS;
constexpr size_t OFF_H = OFF_PS;
constexpr size_t OFF_YB = OFF_Y;

struct Params {
  const float* x; const float* w_in; const float* a_gate_bias; const float* a_norm_w; const float* c_conv_w;
  const float* c_a_log; const float* c_dt_bias; const float* c_norm_w; const float* d_sink;
  const float* w_br_a; const float* w_br_b; const float* w_br_c; const float* w_br_d; const float* w_out;
  const float* ln1_w; const float* ln1_b; const float* ln2_w; const float* ln2_b;
  const float* ffn_w1; const float* ffn_w3; const float* ffn_w2;
  const float* moe_router; const float* moe_w1; const float* moe_w3; const float* moe_w2;
  float* out; unsigned char* ws;
};

DI int otid() { int t = threadIdx.x & 255; asm volatile("" : "+v"(t)); return t; }
DI int otid512() { int t = threadIdx.x; asm volatile("" : "+v"(t)); return t; }
DI float sigmoid_(float x) { return 1.f / (1.f + __expf(-x)); }
DI float silu_(float x) { return x / (1.f + __expf(-x)); }
DI float softplus_(float x) { return x > 20.f ? x : log1pf(__expf(x)); }
DI float logsigmoid_(float x) { return fminf(x, 0.f) - log1pf(__expf(-fabsf(x))); }
DI f4v mfma16(h8v a, h8v b, f4v c) { return __builtin_amdgcn_mfma_f32_16x16x32_f16(a, b, c, 0, 0, 0); }
DI f16v mfma32(h8v a, h8v b, f16v c) { return __builtin_amdgcn_mfma_f32_32x32x16_f16(a, b, c, 0, 0, 0); }
DI float wave_incl_sum(float v, int lane) {
#pragma unroll
  for (int o = 1; o < 64; o <<= 1) { float t = __shfl_up(v, o); if (lane >= o) v += t; }
  return v;
}
DI float wave_incl_max(float v, int lane) {
#pragma unroll
  for (int o = 1; o < 64; o <<= 1) { float t = __shfl_up(v, o); if (lane >= o) v = fmaxf(v, t); }
  return v;
}
DI float wave_max(float v) {
#pragma unroll
  for (int o = 32; o >= 1; o >>= 1) v = fmaxf(v, __shfl_xor(v, o));
  return v;
}
DI float wave_sum(float v) {
#pragma unroll
  for (int o = 32; o >= 1; o >>= 1) v += __shfl_xor(v, o);
  return v;
}
DI float grp16_sum(float v) { v += __shfl_xor(v, 1); v += __shfl_xor(v, 2); v += __shfl_xor(v, 4); v += __shfl_xor(v, 8); return v; }
DI float grp16_max(float v) { v = fmaxf(v, __shfl_xor(v, 1)); v = fmaxf(v, __shfl_xor(v, 2)); v = fmaxf(v, __shfl_xor(v, 4)); v = fmaxf(v, __shfl_xor(v, 8)); return v; }

DI void mm64(const h16* A, const h16* B, f4v (&acc)[4], int w, int lane) {
  const int r = lane & 15, q = lane >> 4;
#pragma unroll
  for (int s = 0; s < 2; ++s) {
    h8v a = *(const h8v*)&A[(16 * w + r) * LDH + 32 * s + 8 * q];
#pragma unroll
    for (int nt = 0; nt < 4; ++nt) {
      h8v b = *(const h8v*)&B[(16 * nt + r) * LDH + 32 * s + 8 * q];
      acc[nt] = mfma16(a, b, acc[nt]);
    }
  }
}
DI h8v perm_frag(const h16* img, int row, int s, int q) {
  h4v lo = *(const h4v*)&img[row * LDH + 32 * s + 4 * q];
  h4v hi = *(const h4v*)&img[row * LDH + 32 * s + 16 + 4 * q];
  return __builtin_shufflevector(lo, hi, 0, 1, 2, 3, 4, 5, 6, 7);
}
DI h8v pack8(f4v a, f4v b) {
  h8v r;
  r[0] = (h16)a[0]; r[1] = (h16)a[1]; r[2] = (h16)a[2]; r[3] = (h16)a[3];
  r[4] = (h16)b[0]; r[5] = (h16)b[1]; r[6] = (h16)b[2]; r[7] = (h16)b[3];
  return r;
}
DI void st_h4(h16* p, f4v v) { h4v o; o[0] = (h16)v[0]; o[1] = (h16)v[1]; o[2] = (h16)v[2]; o[3] = (h16)v[3]; *(h4v*)p = o; }

DI void conv_unit(const float* __restrict__ src, int ld, int col0, int k0, h16* __restrict__ dst, int K, int n0, h16* lds) {
  const int t = otid();
  __syncthreads();
  {
    const int c = t & 31, kq = t >> 5;
#pragma unroll
    for (int i = 0; i < 8; ++i) {
      int kk = kq + 8 * i;
      lds[c * LDH + kk] = (h16)src[(size_t)(k0 + kk) * ld + col0 + c];
    }
  }
  __syncthreads();
  {
    const int c = t >> 3, ks = (t & 7) * 8;
    *(u4v*)&dst[(size_t)(n0 + c) * K + k0 + ks] = *(const u4v*)&lds[c * LDH + ks];
  }
}

DI int map_small(int n) {
  if (n < 1024) return 4096 + n;
  if (n < 3328) return 5136 + (n - 1024);
  if (n < 4352) return 7440 + (n - 3328);
  return 8480 + (n - 4352);
}

DI int conv_total(int l) { return 2560 + 2048 + 640 + 512 + ((l & 1) ? 8 * 2112 : (2816 + 1408)); }
DI void conv_one(const Params& p, int l, int u, h16* lds) {
  unsigned char* ws = p.ws;
  const float* win = p.w_in + (size_t)l * 1024 * NIN;
  const int jj = l >> 1;
  const bool moe = (l & 1);
    int v = u;
const float* src; int ld, col0, k0, K, n0; h16* dst;
if (v < 2560) { n0 = (v >> 4) * 32; k0 = (v & 15) * 64; col0 = map_small(n0); src = win; ld = NIN; K = 1024; dst = (h16*)(ws + OFF_WSM); }
else if ((v -= 2560) < 2048) { n0 = (v >> 4) * 32; k0 = (v & 15) * 64; col0 = n0; src = win; ld = NIN; K = 1024; dst = (h16*)(ws + OFF_WG); }
else if ((v -= 2048) < 640) {
  int b, kt;
  if (v < 384) { b = v >> 7; v &= 127; kt = 4; } else { b = 3; v -= 384; kt = 8; }
  n0 = (v / kt) * 32; k0 = (v % kt) * 64; K = kt * 64;
  const float* base = (b == 0) ? p.w_br_a : (b == 1) ? p.w_br_b : (b == 2) ? p.w_br_c : p.w_br_d;
  src = base + (size_t)l * K * 1024; ld = 1024; col0 = n0; dst = (h16*)(ws + OFF_WBR) + (size_t)b * 262144;
}
else if ((v -= 640) < 512) { n0 = (v >> 4) * 32; k0 = (v & 15) * 64; col0 = n0; src = p.w_out + (size_t)l * 1024 * 1024; ld = 1024; K = 1024; dst = (h16*)(ws + OFF_WOUT); }
else {
  v -= 512;
  if (!moe) {
    if (v < 2816) {
      int nbk = v >> 4; k0 = (v & 15) * 64; n0 = nbk * 32; col0 = (nbk >> 1) * 32;
      src = ((nbk & 1) ? p.ffn_w3 : p.ffn_w1) + (size_t)jj * 1024 * 2816; ld = 2816; K = 1024; dst = (h16*)(ws + OFF_WFF);
    } else {
      v -= 2816; n0 = (v / 44) * 32; k0 = (v % 44) * 64; col0 = n0; K = 2816;
      src = p.ffn_w2 + (size_t)jj * 2816 * 1024; ld = 1024; dst = (h16*)(ws + OFF_WFF) + (size_t)5632 * 1024;
    }
  } else {
    int e = v / 2112; v -= e * 2112;
    if (v < 1408) {
      int nbk = v >> 4; k0 = (v & 15) * 64; n0 = nbk * 32; col0 = (nbk >> 1) * 32;
      src = ((nbk & 1) ? p.moe_w3 : p.moe_w1) + (size_t)(jj * 8 + e) * 1024 * 1408; ld = 1408; K = 1024;
      dst = (h16*)(ws + OFF_WFF) + (size_t)e * 2816 * 1024;
    } else {
      v -= 1408; n0 = (v / 22) * 32; k0 = (v % 22) * 64; col0 = n0; K = 1408;
      src = p.moe_w2 + (size_t)(jj * 8 + e) * 1408 * 1024; ld = 1024;
      dst = (h16*)(ws + OFF_WFF) + (size_t)8 * 2816 * 1024 + (size_t)e * 1024 * 1408;
    }
  }
}
conv_unit(src, ld, col0, k0, dst, K, n0, lds);
}
DI void phase_convert_range(const Params& p, int l, int ubegin, int uend, int bid, int nb, h16* lds) {
  asm volatile("" : "+v"(bid));
  for (int u = ubegin + bid; u < uend; u += nb) conv_one(p, l, u, lds);
}
DI void moe_reset(const Params& p, int bid, int nb) {
  unsigned char* ws = p.ws;
  int* cnt = (int*)(ws + MOE_CNT);
  int* st = (int*)(ws + MOE_ST);
  int gs = nb * 256; asm volatile("" : "+s"(gs));
  const int gt = bid * 256 + otid();
  if (gt < 64) cnt[gt] = 0;
#pragma unroll 1
  for (int i = gt; i < NSLOT; i += gs) st[i] = 0;
}
DI void phase_init(const Params& p, int bid, int nb) {
  asm volatile("" : "+v"(bid));
  float* rc = (float*)(p.ws + OFF_ROPE);
  float* rs = rc + (size_t)SEQ * 32;
  const int gt = bid * 256 + otid(), gs = nb * 256;
  #pragma unroll 1
  for (int i = gt; i < SEQ * 32; i += gs) {
    int pos = i >> 5, d = i & 31;
    float inv = (float)pow(10000.0, -(double)d / 32.0);
    float ang = (float)pos * inv;
    rc[i] = cosf(ang); rs[i] = sinf(ang);
  }
  h16* x16 = (h16*)(p.ws + OFF_X16);
  #pragma unroll 1
  for (int i = gt; i < SEQ * DM / 4; i += gs) {
    float4 v = ((const float4*)p.x)[i];
    h4v o; o[0] = (h16)v.x; o[1] = (h16)v.y; o[2] = (h16)v.z; o[3] = (h16)v.w;
    *(h4v*)&x16[(size_t)i * 4] = o;
  }
}

template <bool GATHER>
DI void gemm_main(const h16* __restrict__ A, int lda, const int* __restrict__ idx, int m0,
                  const h16* __restrict__ B, int ldb, int n0, int K, h16* lds, f16v (&acc)[2][2]) {
  const int tid = otid(), lane = tid & 63, wv = tid >> 6, wm = wv >> 1, wn = wv & 1;
  h16* As = lds; h16* Bs = lds + 128 * LDH;
  const int lr = tid >> 1, lc = (tid & 1) * 32;
  const h16* ap = A + (size_t)(GATHER ? idx[m0 + lr] : (m0 + lr)) * lda + lc;
  const h16* bp = B + (size_t)(n0 + lr) * ldb + lc;
  u4v ra[4], rb[4];
#pragma unroll
  for (int i = 0; i < 4; ++i) { ra[i] = *(const u4v*)(ap + 8 * i); rb[i] = *(const u4v*)(bp + 8 * i); }
  const int nk = K >> 6;
  for (int kt = 0; kt < nk; ++kt) {
    __syncthreads();
#pragma unroll
    for (int i = 0; i < 4; ++i) { *(u4v*)&As[lr * LDH + lc + 8 * i] = ra[i]; *(u4v*)&Bs[lr * LDH + lc + 8 * i] = rb[i]; }
    __syncthreads();
    if (kt + 1 < nk) {
      ap += 64; bp += 64;
#pragma unroll
      for (int i = 0; i < 4; ++i) { ra[i] = *(const u4v*)(ap + 8 * i); rb[i] = *(const u4v*)(bp + 8 * i); }
    }
#pragma unroll
    for (int ks = 0; ks < 4; ++ks) {
      h8v af[2], bf[2];
#pragma unroll
      for (int i = 0; i < 2; ++i) af[i] = *(const h8v*)&As[(wm * 64 + i * 32 + (lane & 31)) * LDH + ks * 16 + 8 * (lane >> 5)];
#pragma unroll
      for (int j = 0; j < 2; ++j) bf[j] = *(const h8v*)&Bs[(wn * 64 + j * 32 + (lane & 31)) * LDH + ks * 16 + 8 * (lane >> 5)];
#pragma unroll
      for (int i = 0; i < 2; ++i)
#pragma unroll
        for (int j = 0; j < 2; ++j) acc[i][j] = mfma32(bf[j], af[i], acc[i][j]);
    }
  }
}
DI void acc_zero(f16v (&acc)[2][2]) {
#pragma unroll
  for (int i = 0; i < 2; ++i)
#pragma unroll
    for (int j = 0; j < 2; ++j)
#pragma unroll
      for (int r = 0; r < 16; ++r) acc[i][j][r] = 0.f;
}
template <class Epi>
DI void gemm_epilogue(f16v (&acc)[2][2], int m0, int n0, Epi epi) {
  const int tid = otid(), lane = tid & 63, wv = tid >> 6, wm = wv >> 1, wn = wv & 1, h = lane >> 5;
#pragma unroll
  for (int i = 0; i < 2; ++i) {
    const int m = m0 + wm * 64 + i * 32 + (lane & 31);
#pragma unroll
    for (int g = 0; g < 4; ++g) {
      const int n = n0 + wn * 64 + 8 * g + 4 * h;
      f4v v0 = {acc[i][0][4 * g], acc[i][0][4 * g + 1], acc[i][0][4 * g + 2], acc[i][0][4 * g + 3]};
      f4v v1 = {acc[i][1][4 * g], acc[i][1][4 * g + 1], acc[i][1][4 * g + 2], acc[i][1][4 * g + 3]};
      epi(m, n, v0, v1);
    }
  }
}


template <bool GATHER>
DI void gemm256_main(const h16* __restrict__ A, int lda, const int* __restrict__ idx, int m0,
                     const h16* __restrict__ B, int ldb, int n0, int K, h16* lds, f16v (&acc)[4][2]) {
  const int tid = otid512(), lane = tid & 63, wv = tid >> 6, wm = wv >> 2, wn = wv & 3;
  const int lr = tid >> 1, lc = (tid & 1) * 32;
  unsigned ao = (unsigned)(GATHER ? idx[m0 + lr] : (m0 + lr)) * (unsigned)lda + lc;
  unsigned bo = (unsigned)(n0 + lr) * (unsigned)ldb + lc;
  const h16* ap = A; const h16* bp = B;
#define AP_ (ap + ao)
#define BP_ (bp + bo)
  u4v ra[4], rb[4];
  const int nk = K >> 6;
  __syncthreads();
#pragma unroll
  for (int i = 0; i < 4; ++i) { ra[i] = *(const u4v*)(AP_ + 8 * i); rb[i] = *(const u4v*)(BP_ + 8 * i); }
  ao += 64; bo += 64;
#pragma unroll
  for (int i = 0; i < 4; ++i) { *(u4v*)&lds[lr * LDH + lc + 8 * i] = ra[i]; *(u4v*)&lds[(256 + lr) * LDH + lc + 8 * i] = rb[i]; }
#pragma unroll
  for (int i = 0; i < 4; ++i) { ra[i] = *(const u4v*)(AP_ + 8 * i); rb[i] = *(const u4v*)(BP_ + 8 * i); }
  ao += 64; bo += 64;
  __syncthreads();
  for (int kt = 0; kt < nk; ++kt) {
    const h16* As = lds + (kt & 1) * (512 * LDH);
    const h16* Bs = As + 256 * LDH;
    h16* Wn = lds + ((kt & 1) ^ 1) * (512 * LDH);
    if (kt + 1 < nk) {
#pragma unroll
      for (int i = 0; i < 4; ++i) { *(u4v*)&Wn[lr * LDH + lc + 8 * i] = ra[i]; *(u4v*)&Wn[(256 + lr) * LDH + lc + 8 * i] = rb[i]; }
    }
    if (kt + 2 < nk) {
#pragma unroll
      for (int i = 0; i < 4; ++i) { ra[i] = *(const u4v*)(AP_ + 8 * i); rb[i] = *(const u4v*)(BP_ + 8 * i); }
      ao += 64; bo += 64;
    }
#pragma unroll
    for (int ks = 0; ks < 4; ++ks) {
      h8v af[4], bf[2];
#pragma unroll
      for (int i = 0; i < 4; ++i) af[i] = *(const h8v*)&As[(wm * 128 + i * 32 + (lane & 31)) * LDH + ks * 16 + 8 * (lane >> 5)];
#pragma unroll
      for (int j = 0; j < 2; ++j) bf[j] = *(const h8v*)&Bs[(wn * 64 + j * 32 + (lane & 31)) * LDH + ks * 16 + 8 * (lane >> 5)];
#pragma unroll
      for (int i = 0; i < 4; ++i)
#pragma unroll
        for (int j = 0; j < 2; ++j) acc[i][j] = mfma32(bf[j], af[i], acc[i][j]);
    }
    __syncthreads();
  }
}
DI void acc256_zero(f16v (&acc)[4][2]) {
#pragma unroll
  for (int i = 0; i < 4; ++i)
#pragma unroll
    for (int j = 0; j < 2; ++j)
#pragma unroll
      for (int r = 0; r < 16; ++r) acc[i][j][r] = 0.f;
}
template <class Epi>
DI void gemm256_epilogue(f16v (&acc)[4][2], int m0, int n0, Epi epi) {
  const int tid = otid512(), lane = tid & 63, wv = tid >> 6, wm = wv >> 2, wn = wv & 3, h = lane >> 5;
#pragma unroll
  for (int i = 0; i < 4; ++i) {
    const int m = m0 + wm * 128 + i * 32 + (lane & 31);
#pragma unroll
    for (int g = 0; g < 4; ++g) {
      const int n = n0 + wn * 64 + 8 * g + 4 * h;
      f4v v0 = {acc[i][0][4 * g], acc[i][0][4 * g + 1], acc[i][0][4 * g + 2], acc[i][0][4 * g + 3]};
      f4v v1 = {acc[i][1][4 * g], acc[i][1][4 * g + 1], acc[i][1][4 * g + 2], acc[i][1][4 * g + 3]};
      epi(m, n, v0, v1);
    }
  }
}

DI void scal_unit(const Params& p, int l, int unit, float* lds) {
  const float* xs = (l == 0) ? p.x : p.out;
  const float* win = p.w_in + (size_t)l * 1024 * NIN;
  float* ps = (float*)(p.ws + OFF_PSCAL);
  float* xt = lds;
  float* wt = lds + 64 * 68;
  const int t = otid(), lane = t & 63, w = t >> 6, r = lane & 15, q = lane >> 4;
  f4v acc[2];
  acc[0] = (f4v){0.f, 0.f, 0.f, 0.f}; acc[1] = (f4v){0.f, 0.f, 0.f, 0.f};
  const int t0 = unit * 64;
  for (int k0 = 0; k0 < 1024; k0 += 64) {
    __syncthreads();
#pragma unroll
    for (int i = 0; i < 4; ++i) { int e = t + 256 * i; int rr = e >> 4, c4 = (e & 15) * 4; *(f4v*)&xt[rr * 68 + c4] = *(const f4v*)&xs[(size_t)(t0 + rr) * DM + k0 + c4]; }
#pragma unroll
    for (int i = 0; i < 8; ++i) { int e = t + 256 * i; int kk = e >> 5, c = e & 31; int col = (c < 16) ? (5120 + c) : (8464 + (c - 16)); wt[kk * 32 + c] = win[(size_t)(k0 + kk) * NIN + col]; }
    __syncthreads();
#pragma unroll
    for (int ks = 0; ks < 16; ++ks) {
      const float a = xt[(16 * w + r) * 68 + ks * 4 + q];
      const float b0 = wt[(ks * 4 + q) * 32 + r], b1 = wt[(ks * 4 + q) * 32 + 16 + r];
      acc[0] = __builtin_amdgcn_mfma_f32_16x16x4f32(a, b0, acc[0], 0, 0, 0);
      acc[1] = __builtin_amdgcn_mfma_f32_16x16x4f32(a, b1, acc[1], 0, 0, 0);
    }
  }
#pragma unroll
  for (int nt = 0; nt < 2; ++nt)
#pragma unroll
    for (int rg = 0; rg < 4; ++rg) ps[(size_t)(t0 + 16 * w + 4 * q + rg) * 32 + 16 * nt + r] = acc[nt][rg];
}

DI void phase_p1(const Params& p, int l, int bid, int nb, int vb, int vnb, unsigned char* smem, unsigned char* smem_half) {
  asm volatile("" : "+v"(vb));
  unsigned char* ws = p.ws;
  const h16* x16 = (const h16*)(ws + OFF_X16);
  const h16* wsm = (const h16*)(ws + OFF_WSM);
  h16* ps = (h16*)(ws + OFF_PS);
  const float* rc = (const float*)(ws + OFF_ROPE);
  const float* rs = rc + (size_t)SEQ * 32;
  for (int u = vb; u < 256; u += vnb) scal_unit(p, l, u, (float*)smem_half);
  for (int u = bid; u < 64 * 20; u += nb) {
    const int m0 = (u / 20) * 256, n0 = (u % 20) * 256;
    f16v acc[4][2]; acc256_zero(acc);
    gemm256_main<false>(x16, DM, nullptr, m0, wsm, 1024, n0, 1024, (h16*)smem, acc);
    gemm256_epilogue(acc, m0, n0, [&](int m, int n, f4v v0, f4v v1) {
      const bool rope = (n >= 1024 && n < 2560) || (n >= 4352 && n < 4992);
      if (rope) {
        const int d = n & 31;
        f4v c = *(const f4v*)&rc[(size_t)m * 32 + d], s = *(const f4v*)&rs[(size_t)m * 32 + d];
        f4v o0 = v0 * c - v1 * s, o1 = v1 * c + v0 * s;
        v0 = o0; v1 = o1;
      }
      st_h4(&ps[(size_t)m * NSM + n], v0);
      st_h4(&ps[(size_t)m * NSM + n + 32], v1);
    });
  }
}

DI void img_store_nat(h16* img, int row, int seg, u4v a, u4v b) {
  *(u4v*)&img[row * LDH + 16 * seg] = a; *(u4v*)&img[row * LDH + 16 * seg + 8] = b;
}
DI void img_store_T(h16* img, int row, int seg, u4v a, u4v b) {
  const h16* pa = (const h16*)&a; const h16* pb = (const h16*)&b;
#pragma unroll
  for (int i = 0; i < 8; ++i) { img[(16 * seg + i) * LDH + row] = pa[i]; img[(16 * seg + 8 + i) * LDH + row] = pb[i]; }
}

template <int NKB>
DI void attn_unit(const Params& p, int l, int mode, int grp, int head, int r0, int dil, int i0, int sub_len, int W, h16* lds) {
  unsigned char* ws = p.ws;
  const h16* P = (const h16*)(ws + OFF_PS);
  h16* Qi = lds; h16* Ki = lds + 64 * LDH; h16* Vt = lds + 128 * LDH; h16* Pi = lds + 192 * LDH;
  const int tid = otid(), lane = tid & 63, w = tid >> 6, r = lane & 15, q = lane >> 4;
  const int lrow = tid >> 2, seg = tid & 3;
  int qcol, kcol, vcol;
  if (mode == 0) { qcol = 1024 + grp * 256 + head * 64; kcol = 1792 + grp * 256 + head * 64; vcol = 2560 + grp * 256 + head * 64; }
  else { qcol = 4352 + head * 64; kcol = 4864 + (head >> 2) * 64; vcol = 4992 + (head >> 2) * 64; }
  __syncthreads();
  {
    const size_t pos = (size_t)r0 + (size_t)dil * (i0 + lrow);
    const h16* g = P + pos * NSM + qcol + 16 * seg;
    img_store_nat(Qi, lrow, seg, *(const u4v*)g, *(const u4v*)(g + 8));
  }
  float mrow[4], lsum[4];
  f4v O[4];
  float m_init = -1e30f, l_init = 0.f;
  if (mode == 1) { m_init = p.d_sink[l * 8 + head]; l_init = 1.f; }
#pragma unroll
  for (int i = 0; i < 4; ++i) { mrow[i] = m_init; lsum[i] = l_init; O[i] = (f4v){0.f, 0.f, 0.f, 0.f}; }
  u4v pk0, pk1, pv0, pv1;
#define ATT_PREFETCH(kb_) do { const int j0p_ = i0 - W + 64 * (kb_); const int j0q_ = ((j0p_ >= 0) && (j0p_ < sub_len)) ? j0p_ : i0; \
    const size_t posp_ = (size_t)r0 + (size_t)dil * (j0q_ + lrow);                                                                  \
    const h16* gk_ = P + posp_ * NSM + kcol + 16 * seg; const h16* gv_ = P + posp_ * NSM + vcol + 16 * seg;                           \
    pk0 = *(const u4v*)gk_; pk1 = *(const u4v*)(gk_ + 8); pv0 = *(const u4v*)gv_; pv1 = *(const u4v*)(gv_ + 8); } while (0)
  ATT_PREFETCH(0);
  for (int kb = 0; kb < NKB; ++kb) {
    const int j0 = i0 - W + 64 * kb;
    const bool inr = (j0 >= 0) && (j0 < sub_len);
    __syncthreads();
    img_store_nat(Ki, lrow, seg, pk0, pk1);
    img_store_T(Vt, lrow, seg, pv0, pv1);
    __syncthreads();
    if (kb + 1 < NKB) ATT_PREFETCH(kb + 1);
    f4v S[4];
#pragma unroll
    for (int i = 0; i < 4; ++i) S[i] = (f4v){0.f, 0.f, 0.f, 0.f};
    mm64(Qi, Ki, S, w, lane);
    float mx[4], al[4], rsum[4];
    bool vm[4][4];
#pragma unroll
    for (int rg = 0; rg < 4; ++rg) {
      const int row = 16 * w + 4 * q + rg;
      float m_ = -1e30f;
#pragma unroll
      for (int nt = 0; nt < 4; ++nt) {
        const int key = 16 * nt + r;
        const int delta = row - key + W - 64 * kb;
        const bool ok = inr && (delta >= -W) && (delta <= W);
        vm[nt][rg] = ok;
        float s = S[nt][rg] * 0.125f;
        S[nt][rg] = s;
        if (ok) m_ = fmaxf(m_, s);
      }
      mx[rg] = grp16_max(m_);
    }
#pragma unroll
    for (int rg = 0; rg < 4; ++rg) {
      const float mn = fmaxf(mrow[rg], mx[rg]);
      al[rg] = __expf(mrow[rg] - mn);
      mrow[rg] = mn;
      float rs_ = 0.f;
#pragma unroll
      for (int nt = 0; nt < 4; ++nt) {
        float pv = vm[nt][rg] ? __expf(S[nt][rg] - mn) : 0.f;
        rs_ += pv;
        Pi[(16 * w + 4 * q + rg) * LDH + 16 * nt + r] = (h16)pv;
      }
      rsum[rg] = grp16_sum(rs_);
      lsum[rg] = lsum[rg] * al[rg] + rsum[rg];
    }
#pragma unroll
    for (int et = 0; et < 4; ++et)
#pragma unroll
      for (int rg = 0; rg < 4; ++rg) O[et][rg] *= al[rg];
    __syncthreads();
    mm64(Pi, Vt, O, w, lane);
  }
#pragma unroll
  for (int rg = 0; rg < 4; ++rg) {
    const int row = 16 * w + 4 * q + rg;
    const size_t pos = (size_t)r0 + (size_t)dil * (i0 + row);
    const float inv = 1.f / lsum[rg];
    if (mode == 0) {
      h16* ob = (h16*)(ws + OFF_OB) + ((size_t)grp * SEQ + pos) * 256 + head * 64;
#pragma unroll
      for (int et = 0; et < 4; ++et) ob[16 * et + r] = (h16)(O[et][rg] * inv);
      if (r == 0) {
        float* ml = (float*)(ws + OFF_MLB) + (((size_t)grp * SEQ + pos) * 4 + head) * 2;
        ml[0] = mrow[rg]; ml[1] = lsum[rg];
      }
    } else {
      h16* y = (h16*)(ws + OFF_Y) + pos * 1280 + 768 + head * 64;
#pragma unroll
      for (int et = 0; et < 4; ++et) y[16 * et + r] = (h16)(O[et][rg] * inv);
    }
  }
}

DI void bcombine_unit(const Params& p, int unit) {
  unsigned char* ws = p.ws;
  const int gi = unit * 256 + otid();
  const int seg = gi & 7, head = (gi >> 3) & 3, pos = gi >> 5;
  const float* ml = (const float*)(ws + OFF_MLB);
  const h16* ob = (const h16*)(ws + OFF_OB);
  float m[3], lv[3];
#pragma unroll
  for (int g = 0; g < 3; ++g) { const float* q = ml + (((size_t)g * SEQ + pos) * 4 + head) * 2; m[g] = q[0]; lv[g] = q[1]; }
  const float M = fmaxf(m[0], fmaxf(m[1], m[2]));
  float wg[3], den = 0.f;
#pragma unroll
  for (int g = 0; g < 3; ++g) { wg[g] = __expf(m[g] - M) * lv[g]; den += wg[g]; }
  const float inv = 1.f / den;
  float o[8];
#pragma unroll
  for (int i = 0; i < 8; ++i) o[i] = 0.f;
#pragma unroll
  for (int g = 0; g < 3; ++g) {
    h8v v = *(const h8v*)&ob[((size_t)g * SEQ + pos) * 256 + head * 64 + seg * 8];
#pragma unroll
    for (int i = 0; i < 8; ++i) o[i] += wg[g] * (float)v[i];
  }
  h8v ov;
#pragma unroll
  for (int i = 0; i < 8; ++i) ov[i] = (h16)(o[i] * inv);
  *(h8v*)((h16*)(ws + OFF_Y) + (size_t)pos * 1280 + 256 + head * 64 + seg * 8) = ov;
}

DI void mlstm_a1_unit(const Params& p, int l, int head, int oc, h16* lds) {
  unsigned char* ws = p.ws;
  const h16* P = (const h16*)(ws + OFF_PS);
  const float* pscal = (const float*)(ws + OFF_PSCAL);
  float* sca = (float*)(ws + OFF_SCA);
  float* scas = (float*)(ws + OFF_SCAS);
  h16* Ks0 = lds; h16* Ks1 = lds + 64 * LDH; h16* Vt = lds + 128 * LDH;
  float* sw = (float*)(lds + 192 * LDH);
  const int tid = otid(), lane = tid & 63, w = tid >> 6, r = lane & 15, q = lane >> 4;
  __syncthreads();
  if (w < 2) {
    const int dir = w;
    const int rr = dir ? 63 - lane : lane;
    const size_t pos = (size_t)oc * 64 + rr;
    const float* gb = p.a_gate_bias + l * 16;
    const float ig = pscal[pos * 32 + dir * 8 + head] + gb[dir * 8 + head];
    const float lf = logsigmoid_(pscal[pos * 32 + dir * 8 + 4 + head] + gb[dir * 8 + 4 + head]);
    const float b = wave_incl_sum(lf, lane);
    const float blast = __shfl(b, 63);
    const float slog = blast - b + ig;
    const float mc = wave_max(slog);
    sw[dir * 64 + rr] = __expf(slog - mc) * 0.125f;
    if (lane == 0) {
      const int nloc = dir ? 255 - oc : oc;
      float* s4 = scas + ((size_t)(dir * 4 + head) * 256 + nloc) * 4;
      s4[0] = blast; s4[1] = mc;
    }
  }
  __syncthreads();
  {
    const int lrow = tid >> 2, seg = tid & 3;
    const size_t pos = (size_t)oc * 64 + lrow;
    const h16* gk = P + pos * NSM + 256 + head * 64 + 16 * seg;
    const h16* gv = P + pos * NSM + 512 + head * 64 + 16 * seg;
    h8v k0 = *(const h8v*)gk, k1 = *(const h8v*)(gk + 8);
    u4v v0 = *(const u4v*)gv, v1 = *(const u4v*)(gv + 8);
    const float s0 = sw[lrow], s1 = sw[64 + lrow];
#pragma unroll
    for (int i = 0; i < 8; ++i) {
      Ks0[(16 * seg + i) * LDH + lrow] = (h16)((float)k0[i] * s0);
      Ks0[(16 * seg + 8 + i) * LDH + lrow] = (h16)((float)k1[i] * s0);
      Ks1[(16 * seg + i) * LDH + lrow] = (h16)((float)k0[i] * s1);
      Ks1[(16 * seg + 8 + i) * LDH + lrow] = (h16)((float)k1[i] * s1);
    }
    img_store_T(Vt, lrow, seg, v0, v1);
  }
  __syncthreads();
#pragma unroll
  for (int dir = 0; dir < 2; ++dir) {
    const h16* Ks = dir ? Ks1 : Ks0;
    const int nloc = dir ? 255 - oc : oc;
    float* dst = sca + ((size_t)(dir * 4 + head) * 256 + nloc) * 4160;
    f4v acc[4];
#pragma unroll
    for (int i = 0; i < 4; ++i) acc[i] = (f4v){0.f, 0.f, 0.f, 0.f};
    mm64(Vt, Ks, acc, w, lane);
#pragma unroll
    for (int nt = 0; nt < 4; ++nt)
#pragma unroll
      for (int rg = 0; rg < 4; ++rg) dst[(16 * w + 4 * q + rg) * 64 + 16 * nt + r] = acc[nt][rg];
    if (w == dir) {
      float s = 0.f;
#pragma unroll 8
      for (int j = 0; j < 64; ++j) s += (float)Ks[lane * LDH + j];
      dst[4096 + lane] = s;
    }
  }
}

DI void mlstm_a2_unit(const Params& p, int unit) {
  unsigned char* ws = p.ws;
  float* sca = (float*)(ws + OFF_SCA);
  float* scas = (float*)(ws + OFF_SCAS);
  const int dh = unit / 17, sl = unit % 17;
  const int e = sl * 256 + otid();
  if (e >= 4160) return;
  float* base = sca + (size_t)dh * 256 * 4160 + e;
  float* s4 = scas + (size_t)dh * 256 * 4;
  float m = 0.f, c = 0.f;
  for (int n0 = 0; n0 < 256; n0 += 8) {
    float cc[8];
#pragma unroll
    for (int i = 0; i < 8; ++i) cc[i] = base[(size_t)(n0 + i) * 4160];
#pragma unroll
    for (int i = 0; i < 8; ++i) {
      const float bl = s4[(n0 + i) * 4], mc = s4[(n0 + i) * 4 + 1];
      const float mn = fmaxf(bl + m, mc);
      const float dec = __expf(bl + m - mn), gain = __expf(mc - mn);
      base[(size_t)(n0 + i) * 4160] = c;
      if (e == 0) s4[(n0 + i) * 4 + 2] = m;
      c = dec * c + gain * cc[i];
      m = mn;
    }
  }
}

DI void mlstm_a3_unit(const Params& p, int l, int head, int oc, h16* lds) {
  unsigned char* ws = p.ws;
  const h16* P = (const h16*)(ws + OFF_PS);
  const float* pscal = (const float*)(ws + OFF_PSCAL);
  const float* sca = (const float*)(ws + OFF_SCA);
  const float* scas = (const float*)(ws + OFF_SCAS);
  h16* Qi = lds; h16* Ki = lds + 64 * LDH; h16* Vt = lds + 128 * LDH; h16* Wi = lds + 192 * LDH; h16* Ci = lds + 256 * LDH;
  float* fl = (float*)(lds + 320 * LDH);
  float* rowterm = fl;
  float* colterm = fl + 128;
  float* ainter = fl + 256;
  float* emt = fl + 384;
  float* nvec = fl + 512;
  float* qn = fl + 576;
  const int tid = otid(), lane = tid & 63, w = tid >> 6, r = lane & 15, q = lane >> 4;
  const int lrow = tid >> 2, seg = tid & 3;
  __syncthreads();
  {
    const size_t pos = (size_t)oc * 64 + lrow;
    const h16* g = P + pos * NSM + head * 64 + 16 * seg;
    img_store_nat(Qi, lrow, seg, *(const u4v*)g, *(const u4v*)(g + 8));
    img_store_nat(Ki, lrow, seg, *(const u4v*)(g + 256), *(const u4v*)(g + 264));
    img_store_T(Vt, lrow, seg, *(const u4v*)(g + 512), *(const u4v*)(g + 520));
  }
  if (w < 2) {
    const int dir = w;
    const int rr = dir ? 63 - lane : lane;
    const size_t pos = (size_t)oc * 64 + rr;
    const int nloc = dir ? 255 - oc : oc;
    const float* gb = p.a_gate_bias + l * 16;
    const float ig = pscal[pos * 32 + dir * 8 + head] + gb[dir * 8 + head];
    const float lf = logsigmoid_(pscal[pos * 32 + dir * 8 + 4 + head] + gb[dir * 8 + 4 + head]);
    const float b = wave_incl_sum(lf, lane);
    const float u = ig - b;
    const float pm = wave_incl_max(u, lane);
    const float m_intra = b + pm;
    const float mprev = scas[((size_t)(dir * 4 + head) * 256 + nloc) * 4 + 2];
    const float mt = fmaxf(b + mprev, m_intra);
    rowterm[dir * 64 + rr] = b - mt;
    colterm[dir * 64 + rr] = u;
    ainter[dir * 64 + rr] = __expf(b + mprev - mt);
    emt[dir * 64 + rr] = __expf(-mt);
  }
  f4v hacc[4];
#pragma unroll
  for (int i = 0; i < 4; ++i) hacc[i] = (f4v){0.f, 0.f, 0.f, 0.f};
#pragma unroll 1
  for (int dir = 0; dir < 2; ++dir) {
    const int nloc = dir ? 255 - oc : oc;
    const float* src = sca + ((size_t)(dir * 4 + head) * 256 + nloc) * 4160;
    __syncthreads();
    {
      const float4* s4 = (const float4*)(src + lrow * 64 + 16 * seg);
      float4 a = s4[0], b = s4[1], c = s4[2], d = s4[3];
      h8v o0, o1;
      o0[0] = (h16)a.x; o0[1] = (h16)a.y; o0[2] = (h16)a.z; o0[3] = (h16)a.w; o0[4] = (h16)b.x; o0[5] = (h16)b.y; o0[6] = (h16)b.z; o0[7] = (h16)b.w;
      o1[0] = (h16)c.x; o1[1] = (h16)c.y; o1[2] = (h16)c.z; o1[3] = (h16)c.w; o1[4] = (h16)d.x; o1[5] = (h16)d.y; o1[6] = (h16)d.z; o1[7] = (h16)d.w;
      *(h8v*)&Ci[lrow * LDH + 16 * seg] = o0; *(h8v*)&Ci[lrow * LDH + 16 * seg + 8] = o1;
      if (tid < 64) nvec[tid] = src[4096 + tid];
    }
    __syncthreads();
    f4v S[4];
#pragma unroll
    for (int i = 0; i < 4; ++i) S[i] = (f4v){0.f, 0.f, 0.f, 0.f};
    mm64(Qi, Ki, S, w, lane);
    float dint[4];
#pragma unroll
    for (int rg = 0; rg < 4; ++rg) {
      const int t = 16 * w + 4 * q + rg;
      const float rt = rowterm[dir * 64 + t];
      float sum = 0.f;
#pragma unroll
      for (int nt = 0; nt < 4; ++nt) {
        const int s = 16 * nt + r;
        const bool ok = dir ? (s >= t) : (s <= t);
        const float wv = ok ? __expf(rt + colterm[dir * 64 + s]) * S[nt][rg] * 0.125f : 0.f;
        sum += wv;
        Wi[t * LDH + s] = (h16)wv;
      }
      dint[rg] = grp16_sum(sum);
    }
    {
      float s = 0.f;
#pragma unroll
      for (int i = 0; i < 16; ++i) s += (float)Qi[lrow * LDH + 16 * seg + i] * nvec[16 * seg + i];
      s += __shfl_xor(s, 1); s += __shfl_xor(s, 2);
      if (seg == 0) qn[lrow] = s;
    }
    __syncthreads();
    f4v a1[4], a2[4];
#pragma unroll
    for (int i = 0; i < 4; ++i) { a1[i] = (f4v){0.f, 0.f, 0.f, 0.f}; a2[i] = (f4v){0.f, 0.f, 0.f, 0.f}; }
    mm64(Wi, Vt, a1, w, lane);
    mm64(Qi, Ci, a2, w, lane);
#pragma unroll
    for (int rg = 0; rg < 4; ++rg) {
      const int t = 16 * w + 4 * q + rg;
      const float ai = ainter[dir * 64 + t];
      const float den = ai * qn[t] + dint[rg];
      const float dn = 1.f / fmaxf(fabsf(den), emt[dir * 64 + t]);
#pragma unroll
      for (int et = 0; et < 4; ++et) hacc[et][rg] += (a1[et][rg] + ai * a2[et][rg]) * dn;
    }
  }
  const float* nw = p.a_norm_w + l * 256 + head * 64;
#pragma unroll
  for (int rg = 0; rg < 4; ++rg) {
    const int t = 16 * w + 4 * q + rg;
    const size_t pos = (size_t)oc * 64 + t;
    float s = hacc[0][rg] + hacc[1][rg] + hacc[2][rg] + hacc[3][rg];
    const float mu = grp16_sum(s) * (1.f / 64.f);
    float vs = 0.f;
#pragma unroll
    for (int et = 0; et < 4; ++et) { float d = hacc[et][rg] - mu; vs += d * d; }
    const float var = grp16_sum(vs) * (1.f / 64.f);
    const float rstd = rsqrtf(var + 1e-5f);
    h16* y = (h16*)(ws + OFF_Y) + pos * 1280 + head * 64;
    const h16* ao = P + pos * NSM + 768 + head * 64;
#pragma unroll
    for (int et = 0; et < 4; ++et) {
      const int e = 16 * et + r;
      y[e] = (h16)((hacc[et][rg] - mu) * rstd * nw[e] * sigmoid_((float)ao[e]));
    }
  }
}

template <int DIR>
DI void dn_solve4(const float* M, const h16* Ki, const h16* Vi, const float* betal, const float* gcl, int half, int c, int pp, float (&x)[16]) {
  const h16* src = half ? (Ki + c) : (Vi + c);
#pragma unroll
  for (int k = 0; k < 16; ++k) x[k] = 0.f;
#pragma unroll
  for (int il = 0; il < 64; ++il) {
    const int ri = DIR ? 63 - il : il;
    float part = 0.f;
#pragma unroll
    for (int k = 0; k < (il + 3) / 4; ++k) {
      const int jl0 = 4 * k;
      float mv = DIR ? M[ri * MLD + 63 - jl0 - pp] : M[ri * MLD + jl0 + pp];
      if (jl0 + 3 >= il) mv = (jl0 + pp < il) ? mv : 0.f;
      part += mv * x[k];
    }
    part += __shfl_xor(part, 1); part += __shfl_xor(part, 2);
    const float e = half ? __expf(gcl[ri]) : 1.f;
    const float xi = betal[ri] * (float)src[ri * LDH] * e - part;
    if ((il & 3) == pp) x[il >> 2] = xi;
  }
}

DI void dn_c1_unit(const Params& p, int l, int head, int oc, h16* lds) {
  unsigned char* ws = p.ws;
  const h16* P = (const h16*)(ws + OFF_PS);
  const float* pscal = (const float*)(ws + OFF_PSCAL);
  h16* cq = (h16*)(ws + OFF_CQKV);
  h16* Ki = lds; h16* Vi = lds + 64 * LDH;
  float* M = (float*)(lds + 128 * LDH);
  float* betal = M + 64 * MLD;
  float* gcl = betal + 128;
  float* glast = gcl + 128;
  const int tid = otid(), lane = tid & 63, w = tid >> 6, r = lane & 15, q = lane >> 4;
  const int lrow = tid >> 2, seg = tid & 3;
  __syncthreads();
  {
    const int pos = oc * 64 + lrow;
    const float* cw = p.c_conv_w + (size_t)l * 5 * 768;
    float vq[16], vk[16], vv[16];
#pragma unroll
    for (int i = 0; i < 16; ++i) { vq[i] = 0.f; vk[i] = 0.f; vv[i] = 0.f; }
#pragma unroll
    for (int j = 0; j < 5; ++j) {
      const int pp = pos + j - 2;
      if (pp < 0 || pp >= SEQ) continue;
      const h16* g = P + (size_t)pp * NSM + 3328 + head * 64 + 16 * seg;
      h8v q0 = *(const h8v*)g, q1 = *(const h8v*)(g + 8);
      h8v k0 = *(const h8v*)(g + 256), k1 = *(const h8v*)(g + 264);
      h8v v0 = *(const h8v*)(g + 512), v1 = *(const h8v*)(g + 520);
      const float* wq = cw + j * 768 + head * 64 + 16 * seg;
#pragma unroll
      for (int i = 0; i < 8; ++i) {
        vq[i] += wq[i] * (float)q0[i]; vq[8 + i] += wq[8 + i] * (float)q1[i];
        vk[i] += wq[256 + i] * (float)k0[i]; vk[8 + i] += wq[264 + i] * (float)k1[i];
        vv[i] += wq[512 + i] * (float)v0[i]; vv[8 + i] += wq[520 + i] * (float)v1[i];
      }
    }
    float sq = 0.f, sk = 0.f;
#pragma unroll
    for (int i = 0; i < 16; ++i) { vq[i] = silu_(vq[i]); vk[i] = silu_(vk[i]); vv[i] = silu_(vv[i]); sq += vq[i] * vq[i]; sk += vk[i] * vk[i]; }
    sq += __shfl_xor(sq, 1); sq += __shfl_xor(sq, 2);
    sk += __shfl_xor(sk, 1); sk += __shfl_xor(sk, 2);
    const float rq = rsqrtf(sq + 1e-6f) * 0.125f, rk = rsqrtf(sk + 1e-6f);
    h8v oq0, oq1, ok0, ok1, ov0, ov1;
#pragma unroll
    for (int i = 0; i < 8; ++i) {
      oq0[i] = (h16)(vq[i] * rq); oq1[i] = (h16)(vq[8 + i] * rq);
      ok0[i] = (h16)(vk[i] * rk); ok1[i] = (h16)(vk[8 + i] * rk);
      ov0[i] = (h16)vv[i]; ov1[i] = (h16)vv[8 + i];
    }
    h16* o = cq + (size_t)pos * 768 + head * 64 + 16 * seg;
    *(h8v*)o = oq0; *(h8v*)(o + 8) = oq1;
    *(h8v*)(o + 256) = ok0; *(h8v*)(o + 264) = ok1;
    *(h8v*)(o + 512) = ov0; *(h8v*)(o + 520) = ov1;
    *(h8v*)&Ki[lrow * LDH + 16 * seg] = ok0; *(h8v*)&Ki[lrow * LDH + 16 * seg + 8] = ok1;
    *(h8v*)&Vi[lrow * LDH + 16 * seg] = ov0; *(h8v*)&Vi[lrow * LDH + 16 * seg + 8] = ov1;
  }
  if (w < 2) {
    const int dir = w;
    const int rr = dir ? 63 - lane : lane;
    const size_t pos = (size_t)oc * 64 + rr;
    const float beta = sigmoid_(pscal[pos * 32 + 16 + dir * 4 + head]);
    const float g = -__expf(p.c_a_log[l * 8 + dir * 4 + head]) * softplus_(pscal[pos * 32 + 24 + dir * 4 + head] + p.c_dt_bias[l * 8 + dir * 4 + head]);
    const float gc = wave_incl_sum(g, lane);
    const float gl = __shfl(gc, 63);
    betal[dir * 64 + rr] = beta; gcl[dir * 64 + rr] = gc;
    if (lane == 0) {
      glast[dir] = gl;
      const int nloc = dir ? 255 - oc : oc;
      ((float*)(ws + OFF_CDL))[(size_t)(dir * 4 + head) * 256 + nloc] = __expf(gl);
    }
  }
  __syncthreads();
  {
    f4v kk[4];
#pragma unroll
    for (int i = 0; i < 4; ++i) kk[i] = (f4v){0.f, 0.f, 0.f, 0.f};
    mm64(Ki, Ki, kk, w, lane);
#pragma unroll
    for (int nt = 0; nt < 4; ++nt)
#pragma unroll
      for (int rg = 0; rg < 4; ++rg) {
        const int i = 16 * w + 4 * q + rg, j = 16 * nt + r;
        float v = 0.f;
        if (j < i) v = betal[i] * kk[nt][rg] * __expf(gcl[i] - gcl[j]);
        else if (j > i) v = betal[64 + i] * kk[nt][rg] * __expf(gcl[64 + i] - gcl[64 + j]);
        M[i * MLD + j] = v;
      }
  }
  __syncthreads();
  {
    const int c = tid >> 2, pp = tid & 3;
#pragma unroll 1
    for (int dh2 = 0; dh2 < 4; ++dh2) {
      const int dir = dh2 >> 1, half = dh2 & 1;
      const int nloc = dir ? 255 - oc : oc;
      const size_t unit = (size_t)(dir * 4 + head) * 256 + nloc;
      float x[16];
      if (dir == 0) dn_solve4<0>(M, Ki, Vi, betal, gcl, half, c, pp, x);
      else dn_solve4<1>(M, Ki, Vi, betal + 64, gcl + 64, half, c, pp, x);
      if (half == 0) {
        float* ud = (float*)(ws + OFF_CU) + unit * 4096;
        const int slice = c >> 4, el = c & 15;
#pragma unroll
        for (int k = 0; k < 16; ++k) {
          const int il = 4 * k + pp;
          const int rr = dir ? 63 - il : il;
          ud[((slice * 4 + (rr >> 4)) * 64 + el + 16 * ((rr & 15) >> 2)) * 4 + (rr & 3)] = x[k];
        }
      } else {
        h16* wd = (h16*)(ws + OFF_CW) + unit * 4096;
        const int s = c >> 5, lq = (c & 15) >> 2, jjx = (c & 3) + 4 * ((c & 31) >> 4);
#pragma unroll
        for (int k = 0; k < 16; ++k) {
          const int il = 4 * k + pp;
          const int rr = dir ? 63 - il : il;
          wd[(((rr >> 4) * 2 + s) * 64 + (rr & 15) + 16 * lq) * 8 + jjx] = (h16)(-x[k]);
        }
      }
    }
  }
#pragma unroll
  for (int dir = 0; dir < 2; ++dir) {
    const int nloc = dir ? 255 - oc : oc;
    const size_t unit = (size_t)(dir * 4 + head) * 256 + nloc;
    h16* kd = (h16*)(ws + OFF_CKD) + unit * 4096;
    const float gl = glast[dir];
#pragma unroll
    for (int it = 0; it < 4; ++it) {
      const int e = tid + 256 * it;
      const int d = e & 63, rq = e >> 6;
      const int r0 = 4 * rq;
      h4v o;
#pragma unroll
      for (int i = 0; i < 4; ++i) o[i] = (h16)((float)Ki[(r0 + i) * LDH + d] * __expf(gl - gcl[dir * 64 + r0 + i]));
      const int tile = d >> 4, s = r0 >> 5, ln = (d & 15) + 16 * ((r0 & 15) >> 2), j4 = 4 * ((r0 & 31) >> 4);
      *(h4v*)&kd[((tile * 2 + s) * 64 + ln) * 8 + j4] = o;
    }
  }
}

DI void dn_c2_unit(const Params& p, int dh, int w) {
  unsigned char* ws = p.ws;
  const int tid = otid(), lane = tid & 63;
  if (tid >= 64) return;
  const h16* cw = (const h16*)(ws + OFF_CW) + (size_t)dh * 256 * 4096;
  const h16* ckd = (const h16*)(ws + OFF_CKD) + (size_t)dh * 256 * 4096;
  const float* cu = (const float*)(ws + OFF_CU) + (size_t)dh * 256 * 4096;
  const float* cdl = (const float*)(ws + OFF_CDL) + (size_t)dh * 256;
  h16* cs = (h16*)(ws + OFF_CS) + (size_t)dh * 256 * 4096;
  h16* cvn = (h16*)(ws + OFF_CVN) + (size_t)dh * 256 * 4096;
  f4v S[4];
#pragma unroll
  for (int i = 0; i < 4; ++i) S[i] = (f4v){0.f, 0.f, 0.f, 0.f};
  h8v wA[4][2], kA[4][2]; f4v uu[4]; float dl;
#pragma unroll
  for (int t = 0; t < 4; ++t) {
#pragma unroll
    for (int s = 0; s < 2; ++s) {
      wA[t][s] = *(const h8v*)&cw[((t * 2 + s) * 64 + lane) * 8];
      kA[t][s] = *(const h8v*)&ckd[((t * 2 + s) * 64 + lane) * 8];
    }
    uu[t] = *(const f4v*)&cu[((w * 4 + t) * 64 + lane) * 4];
  }
  dl = cdl[0];
  for (int n = 0; n < 256; ++n) {
    h8v wN[4][2], kN[4][2]; f4v uN[4]; float dlN = 0.f;
    const int nn = (n + 1 < 256) ? n + 1 : n;
    {
      const h16* cw1 = cw + (size_t)nn * 4096; const h16* ck1 = ckd + (size_t)nn * 4096; const float* cu1 = cu + (size_t)nn * 4096;
#pragma unroll
      for (int t = 0; t < 4; ++t) {
#pragma unroll
        for (int s = 0; s < 2; ++s) {
          wN[t][s] = *(const h8v*)&cw1[((t * 2 + s) * 64 + lane) * 8];
          kN[t][s] = *(const h8v*)&ck1[((t * 2 + s) * 64 + lane) * 8];
        }
        uN[t] = *(const f4v*)&cu1[((w * 4 + t) * 64 + lane) * 4];
      }
      dlN = cdl[nn];
    }
    h8v Sb[2];
    Sb[0] = pack8(S[0], S[1]); Sb[1] = pack8(S[2], S[3]);
    h16* cs1 = cs + (size_t)n * 4096; h16* cv1 = cvn + (size_t)n * 4096;
    *(h8v*)&cs1[((w * 2 + 0) * 64 + lane) * 8] = Sb[0];
    *(h8v*)&cs1[((w * 2 + 1) * 64 + lane) * 8] = Sb[1];
    f4v vn[4];
#pragma unroll
    for (int t = 0; t < 4; ++t) { vn[t] = uu[t]; vn[t] = mfma16(wA[t][0], Sb[0], vn[t]); vn[t] = mfma16(wA[t][1], Sb[1], vn[t]); }
    h8v Vb[2];
    Vb[0] = pack8(vn[0], vn[1]); Vb[1] = pack8(vn[2], vn[3]);
    *(h8v*)&cv1[((w * 2 + 0) * 64 + lane) * 8] = Vb[0];
    *(h8v*)&cv1[((w * 2 + 1) * 64 + lane) * 8] = Vb[1];
#pragma unroll
    for (int t = 0; t < 4; ++t) { S[t] *= dl; S[t] = mfma16(kA[t][0], Vb[0], S[t]); S[t] = mfma16(kA[t][1], Vb[1], S[t]); }
#pragma unroll
    for (int t = 0; t < 4; ++t) { wA[t][0] = wN[t][0]; wA[t][1] = wN[t][1]; kA[t][0] = kN[t][0]; kA[t][1] = kN[t][1]; uu[t] = uN[t]; }
    dl = dlN;
  }
}

DI void dn_c3_unit(const Params& p, int l, int head, int oc, h16* lds) {
  unsigned char* ws = p.ws;
  const h16* P = (const h16*)(ws + OFF_PS);
  const float* pscal = (const float*)(ws + OFF_PSCAL);
  const h16* cq = (const h16*)(ws + OFF_CQKV);
  h16* Qi = lds; h16* Ki = lds + 64 * LDH;
  h16* AT = lds + 128 * LDH;
  h16* QG = lds + 256 * LDH;
  float* gcl = (float*)(lds + 384 * LDH);
  float* Ol = (float*)lds;
  const int tid = otid(), lane = tid & 63, w = tid >> 6, r = lane & 15, q = lane >> 4;
  const int lrow = tid >> 2, seg = tid & 3;
  __syncthreads();
  {
    const size_t pos = (size_t)oc * 64 + lrow;
    const h16* g = cq + pos * 768 + head * 64 + 16 * seg;
    img_store_nat(Qi, lrow, seg, *(const u4v*)g, *(const u4v*)(g + 8));
    img_store_nat(Ki, lrow, seg, *(const u4v*)(g + 256), *(const u4v*)(g + 264));
  }
  if (w < 2) {
    const int dir = w;
    const int rr = dir ? 63 - lane : lane;
    const size_t pos = (size_t)oc * 64 + rr;
    const float g = -__expf(p.c_a_log[l * 8 + dir * 4 + head]) * softplus_(pscal[pos * 32 + 24 + dir * 4 + head] + p.c_dt_bias[l * 8 + dir * 4 + head]);
    gcl[dir * 64 + rr] = wave_incl_sum(g, lane);
  }
  __syncthreads();
  {
    f4v S[4];
#pragma unroll
    for (int i = 0; i < 4; ++i) S[i] = (f4v){0.f, 0.f, 0.f, 0.f};
    mm64(Qi, Ki, S, w, lane);
#pragma unroll
    for (int dir = 0; dir < 2; ++dir) {
#pragma unroll
      for (int nt = 0; nt < 4; ++nt)
#pragma unroll
        for (int rg = 0; rg < 4; ++rg) {
          const int i = 16 * w + 4 * q + rg, j = 16 * nt + r;
          const bool ok = dir ? (j >= i) : (j <= i);
          const float v = ok ? S[nt][rg] * __expf(gcl[dir * 64 + i] - gcl[dir * 64 + j]) : 0.f;
          AT[(dir * 64 + i) * LDH + j] = (h16)v;
        }
      const float eg = __expf(gcl[dir * 64 + lrow]);
#pragma unroll
      for (int i = 0; i < 16; ++i) QG[(dir * 64 + lrow) * LDH + 16 * seg + i] = (h16)((float)Qi[lrow * LDH + 16 * seg + i] * eg);
    }
  }
  __syncthreads();
  f4v o[4];
#pragma unroll
  for (int i = 0; i < 4; ++i) o[i] = (f4v){0.f, 0.f, 0.f, 0.f};
#pragma unroll
  for (int dir = 0; dir < 2; ++dir) {
    const int nloc = dir ? 255 - oc : oc;
    const size_t unit = (size_t)(dir * 4 + head) * 256 + nloc;
    const h16* cs = (const h16*)(ws + OFF_CS) + unit * 4096;
    const h16* cv = (const h16*)(ws + OFF_CVN) + unit * 4096;
#pragma unroll
    for (int s = 0; s < 2; ++s) {
      const h8v Sb = *(const h8v*)&cs[((w * 2 + s) * 64 + lane) * 8];
      const h8v Vb = *(const h8v*)&cv[((w * 2 + s) * 64 + lane) * 8];
#pragma unroll
      for (int it = 0; it < 4; ++it) {
        o[it] = mfma16(perm_frag(QG + dir * 64 * LDH, 16 * it + r, s, q), Sb, o[it]);
        o[it] = mfma16(perm_frag(AT + dir * 64 * LDH, 16 * it + r, s, q), Vb, o[it]);
      }
    }
  }
  __syncthreads();
#pragma unroll
  for (int it = 0; it < 4; ++it)
#pragma unroll
    for (int rg = 0; rg < 4; ++rg) Ol[(16 * it + 4 * q + rg) * 65 + 16 * w + r] = o[it][rg];
  __syncthreads();
  {
    const size_t pos = (size_t)oc * 64 + lrow;
    float v[16]; float ss = 0.f;
#pragma unroll
    for (int i = 0; i < 16; ++i) { v[i] = Ol[lrow * 65 + 16 * seg + i]; ss += v[i] * v[i]; }
    ss += __shfl_xor(ss, 1); ss += __shfl_xor(ss, 2);
    const float rms = rsqrtf(ss * (1.f / 64.f) + 1e-6f);
    const float* nw = p.c_norm_w + l * 64 + 16 * seg;
    const h16* cg_ = P + pos * NSM + 4096 + head * 64 + 16 * seg;
    h8v g0 = *(const h8v*)cg_, g1 = *(const h8v*)(cg_ + 8);
    h8v o0, o1;
#pragma unroll
    for (int i = 0; i < 8; ++i) {
      o0[i] = (h16)(v[i] * rms * nw[i] * silu_((float)g0[i]));
      o1[i] = (h16)(v[8 + i] * rms * nw[8 + i] * silu_((float)g1[i]));
    }
    h16* y = (h16*)(ws + OFF_Y) + pos * 1280 + 512 + head * 64 + 16 * seg;
    *(h8v*)y = o0; *(h8v*)(y + 8) = o1;
  }
}

DI void phase_m1(const Params& p, int l, int bid, int nb, h16* lds) {
  asm volatile("" : "+v"(bid));
  for (int u = bid; u < 2048; u += nb) {
    if (u < 1024) dn_c1_unit(p, l, u & 3, u >> 2, lds);
    else { const int v = u - 1024; mlstm_a1_unit(p, l, v & 3, v >> 2, lds); }
  }
}
DI void phase_m2(const Params& p, int l, int bid, int nb, h16* lds) {
  asm volatile("" : "+v"(bid));
  const int nA = conv_total(l) - 2560;
  const int nB = (l + 1 < 4) ? 2560 : 0;
  const int total = 32 + 136 + 2048 + 3072 + nA + nB;
  if (l & 1) moe_reset(p, bid, nb);
  const int ustart = (bid < 32) ? bid : bid;
  const int ustep = (bid < 32) ? total : (nb - 32);
  for (int u = ustart; u < total; u += ustep) {
    int v = u;
    if (v >= 5288) { v -= 5288; if (v < nA) conv_one(p, l, 2560 + v, lds); else conv_one(p, l + 1, v - nA, lds); continue; }
    if (v < 32) { dn_c2_unit(p, v >> 2, v & 3); continue; }
    if ((v -= 32) < 136) { mlstm_a2_unit(p, v); continue; }
    if ((v -= 136) < 2048) { attn_unit<5>(p, l, 1, 0, v & 7, 0, 1, (v >> 3) * 64, SEQ, 128, lds); continue; }
    v -= 2048;
    const int grp = v >> 10, x = v & 1023, head = x & 3, tl = x >> 2;
    const int dil = (grp == 0) ? 1 : (grp == 1) ? 4 : 16;
    const int sub = SEQ / dil, tps = sub >> 6;
    const int res = tl / tps, ti = tl % tps;
    attn_unit<3>(p, l, 0, grp, head, res, dil, ti * 64, sub, 64, lds);
  }
}
DI void phase_m3(const Params& p, int l, int bid, int nb, h16* lds) {
  asm volatile("" : "+v"(bid));
  const int total = 1024 + 1024 + 2048;
  for (int u = bid; u < total; u += nb) {
    int v = u;
    if (v < 1024) { mlstm_a3_unit(p, l, v & 3, v >> 2, lds); continue; }
    if ((v -= 1024) < 1024) { dn_c3_unit(p, l, v & 3, v >> 2, lds); continue; }
    bcombine_unit(p, v - 1024);
  }
}

DI void phase_gates(const Params& p, int bid, int nb, h16* lds) {
  unsigned char* ws = p.ws;
  const h16* x16 = (const h16*)(ws + OFF_X16);
  const h16* wg = (const h16*)(ws + OFF_WG);
  h16* G = (h16*)(ws + OFF_GATES);
  for (int u = bid; u < 64 * 16; u += nb) {
    const int m0 = (u >> 4) * 256, n0 = (u & 15) * 256;
    f16v acc[4][2]; acc256_zero(acc);
    gemm256_main<false>(x16, DM, nullptr, m0, wg, 1024, n0, 1024, lds, acc);
    gemm256_epilogue(acc, m0, n0, [&](int m, int n, f4v v0, f4v v1) {
      f4v a, b;
#pragma unroll
      for (int i = 0; i < 4; ++i) { a[i] = sigmoid_(v0[i]); b[i] = sigmoid_(v1[i]); }
      st_h4(&G[(size_t)m * 4096 + n], a); st_h4(&G[(size_t)m * 4096 + n + 32], b);
    });
  }
}
DI void phase_merge(const Params& p, int bid, int nb, h16* lds) {
  asm volatile("" : "+v"(bid));
  unsigned char* ws = p.ws;
  const h16* Y = (const h16*)(ws + OFF_Y);
  const h16* wbr = (const h16*)(ws + OFF_WBR);
  const h16* G = (const h16*)(ws + OFF_GATES);
  h16* Mg = (h16*)(ws + OFF_MERGED);
  for (int u = bid; u < 128 * 8; u += nb) {
    const int m0 = (u >> 3) * 128, n0 = (u & 7) * 128;
    f16v macc[2][2]; acc_zero(macc);
#pragma unroll 1
    for (int b = 0; b < 4; ++b) {
      const int Kb = (b == 3) ? 512 : 256;
      f16v acc[2][2]; acc_zero(acc);
      gemm_main<false>(Y + b * 256, 1280, nullptr, m0, wbr + (size_t)b * 262144, Kb, n0, Kb, lds, acc);
      const int tid = otid(), lane = tid & 63, wv = tid >> 6, wm = wv >> 1, wn = wv & 1, h = lane >> 5;
#pragma unroll
      for (int i = 0; i < 2; ++i) {
        const int m = m0 + wm * 64 + i * 32 + (lane & 31);
#pragma unroll
        for (int g = 0; g < 4; ++g) {
          const int n = n0 + wn * 64 + 8 * g + 4 * h;
          const h4v g0 = *(const h4v*)&G[(size_t)m * 4096 + b * 1024 + n];
          const h4v g1 = *(const h4v*)&G[(size_t)m * 4096 + b * 1024 + n + 32];
#pragma unroll
          for (int e = 0; e < 4; ++e) {
            macc[i][0][4 * g + e] += (float)g0[e] * acc[i][0][4 * g + e];
            macc[i][1][4 * g + e] += (float)g1[e] * acc[i][1][4 * g + e];
          }
        }
      }
    }
    gemm_epilogue(macc, m0, n0, [&](int m, int n, f4v v0, f4v v1) {
      st_h4(&Mg[(size_t)m * DM + n], v0); st_h4(&Mg[(size_t)m * DM + n + 32], v1);
    });
  }
}
DI void phase_resid_gemm(const Params& p, const h16* A, int lda, const h16* W, int K, const float* xres, int bid, int nb, h16* lds) {
  float* out = p.out;
  for (int u = bid; u < 64 * 4; u += nb) {
    const int m0 = (u >> 2) * 256, n0 = (u & 3) * 256;
    f16v acc[4][2]; acc256_zero(acc);
    gemm256_main<false>(A, lda, nullptr, m0, W, K, n0, K, lds, acc);
    gemm256_epilogue(acc, m0, n0, [&](int m, int n, f4v v0, f4v v1) {
      const f4v x0 = *(const f4v*)&xres[(size_t)m * DM + n], x1 = *(const f4v*)&xres[(size_t)m * DM + n + 32];
      *(f4v*)&out[(size_t)m * DM + n] = ALPHA * x0 + v0;
      *(f4v*)&out[(size_t)m * DM + n + 32] = ALPHA * x1 + v1;
    });
  }
}
DI void phase_ffn1_dense(const Params& p, int bid, int nb, h16* lds) {
  unsigned char* ws = p.ws;
  const h16* x16 = (const h16*)(ws + OFF_X16);
  const h16* w13 = (const h16*)(ws + OFF_WFF);
  h16* H = (h16*)(ws + OFF_H);
  for (int u = bid; u < 64 * 22; u += nb) {
    const int m0 = (u / 22) * 256, n0 = (u % 22) * 256;
    f16v acc[4][2]; acc256_zero(acc);
    gemm256_main<false>(x16, DM, nullptr, m0, w13, 1024, n0, 1024, lds, acc);
    gemm256_epilogue(acc, m0, n0, [&](int m, int n, f4v v0, f4v v1) {
      f4v hq;
#pragma unroll
      for (int i = 0; i < 4; ++i) hq[i] = silu_(v0[i]) * v1[i];
      st_h4(&H[(size_t)m * 2816 + (n >> 6) * 32 + (n & 31)], hq);
    });
  }
}
DI void moe_prefix(const int* cnt, int (&pstart)[9]) {
  int s = 0;
#pragma unroll
  for (int e = 0; e < 8; ++e) { pstart[e] = s; s += (cnt[e] + 255) & ~255; }
  pstart[8] = s;
}
DI void phase_ffn1_moe(const Params& p, int bid, int nb, h16* lds) {
  unsigned char* ws = p.ws;
  const h16* x16 = (const h16*)(ws + OFF_X16);
  const h16* w13 = (const h16*)(ws + OFF_WFF);
  h16* H = (h16*)(ws + OFF_H);
  const int* st = (const int*)(ws + MOE_ST);
  int ps[9]; moe_prefix((const int*)(ws + MOE_CNT), ps);
  const int ntl = (ps[8] >> 8) * 11;
  for (int u = bid; u < ntl; u += nb) {
    const int mt = u / 11, m0 = mt * 256, n0 = (u % 11) * 256;
    int e = 0;
#pragma unroll
    for (int i = 1; i < 8; ++i) if (m0 >= ps[i]) e = i;
    f16v acc[4][2]; acc256_zero(acc);
    gemm256_main<true>(x16, DM, st, m0, w13 + (size_t)e * 2816 * 1024, 1024, n0, 1024, lds, acc);
    gemm256_epilogue(acc, m0, n0, [&](int m, int n, f4v v0, f4v v1) {
      f4v hq;
#pragma unroll
      for (int i = 0; i < 4; ++i) hq[i] = silu_(v0[i]) * v1[i];
      st_h4(&H[(size_t)m * 1408 + (n >> 6) * 32 + (n & 31)], hq);
    });
  }
}
DI void phase_ffn2_moe(const Params& p, int bid, int nb, h16* lds) {
  unsigned char* ws = p.ws;
  const h16* H = (const h16*)(ws + OFF_H);
  const h16* w2 = (const h16*)(ws + OFF_WFF) + (size_t)8 * 2816 * 1024;
  h16* YB = (h16*)(ws + OFF_YB);
  const float* sg = (const float*)(ws + MOE_SG);
  int ps[9]; moe_prefix((const int*)(ws + MOE_CNT), ps);
  const int ntl = (ps[8] >> 8) * 4;
  for (int u = bid; u < ntl; u += nb) {
    const int mt = u >> 2, m0 = mt * 256, n0 = (u & 3) * 256;
    int e = 0;
#pragma unroll
    for (int i = 1; i < 8; ++i) if (m0 >= ps[i]) e = i;
    f16v acc[4][2]; acc256_zero(acc);
    gemm256_main<false>(H, 1408, nullptr, m0, w2 + (size_t)e * 1024 * 1408, 1408, n0, 1408, lds, acc);
    gemm256_epilogue(acc, m0, n0, [&](int m, int n, f4v v0, f4v v1) {
      const float g = sg[m];
      st_h4(&YB[(size_t)m * DM + n], g * v0); st_h4(&YB[(size_t)m * DM + n + 32], g * v1);
    });
  }
}

DI void phase_ln(const Params& p, int l, int which, int bid, int nb) {
  asm volatile("" : "+v"(bid));
  unsigned char* ws = p.ws;
  const bool moe = (l & 1);
  const bool moe_in = moe && which == 2;
  const bool router = moe && which == 1;
  const float* lw = (which == 1 ? p.ln1_w : p.ln2_w) + l * DM;
  const float* lb = (which == 1 ? p.ln1_b : p.ln2_b) + l * DM;
  float* out = p.out;
  h16* x16 = (h16*)(ws + OFF_X16);
  const int tid_ = otid(); const int lane = tid_ & 63, wv = tid_ >> 6;
  for (int row = bid * 4 + wv; row < SEQ; row += nb * 4) {
    float v[16];
#pragma unroll
    for (int i = 0; i < 4; ++i) {
      const f4v t = *(const f4v*)&out[(size_t)row * DM + 256 * i + lane * 4];
      v[4 * i] = t[0]; v[4 * i + 1] = t[1]; v[4 * i + 2] = t[2]; v[4 * i + 3] = t[3];
    }
    if (moe_in) {
      const int* ts = (const int*)(ws + MOE_TS);
      const h16* YB = (const h16*)(ws + OFF_YB);
      const int s0 = ts[row * 2], s1 = ts[row * 2 + 1];
#pragma unroll
      for (int i = 0; i < 4; ++i) {
        const h4v a = *(const h4v*)&YB[(size_t)s0 * DM + 256 * i + lane * 4];
        const h4v b = *(const h4v*)&YB[(size_t)s1 * DM + 256 * i + lane * 4];
#pragma unroll
        for (int e = 0; e < 4; ++e) v[4 * i + e] = ALPHA * v[4 * i + e] + ((float)a[e] + (float)b[e]);
      }
    }
    float s = 0.f;
#pragma unroll
    for (int i = 0; i < 16; ++i) s += v[i];
    const float mu = wave_sum(s) * (1.f / 1024.f);
    float vs = 0.f;
#pragma unroll
    for (int i = 0; i < 16; ++i) { const float d = v[i] - mu; vs += d * d; }
    const float rstd = rsqrtf(wave_sum(vs) * (1.f / 1024.f) + 1e-5f);
#pragma unroll
    for (int i = 0; i < 4; ++i) {
      const int c = 256 * i + lane * 4;
      const f4v w4 = *(const f4v*)&lw[c], b4 = *(const f4v*)&lb[c];
      f4v y;
#pragma unroll
      for (int e = 0; e < 4; ++e) { y[e] = (v[4 * i + e] - mu) * rstd * w4[e] + b4[e]; v[4 * i + e] = y[e]; }
      *(f4v*)&out[(size_t)row * DM + c] = y;
      st_h4(&x16[(size_t)row * DM + c], y);
    }
    if (router) {
      const float* rw = p.moe_router + (size_t)(l >> 1) * DM * 8;
      float lg[8];
#pragma unroll
      for (int e = 0; e < 8; ++e) lg[e] = 0.f;
#pragma unroll
      for (int i = 0; i < 4; ++i)
#pragma unroll
        for (int k = 0; k < 4; ++k) {
          const int c = 256 * i + lane * 4 + k;
          const f4v r0 = *(const f4v*)&rw[(size_t)c * 8], r1 = *(const f4v*)&rw[(size_t)c * 8 + 4];
          const float xv = v[4 * i + k];
#pragma unroll
          for (int e = 0; e < 4; ++e) { lg[e] += xv * r0[e]; lg[4 + e] += xv * r1[e]; }
        }
#pragma unroll
      for (int e = 0; e < 8; ++e) lg[e] = wave_sum(lg[e]);
      if (lane == 0) {
        int i1 = 0; float b1 = lg[0];
#pragma unroll
        for (int e = 1; e < 8; ++e) if (lg[e] > b1) { b1 = lg[e]; i1 = e; }
        int i2 = -1; float b2 = -3.4e38f;
#pragma unroll
        for (int e = 0; e < 8; ++e) if (e != i1 && lg[e] > b2) { b2 = lg[e]; i2 = e; }
        const float g1 = 1.f / (1.f + __expf(b2 - b1)), g2 = 1.f - g1;
        int* cnt = (int*)(ws + MOE_CNT);
        int* te = (int*)(ws + MOE_TE); int* tp = (int*)(ws + MOE_TP); float* tg = (float*)(ws + MOE_TG);
        te[row * 2] = i1; te[row * 2 + 1] = i2;
        tp[row * 2] = atomicAdd(&cnt[i1], 1); tp[row * 2 + 1] = atomicAdd(&cnt[i2], 1);
        tg[row * 2] = g1; tg[row * 2 + 1] = g2;
      }
    }
  }
}
DI void phase_assign(const Params& p, int bid, int nb) {
  asm volatile("" : "+v"(bid));
  unsigned char* ws = p.ws;
  int ps[9]; moe_prefix((const int*)(ws + MOE_CNT), ps);
  const int* te = (const int*)(ws + MOE_TE); const int* tp = (const int*)(ws + MOE_TP); const float* tg = (const float*)(ws + MOE_TG);
  int* ts = (int*)(ws + MOE_TS); int* st = (int*)(ws + MOE_ST); float* sg = (float*)(ws + MOE_SG);
  #pragma unroll 1
  for (int i = bid * 256 + otid(); i < 32768; i += nb * 256) {
    const int e = te[i];
    int base = 0;
#pragma unroll
    for (int k = 0; k < 8; ++k) if (e == k) base = ps[k];
    const int slot = base + tp[i];
    ts[i] = slot; st[slot] = i >> 1; sg[slot] = tg[i];
  }
}


#define XB_TMO      128
#define XB_XCNT(j)  (256  + 64 * (j))
#define XB_XSUB(j)  (1280 + 64 * (j))
#define XB_XGEN(j)  (2304 + 64 * (j))
#define XB_TOP      3328
#define XB_TOPGEN   3392
#define XCD_BAR_WORDS 3456
#define XB_SPIN_CAP (1u << 22)
#define LAS __attribute__((address_space(3)))
DI unsigned xb_ld(unsigned* p) { return __hip_atomic_load(p, __ATOMIC_RELAXED, __HIP_MEMORY_SCOPE_AGENT); }
DI unsigned xb_add(unsigned* p, unsigned v) { return __hip_atomic_fetch_add(p, v, __ATOMIC_RELAXED, __HIP_MEMORY_SCOPE_AGENT); }
DI unsigned xb_xcc_id() { return (unsigned)__builtin_amdgcn_s_getreg((3 << 11) | 20) & 0xFu; }
#define XB_SPIN(cond, bar) do { unsigned _sp = 0; while (cond) { __builtin_amdgcn_s_sleep(1); \
    if ((++_sp & 255u) == 0u) { if (xb_ld(&(bar)[XB_TMO])) break; if (_sp > XB_SPIN_CAP) { atomicAdd(&(bar)[XB_TMO], 1u); break; } } } } while (0)
struct XcdBarrier { unsigned* bar; unsigned x; volatile LAS unsigned* st; };
DI XcdBarrier xcd_barrier_post(unsigned* bar, volatile LAS unsigned* st) {
  XcdBarrier b; b.bar = bar; b.x = xb_xcc_id(); b.st = st;
  if (threadIdx.x == 0) (void)xb_add(&bar[XB_XCNT(b.x)], 1u);
  return b;
}
DI void xcd_barrier_complete(unsigned* bar, unsigned x, unsigned& nloc, unsigned& nx) {
  const unsigned G = gridDim.x * gridDim.y * gridDim.z;
  unsigned sum, cnt, mine, sp = 0u;
  for (;;) {
    sum = 0u; cnt = 0u; mine = 0u;
#pragma unroll
    for (unsigned j = 0; j < 16; ++j) { const unsigned c = xb_ld(&bar[XB_XCNT(j)]); sum += c; cnt += (c > 0u) ? 1u : 0u; mine = (j == x) ? c : mine; }
    if (sum == G) break;
    __builtin_amdgcn_s_sleep(1);
    if ((++sp & 255u) == 0u) { if (xb_ld(&bar[XB_TMO])) break; if (sp > XB_SPIN_CAP) { atomicAdd(&bar[XB_TMO], 1u); break; } }
  }
  nloc = mine > 0u ? mine : 1u; nx = cnt > 0u ? cnt : 1u;
}
DI void xcd_barrier(const XcdBarrier& b) {
  asm volatile("s_waitcnt vmcnt(0)" ::: "memory");
  __syncthreads();
  if (threadIdx.x == 0) {
    unsigned* bar = b.bar;
    __builtin_amdgcn_s_waitcnt(0);
    unsigned nloc = b.st[0], nx = b.st[1];
    if (nloc == 0u) { xcd_barrier_complete(bar, b.x, nloc, nx); b.st[0] = nloc; b.st[1] = nx; }
    const unsigned old = xb_add(&bar[XB_XSUB(b.x)], 1u);
    const unsigned gen = old / nloc;
    if (old + 1u == (gen + 1u) * nloc) {
      __builtin_amdgcn_fence(__ATOMIC_RELEASE, "agent");
      asm volatile("s_waitcnt vmcnt(0)" ::: "memory");
      const unsigned og = xb_add(&bar[XB_TOP], 1u);
      const unsigned tg = og / nx;
      if (og + 1u == (tg + 1u) * nx) xb_add(&bar[XB_TOPGEN], 1u);
      else XB_SPIN(xb_ld(&bar[XB_TOPGEN]) == tg, bar);
      __builtin_amdgcn_fence(__ATOMIC_ACQUIRE, "agent");
      xb_add(&bar[XB_XGEN(b.x)], 1u);
      asm volatile("s_waitcnt vmcnt(0)" ::: "memory");
    } else {
      XB_SPIN(xb_ld(&bar[XB_XGEN(b.x)]) == gen, bar);
      __builtin_amdgcn_fence(__ATOMIC_ACQUIRE, "agent");
      asm volatile("s_waitcnt vmcnt(0)" ::: "memory");
    }
  }
  __syncthreads();
}

extern __shared__ __attribute__((aligned(16))) unsigned char smem_dyn[];
__global__ void __launch_bounds__(512) fwd_megakernel(Params p) {
  cg::grid_group grid = cg::this_grid();
  unsigned char* smem = smem_dyn;
  const int half = threadIdx.x >> 8;
  unsigned char* smem_half = smem_dyn + half * HALF_LDS;
  h16* lds = (h16*)smem;
  h16* ldh = (h16*)smem_half;
  const int bid = blockIdx.x, nb = gridDim.x;
  const int vb = bid * 2 + half, vnb = nb * 2;
  unsigned char* ws = p.ws;
  __shared__ u4v xb_words;
  if (threadIdx.x == 0) xb_words = (u4v){0u, 0u, 0u, 0u};
  __syncthreads();
  XcdBarrier xb = xcd_barrier_post((unsigned*)(ws + OFF_BAR), (volatile LAS unsigned*)&xb_words);

  phase_init(p, vb, vnb);
  phase_convert_range(p, 0, 0, 2560, vb, vnb, ldh);
  grid.sync();
  for (int l = 0; l < 4; ++l) {
    phase_p1(p, l, bid, nb, vb, vnb, smem, smem_half);
    xcd_barrier(xb);
    phase_m1(p, l, vb, vnb, ldh);
    xcd_barrier(xb);
    phase_m2(p, l, vb, vnb, ldh);
    xcd_barrier(xb);
    phase_m3(p, l, vb, vnb, ldh);
    xcd_barrier(xb);
    phase_gates(p, bid, nb, lds);
    xcd_barrier(xb);
    phase_merge(p, vb, vnb, ldh);
    xcd_barrier(xb);
    phase_resid_gemm(p, (const h16*)(ws + OFF_MERGED), DM, (const h16*)(ws + OFF_WOUT), 1024, (l == 0) ? p.x : p.out, bid, nb, lds);
    xcd_barrier(xb);
    phase_ln(p, l, 1, vb, vnb);
    xcd_barrier(xb);
    if (l & 1) {
      phase_assign(p, vb, vnb);
      xcd_barrier(xb);
      phase_ffn1_moe(p, bid, nb, lds);
      xcd_barrier(xb);
      phase_ffn2_moe(p, bid, nb, lds);
      xcd_barrier(xb);
    } else {
      phase_ffn1_dense(p, bid, nb, lds);
      xcd_barrier(xb);
      phase_resid_gemm(p, (const h16*)(ws + OFF_H), 2816, (const h16*)(ws + OFF_WFF) + (size_t)5632 * 1024, 2816, p.out, bid, nb, lds);
      xcd_barrier(xb);
    }
    phase_ln(p, l, 2, vb, vnb);
    if (l + 1 < 4) xcd_barrier(xb);
  }
}

extern "C" void kernel_launch(void* const* d_in, const int* in_sizes, int n_in, void* d_out, int out_size, void* d_ws, size_t ws_size, hipStream_t stream) {
  static int grid_blocks = 0;
  if (!grid_blocks) {
    int dev = 0, cus = 0, per_cu = 0;
    hipGetDevice(&dev);
    hipDeviceGetAttribute(&cus, hipDeviceAttributeMultiprocessorCount, dev);
    hipFuncSetAttribute((const void*)fwd_megakernel, hipFuncAttributeMaxDynamicSharedMemorySize, LDS_BYTES);
    hipOccupancyMaxActiveBlocksPerMultiprocessor(&per_cu, fwd_megakernel, 512, LDS_BYTES);
    if (per_cu > 1) per_cu = 1;
    if (per_cu < 1) per_cu = 1;
    grid_blocks = cus * per_cu;
    if (ws_size < WS_END) fprintf(stderr, "workspace too small: %zu < %zu\n", ws_size, (size_t)WS_END);
  }
  Params p{};
  const float* const* in = (const float* const*)d_in;
  p.x = in[0]; p.w_in = in[1]; p.a_gate_bias = in[2]; p.a_norm_w = in[3]; p.c_conv_w = in[4]; p.c_a_log = in[5]; p.c_dt_bias = in[6];
  p.c_norm_w = in[7]; p.d_sink = in[8]; p.w_br_a = in[9]; p.w_br_b = in[10]; p.w_br_c = in[11]; p.w_br_d = in[12]; p.w_out = in[13];
  p.ln1_w = in[14]; p.ln1_b = in[15]; p.ln2_w = in[16]; p.ln2_b = in[17]; p.ffn_w1 = in[18]; p.ffn_w3 = in[19]; p.ffn_w2 = in[20];
  p.moe_router = in[21]; p.moe_w1 = in[22]; p.moe_w3 = in[23]; p.moe_w2 = in[24];
  p.out = (float*)d_out; p.ws = (unsigned char*)d_ws;
  void* args[] = {&p};
  hipMemsetAsync((unsigned char*)d_ws + OFF_BAR, 0, XCD_BAR_WORDS * 4, stream);
  hipError_t e = hipLaunchCooperativeKernel((void*)fwd_megakernel, dim3(grid_blocks), dim3(512), args, LDS_BYTES, stream);
  if (e != hipSuccess) fprintf(stderr, "cooperative launch failed: %s (grid %d)\n", hipGetErrorString(e), grid_blocks);
}
```

```cpp
#include <hip/hip_runtime.h>
#include <hip/hip_cooperative_groups.h>
#include <cstdio>
namespace cg = cooperative_groups;

typedef _Float16 h16;
typedef h16 h8v __attribute__((ext_vector_type(8)));
typedef h16 h4v __attribute__((ext_vector_type(4)));
typedef float f4v __attribute__((ext_vector_type(4)));
typedef float f16v __attribute__((ext_vector_type(16)));
typedef unsigned int u4v __attribute__((ext_vector_type(4)));
#define DI __device__ __forceinline__

constexpr int SEQ = 16384, DM = 1024, NIN = 9248, NSM = 5120;
constexpr int LDH = 72;
constexpr float ALPHA = 1.6817928305074290f;
constexpr int NSLOT = 34816;
constexpr int HALF_LDS = 58368;
constexpr int LDS_BYTES = 147456;
constexpr int MLD = 68;

constexpr size_t OFF_X16 = 0;
constexpr size_t OFF_WSM = OFF_X16 + (size_t)SEQ * DM * 2;
constexpr size_t OFF_WG = OFF_WSM + (size_t)NSM * 1024 * 2;
constexpr size_t OFF_WBR = OFF_WG + (size_t)4096 * 1024 * 2;
constexpr size_t OFF_WOUT = OFF_WBR + (size_t)1280 * 1024 * 2;
constexpr size_t OFF_WFF = OFF_WOUT + (size_t)1024 * 1024 * 2;
constexpr size_t OFF_PS = OFF_WFF + (size_t)69206016;
constexpr size_t OFF_PSCAL = OFF_PS + (size_t)SEQ * NSM * 2;
constexpr size_t OFF_Y = OFF_PSCAL + (size_t)SEQ * 32 * 4;
constexpr size_t OFF_MERGED = OFF_Y + (size_t)SEQ * 1280 * 2;
constexpr size_t OFF_ROPE = OFF_MERGED + (size_t)SEQ * DM * 2;
constexpr size_t OFF_SCA = OFF_ROPE + (size_t)SEQ * 32 * 4 * 2;
constexpr size_t OFF_SCAS = OFF_SCA + (size_t)2048 * 4160 * 4;
constexpr size_t OFF_CQKV = OFF_SCAS + (size_t)2048 * 4 * 4;
constexpr size_t OFF_CU = OFF_CQKV + (size_t)SEQ * 768 * 2;
constexpr size_t OFF_CW = OFF_CU + (size_t)2048 * 4096 * 4;
constexpr size_t OFF_CKD = OFF_CW + (size_t)2048 * 4096 * 2;
constexpr size_t OFF_CDL = OFF_CKD + (size_t)2048 * 4096 * 2;
constexpr size_t OFF_CS = OFF_CDL + (size_t)2048 * 4;
constexpr size_t OFF_CVN = OFF_CS + (size_t)2048 * 4096 * 2;
constexpr size_t OFF_OB = OFF_CVN + (size_t)2048 * 4096 * 2;
constexpr size_t OFF_MLB = OFF_OB + (size_t)3 * SEQ * 256 * 2;
constexpr size_t OFF_MOE = OFF_MLB + (size_t)3 * SEQ * 4 * 2 * 4;
constexpr size_t MOE_CNT = OFF_MOE;
constexpr size_t MOE_TE = MOE_CNT + 256;
constexpr size_t MOE_TP = MOE_TE + 32768 * 4;
constexpr size_t MOE_TG = MOE_TP + 32768 * 4;
constexpr size_t MOE_TS = MOE_TG + 32768 * 4;
constexpr size_t MOE_ST = MOE_TS + 32768 * 4;
constexpr size_t MOE_SG = MOE_ST + (size_t)NSLOT * 4;
constexpr size_t OFF_BAR = (MOE_SG + (size_t)NSLOT * 4 + 255) & ~(size_t)255;
constexpr size_t WS_END = OFF_BAR + 16384;
constexpr size_t OFF_GATES = OFF_PS;
constexpr size_t OFF_H = OFF_PS;
constexpr size_t OFF_YB = OFF_Y;

struct Params {
  const float* x; const float* w_in; const float* a_gate_bias; const float* a_norm_w; const float* c_conv_w;
  const float* c_a_log; const float* c_dt_bias; const float* c_norm_w; const float* d_sink;
  const float* w_br_a; const float* w_br_b; const float* w_br_c; const float* w_br_d; const float* w_out;
  const float* ln1_w; const float* ln1_b; const float* ln2_w; const float* ln2_b;
  const float* ffn_w1; const float* ffn_w3; const float* ffn_w2;
  const float* moe_router; const float* moe_w1; const float* moe_w3; const float* moe_w2;
  float* out; unsigned char* ws;
};

DI int otid() { int t = threadIdx.x & 255; asm volatile("" : "+v"(t)); return t; }
DI int otid512() { int t = threadIdx.x; asm volatile("" : "+v"(t)); return t; }
DI float sigmoid_(float x) { return 1.f / (1.f + __expf(-x)); }
DI float silu_(float x) { return x / (1.f + __expf(-x)); }
DI float softplus_(float x) { return x > 20.f ? x : log1pf(__expf(x)); }
DI float logsigmoid_(float x) { return fminf(x, 0.f) - log1pf(__expf(-fabsf(x))); }
DI f4v mfma16(h8v a, h8v b, f4v c) { return __builtin_amdgcn_mfma_f32_16x16x32_f16(a, b, c, 0, 0, 0); }
DI f16v mfma32(h8v a, h8v b, f16v c) { return __builtin_amdgcn_mfma_f32_32x32x16_f16(a, b, c, 0, 0, 0); }
DI float wave_incl_sum(float v, int lane) {
#pragma unroll
  for (int o = 1; o < 64; o <<= 1) { float t = __shfl_up(v, o); if (lane >= o) v += t; }
  return v;
}
DI float wave_incl_max(float v, int lane) {
#pragma unroll
  for (int o = 1; o < 64; o <<= 1) { float t = __shfl_up(v, o); if (lane >= o) v = fmaxf(v, t); }
  return v;
}
DI float wave_max(float v) {
#pragma unroll
  for (int o = 32; o >= 1; o >>= 1) v = fmaxf(v, __shfl_xor(v, o));
  return v;
}
DI float wave_sum(float v) {
#pragma unroll
  for (int o = 32; o >= 1; o >>= 1) v += __shfl_xor(v, o);
  return v;
}
DI float grp16_sum(float v) { v += __shfl_xor(v, 1); v += __shfl_xor(v, 2); v += __shfl_xor(v, 4); v += __shfl_xor(v, 8); return v; }
DI float grp16_max(float v) { v = fmaxf(v, __shfl_xor(v, 1)); v = fmaxf(v, __shfl_xor(v, 2)); v = fmaxf(v, __shfl_xor(v, 4)); v = fmaxf(v, __shfl_xor(v, 8)); return v; }

DI void mm64(const h16* A, const h16* B, f4v (&acc)[4], int w, int lane) {
  const int r = lane & 15, q = lane >> 4;
#pragma unroll
  for (int s = 0; s < 2; ++s) {
    h8v a = *(const h8v*)&A[(16 * w + r) * LDH + 32 * s + 8 * q];
#pragma unroll
    for (int nt = 0; nt < 4; ++nt) {
      h8v b = *(const h8v*)&B[(16 * nt + r) * LDH + 32 * s + 8 * q];
      acc[nt] = mfma16(a, b, acc[nt]);
    }
  }
}
DI h8v perm_frag(const h16* img, int row, int s, int q) {
  h4v lo = *(const h4v*)&img[row * LDH + 32 * s + 4 * q];
  h4v hi = *(const h4v*)&img[row * LDH + 32 * s + 16 + 4 * q];
  return __builtin_shufflevector(lo, hi, 0, 1, 2, 3, 4, 5, 6, 7);
}
DI h8v pack8(f4v a, f4v b) {
  h8v r;
  r[0] = (h16)a[0]; r[1] = (h16)a[1]; r[2] = (h16)a[2]; r[3] = (h16)a[3];
  r[4] = (h16)b[0]; r[5] = (h16)b[1]; r[6] = (h16)b[2]; r[7] = (h16)b[3];
  return r;
}
DI void st_h4(h16* p, f4v v) { h4v o; o[0] = (h16)v[0]; o[1] = (h16)v[1]; o[2] = (h16)v[2]; o[3] = (h16)v[3]; *(h4v*)p = o; }

DI void conv_unit(const float* __restrict__ src, int ld, int col0, int k0, h16* __restrict__ dst, int K, int n0, h16* lds) {
  const int t = otid();
  __syncthreads();
  {
    const int c4 = (t & 7) * 4, kq = t >> 3;
#pragma unroll
    for (int i = 0; i < 2; ++i) {
      const int kk = kq + 32 * i;
      const f4v v = *(const f4v*)&src[(size_t)(k0 + kk) * ld + col0 + c4];
      lds[(c4 + 0) * LDH + kk] = (h16)v[0]; lds[(c4 + 1) * LDH + kk] = (h16)v[1];
      lds[(c4 + 2) * LDH + kk] = (h16)v[2]; lds[(c4 + 3) * LDH + kk] = (h16)v[3];
    }
  }
  __syncthreads();
  {
    const int c = t >> 3, ks = (t & 7) * 8;
    *(u4v*)&dst[(size_t)(n0 + c) * K + k0 + ks] = *(const u4v*)&lds[c * LDH + ks];
  }
}

DI int map_small(int n) {
  if (n < 1024) return 4096 + n;
  if (n < 3328) return 5136 + (n - 1024);
  if (n < 4352) return 7440 + (n - 3328);
  return 8480 + (n - 4352);
}

DI int conv_total(int l) { return 2560 + 2048 + 640 + 512 + ((l & 1) ? 8 * 2112 : (2816 + 1408)); }
DI void conv_one(const Params& p, int l, int u, h16* lds) {
  unsigned char* ws = p.ws;
  const float* win = p.w_in + (size_t)l * 1024 * NIN;
  const int jj = l >> 1;
  const bool moe = (l & 1);
    int v = u;
const float* src; int ld, col0, k0, K, n0; h16* dst;
if (v < 2560) { n0 = (v >> 4) * 32; k0 = (v & 15) * 64; col0 = map_small(n0); src = win; ld = NIN; K = 1024; dst = (h16*)(ws + OFF_WSM); }
else if ((v -= 2560) < 2048) { n0 = (v >> 4) * 32; k0 = (v & 15) * 64; col0 = n0; src = win; ld = NIN; K = 1024; dst = (h16*)(ws + OFF_WG); }
else if ((v -= 2048) < 640) {
  int b, kt;
  if (v < 384) { b = v >> 7; v &= 127; kt = 4; } else { b = 3; v -= 384; kt = 8; }
  n0 = (v / kt) * 32; k0 = (v % kt) * 64; K = kt * 64;
  const float* base = (b == 0) ? p.w_br_a : (b == 1) ? p.w_br_b : (b == 2) ? p.w_br_c : p.w_br_d;
  src = base + (size_t)l * K * 1024; ld = 1024; col0 = n0; dst = (h16*)(ws + OFF_WBR) + (size_t)b * 262144;
}
else if ((v -= 640) < 512) { n0 = (v >> 4) * 32; k0 = (v & 15) * 64; col0 = n0; src = p.w_out + (size_t)l * 1024 * 1024; ld = 1024; K = 1024; dst = (h16*)(ws + OFF_WOUT); }
else {
  v -= 512;
  if (!moe) {
    if (v < 2816) {
      int nbk = v >> 4; k0 = (v & 15) * 64; n0 = nbk * 32; col0 = (nbk >> 1) * 32;
      src = ((nbk & 1) ? p.ffn_w3 : p.ffn_w1) + (size_t)jj * 1024 * 2816; ld = 2816; K = 1024; dst = (h16*)(ws + OFF_WFF);
    } else {
      v -= 2816; n0 = (v / 44) * 32; k0 = (v % 44) * 64; col0 = n0; K = 2816;
      src = p.ffn_w2 + (size_t)jj * 2816 * 1024; ld = 1024; dst = (h16*)(ws + OFF_WFF) + (size_t)5632 * 1024;
    }
  } else {
    int e = v / 2112; v -= e * 2112;
    if (v < 1408) {
      int nbk = v >> 4; k0 = (v & 15) * 64; n0 = nbk * 32; col0 = (nbk >> 1) * 32;
      src = ((nbk & 1) ? p.moe_w3 : p.moe_w1) + (size_t)(jj * 8 + e) * 1024 * 1408; ld = 1408; K = 1024;
      dst = (h16*)(ws + OFF_WFF) + (size_t)e * 2816 * 1024;
    } else {
      v -= 1408; n0 = (v / 22) * 32; k0 = (v % 22) * 64; col0 = n0; K = 1408;
      src = p.moe_w2 + (size_t)(jj * 8 + e) * 1408 * 1024; ld = 1024;
      dst = (h16*)(ws + OFF_WFF) + (size_t)8 * 2816 * 1024 + (size_t)e * 1024 * 1408;
    }
  }
}
conv_unit(src, ld, col0, k0, dst, K, n0, lds);
}
DI void phase_convert_range(const Params& p, int l, int ubegin, int uend, int bid, int nb, h16* lds) {
  asm volatile("" : "+v"(bid));
  for (int u = ubegin + bid; u < uend; u += nb) conv_one(p, l, u, lds);
}
DI void moe_reset(const Params& p, int bid, int nb) {
  unsigned char* ws = p.ws;
  int* cnt = (int*)(ws + MOE_CNT);
  int* st = (int*)(ws + MOE_ST);
  int gs = nb * 256; asm volatile("" : "+s"(gs));
  const int gt = bid * 256 + otid();
  if (gt < 64) cnt[gt] = 0;
#pragma unroll 1
  for (int i = gt; i < NSLOT; i += gs) st[i] = 0;
}
DI void phase_init(const Params& p, int bid, int nb) {
  asm volatile("" : "+v"(bid));
  float* rc = (float*)(p.ws + OFF_ROPE);
  float* rs = rc + (size_t)SEQ * 32;
  const int gt = bid * 256 + otid(), gs = nb * 256;
  #pragma unroll 1
  for (int i = gt; i < SEQ * 32; i += gs) {
    int pos = i >> 5, d = i & 31;
    float inv = (float)pow(10000.0, -(double)d / 32.0);
    float ang = (float)pos * inv;
    rc[i] = cosf(ang); rs[i] = sinf(ang);
  }
  h16* x16 = (h16*)(p.ws + OFF_X16);
  #pragma unroll 1
  for (int i = gt; i < SEQ * DM / 4; i += gs) {
    float4 v = ((const float4*)p.x)[i];
    h4v o; o[0] = (h16)v.x; o[1] = (h16)v.y; o[2] = (h16)v.z; o[3] = (h16)v.w;
    *(h4v*)&x16[(size_t)i * 4] = o;
  }
}

template <bool GATHER>
DI void gemm_main(const h16* __restrict__ A, int lda, const int* __restrict__ idx, int m0,
                  const h16* __restrict__ B, int ldb, int n0, int K, h16* lds, f16v (&acc)[2][2]) {
  const int tid = otid(), lane = tid & 63, wv = tid >> 6, wm = wv >> 1, wn = wv & 1;
  h16* As = lds; h16* Bs = lds + 128 * LDH;
  const int lr = tid >> 1, lc = (tid & 1) * 32;
  const h16* ap = A + (size_t)(GATHER ? idx[m0 + lr] : (m0 + lr)) * lda + lc;
  const h16* bp = B + (size_t)(n0 + lr) * ldb + lc;
  u4v ra[4], rb[4];
#pragma unroll
  for (int i = 0; i < 4; ++i) { ra[i] = *(const u4v*)(ap + 8 * i); rb[i] = *(const u4v*)(bp + 8 * i); }
  const int nk = K >> 6;
  for (int kt = 0; kt < nk; ++kt) {
    __syncthreads();
#pragma unroll
    for (int i = 0; i < 4; ++i) { *(u4v*)&As[lr * LDH + lc + 8 * i] = ra[i]; *(u4v*)&Bs[lr * LDH + lc + 8 * i] = rb[i]; }
    __syncthreads();
    if (kt + 1 < nk) {
      ap += 64; bp += 64;
#pragma unroll
      for (int i = 0; i < 4; ++i) { ra[i] = *(const u4v*)(ap + 8 * i); rb[i] = *(const u4v*)(bp + 8 * i); }
    }
#pragma unroll
    for (int ks = 0; ks < 4; ++ks) {
      h8v af[2], bf[2];
#pragma unroll
      for (int i = 0; i < 2; ++i) af[i] = *(const h8v*)&As[(wm * 64 + i * 32 + (lane & 31)) * LDH + ks * 16 + 8 * (lane >> 5)];
#pragma unroll
      for (int j = 0; j < 2; ++j) bf[j] = *(const h8v*)&Bs[(wn * 64 + j * 32 + (lane & 31)) * LDH + ks * 16 + 8 * (lane >> 5)];
#pragma unroll
      for (int i = 0; i < 2; ++i)
#pragma unroll
        for (int j = 0; j < 2; ++j) acc[i][j] = mfma32(bf[j], af[i], acc[i][j]);
    }
  }
}
DI void acc_zero(f16v (&acc)[2][2]) {
#pragma unroll
  for (int i = 0; i < 2; ++i)
#pragma unroll
    for (int j = 0; j < 2; ++j)
#pragma unroll
      for (int r = 0; r < 16; ++r) acc[i][j][r] = 0.f;
}
template <class Epi>
DI void gemm_epilogue(f16v (&acc)[2][2], int m0, int n0, Epi epi) {
  const int tid = otid(), lane = tid & 63, wv = tid >> 6, wm = wv >> 1, wn = wv & 1, h = lane >> 5;
#pragma unroll
  for (int i = 0; i < 2; ++i) {
    const int m = m0 + wm * 64 + i * 32 + (lane & 31);
#pragma unroll
    for (int g = 0; g < 4; ++g) {
      const int n = n0 + wn * 64 + 8 * g + 4 * h;
      f4v v0 = {acc[i][0][4 * g], acc[i][0][4 * g + 1], acc[i][0][4 * g + 2], acc[i][0][4 * g + 3]};
      f4v v1 = {acc[i][1][4 * g], acc[i][1][4 * g + 1], acc[i][1][4 * g + 2], acc[i][1][4 * g + 3]};
      epi(m, n, v0, v1);
    }
  }
}


template <bool GATHER>
DI void gemm256_main(const h16* __restrict__ A, int lda, const int* __restrict__ idx, int m0,
                     const h16* __restrict__ B, int ldb, int n0, int K, h16* lds, f16v (&acc)[4][2]) {
  const int tid = otid512(), lane = tid & 63, wv = tid >> 6, wm = wv >> 2, wn = wv & 3;
  const int lr = tid >> 1, lc = (tid & 1) * 32;
  unsigned ao = (unsigned)(GATHER ? idx[m0 + lr] : (m0 + lr)) * (unsigned)lda + lc;
  unsigned bo = (unsigned)(n0 + lr) * (unsigned)ldb + lc;
  const h16* ap = A; const h16* bp = B;
#define AP_ (ap + ao)
#define BP_ (bp + bo)
  u4v ra[4], rb[4];
  const int nk = K >> 6;
  __syncthreads();
#pragma unroll
  for (int i = 0; i < 4; ++i) { ra[i] = *(const u4v*)(AP_ + 8 * i); rb[i] = *(const u4v*)(BP_ + 8 * i); }
  ao += 64; bo += 64;
#pragma unroll
  for (int i = 0; i < 4; ++i) { *(u4v*)&lds[lr * LDH + lc + 8 * i] = ra[i]; *(u4v*)&lds[(256 + lr) * LDH + lc + 8 * i] = rb[i]; }
#pragma unroll
  for (int i = 0; i < 4; ++i) { ra[i] = *(const u4v*)(AP_ + 8 * i); rb[i] = *(const u4v*)(BP_ + 8 * i); }
  ao += 64; bo += 64;
  __syncthreads();
  for (int kt = 0; kt < nk; ++kt) {
    const h16* As = lds + (kt & 1) * (512 * LDH);
    const h16* Bs = As + 256 * LDH;
    h16* Wn = lds + ((kt & 1) ^ 1) * (512 * LDH);
    if (kt + 1 < nk) {
#pragma unroll
      for (int i = 0; i < 4; ++i) { *(u4v*)&Wn[lr * LDH + lc + 8 * i] = ra[i]; *(u4v*)&Wn[(256 + lr) * LDH + lc + 8 * i] = rb[i]; }
    }
    if (kt + 2 < nk) {
#pragma unroll
      for (int i = 0; i < 4; ++i) { ra[i] = *(const u4v*)(AP_ + 8 * i); rb[i] = *(const u4v*)(BP_ + 8 * i); }
      ao += 64; bo += 64;
    }
#pragma unroll
    for (int ks = 0; ks < 4; ++ks) {
      h8v af[4], bf[2];
#pragma unroll
      for (int i = 0; i < 4; ++i) af[i] = *(const h8v*)&As[(wm * 128 + i * 32 + (lane & 31)) * LDH + ks * 16 + 8 * (lane >> 5)];
#pragma unroll
      for (int j = 0; j < 2; ++j) bf[j] = *(const h8v*)&Bs[(wn * 64 + j * 32 + (lane & 31)) * LDH + ks * 16 + 8 * (lane >> 5)];
#pragma unroll
      for (int i = 0; i < 4; ++i)
#pragma unroll
        for (int j = 0; j < 2; ++j) acc[i][j] = mfma32(bf[j], af[i], acc[i][j]);
    }
    __syncthreads();
  }
}
DI void acc256_zero(f16v (&acc)[4][2]) {
#pragma unroll
  for (int i = 0; i < 4; ++i)
#pragma unroll
    for (int j = 0; j < 2; ++j)
#pragma unroll
      for (int r = 0; r < 16; ++r) acc[i][j][r] = 0.f;
}
template <class Epi>
DI void gemm256_epilogue(f16v (&acc)[4][2], int m0, int n0, Epi epi) {
  const int tid = otid512(), lane = tid & 63, wv = tid >> 6, wm = wv >> 2, wn = wv & 3, h = lane >> 5;
#pragma unroll
  for (int i = 0; i < 4; ++i) {
    const int m = m0 + wm * 128 + i * 32 + (lane & 31);
#pragma unroll
    for (int g = 0; g < 4; ++g) {
      const int n = n0 + wn * 64 + 8 * g + 4 * h;
      f4v v0 = {acc[i][0][4 * g], acc[i][0][4 * g + 1], acc[i][0][4 * g + 2], acc[i][0][4 * g + 3]};
      f4v v1 = {acc[i][1][4 * g], acc[i][1][4 * g + 1], acc[i][1][4 * g + 2], acc[i][1][4 * g + 3]};
      epi(m, n, v0, v1);
    }
  }
}

DI void scal_unit(const Params& p, int l, int unit, float* lds) {
  const float* xs = (l == 0) ? p.x : p.out;
  const float* win = p.w_in + (size_t)l * 1024 * NIN;
  float* ps = (float*)(p.ws + OFF_PSCAL);
  float* xt = lds;
  float* wt = lds + 64 * 68;
  const int t = otid(), lane = t & 63, w = t >> 6, r = lane & 15, q = lane >> 4;
  f4v acc[2];
  acc[0] = (f4v){0.f, 0.f, 0.f, 0.f}; acc[1] = (f4v){0.f, 0.f, 0.f, 0.f};
  const int t0 = unit * 64;
  for (int k0 = 0; k0 < 1024; k0 += 64) {
    __syncthreads();
#pragma unroll
    for (int i = 0; i < 4; ++i) { int e = t + 256 * i; int rr = e >> 4, c4 = (e & 15) * 4; *(f4v*)&xt[rr * 68 + c4] = *(const f4v*)&xs[(size_t)(t0 + rr) * DM + k0 + c4]; }
#pragma unroll
    for (int i = 0; i < 8; ++i) { int e = t + 256 * i; int kk = e >> 5, c = e & 31; int col = (c < 16) ? (5120 + c) : (8464 + (c - 16)); wt[kk * 32 + c] = win[(size_t)(k0 + kk) * NIN + col]; }
    __syncthreads();
#pragma unroll
    for (int ks = 0; ks < 16; ++ks) {
      const float a = xt[(16 * w + r) * 68 + ks * 4 + q];
      const float b0 = wt[(ks * 4 + q) * 32 + r], b1 = wt[(ks * 4 + q) * 32 + 16 + r];
      acc[0] = __builtin_amdgcn_mfma_f32_16x16x4f32(a, b0, acc[0], 0, 0, 0);
      acc[1] = __builtin_amdgcn_mfma_f32_16x16x4f32(a, b1, acc[1], 0, 0, 0);
    }
  }
#pragma unroll
  for (int nt = 0; nt < 2; ++nt)
#pragma unroll
    for (int rg = 0; rg < 4; ++rg) ps[(size_t)(t0 + 16 * w + 4 * q + rg) * 32 + 16 * nt + r] = acc[nt][rg];
}

DI void phase_p1(const Params& p, int l, int bid, int nb, int vb, int vnb, unsigned char* smem, unsigned char* smem_half) {
  asm volatile("" : "+v"(vb));
  unsigned char* ws = p.ws;
  const h16* x16 = (const h16*)(ws + OFF_X16);
  const h16* wsm = (const h16*)(ws + OFF_WSM);
  h16* ps = (h16*)(ws + OFF_PS);
  const float* rc = (const float*)(ws + OFF_ROPE);
  const float* rs = rc + (size_t)SEQ * 32;
  for (int u = vb; u < 256; u += vnb) scal_unit(p, l, u, (float*)smem_half);
  for (int u = bid; u < 64 * 20; u += nb) {
    const int m0 = (u / 20) * 256, n0 = (u % 20) * 256;
    f16v acc[4][2]; acc256_zero(acc);
    gemm256_main<false>(x16, DM, nullptr, m0, wsm, 1024, n0, 1024, (h16*)smem, acc);
    gemm256_epilogue(acc, m0, n0, [&](int m, int n, f4v v0, f4v v1) {
      const bool rope = (n >= 1024 && n < 2560) || (n >= 4352 && n < 4992);
      if (rope) {
        const int d = n & 31;
        f4v c = *(const f4v*)&rc[(size_t)m * 32 + d], s = *(const f4v*)&rs[(size_t)m * 32 + d];
        f4v o0 = v0 * c - v1 * s, o1 = v1 * c + v0 * s;
        v0 = o0; v1 = o1;
      }
      st_h4(&ps[(size_t)m * NSM + n], v0);
      st_h4(&ps[(size_t)m * NSM + n + 32], v1);
    });
  }
}

DI void img_store_nat(h16* img, int row, int seg, u4v a, u4v b) {
  *(u4v*)&img[row * LDH + 16 * seg] = a; *(u4v*)&img[row * LDH + 16 * seg + 8] = b;
}
DI void img_store_T(h16* img, int row, int seg, u4v a, u4v b) {
  const h16* pa = (const h16*)&a; const h16* pb = (const h16*)&b;
#pragma unroll
  for (int i = 0; i < 8; ++i) { img[(16 * seg + i) * LDH + row] = pa[i]; img[(16 * seg + 8 + i) * LDH + row] = pb[i]; }
}

template <int NKB>
DI void attn_unit(const Params& p, int l, int mode, int grp, int head, int r0, int dil, int i0, int sub_len, int W, h16* lds) {
  unsigned char* ws = p.ws;
  const h16* P = (const h16*)(ws + OFF_PS);
  h16* Qi = lds; h16* Ki = lds + 64 * LDH; h16* Vt = lds + 128 * LDH; h16* Pi = lds + 192 * LDH;
  const int tid = otid(), lane = tid & 63, w = tid >> 6, r = lane & 15, q = lane >> 4;
  const int lrow = tid >> 2, seg = tid & 3;
  int qcol, kcol, vcol;
  if (mode == 0) { qcol = 1024 + grp * 256 + head * 64; kcol = 1792 + grp * 256 + head * 64; vcol = 2560 + grp * 256 + head * 64; }
  else { qcol = 4352 + head * 64; kcol = 4864 + (head >> 2) * 64; vcol = 4992 + (head >> 2) * 64; }
  __syncthreads();
  {
    const size_t pos = (size_t)r0 + (size_t)dil * (i0 + lrow);
    const h16* g = P + pos * NSM + qcol + 16 * seg;
    img_store_nat(Qi, lrow, seg, *(const u4v*)g, *(const u4v*)(g + 8));
  }
  float mrow[4], lsum[4];
  f4v O[4];
  float m_init = -1e30f, l_init = 0.f;
  if (mode == 1) { m_init = p.d_sink[l * 8 + head]; l_init = 1.f; }
#pragma unroll
  for (int i = 0; i < 4; ++i) { mrow[i] = m_init; lsum[i] = l_init; O[i] = (f4v){0.f, 0.f, 0.f, 0.f}; }
  u4v pk0, pk1, pv0, pv1;
#define ATT_PREFETCH(kb_) do { const int j0p_ = i0 - W + 64 * (kb_); const int j0q_ = ((j0p_ >= 0) && (j0p_ < sub_len)) ? j0p_ : i0; \
    const size_t posp_ = (size_t)r0 + (size_t)dil * (j0q_ + lrow);                                                                  \
    const h16* gk_ = P + posp_ * NSM + kcol + 16 * seg; const h16* gv_ = P + posp_ * NSM + vcol + 16 * seg;                           \
    pk0 = *(const u4v*)gk_; pk1 = *(const u4v*)(gk_ + 8); pv0 = *(const u4v*)gv_; pv1 = *(const u4v*)(gv_ + 8); } while (0)
  ATT_PREFETCH(0);
  for (int kb = 0; kb < NKB; ++kb) {
    const int j0 = i0 - W + 64 * kb;
    const bool inr = (j0 >= 0) && (j0 < sub_len);
    __syncthreads();
    img_store_nat(Ki, lrow, seg, pk0, pk1);
    img_store_T(Vt, lrow, seg, pv0, pv1);
    __syncthreads();
    if (kb + 1 < NKB) ATT_PREFETCH(kb + 1);
    f4v S[4];
#pragma unroll
    for (int i = 0; i < 4; ++i) S[i] = (f4v){0.f, 0.f, 0.f, 0.f};
    mm64(Qi, Ki, S, w, lane);
    float mx[4], al[4], rsum[4];
    bool vm[4][4];
#pragma unroll
    for (int rg = 0; rg < 4; ++rg) {
      const int row = 16 * w + 4 * q + rg;
      float m_ = -1e30f;
#pragma unroll
      for (int nt = 0; nt < 4; ++nt) {
        const int key = 16 * nt + r;
        const int delta = row - key + W - 64 * kb;
        const bool ok = inr && (delta >= -W) && (delta <= W);
        vm[nt][rg] = ok;
        float s = S[nt][rg] * 0.125f;
        S[nt][rg] = s;
        if (ok) m_ = fmaxf(m_, s);
      }
      mx[rg] = grp16_max(m_);
    }
#pragma unroll
    for (int rg = 0; rg < 4; ++rg) {
      const float mn = fmaxf(mrow[rg], mx[rg]);
      al[rg] = __expf(mrow[rg] - mn);
      mrow[rg] = mn;
      float rs_ = 0.f;
#pragma unroll
      for (int nt = 0; nt < 4; ++nt) {
        float pv = vm[nt][rg] ? __expf(S[nt][rg] - mn) : 0.f;
        rs_ += pv;
        Pi[(16 * w + 4 * q + rg) * LDH + 16 * nt + r] = (h16)pv;
      }
      rsum[rg] = grp16_sum(rs_);
      lsum[rg] = lsum[rg] * al[rg] + rsum[rg];
    }
#pragma unroll
    for (int et = 0; et < 4; ++et)
#pragma unroll
      for (int rg = 0; rg < 4; ++rg) O[et][rg] *= al[rg];
    __syncthreads();
    mm64(Pi, Vt, O, w, lane);
  }
#pragma unroll
  for (int rg = 0; rg < 4; ++rg) {
    const int row = 16 * w + 4 * q + rg;
    const size_t pos = (size_t)r0 + (size_t)dil * (i0 + row);
    const float inv = 1.f / lsum[rg];
    if (mode == 0) {
      h16* ob = (h16*)(ws + OFF_OB) + ((size_t)grp * SEQ + pos) * 256 + head * 64;
#pragma unroll
      for (int et = 0; et < 4; ++et) ob[16 * et + r] = (h16)(O[et][rg] * inv);
      if (r == 0) {
        float* ml = (float*)(ws + OFF_MLB) + (((size_t)grp * SEQ + pos) * 4 + head) * 2;
        ml[0] = mrow[rg]; ml[1] = lsum[rg];
      }
    } else {
      h16* y = (h16*)(ws + OFF_Y) + pos * 1280 + 768 + head * 64;
#pragma unroll
      for (int et = 0; et < 4; ++et) y[16 * et + r] = (h16)(O[et][rg] * inv);
    }
  }
}

DI void bcombine_unit(const Params& p, int unit) {
  unsigned char* ws = p.ws;
  const int gi = unit * 256 + otid();
  const int seg = gi & 7, head = (gi >> 3) & 3, pos = gi >> 5;
  const float* ml = (const float*)(ws + OFF_MLB);
  const h16* ob = (const h16*)(ws + OFF_OB);
  float m[3], lv[3];
#pragma unroll
  for (int g = 0; g < 3; ++g) { const float* q = ml + (((size_t)g * SEQ + pos) * 4 + head) * 2; m[g] = q[0]; lv[g] = q[1]; }
  const float M = fmaxf(m[0], fmaxf(m[1], m[2]));
  float wg[3], den = 0.f;
#pragma unroll
  for (int g = 0; g < 3; ++g) { wg[g] = __expf(m[g] - M) * lv[g]; den += wg[g]; }
  const float inv = 1.f / den;
  float o[8];
#pragma unroll
  for (int i = 0; i < 8; ++i) o[i] = 0.f;
#pragma unroll
  for (int g = 0; g < 3; ++g) {
    h8v v = *(const h8v*)&ob[((size_t)g * SEQ + pos) * 256 + head * 64 + seg * 8];
#pragma unroll
    for (int i = 0; i < 8; ++i) o[i] += wg[g] * (float)v[i];
  }
  h8v ov;
#pragma unroll
  for (int i = 0; i < 8; ++i) ov[i] = (h16)(o[i] * inv);
  *(h8v*)((h16*)(ws + OFF_Y) + (size_t)pos * 1280 + 256 + head * 64 + seg * 8) = ov;
}

DI void mlstm_a1_unit(const Params& p, int l, int head, int oc, h16* lds) {
  unsigned char* ws = p.ws;
  const h16* P = (const h16*)(ws + OFF_PS);
  const float* pscal = (const float*)(ws + OFF_PSCAL);
  float* sca = (float*)(ws + OFF_SCA);
  float* scas = (float*)(ws + OFF_SCAS);
  h16* Ks0 = lds; h16* Ks1 = lds + 64 * LDH; h16* Vt = lds + 128 * LDH;
  float* sw = (float*)(lds + 192 * LDH);
  const int tid = otid(), lane = tid & 63, w = tid >> 6, r = lane & 15, q = lane >> 4;
  __syncthreads();
  if (w < 2) {
    const int dir = w;
    const int rr = dir ? 63 - lane : lane;
    const size_t pos = (size_t)oc * 64 + rr;
    const float* gb = p.a_gate_bias + l * 16;
    const float ig = pscal[pos * 32 + dir * 8 + head] + gb[dir * 8 + head];
    const float lf = logsigmoid_(pscal[pos * 32 + dir * 8 + 4 + head] + gb[dir * 8 + 4 + head]);
    const float b = wave_incl_sum(lf, lane);
    const float blast = __shfl(b, 63);
    const float slog = blast - b + ig;
    const float mc = wave_max(slog);
    sw[dir * 64 + rr] = __expf(slog - mc) * 0.125f;
    if (lane == 0) {
      const int nloc = dir ? 255 - oc : oc;
      float* s4 = scas + ((size_t)(dir * 4 + head) * 256 + nloc) * 4;
      s4[0] = blast; s4[1] = mc;
    }
  }
  __syncthreads();
  {
    const int lrow = tid >> 2, seg = tid & 3;
    const size_t pos = (size_t)oc * 64 + lrow;
    const h16* gk = P + pos * NSM + 256 + head * 64 + 16 * seg;
    const h16* gv = P + pos * NSM + 512 + head * 64 + 16 * seg;
    h8v k0 = *(const h8v*)gk, k1 = *(const h8v*)(gk + 8);
    u4v v0 = *(const u4v*)gv, v1 = *(const u4v*)(gv + 8);
    const float s0 = sw[lrow], s1 = sw[64 + lrow];
#pragma unroll
    for (int i = 0; i < 8; ++i) {
      Ks0[(16 * seg + i) * LDH + lrow] = (h16)((float)k0[i] * s0);
      Ks0[(16 * seg + 8 + i) * LDH + lrow] = (h16)((float)k1[i] * s0);
      Ks1[(16 * seg + i) * LDH + lrow] = (h16)((float)k0[i] * s1);
      Ks1[(16 * seg + 8 + i) * LDH + lrow] = (h16)((float)k1[i] * s1);
    }
    img_store_T(Vt, lrow, seg, v0, v1);
  }
  __syncthreads();
#pragma unroll
  for (int dir = 0; dir < 2; ++dir) {
    const h16* Ks = dir ? Ks1 : Ks0;
    const int nloc = dir ? 255 - oc : oc;
    float* dst = sca + ((size_t)(dir * 4 + head) * 256 + nloc) * 4160;
    f4v acc[4];
#pragma unroll
    for (int i = 0; i < 4; ++i) acc[i] = (f4v){0.f, 0.f, 0.f, 0.f};
    mm64(Vt, Ks, acc, w, lane);
#pragma unroll
    for (int nt = 0; nt < 4; ++nt)
#pragma unroll
      for (int rg = 0; rg < 4; ++rg) dst[(16 * w + 4 * q + rg) * 64 + 16 * nt + r] = acc[nt][rg];
    if (w == dir) {
      float s = 0.f;
#pragma unroll 8
      for (int j = 0; j < 64; ++j) s += (float)Ks[lane * LDH + j];
      dst[4096 + lane] = s;
    }
  }
}

DI void mlstm_a2_unit(const Params& p, int unit) {
  unsigned char* ws = p.ws;
  float* sca = (float*)(ws + OFF_SCA);
  float* scas = (float*)(ws + OFF_SCAS);
  const int dh = unit / 17, sl = unit % 17;
  const int e = sl * 256 + otid();
  if (e >= 4160) return;
  float* base = sca + (size_t)dh * 256 * 4160 + e;
  float* s4 = scas + (size_t)dh * 256 * 4;
  float m = 0.f, c = 0.f;
  for (int n0 = 0; n0 < 256; n0 += 8) {
    float cc[8];
#pragma unroll
    for (int i = 0; i < 8; ++i) cc[i] = base[(size_t)(n0 + i) * 4160];
#pragma unroll
    for (int i = 0; i < 8; ++i) {
      const float bl = s4[(n0 + i) * 4], mc = s4[(n0 + i) * 4 + 1];
      const float mn = fmaxf(bl + m, mc);
      const float dec = __expf(bl + m - mn), gain = __expf(mc - mn);
      base[(size_t)(n0 + i) * 4160] = c;
      if (e == 0) s4[(n0 + i) * 4 + 2] = m;
      c = dec * c + gain * cc[i];
      m = mn;
    }
  }
}

DI void mlstm_a3_unit(const Params& p, int l, int head, int oc, h16* lds) {
  unsigned char* ws = p.ws;
  const h16* P = (const h16*)(ws + OFF_PS);
  const float* pscal = (const float*)(ws + OFF_PSCAL);
  const float* sca = (const float*)(ws + OFF_SCA);
  const float* scas = (const float*)(ws + OFF_SCAS);
  h16* Qi = lds; h16* Ki = lds + 64 * LDH; h16* Vt = lds + 128 * LDH; h16* Wi = lds + 192 * LDH; h16* Ci = lds + 256 * LDH;
  float* fl = (float*)(lds + 320 * LDH);
  float* rowterm = fl;
  float* colterm = fl + 128;
  float* ainter = fl + 256;
  float* emt = fl + 384;
  float* nvec = fl + 512;
  float* qn = fl + 576;
  const int tid = otid(), lane = tid & 63, w = tid >> 6, r = lane & 15, q = lane >> 4;
  const int lrow = tid >> 2, seg = tid & 3;
  __syncthreads();
  {
    const size_t pos = (size_t)oc * 64 + lrow;
    const h16* g = P + pos * NSM + head * 64 + 16 * seg;
    img_store_nat(Qi, lrow, seg, *(const u4v*)g, *(const u4v*)(g + 8));
    img_store_nat(Ki, lrow, seg, *(const u4v*)(g + 256), *(const u4v*)(g + 264));
    img_store_T(Vt, lrow, seg, *(const u4v*)(g + 512), *(const u4v*)(g + 520));
  }
  if (w < 2) {
    const int dir = w;
    const int rr = dir ? 63 - lane : lane;
    const size_t pos = (size_t)oc * 64 + rr;
    const int nloc = dir ? 255 - oc : oc;
    const float* gb = p.a_gate_bias + l * 16;
    const float ig = pscal[pos * 32 + dir * 8 + head] + gb[dir * 8 + head];
    const float lf = logsigmoid_(pscal[pos * 32 + dir * 8 + 4 + head] + gb[dir * 8 + 4 + head]);
    const float b = wave_incl_sum(lf, lane);
    const float u = ig - b;
    const float pm = wave_incl_max(u, lane);
    const float m_intra = b + pm;
    const float mprev = scas[((size_t)(dir * 4 + head) * 256 + nloc) * 4 + 2];
    const float mt = fmaxf(b + mprev, m_intra);
    rowterm[dir * 64 + rr] = b - mt;
    colterm[dir * 64 + rr] = u;
    ainter[dir * 64 + rr] = __expf(b + mprev - mt);
    emt[dir * 64 + rr] = __expf(-mt);
  }
  f4v hacc[4];
#pragma unroll
  for (int i = 0; i < 4; ++i) hacc[i] = (f4v){0.f, 0.f, 0.f, 0.f};
#pragma unroll 1
  for (int dir = 0; dir < 2; ++dir) {
    const int nloc = dir ? 255 - oc : oc;
    const float* src = sca + ((size_t)(dir * 4 + head) * 256 + nloc) * 4160;
    __syncthreads();
    {
      const float4* s4 = (const float4*)(src + lrow * 64 + 16 * seg);
      float4 a = s4[0], b = s4[1], c = s4[2], d = s4[3];
      h8v o0, o1;
      o0[0] = (h16)a.x; o0[1] = (h16)a.y; o0[2] = (h16)a.z; o0[3] = (h16)a.w; o0[4] = (h16)b.x; o0[5] = (h16)b.y; o0[6] = (h16)b.z; o0[7] = (h16)b.w;
      o1[0] = (h16)c.x; o1[1] = (h16)c.y; o1[2] = (h16)c.z; o1[3] = (h16)c.w; o1[4] = (h16)d.x; o1[5] = (h16)d.y; o1[6] = (h16)d.z; o1[7] = (h16)d.w;
      *(h8v*)&Ci[lrow * LDH + 16 * seg] = o0; *(h8v*)&Ci[lrow * LDH + 16 * seg + 8] = o1;
      if (tid < 64) nvec[tid] = src[4096 + tid];
    }
    __syncthreads();
    f4v S[4];
#pragma unroll
    for (int i = 0; i < 4; ++i) S[i] = (f4v){0.f, 0.f, 0.f, 0.f};
    mm64(Qi, Ki, S, w, lane);
    float dint[4];
#pragma unroll
    for (int rg = 0; rg < 4; ++rg) {
      const int t = 16 * w + 4 * q + rg;
      const float rt = rowterm[dir * 64 + t];
      float sum = 0.f;
#pragma unroll
      for (int nt = 0; nt < 4; ++nt) {
        const int s = 16 * nt + r;
        const bool ok = dir ? (s >= t) : (s <= t);
        const float wv = ok ? __expf(rt + colterm[dir * 64 + s]) * S[nt][rg] * 0.125f : 0.f;
        sum += wv;
        Wi[t * LDH + s] = (h16)wv;
      }
      dint[rg] = grp16_sum(sum);
    }
    {
      float s = 0.f;
#pragma unroll
      for (int i = 0; i < 16; ++i) s += (float)Qi[lrow * LDH + 16 * seg + i] * nvec[16 * seg + i];
      s += __shfl_xor(s, 1); s += __shfl_xor(s, 2);
      if (seg == 0) qn[lrow] = s;
    }
    __syncthreads();
    f4v a1[4], a2[4];
#pragma unroll
    for (int i = 0; i < 4; ++i) { a1[i] = (f4v){0.f, 0.f, 0.f, 0.f}; a2[i] = (f4v){0.f, 0.f, 0.f, 0.f}; }
    mm64(Wi, Vt, a1, w, lane);
    mm64(Qi, Ci, a2, w, lane);
#pragma unroll
    for (int rg = 0; rg < 4; ++rg) {
      const int t = 16 * w + 4 * q + rg;
      const float ai = ainter[dir * 64 + t];
      const float den = ai * qn[t] + dint[rg];
      const float dn = 1.f / fmaxf(fabsf(den), emt[dir * 64 + t]);
#pragma unroll
      for (int et = 0; et < 4; ++et) hacc[et][rg] += (a1[et][rg] + ai * a2[et][rg]) * dn;
    }
  }
  const float* nw = p.a_norm_w + l * 256 + head * 64;
#pragma unroll
  for (int rg = 0; rg < 4; ++rg) {
    const int t = 16 * w + 4 * q + rg;
    const size_t pos = (size_t)oc * 64 + t;
    float s = hacc[0][rg] + hacc[1][rg] + hacc[2][rg] + hacc[3][rg];
    const float mu = grp16_sum(s) * (1.f / 64.f);
    float vs = 0.f;
#pragma unroll
    for (int et = 0; et < 4; ++et) { float d = hacc[et][rg] - mu; vs += d * d; }
    const float var = grp16_sum(vs) * (1.f / 64.f);
    const float rstd = rsqrtf(var + 1e-5f);
    h16* y = (h16*)(ws + OFF_Y) + pos * 1280 + head * 64;
    const h16* ao = P + pos * NSM + 768 + head * 64;
#pragma unroll
    for (int et = 0; et < 4; ++et) {
      const int e = 16 * et + r;
      y[e] = (h16)((hacc[et][rg] - mu) * rstd * nw[e] * sigmoid_((float)ao[e]));
    }
  }
}

template <int DIR>
DI void dn_solve4(const float* M, const h16* Ki, const h16* Vi, const float* betal, const float* gcl, int half, int c, int pp, float (&x)[16]) {
  const h16* src = half ? (Ki + c) : (Vi + c);
#pragma unroll
  for (int k = 0; k < 16; ++k) x[k] = 0.f;
#pragma unroll
  for (int il = 0; il < 64; ++il) {
    const int ri = DIR ? 63 - il : il;
    float part = 0.f;
#pragma unroll
    for (int k = 0; k < (il + 3) / 4; ++k) {
      const int jl0 = 4 * k;
      float mv = DIR ? M[ri * MLD + 63 - jl0 - pp] : M[ri * MLD + jl0 + pp];
      if (jl0 + 3 >= il) mv = (jl0 + pp < il) ? mv : 0.f;
      part += mv * x[k];
    }
    part += __shfl_xor(part, 1); part += __shfl_xor(part, 2);
    const float e = half ? __expf(gcl[ri]) : 1.f;
    const float xi = betal[ri] * (float)src[ri * LDH] * e - part;
    if ((il & 3) == pp) x[il >> 2] = xi;
  }
}

DI void dn_c1_unit(const Params& p, int l, int head, int oc, h16* lds) {
  unsigned char* ws = p.ws;
  const h16* P = (const h16*)(ws + OFF_PS);
  const float* pscal = (const float*)(ws + OFF_PSCAL);
  h16* cq = (h16*)(ws + OFF_CQKV);
  h16* Ki = lds; h16* Vi = lds + 64 * LDH;
  float* M = (float*)(lds + 128 * LDH);
  float* betal = M + 64 * MLD;
  float* gcl = betal + 128;
  float* glast = gcl + 128;
  const int tid = otid(), lane = tid & 63, w = tid >> 6, r = lane & 15, q = lane >> 4;
  const int lrow = tid >> 2, seg = tid & 3;
  __syncthreads();
  {
    const int pos = oc * 64 + lrow;
    const float* cw = p.c_conv_w + (size_t)l * 5 * 768;
    float vq[16], vk[16], vv[16];
#pragma unroll
    for (int i = 0; i < 16; ++i) { vq[i] = 0.f; vk[i] = 0.f; vv[i] = 0.f; }
#pragma unroll
    for (int j = 0; j < 5; ++j) {
      const int pp = pos + j - 2;
      if (pp < 0 || pp >= SEQ) continue;
      const h16* g = P + (size_t)pp * NSM + 3328 + head * 64 + 16 * seg;
      h8v q0 = *(const h8v*)g, q1 = *(const h8v*)(g + 8);
      h8v k0 = *(const h8v*)(g + 256), k1 = *(const h8v*)(g + 264);
      h8v v0 = *(const h8v*)(g + 512), v1 = *(const h8v*)(g + 520);
      const float* wq = cw + j * 768 + head * 64 + 16 * seg;
#pragma unroll
      for (int i = 0; i < 8; ++i) {
        vq[i] += wq[i] * (float)q0[i]; vq[8 + i] += wq[8 + i] * (float)q1[i];
        vk[i] += wq[256 + i] * (float)k0[i]; vk[8 + i] += wq[264 + i] * (float)k1[i];
        vv[i] += wq[512 + i] * (float)v0[i]; vv[8 + i] += wq[520 + i] * (float)v1[i];
      }
    }
    float sq = 0.f, sk = 0.f;
#pragma unroll
    for (int i = 0; i < 16; ++i) { vq[i] = silu_(vq[i]); vk[i] = silu_(vk[i]); vv[i] = silu_(vv[i]); sq += vq[i] * vq[i]; sk += vk[i] * vk[i]; }
    sq += __shfl_xor(sq, 1); sq += __shfl_xor(sq, 2);
    sk += __shfl_xor(sk, 1); sk += __shfl_xor(sk, 2);
    const float rq = rsqrtf(sq + 1e-6f) * 0.125f, rk = rsqrtf(sk + 1e-6f);
    h8v oq0, oq1, ok0, ok1, ov0, ov1;
#pragma unroll
    for (int i = 0; i < 8; ++i) {
      oq0[i] = (h16)(vq[i] * rq); oq1[i] = (h16)(vq[8 + i] * rq);
      ok0[i] = (h16)(vk[i] * rk); ok1[i] = (h16)(vk[8 + i] * rk);
      ov0[i] = (h16)vv[i]; ov1[i] = (h16)vv[8 + i];
    }
    h16* o = cq + (size_t)pos * 768 + head * 64 + 16 * seg;
    *(h8v*)o = oq0; *(h8v*)(o + 8) = oq1;
    *(h8v*)(o + 256) = ok0; *(h8v*)(o + 264) = ok1;
    *(h8v*)(o + 512) = ov0; *(h8v*)(o + 520) = ov1;
    *(h8v*)&Ki[lrow * LDH + 16 * seg] = ok0; *(h8v*)&Ki[lrow * LDH + 16 * seg + 8] = ok1;
    *(h8v*)&Vi[lrow * LDH + 16 * seg] = ov0; *(h8v*)&Vi[lrow * LDH + 16 * seg + 8] = ov1;
  }
  if (w < 2) {
    const int dir = w;
    const int rr = dir ? 63 - lane : lane;
    const size_t pos = (size_t)oc * 64 + rr;
    const float beta = sigmoid_(pscal[pos * 32 + 16 + dir * 4 + head]);
    const float g = -__expf(p.c_a_log[l * 8 + dir * 4 + head]) * softplus_(pscal[pos * 32 + 24 + dir * 4 + head] + p.c_dt_bias[l * 8 + dir * 4 + head]);
    const float gc = wave_incl_sum(g, lane);
    const float gl = __shfl(gc, 63);
    betal[dir * 64 + rr] = beta; gcl[dir * 64 + rr] = gc;
    if (lane == 0) {
      glast[dir] = gl;
      const int nloc = dir ? 255 - oc : oc;
      ((float*)(ws + OFF_CDL))[(size_t)(dir * 4 + head) * 256 + nloc] = __expf(gl);
    }
  }
  __syncthreads();
  {
    f4v kk[4];
#pragma unroll
    for (int i = 0; i < 4; ++i) kk[i] = (f4v){0.f, 0.f, 0.f, 0.f};
    mm64(Ki, Ki, kk, w, lane);
#pragma unroll
    for (int nt = 0; nt < 4; ++nt)
#pragma unroll
      for (int rg = 0; rg < 4; ++rg) {
        const int i = 16 * w + 4 * q + rg, j = 16 * nt + r;
        float v = 0.f;
        if (j < i) v = betal[i] * kk[nt][rg] * __expf(gcl[i] - gcl[j]);
        else if (j > i) v = betal[64 + i] * kk[nt][rg] * __expf(gcl[64 + i] - gcl[64 + j]);
        M[i * MLD + j] = v;
      }
  }
  __syncthreads();
  {
    const int c = tid >> 2, pp = tid & 3;
#pragma unroll 1
    for (int dh2 = 0; dh2 < 4; ++dh2) {
      const int dir = dh2 >> 1, half = dh2 & 1;
      const int nloc = dir ? 255 - oc : oc;
      const size_t unit = (size_t)(dir * 4 + head) * 256 + nloc;
      float x[16];
      if (dir == 0) dn_solve4<0>(M, Ki, Vi, betal, gcl, half, c, pp, x);
      else dn_solve4<1>(M, Ki, Vi, betal + 64, gcl + 64, half, c, pp, x);
      if (half == 0) {
        float* ud = (float*)(ws + OFF_CU) + unit * 4096;
        const int slice = c >> 4, el = c & 15;
#pragma unroll
        for (int k = 0; k < 16; ++k) {
          const int il = 4 * k + pp;
          const int rr = dir ? 63 - il : il;
          ud[((slice * 4 + (rr >> 4)) * 64 + el + 16 * ((rr & 15) >> 2)) * 4 + (rr & 3)] = x[k];
        }
      } else {
        h16* wd = (h16*)(ws + OFF_CW) + unit * 4096;
        const int s = c >> 5, lq = (c & 15) >> 2, jjx = (c & 3) + 4 * ((c & 31) >> 4);
#pragma unroll
        for (int k = 0; k < 16; ++k) {
          const int il = 4 * k + pp;
          const int rr = dir ? 63 - il : il;
          wd[(((rr >> 4) * 2 + s) * 64 + (rr & 15) + 16 * lq) * 8 + jjx] = (h16)(-x[k]);
        }
      }
    }
  }
#pragma unroll
  for (int dir = 0; dir < 2; ++dir) {
    const int nloc = dir ? 255 - oc : oc;
    const size_t unit = (size_t)(dir * 4 + head) * 256 + nloc;
    h16* kd = (h16*)(ws + OFF_CKD) + unit * 4096;
    const float gl = glast[dir];
#pragma unroll
    for (int it = 0; it < 4; ++it) {
      const int e = tid + 256 * it;
      const int d = e & 63, rq = e >> 6;
      const int r0 = 4 * rq;
      h4v o;
#pragma unroll
      for (int i = 0; i < 4; ++i) o[i] = (h16)((float)Ki[(r0 + i) * LDH + d] * __expf(gl - gcl[dir * 64 + r0 + i]));
      const int tile = d >> 4, s = r0 >> 5, ln = (d & 15) + 16 * ((r0 & 15) >> 2), j4 = 4 * ((r0 & 31) >> 4);
      *(h4v*)&kd[((tile * 2 + s) * 64 + ln) * 8 + j4] = o;
    }
  }
}

DI void dn_c2_unit(const Params& p, int dh, int w) {
  unsigned char* ws = p.ws;
  const int tid = otid(), lane = tid & 63;
  if (tid >= 64) return;
  const h16* cw = (const h16*)(ws + OFF_CW) + (size_t)dh * 256 * 4096;
  const h16* ckd = (const h16*)(ws + OFF_CKD) + (size_t)dh * 256 * 4096;
  const float* cu = (const float*)(ws + OFF_CU) + (size_t)dh * 256 * 4096;
  const float* cdl = (const float*)(ws + OFF_CDL) + (size_t)dh * 256;
  h16* cs = (h16*)(ws + OFF_CS) + (size_t)dh * 256 * 4096;
  h16* cvn = (h16*)(ws + OFF_CVN) + (size_t)dh * 256 * 4096;
  f4v S[4];
#pragma unroll
  for (int i = 0; i < 4; ++i) S[i] = (f4v){0.f, 0.f, 0.f, 0.f};
  h8v wA[4][2], kA[4][2]; f4v uu[4]; float dl;
#pragma unroll
  for (int t = 0; t < 4; ++t) {
#pragma unroll
    for (int s = 0; s < 2; ++s) {
      wA[t][s] = *(const h8v*)&cw[((t * 2 + s) * 64 + lane) * 8];
      kA[t][s] = *(const h8v*)&ckd[((t * 2 + s) * 64 + lane) * 8];
    }
    uu[t] = *(const f4v*)&cu[((w * 4 + t) * 64 + lane) * 4];
  }
  dl = cdl[0];
  for (int n = 0; n < 256; ++n) {
    h8v wN[4][2], kN[4][2]; f4v uN[4]; float dlN = 0.f;
    const int nn = (n + 1 < 256) ? n + 1 : n;
    {
      const h16* cw1 = cw + (size_t)nn * 4096; const h16* ck1 = ckd + (size_t)nn * 4096; const float* cu1 = cu + (size_t)nn * 4096;
#pragma unroll
      for (int t = 0; t < 4; ++t) {
#pragma unroll
        for (int s = 0; s < 2; ++s) {
          wN[t][s] = *(const h8v*)&cw1[((t * 2 + s) * 64 + lane) * 8];
          kN[t][s] = *(const h8v*)&ck1[((t * 2 + s) * 64 + lane) * 8];
        }
        uN[t] = *(const f4v*)&cu1[((w * 4 + t) * 64 + lane) * 4];
      }
      dlN = cdl[nn];
    }
    h8v Sb[2];
    Sb[0] = pack8(S[0], S[1]); Sb[1] = pack8(S[2], S[3]);
    h16* cs1 = cs + (size_t)n * 4096; h16* cv1 = cvn + (size_t)n * 4096;
    *(h8v*)&cs1[((w * 2 + 0) * 64 + lane) * 8] = Sb[0];
    *(h8v*)&cs1[((w * 2 + 1) * 64 + lane) * 8] = Sb[1];
    f4v vn[4];
#pragma unroll
    for (int t = 0; t < 4; ++t) { vn[t] = uu[t]; vn[t] = mfma16(wA[t][0], Sb[0], vn[t]); vn[t] = mfma16(wA[t][1], Sb[1], vn[t]); }
    h8v Vb[2];
    Vb[0] = pack8(vn[0], vn[1]); Vb[1] = pack8(vn[2], vn[3]);
    *(h8v*)&cv1[((w * 2 + 0) * 64 + lane) * 8] = Vb[0];
    *(h8v*)&cv1[((w * 2 + 1) * 64 + lane) * 8] = Vb[1];
#pragma unroll
    for (int t = 0; t < 4; ++t) { S[t] *= dl; S[t] = mfma16(kA[t][0], Vb[0], S[t]); S[t] = mfma16(kA[t][1], Vb[1], S[t]); }
#pragma unroll
    for (int t = 0; t < 4; ++t) { wA[t][0] = wN[t][0]; wA[t][1] = wN[t][1]; kA[t][0] = kN[t][0]; kA[t][1] = kN[t][1]; uu[t] = uN[t]; }
    dl = dlN;
  }
}

DI void dn_c3_unit(const Params& p, int l, int head, int oc, h16* lds) {
  unsigned char* ws = p.ws;
  const h16* P = (const h16*)(ws + OFF_PS);
  const float* pscal = (const float*)(ws + OFF_PSCAL);
  const h16* cq = (const h16*)(ws + OFF_CQKV);
  h16* Qi = lds; h16* Ki = lds + 64 * LDH;
  h16* AT = lds + 128 * LDH;
  h16* QG = lds + 256 * LDH;
  float* gcl = (float*)(lds + 384 * LDH);
  float* Ol = (float*)lds;
  const int tid = otid(), lane = tid & 63, w = tid >> 6, r = lane & 15, q = lane >> 4;
  const int lrow = tid >> 2, seg = tid & 3;
  __syncthreads();
  {
    const size_t pos = (size_t)oc * 64 + lrow;
    const h16* g = cq + pos * 768 + head * 64 + 16 * seg;
    img_store_nat(Qi, lrow, seg, *(const u4v*)g, *(const u4v*)(g + 8));
    img_store_nat(Ki, lrow, seg, *(const u4v*)(g + 256), *(const u4v*)(g + 264));
  }
  if (w < 2) {
    const int dir = w;
    const int rr = dir ? 63 - lane : lane;
    const size_t pos = (size_t)oc * 64 + rr;
    const float g = -__expf(p.c_a_log[l * 8 + dir * 4 + head]) * softplus_(pscal[pos * 32 + 24 + dir * 4 + head] + p.c_dt_bias[l * 8 + dir * 4 + head]);
    gcl[dir * 64 + rr] = wave_incl_sum(g, lane);
  }
  __syncthreads();
  {
    f4v S[4];
#pragma unroll
    for (int i = 0; i < 4; ++i) S[i] = (f4v){0.f, 0.f, 0.f, 0.f};
    mm64(Qi, Ki, S, w, lane);
#pragma unroll
    for (int dir = 0; dir < 2; ++dir) {
#pragma unroll
      for (int nt = 0; nt < 4; ++nt)
#pragma unroll
        for (int rg = 0; rg < 4; ++rg) {
          const int i = 16 * w + 4 * q + rg, j = 16 * nt + r;
          const bool ok = dir ? (j >= i) : (j <= i);
          const float v = ok ? S[nt][rg] * __expf(gcl[dir * 64 + i] - gcl[dir * 64 + j]) : 0.f;
          AT[(dir * 64 + i) * LDH + j] = (h16)v;
        }
      const float eg = __expf(gcl[dir * 64 + lrow]);
#pragma unroll
      for (int i = 0; i < 16; ++i) QG[(dir * 64 + lrow) * LDH + 16 * seg + i] = (h16)((float)Qi[lrow * LDH + 16 * seg + i] * eg);
    }
  }
  __syncthreads();
  f4v o[4];
#pragma unroll
  for (int i = 0; i < 4; ++i) o[i] = (f4v){0.f, 0.f, 0.f, 0.f};
#pragma unroll
  for (int dir = 0; dir < 2; ++dir) {
    const int nloc = dir ? 255 - oc : oc;
    const size_t unit = (size_t)(dir * 4 + head) * 256 + nloc;
    const h16* cs = (const h16*)(ws + OFF_CS) + unit * 4096;
    const h16* cv = (const h16*)(ws + OFF_CVN) + unit * 4096;
#pragma unroll
    for (int s = 0; s < 2; ++s) {
      const h8v Sb = *(const h8v*)&cs[((w * 2 + s) * 64 + lane) * 8];
      const h8v Vb = *(const h8v*)&cv[((w * 2 + s) * 64 + lane) * 8];
#pragma unroll
      for (int it = 0; it < 4; ++it) {
        o[it] = mfma16(perm_frag(QG + dir * 64 * LDH, 16 * it + r, s, q), Sb, o[it]);
        o[it] = mfma16(perm_frag(AT + dir * 64 * LDH, 16 * it + r, s, q), Vb, o[it]);
      }
    }
  }
  __syncthreads();
#pragma unroll
  for (int it = 0; it < 4; ++it)
#pragma unroll
    for (int rg = 0; rg < 4; ++rg) Ol[(16 * it + 4 * q + rg) * 65 + 16 * w + r] = o[it][rg];
  __syncthreads();
  {
    const size_t pos = (size_t)oc * 64 + lrow;
    float v[16]; float ss = 0.f;
#pragma unroll
    for (int i = 0; i < 16; ++i) { v[i] = Ol[lrow * 65 + 16 * seg + i]; ss += v[i] * v[i]; }
    ss += __shfl_xor(ss, 1); ss += __shfl_xor(ss, 2);
    const float rms = rsqrtf(ss * (1.f / 64.f) + 1e-6f);
    const float* nw = p.c_norm_w + l * 64 + 16 * seg;
    const h16* cg_ = P + pos * NSM + 4096 + head * 64 + 16 * seg;
    h8v g0 = *(const h8v*)cg_, g1 = *(const h8v*)(cg_ + 8);
    h8v o0, o1;
#pragma unroll
    for (int i = 0; i < 8; ++i) {
      o0[i] = (h16)(v[i] * rms * nw[i] * silu_((float)g0[i]));
      o1[i] = (h16)(v[8 + i] * rms * nw[8 + i] * silu_((float)g1[i]));
    }
    h16* y = (h16*)(ws + OFF_Y) + pos * 1280 + 512 + head * 64 + 16 * seg;
    *(h8v*)y = o0; *(h8v*)(y + 8) = o1;
  }
}

DI void phase_m1(const Params& p, int l, int bid, int nb, h16* lds) {
  asm volatile("" : "+v"(bid));
  for (int u = bid; u < 2048; u += nb) {
    if (u < 1024) dn_c1_unit(p, l, u & 3, u >> 2, lds);
    else { const int v = u - 1024; mlstm_a1_unit(p, l, v & 3, v >> 2, lds); }
  }
}
DI void phase_m2(const Params& p, int l, int bid, int nb, h16* lds) {
  asm volatile("" : "+v"(bid));
  const int nA = conv_total(l) - 2560;
  const int nB = (l + 1 < 4) ? 2560 : 0;
  const int total = 32 + 136 + 2048 + 3072 + nA + nB;
  if (l & 1) moe_reset(p, bid, nb);
  const int ustart = (bid < 32) ? bid : bid;
  const int ustep = (bid < 32) ? total : (nb - 32);
  for (int u = ustart; u < total; u += ustep) {
    int v = u;
    if (v >= 5288) { v -= 5288; if (v < nA) conv_one(p, l, 2560 + v, lds); else conv_one(p, l + 1, v - nA, lds); continue; }
    if (v < 32) { dn_c2_unit(p, v >> 2, v & 3); continue; }
    if ((v -= 32) < 136) { mlstm_a2_unit(p, v); continue; }
    if ((v -= 136) < 2048) { attn_unit<5>(p, l, 1, 0, v & 7, 0, 1, (v >> 3) * 64, SEQ, 128, lds); continue; }
    v -= 2048;
    const int grp = v >> 10, x = v & 1023, head = x & 3, tl = x >> 2;
    const int dil = (grp == 0) ? 1 : (grp == 1) ? 4 : 16;
    const int sub = SEQ / dil, tps = sub >> 6;
    const int res = tl / tps, ti = tl % tps;
    attn_unit<3>(p, l, 0, grp, head, res, dil, ti * 64, sub, 64, lds);
  }
}
DI void phase_m3(const Params& p, int l, int bid, int nb, h16* lds) {
  asm volatile("" : "+v"(bid));
  const int total = 1024 + 1024 + 2048;
  for (int u = bid; u < total; u += nb) {
    int v = u;
    if (v < 1024) { mlstm_a3_unit(p, l, v & 3, v >> 2, lds); continue; }
    if ((v -= 1024) < 1024) { dn_c3_unit(p, l, v & 3, v >> 2, lds); continue; }
    bcombine_unit(p, v - 1024);
  }
}

DI void phase_gates(const Params& p, int bid, int nb, h16* lds) {
  unsigned char* ws = p.ws;
  const h16* x16 = (const h16*)(ws + OFF_X16);
  const h16* wg = (const h16*)(ws + OFF_WG);
  h16* G = (h16*)(ws + OFF_GATES);
  for (int u = bid; u < 64 * 16; u += nb) {
    const int m0 = (u >> 4) * 256, n0 = (u & 15) * 256;
    f16v acc[4][2]; acc256_zero(acc);
    gemm256_main<false>(x16, DM, nullptr, m0, wg, 1024, n0, 1024, lds, acc);
    gemm256_epilogue(acc, m0, n0, [&](int m, int n, f4v v0, f4v v1) {
      f4v a, b;
#pragma unroll
      for (int i = 0; i < 4; ++i) { a[i] = sigmoid_(v0[i]); b[i] = sigmoid_(v1[i]); }
      st_h4(&G[(size_t)m * 4096 + n], a); st_h4(&G[(size_t)m * 4096 + n + 32], b);
    });
  }
}
DI void phase_merge(const Params& p, int bid, int nb, h16* lds) {
  asm volatile("" : "+v"(bid));
  unsigned char* ws = p.ws;
  const h16* Y = (const h16*)(ws + OFF_Y);
  const h16* wbr = (const h16*)(ws + OFF_WBR);
  const h16* G = (const h16*)(ws + OFF_GATES);
  h16* Mg = (h16*)(ws + OFF_MERGED);
  for (int u = bid; u < 128 * 8; u += nb) {
    const int m0 = (u >> 3) * 128, n0 = (u & 7) * 128;
    f16v macc[2][2]; acc_zero(macc);
#pragma unroll 1
    for (int b = 0; b < 4; ++b) {
      const int Kb = (b == 3) ? 512 : 256;
      f16v acc[2][2]; acc_zero(acc);
      gemm_main<false>(Y + b * 256, 1280, nullptr, m0, wbr + (size_t)b * 262144, Kb, n0, Kb, lds, acc);
      const int tid = otid(), lane = tid & 63, wv = tid >> 6, wm = wv >> 1, wn = wv & 1, h = lane >> 5;
#pragma unroll
      for (int i = 0; i < 2; ++i) {
        const int m = m0 + wm * 64 + i * 32 + (lane & 31);
#pragma unroll
        for (int g = 0; g < 4; ++g) {
          const int n = n0 + wn * 64 + 8 * g + 4 * h;
          const h4v g0 = *(const h4v*)&G[(size_t)m * 4096 + b * 1024 + n];
          const h4v g1 = *(const h4v*)&G[(size_t)m * 4096 + b * 1024 + n + 32];
#pragma unroll
          for (int e = 0; e < 4; ++e) {
            macc[i][0][4 * g + e] += (float)g0[e] * acc[i][0][4 * g + e];
            macc[i][1][4 * g + e] += (float)g1[e] * acc[i][1][4 * g + e];
          }
        }
      }
    }
    gemm_epilogue(macc, m0, n0, [&](int m, int n, f4v v0, f4v v1) {
      st_h4(&Mg[(size_t)m * DM + n], v0); st_h4(&Mg[(size_t)m * DM + n + 32], v1);
    });
  }
}
DI void phase_resid_gemm(const Params& p, const h16* A, int lda, const h16* W, int K, const float* xres, int bid, int nb, h16* lds) {
  float* out = p.out;
  for (int u = bid; u < 64 * 4; u += nb) {
    const int m0 = (u >> 2) * 256, n0 = (u & 3) * 256;
    f16v acc[4][2]; acc256_zero(acc);
    gemm256_main<false>(A, lda, nullptr, m0, W, K, n0, K, lds, acc);
    gemm256_epilogue(acc, m0, n0, [&](int m, int n, f4v v0, f4v v1) {
      const f4v x0 = *(const f4v*)&xres[(size_t)m * DM + n], x1 = *(const f4v*)&xres[(size_t)m * DM + n + 32];
      *(f4v*)&out[(size_t)m * DM + n] = ALPHA * x0 + v0;
      *(f4v*)&out[(size_t)m * DM + n + 32] = ALPHA * x1 + v1;
    });
  }
}
DI void phase_ffn1_dense(const Params& p, int bid, int nb, h16* lds) {
  unsigned char* ws = p.ws;
  const h16* x16 = (const h16*)(ws + OFF_X16);
  const h16* w13 = (const h16*)(ws + OFF_WFF);
  h16* H = (h16*)(ws + OFF_H);
  for (int u = bid; u < 64 * 22; u += nb) {
    const int m0 = (u / 22) * 256, n0 = (u % 22) * 256;
    f16v acc[4][2]; acc256_zero(acc);
    gemm256_main<false>(x16, DM, nullptr, m0, w13, 1024, n0, 1024, lds, acc);
    gemm256_epilogue(acc, m0, n0, [&](int m, int n, f4v v0, f4v v1) {
      f4v hq;
#pragma unroll
      for (int i = 0; i < 4; ++i) hq[i] = silu_(v0[i]) * v1[i];
      st_h4(&H[(size_t)m * 2816 + (n >> 6) * 32 + (n & 31)], hq);
    });
  }
}
DI void moe_prefix(const int* cnt, int (&pstart)[9]) {
  int s = 0;
#pragma unroll
  for (int e = 0; e < 8; ++e) { pstart[e] = s; s += (cnt[e] + 255) & ~255; }
  pstart[8] = s;
}
DI void phase_ffn1_moe(const Params& p, int bid, int nb, h16* lds) {
  unsigned char* ws = p.ws;
  const h16* x16 = (const h16*)(ws + OFF_X16);
  const h16* w13 = (const h16*)(ws + OFF_WFF);
  h16* H = (h16*)(ws + OFF_H);
  const int* st = (const int*)(ws + MOE_ST);
  int ps[9]; moe_prefix((const int*)(ws + MOE_CNT), ps);
  const int ntl = (ps[8] >> 8) * 11;
  for (int u = bid; u < ntl; u += nb) {
    const int mt = u / 11, m0 = mt * 256, n0 = (u % 11) * 256;
    int e = 0;
#pragma unroll
    for (int i = 1; i < 8; ++i) if (m0 >= ps[i]) e = i;
    f16v acc[4][2]; acc256_zero(acc);
    gemm256_main<true>(x16, DM, st, m0, w13 + (size_t)e * 2816 * 1024, 1024, n0, 1024, lds, acc);
    gemm256_epilogue(acc, m0, n0, [&](int m, int n, f4v v0, f4v v1) {
      f4v hq;
#pragma unroll
      for (int i = 0; i < 4; ++i) hq[i] = silu_(v0[i]) * v1[i];
      st_h4(&H[(size_t)m * 1408 + (n >> 6) * 32 + (n & 31)], hq);
    });
  }
}
DI void phase_ffn2_moe(const Params& p, int bid, int nb, h16* lds) {
  unsigned char* ws = p.ws;
  const h16* H = (const h16*)(ws + OFF_H);
  const h16* w2 = (const h16*)(ws + OFF_WFF) + (size_t)8 * 2816 * 1024;
  h16* YB = (h16*)(ws + OFF_YB);
  const float* sg = (const float*)(ws + MOE_SG);
  int ps[9]; moe_prefix((const int*)(ws + MOE_CNT), ps);
  const int ntl = (ps[8] >> 8) * 4;
  for (int u = bid; u < ntl; u += nb) {
    const int mt = u >> 2, m0 = mt * 256, n0 = (u & 3) * 256;
    int e = 0;
#pragma unroll
    for (int i = 1; i < 8; ++i) if (m0 >= ps[i]) e = i;
    f16v acc[4][2]; acc256_zero(acc);
    gemm256_main<false>(H, 1408, nullptr, m0, w2 + (size_t)e * 1024 * 1408, 1408, n0, 1408, lds, acc);
    gemm256_epilogue(acc, m0, n0, [&](int m, int n, f4v v0, f4v v1) {
      const float g = sg[m];
      st_h4(&YB[(size_t)m * DM + n], g * v0); st_h4(&YB[(size_t)m * DM + n + 32], g * v1);
    });
  }
}

DI void phase_ln(const Params& p, int l, int which, int bid, int nb) {
  asm volatile("" : "+v"(bid));
  unsigned char* ws = p.ws;
  const bool moe = (l & 1);
  const bool moe_in = moe && which == 2;
  const bool router = moe && which == 1;
  const float* lw = (which == 1 ? p.ln1_w : p.ln2_w) + l * DM;
  const float* lb = (which == 1 ? p.ln1_b : p.ln2_b) + l * DM;
  float* out = p.out;
  h16* x16 = (h16*)(ws + OFF_X16);
  const int tid_ = otid(); const int lane = tid_ & 63, wv = tid_ >> 6;
  for (int row = bid * 4 + wv; row < SEQ; row += nb * 4) {
    float v[16];
#pragma unroll
    for (int i = 0; i < 4; ++i) {
      const f4v t = *(const f4v*)&out[(size_t)row * DM + 256 * i + lane * 4];
      v[4 * i] = t[0]; v[4 * i + 1] = t[1]; v[4 * i + 2] = t[2]; v[4 * i + 3] = t[3];
    }
    if (moe_in) {
      const int* ts = (const int*)(ws + MOE_TS);
      const h16* YB = (const h16*)(ws + OFF_YB);
      const int s0 = ts[row * 2], s1 = ts[row * 2 + 1];
#pragma unroll
      for (int i = 0; i < 4; ++i) {
        const h4v a = *(const h4v*)&YB[(size_t)s0 * DM + 256 * i + lane * 4];
        const h4v b = *(const h4v*)&YB[(size_t)s1 * DM + 256 * i + lane * 4];
#pragma unroll
        for (int e = 0; e < 4; ++e) v[4 * i + e] = ALPHA * v[4 * i + e] + ((float)a[e] + (float)b[e]);
      }
    }
    float s = 0.f;
#pragma unroll
    for (int i = 0; i < 16; ++i) s += v[i];
    const float mu = wave_sum(s) * (1.f / 1024.f);
    float vs = 0.f;
#pragma unroll
    for (int i = 0; i < 16; ++i) { const float d = v[i] - mu; vs += d * d; }
    const float rstd = rsqrtf(wave_sum(vs) * (1.f / 1024.f) + 1e-5f);
#pragma unroll
    for (int i = 0; i < 4; ++i) {
      const int c = 256 * i + lane * 4;
      const f4v w4 = *(const f4v*)&lw[c], b4 = *(const f4v*)&lb[c];
      f4v y;
#pragma unroll
      for (int e = 0; e < 4; ++e) { y[e] = (v[4 * i + e] - mu) * rstd * w4[e] + b4[e]; v[4 * i + e] = y[e]; }
      *(f4v*)&out[(size_t)row * DM + c] = y;
      st_h4(&x16[(size_t)row * DM + c], y);
    }
    if (router) {
      const float* rw = p.moe_router + (size_t)(l >> 1) * DM * 8;
      float lg[8];
#pragma unroll
      for (int e = 0; e < 8; ++e) lg[e] = 0.f;
#pragma unroll
      for (int i = 0; i < 4; ++i)
#pragma unroll
        for (int k = 0; k < 4; ++k) {
          const int c = 256 * i + lane * 4 + k;
          const f4v r0 = *(const f4v*)&rw[(size_t)c * 8], r1 = *(const f4v*)&rw[(size_t)c * 8 + 4];
          const float xv = v[4 * i + k];
#pragma unroll
          for (int e = 0; e < 4; ++e) { lg[e] += xv * r0[e]; lg[4 + e] += xv * r1[e]; }
        }
#pragma unroll
      for (int e = 0; e < 8; ++e) lg[e] = wave_sum(lg[e]);
      if (lane == 0) {
        int i1 = 0; float b1 = lg[0];
#pragma unroll
        for (int e = 1; e < 8; ++e) if (lg[e] > b1) { b1 = lg[e]; i1 = e; }
        int i2 = -1; float b2 = -3.4e38f;
#pragma unroll
        for (int e = 0; e < 8; ++e) if (e != i1 && lg[e] > b2) { b2 = lg[e]; i2 = e; }
        const float g1 = 1.f / (1.f + __expf(b2 - b1)), g2 = 1.f - g1;
        int* cnt = (int*)(ws + MOE_CNT);
        int* te = (int*)(ws + MOE_TE); int* tp = (int*)(ws + MOE_TP); float* tg = (float*)(ws + MOE_TG);
        te[row * 2] = i1; te[row * 2 + 1] = i2;
        tp[row * 2] = atomicAdd(&cnt[i1], 1); tp[row * 2 + 1] = atomicAdd(&cnt[i2], 1);
        tg[row * 2] = g1; tg[row * 2 + 1] = g2;
      }
    }
  }
}
DI void phase_assign(const Params& p, int bid, int nb) {
  asm volatile("" : "+v"(bid));
  unsigned char* ws = p.ws;
  int ps[9]; moe_prefix((const int*)(ws + MOE_CNT), ps);
  const int* te = (const int*)(ws + MOE_TE); const int* tp = (const int*)(ws + MOE_TP); const float* tg = (const float*)(ws + MOE_TG);
  int* ts = (int*)(ws + MOE_TS); int* st = (int*)(ws + MOE_ST); float* sg = (float*)(ws + MOE_SG);
  #pragma unroll 1
  for (int i = bid * 256 + otid(); i < 32768; i += nb * 256) {
    const int e = te[i];
    int base = 0;
#pragma unroll
    for (int k = 0; k < 8; ++k) if (e == k) base = ps[k];
    const int slot = base + tp[i];
    ts[i] = slot; st[slot] = i >> 1; sg[slot] = tg[i];
  }
}


#define XB_TMO      128
#define XB_XCNT(j)  (256  + 64 * (j))
#define XB_XSUB(j)  (1280 + 64 * (j))
#define XB_XGEN(j)  (2304 + 64 * (j))
#define XB_TOP      3328
#define XB_TOPGEN   3392
#define XCD_BAR_WORDS 3456
#define XB_SPIN_CAP (1u << 22)
#define LAS __attribute__((address_space(3)))
DI unsigned xb_ld(unsigned* p) { return __hip_atomic_load(p, __ATOMIC_RELAXED, __HIP_MEMORY_SCOPE_AGENT); }
DI unsigned xb_add(unsigned* p, unsigned v) { return __hip_atomic_fetch_add(p, v, __ATOMIC_RELAXED, __HIP_MEMORY_SCOPE_AGENT); }
DI unsigned xb_xcc_id() { return (unsigned)__builtin_amdgcn_s_getreg((3 << 11) | 20) & 0xFu; }
#define XB_SPIN(cond, bar) do { unsigned _sp = 0; while (cond) { __builtin_amdgcn_s_sleep(1); \
    if ((++_sp & 255u) == 0u) { if (xb_ld(&(bar)[XB_TMO])) break; if (_sp > XB_SPIN_CAP) { atomicAdd(&(bar)[XB_TMO], 1u); break; } } } } while (0)
struct XcdBarrier { unsigned* bar; unsigned x; volatile LAS unsigned* st; };
DI XcdBarrier xcd_barrier_post(unsigned* bar, volatile LAS unsigned* st) {
  XcdBarrier b; b.bar = bar; b.x = xb_xcc_id(); b.st = st;
  if (threadIdx.x == 0) (void)xb_add(&bar[XB_XCNT(b.x)], 1u);
  return b;
}
DI void xcd_barrier_complete(unsigned* bar, unsigned x, unsigned& nloc, unsigned& nx) {
  const unsigned G = gridDim.x * gridDim.y * gridDim.z;
  unsigned sum, cnt, mine, sp = 0u;
  for (;;) {
    sum = 0u; cnt = 0u; mine = 0u;
#pragma unroll
    for (unsigned j = 0; j < 16; ++j) { const unsigned c = xb_ld(&bar[XB_XCNT(j)]); sum += c; cnt += (c > 0u) ? 1u : 0u; mine = (j == x) ? c : mine; }
    if (sum == G) break;
    __builtin_amdgcn_s_sleep(1);
    if ((++sp & 255u) == 0u) { if (xb_ld(&bar[XB_TMO])) break; if (sp > XB_SPIN_CAP) { atomicAdd(&bar[XB_TMO], 1u); break; } }
  }
  nloc = mine > 0u ? mine : 1u; nx = cnt > 0u ? cnt : 1u;
}
DI void xcd_barrier(const XcdBarrier& b) {
  asm volatile("s_waitcnt vmcnt(0)" ::: "memory");
  __syncthreads();
  if (threadIdx.x == 0) {
    unsigned* bar = b.bar;
    __builtin_amdgcn_s_waitcnt(0);
    unsigned nloc = b.st[0], nx = b.st[1];
    if (nloc == 0u) { xcd_barrier_complete(bar, b.x, nloc, nx); b.st[0] = nloc; b.st[1] = nx; }
    const unsigned old = xb_add(&bar[XB_XSUB(b.x)], 1u);
    const unsigned gen = old / nloc;
    if (old + 1u == (gen + 1u) * nloc) {
      __builtin_amdgcn_fence(__ATOMIC_RELEASE, "agent");
      asm volatile("s_waitcnt vmcnt(0)" ::: "memory");
      const unsigned og = xb_add(&bar[XB_TOP], 1u);
      const unsigned tg = og / nx;
      if (og + 1u == (tg + 1u) * nx) xb_add(&bar[XB_TOPGEN], 1u);
      else XB_SPIN(xb_ld(&bar[XB_TOPGEN]) == tg, bar);
      __builtin_amdgcn_fence(__ATOMIC_ACQUIRE, "agent");
      xb_add(&bar[XB_XGEN(b.x)], 1u);
      asm volatile("s_waitcnt vmcnt(0)" ::: "memory");
    } else {
      XB_SPIN(xb_ld(&bar[XB_XGEN(b.x)]) == gen, bar);
      __builtin_amdgcn_fence(__ATOMIC_ACQUIRE, "agent");
      asm volatile("s_waitcnt vmcnt(0)" ::: "memory");
    }
  }
  __syncthreads();
}

extern __shared__ __attribute__((aligned(16))) unsigned char smem_dyn[];
__global__ void __launch_bounds__(512) fwd_megakernel(Params p) {
  cg::grid_group grid = cg::this_grid();
  unsigned char* smem = smem_dyn;
  const int half = threadIdx.x >> 8;
  unsigned char* smem_half = smem_dyn + half * HALF_LDS;
  h16* lds = (h16*)smem;
  h16* ldh = (h16*)smem_half;
  const int bid = blockIdx.x, nb = gridDim.x;
  const int vb = bid * 2 + half, vnb = nb * 2;
  unsigned char* ws = p.ws;
  __shared__ u4v xb_words;
  if (threadIdx.x == 0) xb_words = (u4v){0u, 0u, 0u, 0u};
  __syncthreads();
  XcdBarrier xb = xcd_barrier_post((unsigned*)(ws + OFF_BAR), (volatile LAS unsigned*)&xb_words);

  phase_init(p, vb, vnb);
  phase_convert_range(p, 0, 0, 2560, vb, vnb, ldh);
  grid.sync();
  for (int l = 0; l < 4; ++l) {
    phase_p1(p, l, bid, nb, vb, vnb, smem, smem_half);
    xcd_barrier(xb);
    phase_m1(p, l, vb, vnb, ldh);
    xcd_barrier(xb);
    phase_m2(p, l, vb, vnb, ldh);
    xcd_barrier(xb);
    phase_m3(p, l, vb, vnb, ldh);
    xcd_barrier(xb);
    phase_gates(p, bid, nb, lds);
    xcd_barrier(xb);
    phase_merge(p, vb, vnb, ldh);
    xcd_barrier(xb);
    phase_resid_gemm(p, (const h16*)(ws + OFF_MERGED), DM, (const h16*)(ws + OFF_WOUT), 1024, (l == 0) ? p.x : p.out, bid, nb, lds);
    xcd_barrier(xb);
    phase_ln(p, l, 1, vb, vnb);
    xcd_barrier(xb);
    if (l & 1) {
      phase_assign(p, vb, vnb);
      xcd_barrier(xb);
      phase_ffn1_moe(p, bid, nb, lds);
      xcd_barrier(xb);
      phase_ffn2_moe(p, bid, nb, lds);
      xcd_barrier(xb);
    } else {
      phase_ffn1_dense(p, bid, nb, lds);
      xcd_barrier(xb);
      phase_resid_gemm(p, (const h16*)(ws + OFF_H), 2816, (const h16*)(ws + OFF_WFF) + (size_t)5632 * 1024, 2816, p.out, bid, nb, lds);
      xcd_barrier(xb);
    }
    phase_ln(p, l, 2, vb, vnb);
    if (l + 1 < 4) xcd_barrier(xb);
  }
}

extern "C" void kernel_launch(void* const* d_in, const int* in_sizes, int n_in, void* d_out, int out_size, void* d_ws, size_t ws_size, hipStream_t stream) {
  static int grid_blocks = 0;
  if (!grid_blocks) {
    int dev = 0, cus = 0, per_cu = 0;
    hipGetDevice(&dev);
    hipDeviceGetAttribute(&cus, hipDeviceAttributeMultiprocessorCount, dev);
    hipFuncSetAttribute((const void*)fwd_megakernel, hipFuncAttributeMaxDynamicSharedMemorySize, LDS_BYTES);
    hipOccupancyMaxActiveBlocksPerMultiprocessor(&per_cu, fwd_megakernel, 512, LDS_BYTES);
    if (per_cu > 1) per_cu = 1;
    if (per_cu < 1) per_cu = 1;
    grid_blocks = cus * per_cu;
    if (ws_size < WS_END) fprintf(stderr, "workspace too small: %zu < %zu\n", ws_size, (size_t)WS_END);
  }
  Params p{};
  const float* const* in = (const float* const*)d_in;
  p.x = in[0]; p.w_in = in[1]; p.a_gate_bias = in[2]; p.a_norm_w = in[3]; p.c_conv_w = in[4]; p.c_a_log = in[5]; p.c_dt_bias = in[6];
  p.c_norm_w = in[7]; p.d_sink = in[8]; p.w_br_a = in[9]; p.w_br_b = in[10]; p.w_br_c = in[11]; p.w_br_d = in[12]; p.w_out = in[13];
  p.ln1_w = in[14]; p.ln1_b = in[15]; p.ln2_w = in[16]; p.ln2_b = in[17]; p.ffn_w1 = in[18]; p.ffn_w3 = in[19]; p.ffn_w2 = in[20];
  p.moe_router = in[21]; p.moe_w1 = in[22]; p.moe_w3 = in[23]; p.moe_w2 = in[24];
  p.out = (float*)d_out; p.ws = (unsigned char*)d_ws;
  void* args[] = {&p};
  hipMemsetAsync((unsigned char*)d_ws + OFF_BAR, 0, XCD_BAR_WORDS * 4, stream);
  hipError_t e = hipLaunchCooperativeKernel((void*)fwd_megakernel, dim3(grid_blocks), dim3(512), args, LDS_BYTES, stream);
  if (e != hipSuccess) fprintf(stderr, "cooperative launch failed: %s (grid %d)\n", hipGetErrorString(e), grid_blocks);
}
```

```cpp
#include <hip/hip_runtime.h>
#include <hip/hip_cooperative_groups.h>
#include <cstdio>
namespace cg = cooperative_groups;

typedef _Float16 h16;
typedef h16 h8v __attribute__((ext_vector_type(8)));
typedef h16 h4v __attribute__((ext_vector_type(4)));
typedef float f4v __attribute__((ext_vector_type(4)));
typedef float f16v __attribute__((ext_vector_type(16)));
typedef unsigned int u4v __attribute__((ext_vector_type(4)));
#define DI __device__ __forceinline__

constexpr int SEQ = 16384, DM = 1024, NIN = 9248, NSM = 5120;
constexpr int LDH = 72;
constexpr float ALPHA = 1.6817928305074290f;
constexpr int NSLOT = 34816;
constexpr int HALF_LDS = 58368;
constexpr int LDS_BYTES = 147456;
constexpr int MLD = 68;

constexpr size_t OFF_X16 = 0;
constexpr size_t OFF_WSM = OFF_X16 + (size_t)SEQ * DM * 2;
constexpr size_t OFF_WG = OFF_WSM + (size_t)NSM * 1024 * 2;
constexpr size_t OFF_WBR = OFF_WG + (size_t)4096 * 1024 * 2;
constexpr size_t OFF_WOUT = OFF_WBR + (size_t)1280 * 1024 * 2;
constexpr size_t OFF_WFF = OFF_WOUT + (size_t)1024 * 1024 * 2;
constexpr size_t OFF_PS = OFF_WFF + (size_t)69206016;
constexpr size_t OFF_PSCAL = OFF_PS + (size_t)SEQ * NSM * 2;
constexpr size_t OFF_Y = OFF_PSCAL + (size_t)SEQ * 32 * 4;
constexpr size_t OFF_MERGED = OFF_Y + (size_t)SEQ * 1280 * 2;
constexpr size_t OFF_ROPE = OFF_MERGED + (size_t)SEQ * DM * 2;
constexpr size_t OFF_SCA = OFF_ROPE + (size_t)SEQ * 32 * 4 * 2;
constexpr size_t OFF_SCAS = OFF_SCA + (size_t)2048 * 4160 * 4;
constexpr size_t OFF_CQKV = OFF_SCAS + (size_t)2048 * 4 * 4;
constexpr size_t OFF_CU = OFF_CQKV + (size_t)SEQ * 768 * 2;
constexpr size_t OFF_CW = OFF_CU + (size_t)2048 * 4096 * 4;
constexpr size_t OFF_CKD = OFF_CW + (size_t)2048 * 4096 * 2;
constexpr size_t OFF_CDL = OFF_CKD + (size_t)2048 * 4096 * 2;
constexpr size_t OFF_CS = OFF_CDL + (size_t)2048 * 4;
constexpr size_t OFF_CVN = OFF_CS + (size_t)2048 * 4096 * 2;
constexpr size_t OFF_OB = OFF_CVN + (size_t)2048 * 4096 * 2;
constexpr size_t OFF_MLB = OFF_OB + (size_t)3 * SEQ * 256 * 2;
constexpr size_t OFF_MOE = OFF_MLB + (size_t)3 * SEQ * 4 * 2 * 4;
constexpr size_t MOE_CNT = OFF_MOE;
constexpr size_t MOE_TE = MOE_CNT + 256;
constexpr size_t MOE_TP = MOE_TE + 32768 * 4;
constexpr size_t MOE_TG = MOE_TP + 32768 * 4;
constexpr size_t MOE_TS = MOE_TG + 32768 * 4;
constexpr size_t MOE_ST = MOE_TS + 32768 * 4;
constexpr size_t MOE_SG = MOE_ST + (size_t)NSLOT * 4;
constexpr size_t OFF_BAR = (MOE_SG + (size_t)NSLOT * 4 + 255) & ~(size_t)255;
constexpr size_t WS_END = OFF_BAR + 16384;
constexpr size_t OFF_GATES = OFF_PS;
constexpr size_t OFF_H = OFF_PS;
constexpr size_t OFF_YB = OFF_Y;

struct Params {
  const float* x; const float* w_in; const float* a_gate_bias; const float* a_norm_w; const float* c_conv_w;
  const float* c_a_log; const float* c_dt_bias; const float* c_norm_w; const float* d_sink;
  const float* w_br_a; const float* w_br_b; const float* w_br_c; const float* w_br_d; const float* w_out;
  const float* ln1_w; const float* ln1_b; const float* ln2_w; const float* ln2_b;
  const float* ffn_w1; const float* ffn_w3; const float* ffn_w2;
  const float* moe_router; const float* moe_w1; const float* moe_w3; const float* moe_w2;
  float* out; unsigned char* ws;
};

DI int otid() { int t = threadIdx.x & 255; asm volatile("" : "+v"(t)); return t; }
DI int otid512() { int t = threadIdx.x; asm volatile("" : "+v"(t)); return t; }
DI float sigmoid_(float x) { return 1.f / (1.f + __expf(-x)); }
DI float silu_(float x) { return x / (1.f + __expf(-x)); }
DI float softplus_(float x) { return x > 20.f ? x : log1pf(__expf(x)); }
DI float logsigmoid_(float x) { return fminf(x, 0.f) - log1pf(__expf(-fabsf(x))); }
DI f4v mfma16(h8v a, h8v b, f4v c) { return __builtin_amdgcn_mfma_f32_16x16x32_f16(a, b, c, 0, 0, 0); }
DI f16v mfma32(h8v a, h8v b, f16v c) { return __builtin_amdgcn_mfma_f32_32x32x16_f16(a, b, c, 0, 0, 0); }
DI float wave_incl_sum(float v, int lane) {
#pragma unroll
  for (int o = 1; o < 64; o <<= 1) { float t = __shfl_up(v, o); if (lane >= o) v += t; }
  return v;
}
DI float wave_incl_max(float v, int lane) {
#pragma unroll
  for (int o = 1; o < 64; o <<= 1) { float t = __shfl_up(v, o); if (lane >= o) v = fmaxf(v, t); }
  return v;
}
DI float wave_max(float v) {
#pragma unroll
  for (int o = 32; o >= 1; o >>= 1) v = fmaxf(v, __shfl_xor(v, o));
  return v;
}
DI float wave_sum(float v) {
#pragma unroll
  for (int o = 32; o >= 1; o >>= 1) v += __shfl_xor(v, o);
  return v;
}
DI float grp16_sum(float v) { v += __shfl_xor(v, 1); v += __shfl_xor(v, 2); v += __shfl_xor(v, 4); v += __shfl_xor(v, 8); return v; }
DI float grp16_max(float v) { v = fmaxf(v, __shfl_xor(v, 1)); v = fmaxf(v, __shfl_xor(v, 2)); v = fmaxf(v, __shfl_xor(v, 4)); v = fmaxf(v, __shfl_xor(v, 8)); return v; }

DI void mm64(const h16* A, const h16* B, f4v (&acc)[4], int w, int lane) {
  const int r = lane & 15, q = lane >> 4;
#pragma unroll
  for (int s = 0; s < 2; ++s) {
    h8v a = *(const h8v*)&A[(16 * w + r) * LDH + 32 * s + 8 * q];
#pragma unroll
    for (int nt = 0; nt < 4; ++nt) {
      h8v b = *(const h8v*)&B[(16 * nt + r) * LDH + 32 * s + 8 * q];
      acc[nt] = mfma16(a, b, acc[nt]);
    }
  }
}
DI h8v perm_frag(const h16* img, int row, int s, int q) {
  h4v lo = *(const h4v*)&img[row * LDH + 32 * s + 4 * q];
  h4v hi = *(const h4v*)&img[row * LDH + 32 * s + 16 + 4 * q];
  return __builtin_shufflevector(lo, hi, 0, 1, 2, 3, 4, 5, 6, 7);
}
DI h8v pack8(f4v a, f4v b) {
  h8v r;
  r[0] = (h16)a[0]; r[1] = (h16)a[1]; r[2] = (h16)a[2]; r[3] = (h16)a[3];
  r[4] = (h16)b[0]; r[5] = (h16)b[1]; r[6] = (h16)b[2]; r[7] = (h16)b[3];
  return r;
}
DI void st_h4(h16* p, f4v v) { h4v o; o[0] = (h16)v[0]; o[1] = (h16)v[1]; o[2] = (h16)v[2]; o[3] = (h16)v[3]; *(h4v*)p = o; }

DI void conv_unit(const float* __restrict__ src, int ld, int col0, int k0, h16* __restrict__ dst, int K, int n0, h16* lds) {
  const int t = otid();
  __syncthreads();
  {
    const int c4 = (t & 7) * 4, kq = t >> 3;
#pragma unroll
    for (int i = 0; i < 2; ++i) {
      const int kk = kq + 32 * i;
      const f4v v = *(const f4v*)&src[(size_t)(k0 + kk) * ld + col0 + c4];
      lds[(c4 + 0) * LDH + kk] = (h16)v[0]; lds[(c4 + 1) * LDH + kk] = (h16)v[1];
      lds[(c4 + 2) * LDH + kk] = (h16)v[2]; lds[(c4 + 3) * LDH + kk] = (h16)v[3];
    }
  }
  __syncthreads();
  {
    const int c = t >> 3, ks = (t & 7) * 8;
    *(u4v*)&dst[(size_t)(n0 + c) * K + k0 + ks] = *(const u4v*)&lds[c * LDH + ks];
  }
}

DI int map_small(int n) {
  if (n < 1024) return 4096 + n;
  if (n < 3328) return 5136 + (n - 1024);
  if (n < 4352) return 7440 + (n - 3328);
  return 8480 + (n - 4352);
}

DI int conv_total(int l) { return 2560 + 2048 + 640 + 512 + ((l & 1) ? 8 * 2112 : (2816 + 1408)); }
DI void conv_one(const Params& p, int l, int u, h16* lds) {
  unsigned char* ws = p.ws;
  const float* win = p.w_in + (size_t)l * 1024 * NIN;
  const int jj = l >> 1;
  const bool moe = (l & 1);
    int v = u;
const float* src; int ld, col0, k0, K, n0; h16* dst;
if (v < 2560) { n0 = (v >> 4) * 32; k0 = (v & 15) * 64; col0 = map_small(n0); src = win; ld = NIN; K = 1024; dst = (h16*)(ws + OFF_WSM); }
else if ((v -= 2560) < 2048) { n0 = (v >> 4) * 32; k0 = (v & 15) * 64; col0 = n0; src = win; ld = NIN; K = 1024; dst = (h16*)(ws + OFF_WG); }
else if ((v -= 2048) < 640) {
  int b, kt;
  if (v < 384) { b = v >> 7; v &= 127; kt = 4; } else { b = 3; v -= 384; kt = 8; }
  n0 = (v / kt) * 32; k0 = (v % kt) * 64; K = kt * 64;
  const float* base = (b == 0) ? p.w_br_a : (b == 1) ? p.w_br_b : (b == 2) ? p.w_br_c : p.w_br_d;
  src = base + (size_t)l * K * 1024; ld = 1024; col0 = n0; dst = (h16*)(ws + OFF_WBR) + (size_t)b * 262144;
}
else if ((v -= 640) < 512) { n0 = (v >> 4) * 32; k0 = (v & 15) * 64; col0 = n0; src = p.w_out + (size_t)l * 1024 * 1024; ld = 1024; K = 1024; dst = (h16*)(ws + OFF_WOUT); }
else {
  v -= 512;
  if (!moe) {
    if (v < 2816) {
      int nbk = v >> 4; k0 = (v & 15) * 64; n0 = nbk * 32; col0 = (nbk >> 1) * 32;
      src = ((nbk & 1) ? p.ffn_w3 : p.ffn_w1) + (size_t)jj * 1024 * 2816; ld = 2816; K = 1024; dst = (h16*)(ws + OFF_WFF);
    } else {
      v -= 2816; n0 = (v / 44) * 32; k0 = (v % 44) * 64; col0 = n0; K = 2816;
      src = p.ffn_w2 + (size_t)jj * 2816 * 1024; ld = 1024; dst = (h16*)(ws + OFF_WFF) + (size_t)5632 * 1024;
    }
  } else {
    int e = v / 2112; v -= e * 2112;
    if (v < 1408) {
      int nbk = v >> 4; k0 = (v & 15) * 64; n0 = nbk * 32; col0 = (nbk >> 1) * 32;
      src = ((nbk & 1) ? p.moe_w3 : p.moe_w1) + (size_t)(jj * 8 + e) * 1024 * 1408; ld = 1408; K = 1024;
      dst = (h16*)(ws + OFF_WFF) + (size_t)e * 2816 * 1024;
    } else {
      v -= 1408; n0 = (v / 22) * 32; k0 = (v % 22) * 64; col0 = n0; K = 1408;
      src = p.moe_w2 + (size_t)(jj * 8 + e) * 1408 * 1024; ld = 1024;
      dst = (h16*)(ws + OFF_WFF) + (size_t)8 * 2816 * 1024 + (size_t)e * 1024 * 1408;
    }
  }
}
conv_unit(src, ld, col0, k0, dst, K, n0, lds);
}
DI void phase_convert_range(const Params& p, int l, int ubegin, int uend, int bid, int nb, h16* lds) {
  asm volatile("" : "+v"(bid));
  for (int u = ubegin + bid; u < uend; u += nb) conv_one(p, l, u, lds);
}
DI void moe_reset(const Params& p, int bid, int nb) {
  unsigned char* ws = p.ws;
  int* cnt = (int*)(ws + MOE_CNT);
  int* st = (int*)(ws + MOE_ST);
  int gs = nb * 256; asm volatile("" : "+s"(gs));
  const int gt = bid * 256 + otid();
  if (gt < 64) cnt[gt] = 0;
#pragma unroll 1
  for (int i = gt; i < NSLOT; i += gs) st[i] = 0;
}
DI void phase_init(const Params& p, int bid, int nb) {
  asm volatile("" : "+v"(bid));
  float* rc = (float*)(p.ws + OFF_ROPE);
  float* rs = rc + (size_t)SEQ * 32;
  const int gt = bid * 256 + otid(), gs = nb * 256;
  #pragma unroll 1
  for (int i = gt; i < SEQ * 32; i += gs) {
    int pos = i >> 5, d = i & 31;
    float inv = (float)pow(10000.0, -(double)d / 32.0);
    float ang = (float)pos * inv;
    rc[i] = cosf(ang); rs[i] = sinf(ang);
  }
  h16* x16 = (h16*)(p.ws + OFF_X16);
  #pragma unroll 1
  for (int i = gt; i < SEQ * DM / 4; i += gs) {
    float4 v = ((const float4*)p.x)[i];
    h4v o; o[0] = (h16)v.x; o[1] = (h16)v.y; o[2] = (h16)v.z; o[3] = (h16)v.w;
    *(h4v*)&x16[(size_t)i * 4] = o;
  }
}

template <bool GATHER>
DI void gemm_main(const h16* __restrict__ A, int lda, const int* __restrict__ idx, int m0,
                  const h16* __restrict__ B, int ldb, int n0, int K, h16* lds, f16v (&acc)[2][2]) {
  const int tid = otid(), lane = tid & 63, wv = tid >> 6, wm = wv >> 1, wn = wv & 1;
  h16* As = lds; h16* Bs = lds + 128 * LDH;
  const int lr = tid >> 1, lc = (tid & 1) * 32;
  const h16* ap = A + (size_t)(GATHER ? idx[m0 + lr] : (m0 + lr)) * lda + lc;
  const h16* bp = B + (size_t)(n0 + lr) * ldb + lc;
  u4v ra[4], rb[4];
#pragma unroll
  for (int i = 0; i < 4; ++i) { ra[i] = *(const u4v*)(ap + 8 * i); rb[i] = *(const u4v*)(bp + 8 * i); }
  const int nk = K >> 6;
  for (int kt = 0; kt < nk; ++kt) {
    __syncthreads();
#pragma unroll
    for (int i = 0; i < 4; ++i) { *(u4v*)&As[lr * LDH + lc + 8 * i] = ra[i]; *(u4v*)&Bs[lr * LDH + lc + 8 * i] = rb[i]; }
    __syncthreads();
    if (kt + 1 < nk) {
      ap += 64; bp += 64;
#pragma unroll
      for (int i = 0; i < 4; ++i) { ra[i] = *(const u4v*)(ap + 8 * i); rb[i] = *(const u4v*)(bp + 8 * i); }
    }
#pragma unroll
    for (int ks = 0; ks < 4; ++ks) {
      h8v af[2], bf[2];
#pragma unroll
      for (int i = 0; i < 2; ++i) af[i] = *(const h8v*)&As[(wm * 64 + i * 32 + (lane & 31)) * LDH + ks * 16 + 8 * (lane >> 5)];
#pragma unroll
      for (int j = 0; j < 2; ++j) bf[j] = *(const h8v*)&Bs[(wn * 64 + j * 32 + (lane & 31)) * LDH + ks * 16 + 8 * (lane >> 5)];
#pragma unroll
      for (int i = 0; i < 2; ++i)
#pragma unroll
        for (int j = 0; j < 2; ++j) acc[i][j] = mfma32(bf[j], af[i], acc[i][j]);
    }
  }
}
DI void acc_zero(f16v (&acc)[2][2]) {
#pragma unroll
  for (int i = 0; i < 2; ++i)
#pragma unroll
    for (int j = 0; j < 2; ++j)
#pragma unroll
      for (int r = 0; r < 16; ++r) acc[i][j][r] = 0.f;
}
template <class Epi>
DI void gemm_epilogue(f16v (&acc)[2][2], int m0, int n0, Epi epi) {
  const int tid = otid(), lane = tid & 63, wv = tid >> 6, wm = wv >> 1, wn = wv & 1, h = lane >> 5;
#pragma unroll
  for (int i = 0; i < 2; ++i) {
    const int m = m0 + wm * 64 + i * 32 + (lane & 31);
#pragma unroll
    for (int g = 0; g < 4; ++g) {
      const int n = n0 + wn * 64 + 8 * g + 4 * h;
      f4v v0 = {acc[i][0][4 * g], acc[i][0][4 * g + 1], acc[i][0][4 * g + 2], acc[i][0][4 * g + 3]};
      f4v v1 = {acc[i][1][4 * g], acc[i][1][4 * g + 1], acc[i][1][4 * g + 2], acc[i][1][4 * g + 3]};
      epi(m, n, v0, v1);
    }
  }
}


template <bool GATHER>
DI void gemm256_main(const h16* __restrict__ A, int lda, const int* __restrict__ idx, int m0,
                     const h16* __restrict__ B, int ldb, int n0, int K, h16* lds, f16v (&acc)[4][2]) {
  const int tid = otid512(), lane = tid & 63, wv = tid >> 6, wm = wv >> 2, wn = wv & 3;
  const int lr = tid >> 1, lc = (tid & 1) * 32;
  unsigned ao = (unsigned)(GATHER ? idx[m0 + lr] : (m0 + lr)) * (unsigned)lda + lc;
  unsigned bo = (unsigned)(n0 + lr) * (unsigned)ldb + lc;
  const h16* ap = A; const h16* bp = B;
#define AP_ (ap + ao)
#define BP_ (bp + bo)
  u4v ra[4], rb[4];
  const int nk = K >> 6;
  __syncthreads();
#pragma unroll
  for (int i = 0; i < 4; ++i) { ra[i] = *(const u4v*)(AP_ + 8 * i); rb[i] = *(const u4v*)(BP_ + 8 * i); }
  ao += 64; bo += 64;
#pragma unroll
  for (int i = 0; i < 4; ++i) { *(u4v*)&lds[lr * LDH + lc + 8 * i] = ra[i]; *(u4v*)&lds[(256 + lr) * LDH + lc + 8 * i] = rb[i]; }
#pragma unroll
  for (int i = 0; i < 4; ++i) { ra[i] = *(const u4v*)(AP_ + 8 * i); rb[i] = *(const u4v*)(BP_ + 8 * i); }
  ao += 64; bo += 64;
  __syncthreads();
  for (int kt = 0; kt < nk; ++kt) {
    const h16* As = lds + (kt & 1) * (512 * LDH);
    const h16* Bs = As + 256 * LDH;
    h16* Wn = lds + ((kt & 1) ^ 1) * (512 * LDH);
    if (kt + 1 < nk) {
#pragma unroll
      for (int i = 0; i < 4; ++i) { *(u4v*)&Wn[lr * LDH + lc + 8 * i] = ra[i]; *(u4v*)&Wn[(256 + lr) * LDH + lc + 8 * i] = rb[i]; }
    }
    if (kt + 2 < nk) {
#pragma unroll
      for (int i = 0; i < 4; ++i) { ra[i] = *(const u4v*)(AP_ + 8 * i); rb[i] = *(const u4v*)(BP_ + 8 * i); }
      ao += 64; bo += 64;
    }
#pragma unroll
    for (int ks = 0; ks < 4; ++ks) {
      h8v af[4], bf[2];
#pragma unroll
      for (int i = 0; i < 4; ++i) af[i] = *(const h8v*)&As[(wm * 128 + i * 32 + (lane & 31)) * LDH + ks * 16 + 8 * (lane >> 5)];
#pragma unroll
      for (int j = 0; j < 2; ++j) bf[j] = *(const h8v*)&Bs[(wn * 64 + j * 32 + (lane & 31)) * LDH + ks * 16 + 8 * (lane >> 5)];
#pragma unroll
      for (int i = 0; i < 4; ++i)
#pragma unroll
        for (int j = 0; j < 2; ++j) acc[i][j] = mfma32(bf[j], af[i], acc[i][j]);
    }
    __syncthreads();
  }
}
DI void acc256_zero(f16v (&acc)[4][2]) {
#pragma unroll
  for (int i = 0; i < 4; ++i)
#pragma unroll
    for (int j = 0; j < 2; ++j)
#pragma unroll
      for (int r = 0; r < 16; ++r) acc[i][j][r] = 0.f;
}
template <class Epi>
DI void gemm256_epilogue(f16v (&acc)[4][2], int m0, int n0, Epi epi) {
  const int tid = otid512(), lane = tid & 63, wv = tid >> 6, wm = wv >> 2, wn = wv & 3, h = lane >> 5;
#pragma unroll
  for (int i = 0; i < 4; ++i) {
    const int m = m0 + wm * 128 + i * 32 + (lane & 31);
#pragma unroll
    for (int g = 0; g < 4; ++g) {
      const int n = n0 + wn * 64 + 8 * g + 4 * h;
      f4v v0 = {acc[i][0][4 * g], acc[i][0][4 * g + 1], acc[i][0][4 * g + 2], acc[i][0][4 * g + 3]};
      f4v v1 = {acc[i][1][4 * g], acc[i][1][4 * g + 1], acc[i][1][4 * g + 2], acc[i][1][4 * g + 3]};
      epi(m, n, v0, v1);
    }
  }
}

DI void scal_unit(const Params& p, int l, int unit, float* lds) {
  const float* xs = (l == 0) ? p.x : p.out;
  const float* win = p.w_in + (size_t)l * 1024 * NIN;
  float* ps = (float*)(p.ws + OFF_PSCAL);
  float* xt = lds;
  float* wt = lds + 64 * 68;
  const int t = otid(), lane = t & 63, w = t >> 6, r = lane & 15, q = lane >> 4;
  f4v acc[2];
  acc[0] = (f4v){0.f, 0.f, 0.f, 0.f}; acc[1] = (f4v){0.f, 0.f, 0.f, 0.f};
  const int t0 = unit * 64;
  for (int k0 = 0; k0 < 1024; k0 += 64) {
    __syncthreads();
#pragma unroll
    for (int i = 0; i < 4; ++i) { int e = t + 256 * i; int rr = e >> 4, c4 = (e & 15) * 4; *(f4v*)&xt[rr * 68 + c4] = *(const f4v*)&xs[(size_t)(t0 + rr) * DM + k0 + c4]; }
#pragma unroll
    for (int i = 0; i < 8; ++i) { int e = t + 256 * i; int kk = e >> 5, c = e & 31; int col = (c < 16) ? (5120 + c) : (8464 + (c - 16)); wt[kk * 32 + c] = win[(size_t)(k0 + kk) * NIN + col]; }
    __syncthreads();
#pragma unroll
    for (int ks = 0; ks < 16; ++ks) {
      const float a = xt[(16 * w + r) * 68 + ks * 4 + q];
      const float b0 = wt[(ks * 4 + q) * 32 + r], b1 = wt[(ks * 4 + q) * 32 + 16 + r];
      acc[0] = __builtin_amdgcn_mfma_f32_16x16x4f32(a, b0, acc[0], 0, 0, 0);
      acc[1] = __builtin_amdgcn_mfma_f32_16x16x4f32(a, b1, acc[1], 0, 0, 0);
    }
  }
#pragma unroll
  for (int nt = 0; nt < 2; ++nt)
#pragma unroll
    for (int rg = 0; rg < 4; ++rg) ps[(size_t)(t0 + 16 * w + 4 * q + rg) * 32 + 16 * nt + r] = acc[nt][rg];
}

DI void phase_p1(const Params& p, int l, int bid, int nb, int vb, int vnb, unsigned char* smem, unsigned char* smem_half) {
  asm volatile("" : "+v"(vb));
  unsigned char* ws = p.ws;
  const h16* x16 = (const h16*)(ws + OFF_X16);
  const h16* wsm = (const h16*)(ws + OFF_WSM);
  h16* ps = (h16*)(ws + OFF_PS);
  const float* rc = (const float*)(ws + OFF_ROPE);
  const float* rs = rc + (size_t)SEQ * 32;
  for (int u = vb; u < 256; u += vnb) scal_unit(p, l, u, (float*)smem_half);
  for (int u = bid; u < 64 * 20; u += nb) {
    const int m0 = (u / 20) * 256, n0 = (u % 20) * 256;
    f16v acc[4][2]; acc256_zero(acc);
    gemm256_main<false>(x16, DM, nullptr, m0, wsm, 1024, n0, 1024, (h16*)smem, acc);
    gemm256_epilogue(acc, m0, n0, [&](int m, int n, f4v v0, f4v v1) {
      const bool rope = (n >= 1024 && n < 2560) || (n >= 4352 && n < 4992);
      if (rope) {
        const int d = n & 31;
        f4v c = *(const f4v*)&rc[(size_t)m * 32 + d], s = *(const f4v*)&rs[(size_t)m * 32 + d];
        f4v o0 = v0 * c - v1 * s, o1 = v1 * c + v0 * s;
        v0 = o0; v1 = o1;
      }
      st_h4(&ps[(size_t)m * NSM + n], v0);
      st_h4(&ps[(size_t)m * NSM + n + 32], v1);
    });
  }
}

DI void img_store_nat(h16* img, int row, int seg, u4v a, u4v b) {
  *(u4v*)&img[row * LDH + 16 * seg] = a; *(u4v*)&img[row * LDH + 16 * seg + 8] = b;
}
DI void img_store_T(h16* img, int row, int seg, u4v a, u4v b) {
  const h16* pa = (const h16*)&a; const h16* pb = (const h16*)&b;
#pragma unroll
  for (int i = 0; i < 8; ++i) { img[(16 * seg + i) * LDH + row] = pa[i]; img[(16 * seg + 8 + i) * LDH + row] = pb[i]; }
}

template <int NKB>
DI void attn_unit(const Params& p, int l, int mode, int grp, int head, int r0, int dil, int i0, int sub_len, int W, h16* lds) {
  unsigned char* ws = p.ws;
  const h16* P = (const h16*)(ws + OFF_PS);
  h16* Qi = lds; h16* Ki = lds + 64 * LDH; h16* Vt = lds + 128 * LDH; h16* Pi = lds + 192 * LDH;
  const int tid = otid(), lane = tid & 63, w = tid >> 6, r = lane & 15, q = lane >> 4;
  const int lrow = tid >> 2, seg = tid & 3;
  int qcol, kcol, vcol;
  if (mode == 0) { qcol = 1024 + grp * 256 + head * 64; kcol = 1792 + grp * 256 + head * 64; vcol = 2560 + grp * 256 + head * 64; }
  else { qcol = 4352 + head * 64; kcol = 4864 + (head >> 2) * 64; vcol = 4992 + (head >> 2) * 64; }
  __syncthreads();
  {
    const size_t pos = (size_t)r0 + (size_t)dil * (i0 + lrow);
    const h16* g = P + pos * NSM + qcol + 16 * seg;
    img_store_nat(Qi, lrow, seg, *(const u4v*)g, *(const u4v*)(g + 8));
  }
  float mrow[4], lsum[4];
  f4v O[4];
  float m_init = -1e30f, l_init = 0.f;
  if (mode == 1) { m_init = p.d_sink[l * 8 + head]; l_init = 1.f; }
#pragma unroll
  for (int i = 0; i < 4; ++i) { mrow[i] = m_init; lsum[i] = l_init; O[i] = (f4v){0.f, 0.f, 0.f, 0.f}; }
  u4v pk0, pk1, pv0, pv1;
#define ATT_PREFETCH(kb_) do { const int j0p_ = i0 - W + 64 * (kb_); const int j0q_ = ((j0p_ >= 0) && (j0p_ < sub_len)) ? j0p_ : i0; \
    const size_t posp_ = (size_t)r0 + (size_t)dil * (j0q_ + lrow);                                                                  \
    const h16* gk_ = P + posp_ * NSM + kcol + 16 * seg; const h16* gv_ = P + posp_ * NSM + vcol + 16 * seg;                           \
    pk0 = *(const u4v*)gk_; pk1 = *(const u4v*)(gk_ + 8); pv0 = *(const u4v*)gv_; pv1 = *(const u4v*)(gv_ + 8); } while (0)
  ATT_PREFETCH(0);
  for (int kb = 0; kb < NKB; ++kb) {
    const int j0 = i0 - W + 64 * kb;
    const bool inr = (j0 >= 0) && (j0 < sub_len);
    __syncthreads();
    img_store_nat(Ki, lrow, seg, pk0, pk1);
    img_store_T(Vt, lrow, seg, pv0, pv1);
    __syncthreads();
    if (kb + 1 < NKB) ATT_PREFETCH(kb + 1);
    f4v S[4];
#pragma unroll
    for (int i = 0; i < 4; ++i) S[i] = (f4v){0.f, 0.f, 0.f, 0.f};
    mm64(Qi, Ki, S, w, lane);
    float mx[4], al[4], rsum[4];
    bool vm[4][4];
#pragma unroll
    for (int rg = 0; rg < 4; ++rg) {
      const int row = 16 * w + 4 * q + rg;
      float m_ = -1e30f;
#pragma unroll
      for (int nt = 0; nt < 4; ++nt) {
        const int key = 16 * nt + r;
        const int delta = row - key + W - 64 * kb;
        const bool ok = inr && (delta >= -W) && (delta <= W);
        vm[nt][rg] = ok;
        float s = S[nt][rg] * 0.125f;
        S[nt][rg] = s;
        if (ok) m_ = fmaxf(m_, s);
      }
      mx[rg] = grp16_max(m_);
    }
#pragma unroll
    for (int rg = 0; rg < 4; ++rg) {
      const float mn = fmaxf(mrow[rg], mx[rg]);
      al[rg] = __expf(mrow[rg] - mn);
      mrow[rg] = mn;
      float rs_ = 0.f;
#pragma unroll
      for (int nt = 0; nt < 4; ++nt) {
        float pv = vm[nt][rg] ? __expf(S[nt][rg] - mn) : 0.f;
        rs_ += pv;
        Pi[(16 * w + 4 * q + rg) * LDH + 16 * nt + r] = (h16)pv;
      }
      rsum[rg] = grp16_sum(rs_);
      lsum[rg] = lsum[rg] * al[rg] + rsum[rg];
    }
#pragma unroll
    for (int et = 0; et < 4; ++et)
#pragma unroll
      for (int rg = 0; rg < 4; ++rg) O[et][rg] *= al[rg];
    __syncthreads();
    mm64(Pi, Vt, O, w, lane);
  }
#pragma unroll
  for (int rg = 0; rg < 4; ++rg) {
    const int row = 16 * w + 4 * q + rg;
    const size_t pos = (size_t)r0 + (size_t)dil * (i0 + row);
    const float inv = 1.f / lsum[rg];
    if (mode == 0) {
      h16* ob = (h16*)(ws + OFF_OB) + ((size_t)grp * SEQ + pos) * 256 + head * 64;
#pragma unroll
      for (int et = 0; et < 4; ++et) ob[16 * et + r] = (h16)(O[et][rg] * inv);
      if (r == 0) {
        float* ml = (float*)(ws + OFF_MLB) + (((size_t)grp * SEQ + pos) * 4 + head) * 2;
        ml[0] = mrow[rg]; ml[1] = lsum[rg];
      }
    } else {
      h16* y = (h16*)(ws + OFF_Y) + pos * 1280 + 768 + head * 64;
#pragma unroll
      for (int et = 0; et < 4; ++et) y[16 * et + r] = (h16)(O[et][rg] * inv);
    }
  }
}

DI void bcombine_unit(const Params& p, int unit) {
  unsigned char* ws = p.ws;
  const int gi = unit * 256 + otid();
  const int seg = gi & 7, head = (gi >> 3) & 3, pos = gi >> 5;
  const float* ml = (const float*)(ws + OFF_MLB);
  const h16* ob = (const h16*)(ws + OFF_OB);
  float m[3], lv[3];
#pragma unroll
  for (int g = 0; g < 3; ++g) { const float* q = ml + (((size_t)g * SEQ + pos) * 4 + head) * 2; m[g] = q[0]; lv[g] = q[1]; }
  const float M = fmaxf(m[0], fmaxf(m[1], m[2]));
  float wg[3], den = 0.f;
#pragma unroll
  for (int g = 0; g < 3; ++g) { wg[g] = __expf(m[g] - M) * lv[g]; den += wg[g]; }
  const float inv = 1.f / den;
  float o[8];
#pragma unroll
  for (int i = 0; i < 8; ++i) o[i] = 0.f;
#pragma unroll
  for (int g = 0; g < 3; ++g) {
    h8v v = *(const h8v*)&ob[((size_t)g * SEQ + pos) * 256 + head * 64 + seg * 8];
#pragma unroll
    for (int i = 0; i < 8; ++i) o[i] += wg[g] * (float)v[i];
  }
  h8v ov;
#pragma unroll
  for (int i = 0; i < 8; ++i) ov[i] = (h16)(o[i] * inv);
  *(h8v*)((h16*)(ws + OFF_Y) + (size_t)pos * 1280 + 256 + head * 64 + seg * 8) = ov;
}

DI void mlstm_a1_unit(const Params& p, int l, int head, int oc, h16* lds) {
  unsigned char* ws = p.ws;
  const h16* P = (const h16*)(ws + OFF_PS);
  const float* pscal = (const float*)(ws + OFF_PSCAL);
  float* sca = (float*)(ws + OFF_SCA);
  float* scas = (float*)(ws + OFF_SCAS);
  h16* Ks0 = lds; h16* Ks1 = lds + 64 * LDH; h16* Vt = lds + 128 * LDH;
  float* sw = (float*)(lds + 192 * LDH);
  const int tid = otid(), lane = tid & 63, w = tid >> 6, r = lane & 15, q = lane >> 4;
  __syncthreads();
  if (w < 2) {
    const int dir = w;
    const int rr = dir ? 63 - lane : lane;
    const size_t pos = (size_t)oc * 64 + rr;
    const float* gb = p.a_gate_bias + l * 16;
    const float ig = pscal[pos * 32 + dir * 8 + head] + gb[dir * 8 + head];
    const float lf = logsigmoid_(pscal[pos * 32 + dir * 8 + 4 + head] + gb[dir * 8 + 4 + head]);
    const float b = wave_incl_sum(lf, lane);
    const float blast = __shfl(b, 63);
    const float slog = blast - b + ig;
    const float mc = wave_max(slog);
    sw[dir * 64 + rr] = __expf(slog - mc) * 0.125f;
    if (lane == 0) {
      const int nloc = dir ? 255 - oc : oc;
      float* s4 = scas + ((size_t)(dir * 4 + head) * 256 + nloc) * 4;
      s4[0] = blast; s4[1] = mc;
    }
  }
  __syncthreads();
  {
    const int lrow = tid >> 2, seg = tid & 3;
    const size_t pos = (size_t)oc * 64 + lrow;
    const h16* gk = P + pos * NSM + 256 + head * 64 + 16 * seg;
    const h16* gv = P + pos * NSM + 512 + head * 64 + 16 * seg;
    h8v k0 = *(const h8v*)gk, k1 = *(const h8v*)(gk + 8);
    u4v v0 = *(const u4v*)gv, v1 = *(const u4v*)(gv + 8);
    const float s0 = sw[lrow], s1 = sw[64 + lrow];
#pragma unroll
    for (int i = 0; i < 8; ++i) {
      Ks0[(16 * seg + i) * LDH + lrow] = (h16)((float)k0[i] * s0);
      Ks0[(16 * seg + 8 + i) * LDH + lrow] = (h16)((float)k1[i] * s0);
      Ks1[(16 * seg + i) * LDH + lrow] = (h16)((float)k0[i] * s1);
      Ks1[(16 * seg + 8 + i) * LDH + lrow] = (h16)((float)k1[i] * s1);
    }
    img_store_T(Vt, lrow, seg, v0, v1);
  }
  __syncthreads();
#pragma unroll
  for (int dir = 0; dir < 2; ++dir) {
    const h16* Ks = dir ? Ks1 : Ks0;
    const int nloc = dir ? 255 - oc : oc;
    float* dst = sca + ((size_t)(dir * 4 + head) * 256 + nloc) * 4160;
    f4v acc[4];
#pragma unroll
    for (int i = 0; i < 4; ++i) acc[i] = (f4v){0.f, 0.f, 0.f, 0.f};
    mm64(Vt, Ks, acc, w, lane);
#pragma unroll
    for (int nt = 0; nt < 4; ++nt)
#pragma unroll
      for (int rg = 0; rg < 4; ++rg) dst[(16 * w + 4 * q + rg) * 64 + 16 * nt + r] = acc[nt][rg];
    if (w == dir) {
      float s = 0.f;
#pragma unroll 8
      for (int j = 0; j < 64; ++j) s += (float)Ks[lane * LDH + j];
      dst[4096 + lane] = s;
    }
  }
}

DI void mlstm_a2_unit(const Params& p, int unit) {
  unsigned char* ws = p.ws;
  float* sca = (float*)(ws + OFF_SCA);
  float* scas = (float*)(ws + OFF_SCAS);
  const int dh = unit / 17, sl = unit % 17;
  const int e = sl * 256 + otid();
  if (e >= 4160) return;
  float* base = sca + (size_t)dh * 256 * 4160 + e;
  float* s4 = scas + (size_t)dh * 256 * 4;
  float m = 0.f, c = 0.f;
  for (int n0 = 0; n0 < 256; n0 += 16) {
    float cc[16], bls[16], mcs[16];
#pragma unroll
    for (int i = 0; i < 16; ++i) { cc[i] = base[(size_t)(n0 + i) * 4160]; bls[i] = s4[(n0 + i) * 4]; mcs[i] = s4[(n0 + i) * 4 + 1]; }
#pragma unroll
    for (int i = 0; i < 16; ++i) {
      const float bl = bls[i], mc = mcs[i];
      const float mn = fmaxf(bl + m, mc);
      const float dec = __expf(bl + m - mn), gain = __expf(mc - mn);
      base[(size_t)(n0 + i) * 4160] = c;
      if (e == 0) s4[(n0 + i) * 4 + 2] = m;
      c = dec * c + gain * cc[i];
      m = mn;
    }
  }
}

DI void mlstm_a3_unit(const Params& p, int l, int head, int oc, h16* lds) {
  unsigned char* ws = p.ws;
  const h16* P = (const h16*)(ws + OFF_PS);
  const float* pscal = (const float*)(ws + OFF_PSCAL);
  const float* sca = (const float*)(ws + OFF_SCA);
  const float* scas = (const float*)(ws + OFF_SCAS);
  h16* Qi = lds; h16* Ki = lds + 64 * LDH; h16* Vt = lds + 128 * LDH; h16* Wi = lds + 192 * LDH; h16* Ci = lds + 256 * LDH;
  float* fl = (float*)(lds + 320 * LDH);
  float* rowterm = fl;
  float* colterm = fl + 128;
  float* ainter = fl + 256;
  float* emt = fl + 384;
  float* nvec = fl + 512;
  float* qn = fl + 576;
  const int tid = otid(), lane = tid & 63, w = tid >> 6, r = lane & 15, q = lane >> 4;
  const int lrow = tid >> 2, seg = tid & 3;
  __syncthreads();
  {
    const size_t pos = (size_t)oc * 64 + lrow;
    const h16* g = P + pos * NSM + head * 64 + 16 * seg;
    img_store_nat(Qi, lrow, seg, *(const u4v*)g, *(const u4v*)(g + 8));
    img_store_nat(Ki, lrow, seg, *(const u4v*)(g + 256), *(const u4v*)(g + 264));
    img_store_T(Vt, lrow, seg, *(const u4v*)(g + 512), *(const u4v*)(g + 520));
  }
  if (w < 2) {
    const int dir = w;
    const int rr = dir ? 63 - lane : lane;
    const size_t pos = (size_t)oc * 64 + rr;
    const int nloc = dir ? 255 - oc : oc;
    const float* gb = p.a_gate_bias + l * 16;
    const float ig = pscal[pos * 32 + dir * 8 + head] + gb[dir * 8 + head];
    const float lf = logsigmoid_(pscal[pos * 32 + dir * 8 + 4 + head] + gb[dir * 8 + 4 + head]);
    const float b = wave_incl_sum(lf, lane);
    const float u = ig - b;
    const float pm = wave_incl_max(u, lane);
    const float m_intra = b + pm;
    const float mprev = scas[((size_t)(dir * 4 + head) * 256 + nloc) * 4 + 2];
    const float mt = fmaxf(b + mprev, m_intra);
    rowterm[dir * 64 + rr] = b - mt;
    colterm[dir * 64 + rr] = u;
    ainter[dir * 64 + rr] = __expf(b + mprev - mt);
    emt[dir * 64 + rr] = __expf(-mt);
  }
  f4v hacc[4];
#pragma unroll
  for (int i = 0; i < 4; ++i) hacc[i] = (f4v){0.f, 0.f, 0.f, 0.f};
#pragma unroll 1
  for (int dir = 0; dir < 2; ++dir) {
    const int nloc = dir ? 255 - oc : oc;
    const float* src = sca + ((size_t)(dir * 4 + head) * 256 + nloc) * 4160;
    __syncthreads();
    {
      const float4* s4 = (const float4*)(src + lrow * 64 + 16 * seg);
      float4 a = s4[0], b = s4[1], c = s4[2], d = s4[3];
      h8v o0, o1;
      o0[0] = (h16)a.x; o0[1] = (h16)a.y; o0[2] = (h16)a.z; o0[3] = (h16)a.w; o0[4] = (h16)b.x; o0[5] = (h16)b.y; o0[6] = (h16)b.z; o0[7] = (h16)b.w;
      o1[0] = (h16)c.x; o1[1] = (h16)c.y; o1[2] = (h16)c.z; o1[3] = (h16)c.w; o1[4] = (h16)d.x; o1[5] = (h16)d.y; o1[6] = (h16)d.z; o1[7] = (h16)d.w;
      *(h8v*)&Ci[lrow * LDH + 16 * seg] = o0; *(h8v*)&Ci[lrow * LDH + 16 * seg + 8] = o1;
      if (tid < 64) nvec[tid] = src[4096 + tid];
    }
    __syncthreads();
    f4v S[4];
#pragma unroll
    for (int i = 0; i < 4; ++i) S[i] = (f4v){0.f, 0.f, 0.f, 0.f};
    mm64(Qi, Ki, S, w, lane);
    float dint[4];
#pragma unroll
    for (int rg = 0; rg < 4; ++rg) {
      const int t = 16 * w + 4 * q + rg;
      const float rt = rowterm[dir * 64 + t];
      float sum = 0.f;
#pragma unroll
      for (int nt = 0; nt < 4; ++nt) {
        const int s = 16 * nt + r;
        const bool ok = dir ? (s >= t) : (s <= t);
        const float wv = ok ? __expf(rt + colterm[dir * 64 + s]) * S[nt][rg] * 0.125f : 0.f;
        sum += wv;
        Wi[t * LDH + s] = (h16)wv;
      }
      dint[rg] = grp16_sum(sum);
    }
    {
      float s = 0.f;
#pragma unroll
      for (int i = 0; i < 16; ++i) s += (float)Qi[lrow * LDH + 16 * seg + i] * nvec[16 * seg + i];
      s += __shfl_xor(s, 1); s += __shfl_xor(s, 2);
      if (seg == 0) qn[lrow] = s;
    }
    __syncthreads();
    f4v a1[4], a2[4];
#pragma unroll
    for (int i = 0; i < 4; ++i) { a1[i] = (f4v){0.f, 0.f, 0.f, 0.f}; a2[i] = (f4v){0.f, 0.f, 0.f, 0.f}; }
    mm64(Wi, Vt, a1, w, lane);
    mm64(Qi, Ci, a2, w, lane);
#pragma unroll
    for (int rg = 0; rg < 4; ++rg) {
      const int t = 16 * w + 4 * q + rg;
      const float ai = ainter[dir * 64 + t];
      const float den = ai * qn[t] + dint[rg];
      const float dn = 1.f / fmaxf(fabsf(den), emt[dir * 64 + t]);
#pragma unroll
      for (int et = 0; et < 4; ++et) hacc[et][rg] += (a1[et][rg] + ai * a2[et][rg]) * dn;
    }
  }
  const float* nw = p.a_norm_w + l * 256 + head * 64;
#pragma unroll
  for (int rg = 0; rg < 4; ++rg) {
    const int t = 16 * w + 4 * q + rg;
    const size_t pos = (size_t)oc * 64 + t;
    float s = hacc[0][rg] + hacc[1][rg] + hacc[2][rg] + hacc[3][rg];
    const float mu = grp16_sum(s) * (1.f / 64.f);
    float vs = 0.f;
#pragma unroll
    for (int et = 0; et < 4; ++et) { float d = hacc[et][rg] - mu; vs += d * d; }
    const float var = grp16_sum(vs) * (1.f / 64.f);
    const float rstd = rsqrtf(var + 1e-5f);
    h16* y = (h16*)(ws + OFF_Y) + pos * 1280 + head * 64;
    const h16* ao = P + pos * NSM + 768 + head * 64;
#pragma unroll
    for (int et = 0; et < 4; ++et) {
      const int e = 16 * et + r;
      y[e] = (h16)((hacc[et][rg] - mu) * rstd * nw[e] * sigmoid_((float)ao[e]));
    }
  }
}

template <int DIR>
DI void dn_solve4(const float* M, const h16* Ki, const h16* Vi, const float* betal, const float* gcl, int half, int c, int pp, float (&x)[16]) {
  const h16* src = half ? (Ki + c) : (Vi + c);
#pragma unroll
  for (int k = 0; k < 16; ++k) x[k] = 0.f;
#pragma unroll
  for (int il = 0; il < 64; ++il) {
    const int ri = DIR ? 63 - il : il;
    float part = 0.f;
#pragma unroll
    for (int k = 0; k < (il + 3) / 4; ++k) {
      const int jl0 = 4 * k;
      float mv = DIR ? M[ri * MLD + 63 - jl0 - pp] : M[ri * MLD + jl0 + pp];
      if (jl0 + 3 >= il) mv = (jl0 + pp < il) ? mv : 0.f;
      part += mv * x[k];
    }
    part += __shfl_xor(part, 1); part += __shfl_xor(part, 2);
    const float e = half ? __expf(gcl[ri]) : 1.f;
    const float xi = betal[ri] * (float)src[ri * LDH] * e - part;
    if ((il & 3) == pp) x[il >> 2] = xi;
  }
}

DI void dn_c1_unit(const Params& p, int l, int head, int oc, h16* lds) {
  unsigned char* ws = p.ws;
  const h16* P = (const h16*)(ws + OFF_PS);
  const float* pscal = (const float*)(ws + OFF_PSCAL);
  h16* cq = (h16*)(ws + OFF_CQKV);
  h16* Ki = lds; h16* Vi = lds + 64 * LDH;
  float* M = (float*)(lds + 128 * LDH);
  float* betal = M + 64 * MLD;
  float* gcl = betal + 128;
  float* glast = gcl + 128;
  const int tid = otid(), lane = tid & 63, w = tid >> 6, r = lane & 15, q = lane >> 4;
  const int lrow = tid >> 2, seg = tid & 3;
  __syncthreads();
  {
    const int pos = oc * 64 + lrow;
    const float* cw = p.c_conv_w + (size_t)l * 5 * 768;
    float vq[16], vk[16], vv[16];
#pragma unroll
    for (int i = 0; i < 16; ++i) { vq[i] = 0.f; vk[i] = 0.f; vv[i] = 0.f; }
#pragma unroll
    for (int j = 0; j < 5; ++j) {
      const int pp = pos + j - 2;
      if (pp < 0 || pp >= SEQ) continue;
      const h16* g = P + (size_t)pp * NSM + 3328 + head * 64 + 16 * seg;
      h8v q0 = *(const h8v*)g, q1 = *(const h8v*)(g + 8);
      h8v k0 = *(const h8v*)(g + 256), k1 = *(const h8v*)(g + 264);
      h8v v0 = *(const h8v*)(g + 512), v1 = *(const h8v*)(g + 520);
      const float* wq = cw + j * 768 + head * 64 + 16 * seg;
#pragma unroll
      for (int i = 0; i < 8; ++i) {
        vq[i] += wq[i] * (float)q0[i]; vq[8 + i] += wq[8 + i] * (float)q1[i];
        vk[i] += wq[256 + i] * (float)k0[i]; vk[8 + i] += wq[264 + i] * (float)k1[i];
        vv[i] += wq[512 + i] * (float)v0[i]; vv[8 + i] += wq[520 + i] * (float)v1[i];
      }
    }
    float sq = 0.f, sk = 0.f;
#pragma unroll
    for (int i = 0; i < 16; ++i) { vq[i] = silu_(vq[i]); vk[i] = silu_(vk[i]); vv[i] = silu_(vv[i]); sq += vq[i] * vq[i]; sk += vk[i] * vk[i]; }
    sq += __shfl_xor(sq, 1); sq += __shfl_xor(sq, 2);
    sk += __shfl_xor(sk, 1); sk += __shfl_xor(sk, 2);
    const float rq = rsqrtf(sq + 1e-6f) * 0.125f, rk = rsqrtf(sk + 1e-6f);
    h8v oq0, oq1, ok0, ok1, ov0, ov1;
#pragma unroll
    for (int i = 0; i < 8; ++i) {
      oq0[i] = (h16)(vq[i] * rq); oq1[i] = (h16)(vq[8 + i] * rq);
      ok0[i] = (h16)(vk[i] * rk); ok1[i] = (h16)(vk[8 + i] * rk);
      ov0[i] = (h16)vv[i]; ov1[i] = (h16)vv[8 + i];
    }
    h16* o = cq + (size_t)pos * 768 + head * 64 + 16 * seg;
    *(h8v*)o = oq0; *(h8v*)(o + 8) = oq1;
    *(h8v*)(o + 256) = ok0; *(h8v*)(o + 264) = ok1;
    *(h8v*)(o + 512) = ov0; *(h8v*)(o + 520) = ov1;
    *(h8v*)&Ki[lrow * LDH + 16 * seg] = ok0; *(h8v*)&Ki[lrow * LDH + 16 * seg + 8] = ok1;
    *(h8v*)&Vi[lrow * LDH + 16 * seg] = ov0; *(h8v*)&Vi[lrow * LDH + 16 * seg + 8] = ov1;
  }
  if (w < 2) {
    const int dir = w;
    const int rr = dir ? 63 - lane : lane;
    const size_t pos = (size_t)oc * 64 + rr;
    const float beta = sigmoid_(pscal[pos * 32 + 16 + dir * 4 + head]);
    const float g = -__expf(p.c_a_log[l * 8 + dir * 4 + head]) * softplus_(pscal[pos * 32 + 24 + dir * 4 + head] + p.c_dt_bias[l * 8 + dir * 4 + head]);
    const float gc = wave_incl_sum(g, lane);
    const float gl = __shfl(gc, 63);
    betal[dir * 64 + rr] = beta; gcl[dir * 64 + rr] = gc;
    if (lane == 0) {
      glast[dir] = gl;
      const int nloc = dir ? 255 - oc : oc;
      ((float*)(ws + OFF_CDL))[(size_t)(dir * 4 + head) * 256 + nloc] = __expf(gl);
    }
  }
  __syncthreads();
  {
    f4v kk[4];
#pragma unroll
    for (int i = 0; i < 4; ++i) kk[i] = (f4v){0.f, 0.f, 0.f, 0.f};
    mm64(Ki, Ki, kk, w, lane);
#pragma unroll
    for (int nt = 0; nt < 4; ++nt)
#pragma unroll
      for (int rg = 0; rg < 4; ++rg) {
        const int i = 16 * w + 4 * q + rg, j = 16 * nt + r;
        float v = 0.f;
        if (j < i) v = betal[i] * kk[nt][rg] * __expf(gcl[i] - gcl[j]);
        else if (j > i) v = betal[64 + i] * kk[nt][rg] * __expf(gcl[64 + i] - gcl[64 + j]);
        M[i * MLD + j] = v;
      }
  }
  __syncthreads();
  {
    const int c = tid >> 2, pp = tid & 3;
#pragma unroll 1
    for (int dh2 = 0; dh2 < 4; ++dh2) {
      const int dir = dh2 >> 1, half = dh2 & 1;
      const int nloc = dir ? 255 - oc : oc;
      const size_t unit = (size_t)(dir * 4 + head) * 256 + nloc;
      float x[16];
      if (dir == 0) dn_solve4<0>(M, Ki, Vi, betal, gcl, half, c, pp, x);
      else dn_solve4<1>(M, Ki, Vi, betal + 64, gcl + 64, half, c, pp, x);
      if (half == 0) {
        float* ud = (float*)(ws + OFF_CU) + unit * 4096;
        const int slice = c >> 4, el = c & 15;
#pragma unroll
        for (int k = 0; k < 16; ++k) {
          const int il = 4 * k + pp;
          const int rr = dir ? 63 - il : il;
          ud[((slice * 4 + (rr >> 4)) * 64 + el + 16 * ((rr & 15) >> 2)) * 4 + (rr & 3)] = x[k];
        }
      } else {
        h16* wd = (h16*)(ws + OFF_CW) + unit * 4096;
        const int s = c >> 5, lq = (c & 15) >> 2, jjx = (c & 3) + 4 * ((c & 31) >> 4);
#pragma unroll
        for (int k = 0; k < 16; ++k) {
          const int il = 4 * k + pp;
          const int rr = dir ? 63 - il : il;
          wd[(((rr >> 4) * 2 + s) * 64 + (rr & 15) + 16 * lq) * 8 + jjx] = (h16)(-x[k]);
        }
      }
    }
  }
#pragma unroll
  for (int dir = 0; dir < 2; ++dir) {
    const int nloc = dir ? 255 - oc : oc;
    const size_t unit = (size_t)(dir * 4 + head) * 256 + nloc;
    h16* kd = (h16*)(ws + OFF_CKD) + unit * 4096;
    const float gl = glast[dir];
#pragma unroll
    for (int it = 0; it < 4; ++it) {
      const int e = tid + 256 * it;
      const int d = e & 63, rq = e >> 6;
      const int r0 = 4 * rq;
      h4v o;
#pragma unroll
      for (int i = 0; i < 4; ++i) o[i] = (h16)((float)Ki[(r0 + i) * LDH + d] * __expf(gl - gcl[dir * 64 + r0 + i]));
      const int tile = d >> 4, s = r0 >> 5, ln = (d & 15) + 16 * ((r0 & 15) >> 2), j4 = 4 * ((r0 & 31) >> 4);
      *(h4v*)&kd[((tile * 2 + s) * 64 + ln) * 8 + j4] = o;
    }
  }
}

DI void dn_c2_unit(const Params& p, int dh, int w) {
  unsigned char* ws = p.ws;
  const int tid = otid(), lane = tid & 63;
  if (tid >= 64) return;
  const h16* cw = (const h16*)(ws + OFF_CW) + (size_t)dh * 256 * 4096;
  const h16* ckd = (const h16*)(ws + OFF_CKD) + (size_t)dh * 256 * 4096;
  const float* cu = (const float*)(ws + OFF_CU) + (size_t)dh * 256 * 4096;
  const float* cdl = (const float*)(ws + OFF_CDL) + (size_t)dh * 256;
  h16* cs = (h16*)(ws + OFF_CS) + (size_t)dh * 256 * 4096;
  h16* cvn = (h16*)(ws + OFF_CVN) + (size_t)dh * 256 * 4096;
  f4v S[4];
#pragma unroll
  for (int i = 0; i < 4; ++i) S[i] = (f4v){0.f, 0.f, 0.f, 0.f};
  h8v wA[4][2], kA[4][2]; f4v uu[4]; float dl;
#pragma unroll
  for (int t = 0; t < 4; ++t) {
#pragma unroll
    for (int s = 0; s < 2; ++s) {
      wA[t][s] = *(const h8v*)&cw[((t * 2 + s) * 64 + lane) * 8];
      kA[t][s] = *(const h8v*)&ckd[((t * 2 + s) * 64 + lane) * 8];
    }
    uu[t] = *(const f4v*)&cu[((w * 4 + t) * 64 + lane) * 4];
  }
  dl = cdl[0];
  for (int n = 0; n < 256; ++n) {
    h8v wN[4][2], kN[4][2]; f4v uN[4]; float dlN = 0.f;
    const int nn = (n + 1 < 256) ? n + 1 : n;
    {
      const h16* cw1 = cw + (size_t)nn * 4096; const h16* ck1 = ckd + (size_t)nn * 4096; const float* cu1 = cu + (size_t)nn * 4096;
#pragma unroll
      for (int t = 0; t < 4; ++t) {
#pragma unroll
        for (int s = 0; s < 2; ++s) {
          wN[t][s] = *(const h8v*)&cw1[((t * 2 + s) * 64 + lane) * 8];
          kN[t][s] = *(const h8v*)&ck1[((t * 2 + s) * 64 + lane) * 8];
        }
        uN[t] = *(const f4v*)&cu1[((w * 4 + t) * 64 + lane) * 4];
      }
      dlN = cdl[nn];
    }
    h8v Sb[2];
    Sb[0] = pack8(S[0], S[1]); Sb[1] = pack8(S[2], S[3]);
    h16* cs1 = cs + (size_t)n * 4096; h16* cv1 = cvn + (size_t)n * 4096;
    *(h8v*)&cs1[((w * 2 + 0) * 64 + lane) * 8] = Sb[0];
    *(h8v*)&cs1[((w * 2 + 1) * 64 + lane) * 8] = Sb[1];
    f4v vn[4];
#pragma unroll
    for (int t = 0; t < 4; ++t) { vn[t] = uu[t]; vn[t] = mfma16(wA[t][0], Sb[0], vn[t]); vn[t] = mfma16(wA[t][1], Sb[1], vn[t]); }
    h8v Vb[2];
    Vb[0] = pack8(vn[0], vn[1]); Vb[1] = pack8(vn[2], vn[3]);
    *(h8v*)&cv1[((w * 2 + 0) * 64 + lane) * 8] = Vb[0];
    *(h8v*)&cv1[((w * 2 + 1) * 64 + lane) * 8] = Vb[1];
#pragma unroll
    for (int t = 0; t < 4; ++t) { S[t] *= dl; S[t] = mfma16(kA[t][0], Vb[0], S[t]); S[t] = mfma16(kA[t][1], Vb[1], S[t]); }
#pragma unroll
    for (int t = 0; t < 4; ++t) { wA[t][0] = wN[t][0]; wA[t][1] = wN[t][1]; kA[t][0] = kN[t][0]; kA[t][1] = kN[t][1]; uu[t] = uN[t]; }
    dl = dlN;
  }
}

DI void dn_c3_unit(const Params& p, int l, int head, int oc, h16* lds) {
  unsigned char* ws = p.ws;
  const h16* P = (const h16*)(ws + OFF_PS);
  const float* pscal = (const float*)(ws + OFF_PSCAL);
  const h16* cq = (const h16*)(ws + OFF_CQKV);
  h16* Qi = lds; h16* Ki = lds + 64 * LDH;
  h16* AT = lds + 128 * LDH;
  h16* QG = lds + 256 * LDH;
  float* gcl = (float*)(lds + 384 * LDH);
  float* Ol = (float*)lds;
  const int tid = otid(), lane = tid & 63, w = tid >> 6, r = lane & 15, q = lane >> 4;
  const int lrow = tid >> 2, seg = tid & 3;
  __syncthreads();
  {
    const size_t pos = (size_t)oc * 64 + lrow;
    const h16* g = cq + pos * 768 + head * 64 + 16 * seg;
    img_store_nat(Qi, lrow, seg, *(const u4v*)g, *(const u4v*)(g + 8));
    img_store_nat(Ki, lrow, seg, *(const u4v*)(g + 256), *(const u4v*)(g + 264));
  }
  if (w < 2) {
    const int dir = w;
    const int rr = dir ? 63 - lane : lane;
    const size_t pos = (size_t)oc * 64 + rr;
    const float g = -__expf(p.c_a_log[l * 8 + dir * 4 + head]) * softplus_(pscal[pos * 32 + 24 + dir * 4 + head] + p.c_dt_bias[l * 8 + dir * 4 + head]);
    gcl[dir * 64 + rr] = wave_incl_sum(g, lane);
  }
  __syncthreads();
  {
    f4v S[4];
#pragma unroll
    for (int i = 0; i < 4; ++i) S[i] = (f4v){0.f, 0.f, 0.f, 0.f};
    mm64(Qi, Ki, S, w, lane);
#pragma unroll
    for (int dir = 0; dir < 2; ++dir) {
#pragma unroll
      for (int nt = 0; nt < 4; ++nt)
#pragma unroll
        for (int rg = 0; rg < 4; ++rg) {
          const int i = 16 * w + 4 * q + rg, j = 16 * nt + r;
          const bool ok = dir ? (j >= i) : (j <= i);
          const float v = ok ? S[nt][rg] * __expf(gcl[dir * 64 + i] - gcl[dir * 64 + j]) : 0.f;
          AT[(dir * 64 + i) * LDH + j] = (h16)v;
        }
      const float eg = __expf(gcl[dir * 64 + lrow]);
#pragma unroll
      for (int i = 0; i < 16; ++i) QG[(dir * 64 + lrow) * LDH + 16 * seg + i] = (h16)((float)Qi[lrow * LDH + 16 * seg + i] * eg);
    }
  }
  __syncthreads();
  f4v o[4];
#pragma unroll
  for (int i = 0; i < 4; ++i) o[i] = (f4v){0.f, 0.f, 0.f, 0.f};
#pragma unroll
  for (int dir = 0; dir < 2; ++dir) {
    const int nloc = dir ? 255 - oc : oc;
    const size_t unit = (size_t)(dir * 4 + head) * 256 + nloc;
    const h16* cs = (const h16*)(ws + OFF_CS) + unit * 4096;
    const h16* cv = (const h16*)(ws + OFF_CVN) + unit * 4096;
#pragma unroll
    for (int s = 0; s < 2; ++s) {
      const h8v Sb = *(const h8v*)&cs[((w * 2 + s) * 64 + lane) * 8];
      const h8v Vb = *(const h8v*)&cv[((w * 2 + s) * 64 + lane) * 8];
#pragma unroll
      for (int it = 0; it < 4; ++it) {
        o[it] = mfma16(perm_frag(QG + dir * 64 * LDH, 16 * it + r, s, q), Sb, o[it]);
        o[it] = mfma16(perm_frag(AT + dir * 64 * LDH, 16 * it + r, s, q), Vb, o[it]);
      }
    }
  }
  __syncthreads();
#pragma unroll
  for (int it = 0; it < 4; ++it)
#pragma unroll
    for (int rg = 0; rg < 4; ++rg) Ol[(16 * it + 4 * q + rg) * 65 + 16 * w + r] = o[it][rg];
  __syncthreads();
  {
    const size_t pos = (size_t)oc * 64 + lrow;
    float v[16]; float ss = 0.f;
#pragma unroll
    for (int i = 0; i < 16; ++i) { v[i] = Ol[lrow * 65 + 16 * seg + i]; ss += v[i] * v[i]; }
    ss += __shfl_xor(ss, 1); ss += __shfl_xor(ss, 2);
    const float rms = rsqrtf(ss * (1.f / 64.f) + 1e-6f);
    const float* nw = p.c_norm_w + l * 64 + 16 * seg;
    const h16* cg_ = P + pos * NSM + 4096 + head * 64 + 16 * seg;
    h8v g0 = *(const h8v*)cg_, g1 = *(const h8v*)(cg_ + 8);
    h8v o0, o1;
#pragma unroll
    for (int i = 0; i < 8; ++i) {
      o0[i] = (h16)(v[i] * rms * nw[i] * silu_((float)g0[i]));
      o1[i] = (h16)(v[8 + i] * rms * nw[8 + i] * silu_((float)g1[i]));
    }
    h16* y = (h16*)(ws + OFF_Y) + pos * 1280 + 512 + head * 64 + 16 * seg;
    *(h8v*)y = o0; *(h8v*)(y + 8) = o1;
  }
}

DI void phase_m1(const Params& p, int l, int bid, int nb, h16* lds) {
  asm volatile("" : "+v"(bid));
  for (int u = bid; u < 2048; u += nb) {
    if (u < 1024) dn_c1_unit(p, l, u & 3, u >> 2, lds);
    else { const int v = u - 1024; mlstm_a1_unit(p, l, v & 3, v >> 2, lds); }
  }
}
DI void phase_m2(const Params& p, int l, int bid, int nb, h16* lds) {
  asm volatile("" : "+v"(bid));
  const int nA = conv_total(l) - 2560;
  const int nB = (l + 1 < 4) ? 2560 : 0;
  const int total = 32 + 136 + 2048 + 3072 + nA + nB;
  if (l & 1) moe_reset(p, bid, nb);
  const int ustart = (bid < 32) ? bid : bid;
  const int ustep = (bid < 32) ? total : (nb - 32);
  for (int u = ustart; u < total; u += ustep) {
    int v = u;
    if (v >= 5288) { v -= 5288; if (v < nA) conv_one(p, l, 2560 + v, lds); else conv_one(p, l + 1, v - nA, lds); continue; }
    if (v < 32) { dn_c2_unit(p, v >> 2, v & 3); continue; }
    if ((v -= 32) < 136) { mlstm_a2_unit(p, v); continue; }
    if ((v -= 136) < 2048) { attn_unit<5>(p, l, 1, 0, v & 7, 0, 1, (v >> 3) * 64, SEQ, 128, lds); continue; }
    v -= 2048;
    const int grp = v >> 10, x = v & 1023, head = x & 3, tl = x >> 2;
    const int dil = (grp == 0) ? 1 : (grp == 1) ? 4 : 16;
    const int sub = SEQ / dil, tps = sub >> 6;
    const int res = tl / tps, ti = tl % tps;
    attn_unit<3>(p, l, 0, grp, head, res, dil, ti * 64, sub, 64, lds);
  }
}
DI void phase_m3(const Params& p, int l, int bid, int nb, h16* lds) {
  asm volatile("" : "+v"(bid));
  const int total = 1024 + 1024 + 2048;
  for (int u = bid; u < total; u += nb) {
    int v = u;
    if (v < 1024) { mlstm_a3_unit(p, l, v & 3, v >> 2, lds); continue; }
    if ((v -= 1024) < 1024) { dn_c3_unit(p, l, v & 3, v >> 2, lds); continue; }
    bcombine_unit(p, v - 1024);
  }
}

DI void phase_gates(const Params& p, int bid, int nb, h16* lds) {
  unsigned char* ws = p.ws;
  const h16* x16 = (const h16*)(ws + OFF_X16);
  const h16* wg = (const h16*)(ws + OFF_WG);
  h16* G = (h16*)(ws + OFF_GATES);
  for (int u = bid; u < 64 * 16; u += nb) {
    const int m0 = (u >> 4) * 256, n0 = (u & 15) * 256;
    f16v acc[4][2]; acc256_zero(acc);
    gemm256_main<false>(x16, DM, nullptr, m0, wg, 1024, n0, 1024, lds, acc);
    gemm256_epilogue(acc, m0, n0, [&](int m, int n, f4v v0, f4v v1) {
      f4v a, b;
#pragma unroll
      for (int i = 0; i < 4; ++i) { a[i] = sigmoid_(v0[i]); b[i] = sigmoid_(v1[i]); }
      st_h4(&G[(size_t)m * 4096 + n], a); st_h4(&G[(size_t)m * 4096 + n + 32], b);
    });
  }
}
DI void phase_merge(const Params& p, int bid, int nb, h16* lds) {
  asm volatile("" : "+v"(bid));
  unsigned char* ws = p.ws;
  const h16* Y = (const h16*)(ws + OFF_Y);
  const h16* wbr = (const h16*)(ws + OFF_WBR);
  const h16* G = (const h16*)(ws + OFF_GATES);
  h16* Mg = (h16*)(ws + OFF_MERGED);
  for (int u = bid; u < 128 * 8; u += nb) {
    const int m0 = (u >> 3) * 128, n0 = (u & 7) * 128;
    f16v macc[2][2]; acc_zero(macc);
#pragma unroll 1
    for (int b = 0; b < 4; ++b) {
      const int Kb = (b == 3) ? 512 : 256;
      f16v acc[2][2]; acc_zero(acc);
      gemm_main<false>(Y + b * 256, 1280, nullptr, m0, wbr + (size_t)b * 262144, Kb, n0, Kb, lds, acc);
      const int tid = otid(), lane = tid & 63, wv = tid >> 6, wm = wv >> 1, wn = wv & 1, h = lane >> 5;
#pragma unroll
      for (int i = 0; i < 2; ++i) {
        const int m = m0 + wm * 64 + i * 32 + (lane & 31);
#pragma unroll
        for (int g = 0; g < 4; ++g) {
          const int n = n0 + wn * 64 + 8 * g + 4 * h;
          const h4v g0 = *(const h4v*)&G[(size_t)m * 4096 + b * 1024 + n];
          const h4v g1 = *(const h4v*)&G[(size_t)m * 4096 + b * 1024 + n + 32];
#pragma unroll
          for (int e = 0; e < 4; ++e) {
            macc[i][0][4 * g + e] += (float)g0[e] * acc[i][0][4 * g + e];
            macc[i][1][4 * g + e] += (float)g1[e] * acc[i][1][4 * g + e];
          }
        }
      }
    }
    gemm_epilogue(macc, m0, n0, [&](int m, int n, f4v v0, f4v v1) {
      st_h4(&Mg[(size_t)m * DM + n], v0); st_h4(&Mg[(size_t)m * DM + n + 32], v1);
    });
  }
}
DI void phase_resid_gemm(const Params& p, const h16* A, int lda, const h16* W, int K, const float* xres, int bid, int nb, h16* lds) {
  float* out = p.out;
  for (int u = bid; u < 64 * 4; u += nb) {
    const int m0 = (u >> 2) * 256, n0 = (u & 3) * 256;
    f16v acc[4][2]; acc256_zero(acc);
    gemm256_main<false>(A, lda, nullptr, m0, W, K, n0, K, lds, acc);
    gemm256_epilogue(acc, m0, n0, [&](int m, int n, f4v v0, f4v v1) {
      const f4v x0 = *(const f4v*)&xres[(size_t)m * DM + n], x1 = *(const f4v*)&xres[(size_t)m * DM + n + 32];
      *(f4v*)&out[(size_t)m * DM + n] = ALPHA * x0 + v0;
      *(f4v*)&out[(size_t)m * DM + n + 32] = ALPHA * x1 + v1;
    });
  }
}
DI void phase_ffn1_dense(const Params& p, int bid, int nb, h16* lds) {
  unsigned char* ws = p.ws;
  const h16* x16 = (const h16*)(ws + OFF_X16);
  const h16* w13 = (const h16*)(ws + OFF_WFF);
  h16* H = (h16*)(ws + OFF_H);
  for (int u = bid; u < 64 * 22; u += nb) {
    const int m0 = (u / 22) * 256, n0 = (u % 22) * 256;
    f16v acc[4][2]; acc256_zero(acc);
    gemm256_main<false>(x16, DM, nullptr, m0, w13, 1024, n0, 1024, lds, acc);
    gemm256_epilogue(acc, m0, n0, [&](int m, int n, f4v v0, f4v v1) {
      f4v hq;
#pragma unroll
      for (int i = 0; i < 4; ++i) hq[i] = silu_(v0[i]) * v1[i];
      st_h4(&H[(size_t)m * 2816 + (n >> 6) * 32 + (n & 31)], hq);
    });
  }
}
DI void moe_prefix(const int* cnt, int (&pstart)[9]) {
  int s = 0;
#pragma unroll
  for (int e = 0; e < 8; ++e) { pstart[e] = s; s += (cnt[e] + 255) & ~255; }
  pstart[8] = s;
}
DI void phase_ffn1_moe(const Params& p, int bid, int nb, h16* lds) {
  unsigned char* ws = p.ws;
  const h16* x16 = (const h16*)(ws + OFF_X16);
  const h16* w13 = (const h16*)(ws + OFF_WFF);
  h16* H = (h16*)(ws + OFF_H);
  const int* st = (const int*)(ws + MOE_ST);
  int ps[9]; moe_prefix((const int*)(ws + MOE_CNT), ps);
  const int ntl = (ps[8] >> 8) * 11;
  for (int u = bid; u < ntl; u += nb) {
    const int mt = u / 11, m0 = mt * 256, n0 = (u % 11) * 256;
    int e = 0;
#pragma unroll
    for (int i = 1; i < 8; ++i) if (m0 >= ps[i]) e = i;
    f16v acc[4][2]; acc256_zero(acc);
    gemm256_main<true>(x16, DM, st, m0, w13 + (size_t)e * 2816 * 1024, 1024, n0, 1024, lds, acc);
    gemm256_epilogue(acc, m0, n0, [&](int m, int n, f4v v0, f4v v1) {
      f4v hq;
#pragma unroll
      for (int i = 0; i < 4; ++i) hq[i] = silu_(v0[i]) * v1[i];
      st_h4(&H[(size_t)m * 1408 + (n >> 6) * 32 + (n & 31)], hq);
    });
  }
}
DI void phase_ffn2_moe(const Params& p, int bid, int nb, h16* lds) {
  unsigned char* ws = p.ws;
  const h16* H = (const h16*)(ws + OFF_H);
  const h16* w2 = (const h16*)(ws + OFF_WFF) + (size_t)8 * 2816 * 1024;
  h16* YB = (h16*)(ws + OFF_YB);
  const float* sg = (const float*)(ws + MOE_SG);
  int ps[9]; moe_prefix((const int*)(ws + MOE_CNT), ps);
  const int ntl = (ps[8] >> 8) * 4;
  for (int u = bid; u < ntl; u += nb) {
    const int mt = u >> 2, m0 = mt * 256, n0 = (u & 3) * 256;
    int e = 0;
#pragma unroll
    for (int i = 1; i < 8; ++i) if (m0 >= ps[i]) e = i;
    f16v acc[4][2]; acc256_zero(acc);
    gemm256_main<false>(H, 1408, nullptr, m0, w2 + (size_t)e * 1024 * 1408, 1408, n0, 1408, lds, acc);
    gemm256_epilogue(acc, m0, n0, [&](int m, int n, f4v v0, f4v v1) {
      const float g = sg[m];
      st_h4(&YB[(size_t)m * DM + n], g * v0); st_h4(&YB[(size_t)m * DM + n + 32], g * v1);
    });
  }
}

DI void phase_ln(const Params& p, int l, int which, int bid, int nb) {
  asm volatile("" : "+v"(bid));
  unsigned char* ws = p.ws;
  const bool moe = (l & 1);
  const bool moe_in = moe && which == 2;
  const bool router = moe && which == 1;
  const float* lw = (which == 1 ? p.ln1_w : p.ln2_w) + l * DM;
  const float* lb = (which == 1 ? p.ln1_b : p.ln2_b) + l * DM;
  float* out = p.out;
  h16* x16 = (h16*)(ws + OFF_X16);
  const int tid_ = otid(); const int lane = tid_ & 63, wv = tid_ >> 6;
  for (int row = bid * 4 + wv; row < SEQ; row += nb * 4) {
    float v[16];
#pragma unroll
    for (int i = 0; i < 4; ++i) {
      const f4v t = *(const f4v*)&out[(size_t)row * DM + 256 * i + lane * 4];
      v[4 * i] = t[0]; v[4 * i + 1] = t[1]; v[4 * i + 2] = t[2]; v[4 * i + 3] = t[3];
    }
    if (moe_in) {
      const int* ts = (const int*)(ws + MOE_TS);
      const h16* YB = (const h16*)(ws + OFF_YB);
      const int s0 = ts[row * 2], s1 = ts[row * 2 + 1];
#pragma unroll
      for (int i = 0; i < 4; ++i) {
        const h4v a = *(const h4v*)&YB[(size_t)s0 * DM + 256 * i + lane * 4];
        const h4v b = *(const h4v*)&YB[(size_t)s1 * DM + 256 * i + lane * 4];
#pragma unroll
        for (int e = 0; e < 4; ++e) v[4 * i + e] = ALPHA * v[4 * i + e] + ((float)a[e] + (float)b[e]);
      }
    }
    float s = 0.f;
#pragma unroll
    for (int i = 0; i < 16; ++i) s += v[i];
    const float mu = wave_sum(s) * (1.f / 1024.f);
    float vs = 0.f;
#pragma unroll
    for (int i = 0; i < 16; ++i) { const float d = v[i] - mu; vs += d * d; }
    const float rstd = rsqrtf(wave_sum(vs) * (1.f / 1024.f) + 1e-5f);
#pragma unroll
    for (int i = 0; i < 4; ++i) {
      const int c = 256 * i + lane * 4;
      const f4v w4 = *(const f4v*)&lw[c], b4 = *(const f4v*)&lb[c];
      f4v y;
#pragma unroll
      for (int e = 0; e < 4; ++e) { y[e] = (v[4 * i + e] - mu) * rstd * w4[e] + b4[e]; v[4 * i + e] = y[e]; }
      *(f4v*)&out[(size_t)row * DM + c] = y;
      st_h4(&x16[(size_t)row * DM + c], y);
    }
    if (router) {
      const float* rw = p.moe_router + (size_t)(l >> 1) * DM * 8;
      float lg[8];
#pragma unroll
      for (int e = 0; e < 8; ++e) lg[e] = 0.f;
#pragma unroll
      for (int i = 0; i < 4; ++i)
#pragma unroll
        for (int k = 0; k < 4; ++k) {
          const int c = 256 * i + lane * 4 + k;
          const f4v r0 = *(const f4v*)&rw[(size_t)c * 8], r1 = *(const f4v*)&rw[(size_t)c * 8 + 4];
          const float xv = v[4 * i + k];
#pragma unroll
          for (int e = 0; e < 4; ++e) { lg[e] += xv * r0[e]; lg[4 + e] += xv * r1[e]; }
        }
#pragma unroll
      for (int e = 0; e < 8; ++e) lg[e] = wave_sum(lg[e]);
      if (lane == 0) {
        int i1 = 0; float b1 = lg[0];
#pragma unroll
        for (int e = 1; e < 8; ++e) if (lg[e] > b1) { b1 = lg[e]; i1 = e; }
        int i2 = -1; float b2 = -3.4e38f;
#pragma unroll
        for (int e = 0; e < 8; ++e) if (e != i1 && lg[e] > b2) { b2 = lg[e]; i2 = e; }
        const float g1 = 1.f / (1.f + __expf(b2 - b1)), g2 = 1.f - g1;
        int* cnt = (int*)(ws + MOE_CNT);
        int* te = (int*)(ws + MOE_TE); int* tp = (int*)(ws + MOE_TP); float* tg = (float*)(ws + MOE_TG);
        te[row * 2] = i1; te[row * 2 + 1] = i2;
        tp[row * 2] = atomicAdd(&cnt[i1], 1); tp[row * 2 + 1] = atomicAdd(&cnt[i2], 1);
        tg[row * 2] = g1; tg[row * 2 + 1] = g2;
      }
    }
  }
}
DI void phase_assign(const Params& p, int bid, int nb) {
  asm volatile("" : "+v"(bid));
  unsigned char* ws = p.ws;
  int ps[9]; moe_prefix((const int*)(ws + MOE_CNT), ps);
  const int* te = (const int*)(ws + MOE_TE); const int* tp = (const int*)(ws + MOE_TP); const float* tg = (const float*)(ws + MOE_TG);
  int* ts = (int*)(ws + MOE_TS); int* st = (int*)(ws + MOE_ST); float* sg = (float*)(ws + MOE_SG);
  #pragma unroll 1
  for (int i = bid * 256 + otid(); i < 32768; i += nb * 256) {
    const int e = te[i];
    int base = 0;
#pragma unroll
    for (int k = 0; k < 8; ++k) if (e == k) base = ps[k];
    const int slot = base + tp[i];
    ts[i] = slot; st[slot] = i >> 1; sg[slot] = tg[i];
  }
}


#define XB_TMO      128
#define XB_XCNT(j)  (256  + 64 * (j))
#define XB_XSUB(j)  (1280 + 64 * (j))
#define XB_XGEN(j)  (2304 + 64 * (j))
#define XB_TOP      3328
#define XB_TOPGEN   3392
#define XCD_BAR_WORDS 3456
#define XB_SPIN_CAP (1u << 22)
#define LAS __attribute__((address_space(3)))
DI unsigned xb_ld(unsigned* p) { return __hip_atomic_load(p, __ATOMIC_RELAXED, __HIP_MEMORY_SCOPE_AGENT); }
DI unsigned xb_add(unsigned* p, unsigned v) { return __hip_atomic_fetch_add(p, v, __ATOMIC_RELAXED, __HIP_MEMORY_SCOPE_AGENT); }
DI unsigned xb_xcc_id() { return (unsigned)__builtin_amdgcn_s_getreg((3 << 11) | 20) & 0xFu; }
#define XB_SPIN(cond, bar) do { unsigned _sp = 0; while (cond) { __builtin_amdgcn_s_sleep(1); \
    if ((++_sp & 255u) == 0u) { if (xb_ld(&(bar)[XB_TMO])) break; if (_sp > XB_SPIN_CAP) { atomicAdd(&(bar)[XB_TMO], 1u); break; } } } } while (0)
struct XcdBarrier { unsigned* bar; unsigned x; volatile LAS unsigned* st; };
DI XcdBarrier xcd_barrier_post(unsigned* bar, volatile LAS unsigned* st) {
  XcdBarrier b; b.bar = bar; b.x = xb_xcc_id(); b.st = st;
  if (threadIdx.x == 0) (void)xb_add(&bar[XB_XCNT(b.x)], 1u);
  return b;
}
DI void xcd_barrier_complete(unsigned* bar, unsigned x, unsigned& nloc, unsigned& nx) {
  const unsigned G = gridDim.x * gridDim.y * gridDim.z;
  unsigned sum, cnt, mine, sp = 0u;
  for (;;) {
    sum = 0u; cnt = 0u; mine = 0u;
#pragma unroll
    for (unsigned j = 0; j < 16; ++j) { const unsigned c = xb_ld(&bar[XB_XCNT(j)]); sum += c; cnt += (c > 0u) ? 1u : 0u; mine = (j == x) ? c : mine; }
    if (sum == G) break;
    __builtin_amdgcn_s_sleep(1);
    if ((++sp & 255u) == 0u) { if (xb_ld(&bar[XB_TMO])) break; if (sp > XB_SPIN_CAP) { atomicAdd(&bar[XB_TMO], 1u); break; } }
  }
  nloc = mine > 0u ? mine : 1u; nx = cnt > 0u ? cnt : 1u;
}
DI void xcd_barrier(const XcdBarrier& b) {
  asm volatile("s_waitcnt vmcnt(0)" ::: "memory");
  __syncthreads();
  if (threadIdx.x == 0) {
    unsigned* bar = b.bar;
    __builtin_amdgcn_s_waitcnt(0);
    unsigned nloc = b.st[0], nx = b.st[1];
    if (nloc == 0u) { xcd_barrier_complete(bar, b.x, nloc, nx); b.st[0] = nloc; b.st[1] = nx; }
    const unsigned old = xb_add(&bar[XB_XSUB(b.x)], 1u);
    const unsigned gen = old / nloc;
    if (old + 1u == (gen + 1u) * nloc) {
      __builtin_amdgcn_fence(__ATOMIC_RELEASE, "agent");
      asm volatile("s_waitcnt vmcnt(0)" ::: "memory");
      const unsigned og = xb_add(&bar[XB_TOP], 1u);
      const unsigned tg = og / nx;
      if (og + 1u == (tg + 1u) * nx) xb_add(&bar[XB_TOPGEN], 1u);
      else XB_SPIN(xb_ld(&bar[XB_TOPGEN]) == tg, bar);
      __builtin_amdgcn_fence(__ATOMIC_ACQUIRE, "agent");
      xb_add(&bar[XB_XGEN(b.x)], 1u);
      asm volatile("s_waitcnt vmcnt(0)" ::: "memory");
    } else {
      XB_SPIN(xb_ld(&bar[XB_XGEN(b.x)]) == gen, bar);
      __builtin_amdgcn_fence(__ATOMIC_ACQUIRE, "agent");
      asm volatile("s_waitcnt vmcnt(0)" ::: "memory");
    }
  }
  __syncthreads();
}

extern __shared__ __attribute__((aligned(16))) unsigned char smem_dyn[];
__global__ void __launch_bounds__(512) fwd_megakernel(Params p) {
  cg::grid_group grid = cg::this_grid();
  unsigned char* smem = smem_dyn;
  const int half = threadIdx.x >> 8;
  unsigned char* smem_half = smem_dyn + half * HALF_LDS;
  h16* lds = (h16*)smem;
  h16* ldh = (h16*)smem_half;
  const int bid = blockIdx.x, nb = gridDim.x;
  const int vb = bid * 2 + half, vnb = nb * 2;
  unsigned char* ws = p.ws;
  __shared__ u4v xb_words;
  if (threadIdx.x == 0) xb_words = (u4v){0u, 0u, 0u, 0u};
  __syncthreads();
  XcdBarrier xb = xcd_barrier_post((unsigned*)(ws + OFF_BAR), (volatile LAS unsigned*)&xb_words);

  phase_init(p, vb, vnb);
  phase_convert_range(p, 0, 0, 2560, vb, vnb, ldh);
  grid.sync();
  for (int l = 0; l < 4; ++l) {
    phase_p1(p, l, bid, nb, vb, vnb, smem, smem_half);
    xcd_barrier(xb);
    phase_m1(p, l, vb, vnb, ldh);
    xcd_barrier(xb);
    phase_m2(p, l, vb, vnb, ldh);
    xcd_barrier(xb);
    phase_m3(p, l, vb, vnb, ldh);
    xcd_barrier(xb);
    phase_gates(p, bid, nb, lds);
    xcd_barrier(xb);
    phase_merge(p, vb, vnb, ldh);
    xcd_barrier(xb);
    phase_resid_gemm(p, (const h16*)(ws + OFF_MERGED), DM, (const h16*)(ws + OFF_WOUT), 1024, (l == 0) ? p.x : p.out, bid, nb, lds);
    xcd_barrier(xb);
    phase_ln(p, l, 1, vb, vnb);
    xcd_barrier(xb);
    if (l & 1) {
      phase_assign(p, vb, vnb);
      xcd_barrier(xb);
      phase_ffn1_moe(p, bid, nb, lds);
      xcd_barrier(xb);
      phase_ffn2_moe(p, bid, nb, lds);
      xcd_barrier(xb);
    } else {
      phase_ffn1_dense(p, bid, nb, lds);
      xcd_barrier(xb);
      phase_resid_gemm(p, (const h16*)(ws + OFF_H), 2816, (const h16*)(ws + OFF_WFF) + (size_t)5632 * 1024, 2816, p.out, bid, nb, lds);
      xcd_barrier(xb);
    }
    phase_ln(p, l, 2, vb, vnb);
    if (l + 1 < 4) xcd_barrier(xb);
  }
}

extern "C" void kernel_launch(void* const* d_in, const int* in_sizes, int n_in, void* d_out, int out_size, void* d_ws, size_t ws_size, hipStream_t stream) {
  static int grid_blocks = 0;
  if (!grid_blocks) {
    int dev = 0, cus = 0, per_cu = 0;
    hipGetDevice(&dev);
    hipDeviceGetAttribute(&cus, hipDeviceAttributeMultiprocessorCount, dev);
    hipFuncSetAttribute((const void*)fwd_megakernel, hipFuncAttributeMaxDynamicSharedMemorySize, LDS_BYTES);
    hipOccupancyMaxActiveBlocksPerMultiprocessor(&per_cu, fwd_megakernel, 512, LDS_BYTES);
    if (per_cu > 1) per_cu = 1;
    if (per_cu < 1) per_cu = 1;
    grid_blocks = cus * per_cu;
    if (ws_size < WS_END) fprintf(stderr, "workspace too small: %zu < %zu\n", ws_size, (size_t)WS_END);
  }
  Params p{};
  const float* const* in = (const float* const*)d_in;
  p.x = in[0]; p.w_in = in[1]; p.a_gate_bias = in[2]; p.a_norm_w = in[3]; p.c_conv_w = in[4]; p.c_a_log = in[5]; p.c_dt_bias = in[6];
  p.c_norm_w = in[7]; p.d_sink = in[8]; p.w_br_a = in[9]; p.w_br_b = in[10]; p.w_br_c = in[11]; p.w_br_d = in[12]; p.w_out = in[13];
  p.ln1_w = in[14]; p.ln1_b = in[15]; p.ln2_w = in[16]; p.ln2_b = in[17]; p.ffn_w1 = in[18]; p.ffn_w3 = in[19]; p.ffn_w2 = in[20];
  p.moe_router = in[21]; p.moe_w1 = in[22]; p.moe_w3 = in[23]; p.moe_w2 = in[24];
  p.out = (float*)d_out; p.ws = (unsigned char*)d_ws;
  void* args[] = {&p};
  hipMemsetAsync((unsigned char*)d_ws + OFF_BAR, 0, XCD_BAR_WORDS * 4, stream);
  hipError_t e = hipLaunchCooperativeKernel((void*)fwd_megakernel, dim3(grid_blocks), dim3(512), args, LDS_BYTES, stream);
  if (e != hipSuccess) fprintf(stderr, "cooperative launch failed: %s (grid %d)\n", hipGetErrorString(e), grid_blocks);
}
```

```cpp
#include <hip/hip_runtime.h>
#include <hip/hip_cooperative_groups.h>
#include <cstdio>
namespace cg = cooperative_groups;

typedef _Float16 h16;
typedef h16 h8v __attribute__((ext_vector_type(8)));
typedef h16 h4v __attribute__((ext_vector_type(4)));
typedef float f4v __attribute__((ext_vector_type(4)));
typedef float f16v __attribute__((ext_vector_type(16)));
typedef unsigned int u4v __attribute__((ext_vector_type(4)));
#define DI __device__ __forceinline__

constexpr int SEQ = 16384, DM = 1024, NIN = 9248, NSM = 5120;
constexpr int LDH = 72;
constexpr float ALPHA = 1.6817928305074290f;
constexpr int NSLOT = 34816;
constexpr int HALF_LDS = 58368;
constexpr int LDS_BYTES = 147456;
constexpr int MLD = 68;

constexpr size_t OFF_X16 = 0;
constexpr size_t OFF_WSM = OFF_X16 + (size_t)SEQ * DM * 2;
constexpr size_t OFF_WG = OFF_WSM + (size_t)NSM * 1024 * 2;
constexpr size_t OFF_WBR = OFF_WG + (size_t)4096 * 1024 * 2;
constexpr size_t OFF_WOUT = OFF_WBR + (size_t)1280 * 1024 * 2;
constexpr size_t OFF_WFF = OFF_WOUT + (size_t)1024 * 1024 * 2;
constexpr size_t OFF_PS = OFF_WFF + (size_t)69206016;
constexpr size_t OFF_PSCAL = OFF_PS + (size_t)SEQ * NSM * 2;
constexpr size_t OFF_Y = OFF_PSCAL + (size_t)SEQ * 32 * 4;
constexpr size_t OFF_MERGED = OFF_Y + (size_t)SEQ * 1280 * 2;
constexpr size_t OFF_ROPE = OFF_MERGED + (size_t)SEQ * DM * 2;
constexpr size_t OFF_SCA = OFF_ROPE + (size_t)SEQ * 32 * 4 * 2;
constexpr size_t OFF_SCAS = OFF_SCA + (size_t)2048 * 4160 * 4;
constexpr size_t OFF_CQKV = OFF_SCAS + (size_t)2048 * 4 * 4;
constexpr size_t OFF_CU = OFF_CQKV + (size_t)SEQ * 768 * 2;
constexpr size_t OFF_CW = OFF_CU + (size_t)2048 * 4096 * 4;
constexpr size_t OFF_CKD = OFF_CW + (size_t)2048 * 4096 * 2;
constexpr size_t OFF_CDL = OFF_CKD + (size_t)2048 * 4096 * 2;
constexpr size_t OFF_CS = OFF_CDL + (size_t)2048 * 4;
constexpr size_t OFF_CVN = OFF_CS + (size_t)2048 * 4096 * 2;
constexpr size_t OFF_OB = OFF_CVN + (size_t)2048 * 4096 * 2;
constexpr size_t OFF_MLB = OFF_OB + (size_t)3 * SEQ * 256 * 2;
constexpr size_t OFF_MOE = OFF_MLB + (size_t)3 * SEQ * 4 * 2 * 4;
constexpr size_t MOE_CNT = OFF_MOE;
constexpr size_t MOE_TE = MOE_CNT + 256;
constexpr size_t MOE_TP = MOE_TE + 32768 * 4;
constexpr size_t MOE_TG = MOE_TP + 32768 * 4;
constexpr size_t MOE_TS = MOE_TG + 32768 * 4;
constexpr size_t MOE_ST = MOE_TS + 32768 * 4;
constexpr size_t MOE_SG = MOE_ST + (size_t)NSLOT * 4;
constexpr size_t OFF_BAR = (MOE_SG + (size_t)NSLOT * 4 + 255) & ~(size_t)255;
constexpr size_t WS_END = OFF_BAR + 16384;
constexpr size_t OFF_GATES = OFF_PS;
constexpr size_t OFF_H = OFF_PS;
constexpr size_t OFF_YB = OFF_Y;

struct Params {
  const float* x; const float* w_in; const float* a_gate_bias; const float* a_norm_w; const float* c_conv_w;
  const float* c_a_log; const float* c_dt_bias; const float* c_norm_w; const float* d_sink;
  const float* w_br_a; const float* w_br_b; const float* w_br_c; const float* w_br_d; const float* w_out;
  const float* ln1_w; const float* ln1_b; const float* ln2_w; const float* ln2_b;
  const float* ffn_w1; const float* ffn_w3; const float* ffn_w2;
  const float* moe_router; const float* moe_w1; const float* moe_w3; const float* moe_w2;
  float* out; unsigned char* ws;
};

DI int otid() { int t = threadIdx.x & 255; asm volatile("" : "+v"(t)); return t; }
DI int otid512() { int t = threadIdx.x; asm volatile("" : "+v"(t)); return t; }
DI float sigmoid_(float x) { return 1.f / (1.f + __expf(-x)); }
DI float silu_(float x) { return x / (1.f + __expf(-x)); }
DI float softplus_(float x) { return x > 20.f ? x : log1pf(__expf(x)); }
DI float logsigmoid_(float x) { return fminf(x, 0.f) - log1pf(__expf(-fabsf(x))); }
DI f4v mfma16(h8v a, h8v b, f4v c) { return __builtin_amdgcn_mfma_f32_16x16x32_f16(a, b, c, 0, 0, 0); }
DI f16v mfma32(h8v a, h8v b, f16v c) { return __builtin_amdgcn_mfma_f32_32x32x16_f16(a, b, c, 0, 0, 0); }
DI float wave_incl_sum(float v, int lane) {
#pragma unroll
  for (int o = 1; o < 64; o <<= 1) { float t = __shfl_up(v, o); if (lane >= o) v += t; }
  return v;
}
DI float wave_incl_max(float v, int lane) {
#pragma unroll
  for (int o = 1; o < 64; o <<= 1) { float t = __shfl_up(v, o); if (lane >= o) v = fmaxf(v, t); }
  return v;
}
DI float wave_max(float v) {
#pragma unroll
  for (int o = 32; o >= 1; o >>= 1) v = fmaxf(v, __shfl_xor(v, o));
  return v;
}
DI float wave_sum(float v) {
#pragma unroll
  for (int o = 32; o >= 1; o >>= 1) v += __shfl_xor(v, o);
  return v;
}
DI float grp16_sum(float v) { v += __shfl_xor(v, 1); v += __shfl_xor(v, 2); v += __shfl_xor(v, 4); v += __shfl_xor(v, 8); return v; }
DI float grp16_max(float v) { v = fmaxf(v, __shfl_xor(v, 1)); v = fmaxf(v, __shfl_xor(v, 2)); v = fmaxf(v, __shfl_xor(v, 4)); v = fmaxf(v, __shfl_xor(v, 8)); return v; }

DI void mm64(const h16* A, const h16* B, f4v (&acc)[4], int w, int lane) {
  const int r = lane & 15, q = lane >> 4;
#pragma unroll
  for (int s = 0; s < 2; ++s) {
    h8v a = *(const h8v*)&A[(16 * w + r) * LDH + 32 * s + 8 * q];
#pragma unroll
    for (int nt = 0; nt < 4; ++nt) {
      h8v b = *(const h8v*)&B[(16 * nt + r) * LDH + 32 * s + 8 * q];
      acc[nt] = mfma16(a, b, acc[nt]);
    }
  }
}
DI h8v perm_frag(const h16* img, int row, int s, int q) {
  h4v lo = *(const h4v*)&img[row * LDH + 32 * s + 4 * q];
  h4v hi = *(const h4v*)&img[row * LDH + 32 * s + 16 + 4 * q];
  return __builtin_shufflevector(lo, hi, 0, 1, 2, 3, 4, 5, 6, 7);
}
DI h8v pack8(f4v a, f4v b) {
  h8v r;
  r[0] = (h16)a[0]; r[1] = (h16)a[1]; r[2] = (h16)a[2]; r[3] = (h16)a[3];
  r[4] = (h16)b[0]; r[5] = (h16)b[1]; r[6] = (h16)b[2]; r[7] = (h16)b[3];
  return r;
}
DI void st_h4(h16* p, f4v v) { h4v o; o[0] = (h16)v[0]; o[1] = (h16)v[1]; o[2] = (h16)v[2]; o[3] = (h16)v[3]; *(h4v*)p = o; }

DI void conv_unit(const float* __restrict__ src, int ld, int col0, int k0, h16* __restrict__ dst, int K, int n0, h16* lds) {
  const int t = otid();
  __syncthreads();
  {
    const int c4 = (t & 7) * 4, kq = t >> 3;
#pragma unroll
    for (int i = 0; i < 2; ++i) {
      const int kk = kq + 32 * i;
      const f4v v = *(const f4v*)&src[(size_t)(k0 + kk) * ld + col0 + c4];
      lds[(c4 + 0) * LDH + kk] = (h16)v[0]; lds[(c4 + 1) * LDH + kk] = (h16)v[1];
      lds[(c4 + 2) * LDH + kk] = (h16)v[2]; lds[(c4 + 3) * LDH + kk] = (h16)v[3];
    }
  }
  __syncthreads();
  {
    const int c = t >> 3, ks = (t & 7) * 8;
    *(u4v*)&dst[(size_t)(n0 + c) * K + k0 + ks] = *(const u4v*)&lds[c * LDH + ks];
  }
}

DI int map_small(int n) {
  if (n < 1024) return 4096 + n;
  if (n < 3328) return 5136 + (n - 1024);
  if (n < 4352) return 7440 + (n - 3328);
  return 8480 + (n - 4352);
}

DI int conv_total(int l) { return 2560 + 2048 + 640 + 512 + ((l & 1) ? 8 * 2112 : (2816 + 1408)); }
DI void conv_one(const Params& p, int l, int u, h16* lds) {
  unsigned char* ws = p.ws;
  const float* win = p.w_in + (size_t)l * 1024 * NIN;
  const int jj = l >> 1;
  const bool moe = (l & 1);
    int v = u;
const float* src; int ld, col0, k0, K, n0; h16* dst;
if (v < 2560) { n0 = (v >> 4) * 32; k0 = (v & 15) * 64; col0 = map_small(n0); src = win; ld = NIN; K = 1024; dst = (h16*)(ws + OFF_WSM); }
else if ((v -= 2560) < 2048) { n0 = (v >> 4) * 32; k0 = (v & 15) * 64; col0 = n0; src = win; ld = NIN; K = 1024; dst = (h16*)(ws + OFF_WG); }
else if ((v -= 2048) < 640) {
  int b, kt;
  if (v < 384) { b = v >> 7; v &= 127; kt = 4; } else { b = 3; v -= 384; kt = 8; }
  n0 = (v / kt) * 32; k0 = (v % kt) * 64; K = kt * 64;
  const float* base = (b == 0) ? p.w_br_a : (b == 1) ? p.w_br_b : (b == 2) ? p.w_br_c : p.w_br_d;
  src = base + (size_t)l * K * 1024; ld = 1024; col0 = n0; dst = (h16*)(ws + OFF_WBR) + (size_t)b * 262144;
}
else if ((v -= 640) < 512) { n0 = (v >> 4) * 32; k0 = (v & 15) * 64; col0 = n0; src = p.w_out + (size_t)l * 1024 * 1024; ld = 1024; K = 1024; dst = (h16*)(ws + OFF_WOUT); }
else {
  v -= 512;
  if (!moe) {
    if (v < 2816) {
      int nbk = v >> 4; k0 = (v & 15) * 64; n0 = nbk * 32; col0 = (nbk >> 1) * 32;
      src = ((nbk & 1) ? p.ffn_w3 : p.ffn_w1) + (size_t)jj * 1024 * 2816; ld = 2816; K = 1024; dst = (h16*)(ws + OFF_WFF);
    } else {
      v -= 2816; n0 = (v / 44) * 32; k0 = (v % 44) * 64; col0 = n0; K = 2816;
      src = p.ffn_w2 + (size_t)jj * 2816 * 1024; ld = 1024; dst = (h16*)(ws + OFF_WFF) + (size_t)5632 * 1024;
    }
  } else {
    int e = v / 2112; v -= e * 2112;
    if (v < 1408) {
      int nbk = v >> 4; k0 = (v & 15) * 64; n0 = nbk * 32; col0 = (nbk >> 1) * 32;
      src = ((nbk & 1) ? p.moe_w3 : p.moe_w1) + (size_t)(jj * 8 + e) * 1024 * 1408; ld = 1408; K = 1024;
      dst = (h16*)(ws + OFF_WFF) + (size_t)e * 2816 * 1024;
    } else {
      v -= 1408; n0 = (v / 22) * 32; k0 = (v % 22) * 64; col0 = n0; K = 1408;
      src = p.moe_w2 + (size_t)(jj * 8 + e) * 1408 * 1024; ld = 1024;
      dst = (h16*)(ws + OFF_WFF) + (size_t)8 * 2816 * 1024 + (size_t)e * 1024 * 1408;
    }
  }
}
conv_unit(src, ld, col0, k0, dst, K, n0, lds);
}
DI void phase_convert_range(const Params& p, int l, int ubegin, int uend, int bid, int nb, h16* lds) {
  asm volatile("" : "+v"(bid));
  for (int u = ubegin + bid; u < uend; u += nb) conv_one(p, l, u, lds);
}
DI void moe_reset(const Params& p, int bid, int nb) {
  unsigned char* ws = p.ws;
  int* cnt = (int*)(ws + MOE_CNT);
  int* st = (int*)(ws + MOE_ST);
  int gs = nb * 256; asm volatile("" : "+s"(gs));
  const int gt = bid * 256 + otid();
  if (gt < 64) cnt[gt] = 0;
#pragma unroll 1
  for (int i = gt; i < NSLOT; i += gs) st[i] = 0;
}
DI void phase_init(const Params& p, int bid, int nb) {
  asm volatile("" : "+v"(bid));
  float* rc = (float*)(p.ws + OFF_ROPE);
  float* rs = rc + (size_t)SEQ * 32;
  const int gt = bid * 256 + otid(), gs = nb * 256;
  #pragma unroll 1
  for (int i = gt; i < SEQ * 32; i += gs) {
    int pos = i >> 5, d = i & 31;
    float inv = (float)pow(10000.0, -(double)d / 32.0);
    float ang = (float)pos * inv;
    rc[i] = cosf(ang); rs[i] = sinf(ang);
  }
  h16* x16 = (h16*)(p.ws + OFF_X16);
  #pragma unroll 1
  for (int i = gt; i < SEQ * DM / 4; i += gs) {
    float4 v = ((const float4*)p.x)[i];
    h4v o; o[0] = (h16)v.x; o[1] = (h16)v.y; o[2] = (h16)v.z; o[3] = (h16)v.w;
    *(h4v*)&x16[(size_t)i * 4] = o;
  }
}

template <bool GATHER>
DI void gemm_main(const h16* __restrict__ A, int lda, const int* __restrict__ idx, int m0,
                  const h16* __restrict__ B, int ldb, int n0, int K, h16* lds, f16v (&acc)[2][2]) {
  const int tid = otid(), lane = tid & 63, wv = tid >> 6, wm = wv >> 1, wn = wv & 1;
  h16* As = lds; h16* Bs = lds + 128 * LDH;
  const int lr = tid >> 1, lc = (tid & 1) * 32;
  const h16* ap = A + (size_t)(GATHER ? idx[m0 + lr] : (m0 + lr)) * lda + lc;
  const h16* bp = B + (size_t)(n0 + lr) * ldb + lc;
  u4v ra[4], rb[4];
#pragma unroll
  for (int i = 0; i < 4; ++i) { ra[i] = *(const u4v*)(ap + 8 * i); rb[i] = *(const u4v*)(bp + 8 * i); }
  const int nk = K >> 6;
  for (int kt = 0; kt < nk; ++kt) {
    __syncthreads();
#pragma unroll
    for (int i = 0; i < 4; ++i) { *(u4v*)&As[lr * LDH + lc + 8 * i] = ra[i]; *(u4v*)&Bs[lr * LDH + lc + 8 * i] = rb[i]; }
    __syncthreads();
    if (kt + 1 < nk) {
      ap += 64; bp += 64;
#pragma unroll
      for (int i = 0; i < 4; ++i) { ra[i] = *(const u4v*)(ap + 8 * i); rb[i] = *(const u4v*)(bp + 8 * i); }
    }
#pragma unroll
    for (int ks = 0; ks < 4; ++ks) {
      h8v af[2], bf[2];
#pragma unroll
      for (int i = 0; i < 2; ++i) af[i] = *(const h8v*)&As[(wm * 64 + i * 32 + (lane & 31)) * LDH + ks * 16 + 8 * (lane >> 5)];
#pragma unroll
      for (int j = 0; j < 2; ++j) bf[j] = *(const h8v*)&Bs[(wn * 64 + j * 32 + (lane & 31)) * LDH + ks * 16 + 8 * (lane >> 5)];
#pragma unroll
      for (int i = 0; i < 2; ++i)
#pragma unroll
        for (int j = 0; j < 2; ++j) acc[i][j] = mfma32(bf[j], af[i], acc[i][j]);
    }
  }
}
DI void acc_zero(f16v (&acc)[2][2]) {
#pragma unroll
  for (int i = 0; i < 2; ++i)
#pragma unroll
    for (int j = 0; j < 2; ++j)
#pragma unroll
      for (int r = 0; r < 16; ++r) acc[i][j][r] = 0.f;
}
template <class Epi>
DI void gemm_epilogue(f16v (&acc)[2][2], int m0, int n0, Epi epi) {
  const int tid = otid(), lane = tid & 63, wv = tid >> 6, wm = wv >> 1, wn = wv & 1, h = lane >> 5;
#pragma unroll
  for (int i = 0; i < 2; ++i) {
    const int m = m0 + wm * 64 + i * 32 + (lane & 31);
#pragma unroll
    for (int g = 0; g < 4; ++g) {
      const int n = n0 + wn * 64 + 8 * g + 4 * h;
      f4v v0 = {acc[i][0][4 * g], acc[i][0][4 * g + 1], acc[i][0][4 * g + 2], acc[i][0][4 * g + 3]};
      f4v v1 = {acc[i][1][4 * g], acc[i][1][4 * g + 1], acc[i][1][4 * g + 2], acc[i][1][4 * g + 3]};
      epi(m, n, v0, v1);
    }
  }
}


template <bool GATHER>
DI void gemm256_main(const h16* __restrict__ A, int lda, const int* __restrict__ idx, int m0,
                     const h16* __restrict__ B, int ldb, int n0, int K, h16* lds, f16v (&acc)[4][2]) {
  const int tid = otid512(), lane = tid & 63, wv = tid >> 6, wm = wv >> 2, wn = wv & 3;
  const int lr = tid >> 1, lc = (tid & 1) * 32;
  unsigned ao = (unsigned)(GATHER ? idx[m0 + lr] : (m0 + lr)) * (unsigned)lda + lc;
  unsigned bo = (unsigned)(n0 + lr) * (unsigned)ldb + lc;
  const h16* ap = A; const h16* bp = B;
#define AP_ (ap + ao)
#define BP_ (bp + bo)
  u4v ra[4], rb[4];
  const int nk = K >> 6;
  __syncthreads();
#pragma unroll
  for (int i = 0; i < 4; ++i) { ra[i] = *(const u4v*)(AP_ + 8 * i); rb[i] = *(const u4v*)(BP_ + 8 * i); }
  ao += 64; bo += 64;
#pragma unroll
  for (int i = 0; i < 4; ++i) { *(u4v*)&lds[lr * LDH + lc + 8 * i] = ra[i]; *(u4v*)&lds[(256 + lr) * LDH + lc + 8 * i] = rb[i]; }
#pragma unroll
  for (int i = 0; i < 4; ++i) { ra[i] = *(const u4v*)(AP_ + 8 * i); rb[i] = *(const u4v*)(BP_ + 8 * i); }
  ao += 64; bo += 64;
  __syncthreads();
  for (int kt = 0; kt < nk; ++kt) {
    const h16* As = lds + (kt & 1) * (512 * LDH);
    const h16* Bs = As + 256 * LDH;
    h16* Wn = lds + ((kt & 1) ^ 1) * (512 * LDH);
    if (kt + 1 < nk) {
#pragma unroll
      for (int i = 0; i < 4; ++i) { *(u4v*)&Wn[lr * LDH + lc + 8 * i] = ra[i]; *(u4v*)&Wn[(256 + lr) * LDH + lc + 8 * i] = rb[i]; }
    }
    if (kt + 2 < nk) {
#pragma unroll
      for (int i = 0; i < 4; ++i) { ra[i] = *(const u4v*)(AP_ + 8 * i); rb[i] = *(const u4v*)(BP_ + 8 * i); }
      ao += 64; bo += 64;
    }
#pragma unroll
    for (int ks = 0; ks < 4; ++ks) {
      h8v af[4], bf[2];
#pragma unroll
      for (int i = 0; i < 4; ++i) af[i] = *(const h8v*)&As[(wm * 128 + i * 32 + (lane & 31)) * LDH + ks * 16 + 8 * (lane >> 5)];
#pragma unroll
      for (int j = 0; j < 2; ++j) bf[j] = *(const h8v*)&Bs[(wn * 64 + j * 32 + (lane & 31)) * LDH + ks * 16 + 8 * (lane >> 5)];
#pragma unroll
      for (int i = 0; i < 4; ++i)
#pragma unroll
        for (int j = 0; j < 2; ++j) acc[i][j] = mfma32(bf[j], af[i], acc[i][j]);
    }
    __syncthreads();
  }
}
DI void acc256_zero(f16v (&acc)[4][2]) {
#pragma unroll
  for (int i = 0; i < 4; ++i)
#pragma unroll
    for (int j = 0; j < 2; ++j)
#pragma unroll
      for (int r = 0; r < 16; ++r) acc[i][j][r] = 0.f;
}
template <class Epi>
DI void gemm256_epilogue(f16v (&acc)[4][2], int m0, int n0, Epi epi) {
  const int tid = otid512(), lane = tid & 63, wv = tid >> 6, wm = wv >> 2, wn = wv & 3, h = lane >> 5;
#pragma unroll
  for (int i = 0; i < 4; ++i) {
    const int m = m0 + wm * 128 + i * 32 + (lane & 31);
#pragma unroll
    for (int g = 0; g < 4; ++g) {
      const int n = n0 + wn * 64 + 8 * g + 4 * h;
      f4v v0 = {acc[i][0][4 * g], acc[i][0][4 * g + 1], acc[i][0][4 * g + 2], acc[i][0][4 * g + 3]};
      f4v v1 = {acc[i][1][4 * g], acc[i][1][4 * g + 1], acc[i][1][4 * g + 2], acc[i][1][4 * g + 3]};
      epi(m, n, v0, v1);
    }
  }
}

DI void scal_unit(const Params& p, int l, int unit, float* lds) {
  const float* xs = (l == 0) ? p.x : p.out;
  const float* win = p.w_in + (size_t)l * 1024 * NIN;
  float* ps = (float*)(p.ws + OFF_PSCAL);
  float* xt = lds;
  float* wt = lds + 64 * 68;
  const int t = otid(), lane = t & 63, w = t >> 6, r = lane & 15, q = lane >> 4;
  f4v acc[2];
  acc[0] = (f4v){0.f, 0.f, 0.f, 0.f}; acc[1] = (f4v){0.f, 0.f, 0.f, 0.f};
  const int t0 = unit * 64;
  for (int k0 = 0; k0 < 1024; k0 += 64) {
    __syncthreads();
#pragma unroll
    for (int i = 0; i < 4; ++i) { int e = t + 256 * i; int rr = e >> 4, c4 = (e & 15) * 4; *(f4v*)&xt[rr * 68 + c4] = *(const f4v*)&xs[(size_t)(t0 + rr) * DM + k0 + c4]; }
#pragma unroll
    for (int i = 0; i < 8; ++i) { int e = t + 256 * i; int kk = e >> 5, c = e & 31; int col = (c < 16) ? (5120 + c) : (8464 + (c - 16)); wt[kk * 32 + c] = win[(size_t)(k0 + kk) * NIN + col]; }
    __syncthreads();
#pragma unroll
    for (int ks = 0; ks < 16; ++ks) {
      const float a = xt[(16 * w + r) * 68 + ks * 4 + q];
      const float b0 = wt[(ks * 4 + q) * 32 + r], b1 = wt[(ks * 4 + q) * 32 + 16 + r];
      acc[0] = __builtin_amdgcn_mfma_f32_16x16x4f32(a, b0, acc[0], 0, 0, 0);
      acc[1] = __builtin_amdgcn_mfma_f32_16x16x4f32(a, b1, acc[1], 0, 0, 0);
    }
  }
#pragma unroll
  for (int nt = 0; nt < 2; ++nt)
#pragma unroll
    for (int rg = 0; rg < 4; ++rg) ps[(size_t)(t0 + 16 * w + 4 * q + rg) * 32 + 16 * nt + r] = acc[nt][rg];
}

DI void phase_p1(const Params& p, int l, int bid, int nb, int vb, int vnb, unsigned char* smem, unsigned char* smem_half) {
  asm volatile("" : "+v"(vb));
  unsigned char* ws = p.ws;
  const h16* x16 = (const h16*)(ws + OFF_X16);
  const h16* wsm = (const h16*)(ws + OFF_WSM);
  h16* ps = (h16*)(ws + OFF_PS);
  const float* rc = (const float*)(ws + OFF_ROPE);
  const float* rs = rc + (size_t)SEQ * 32;
  for (int u = vb; u < 256; u += vnb) scal_unit(p, l, u, (float*)smem_half);
  for (int u = bid; u < 64 * 20; u += nb) {
    const int m0 = (u / 20) * 256, n0 = (u % 20) * 256;
    f16v acc[4][2]; acc256_zero(acc);
    gemm256_main<false>(x16, DM, nullptr, m0, wsm, 1024, n0, 1024, (h16*)smem, acc);
    gemm256_epilogue(acc, m0, n0, [&](int m, int n, f4v v0, f4v v1) {
      const bool rope = (n >= 1024 && n < 2560) || (n >= 4352 && n < 4992);
      if (rope) {
        const int d = n & 31;
        f4v c = *(const f4v*)&rc[(size_t)m * 32 + d], s = *(const f4v*)&rs[(size_t)m * 32 + d];
        f4v o0 = v0 * c - v1 * s, o1 = v1 * c + v0 * s;
        v0 = o0; v1 = o1;
      }
      st_h4(&ps[(size_t)m * NSM + n], v0);
      st_h4(&ps[(size_t)m * NSM + n + 32], v1);
    });
  }
}

DI void img_store_nat(h16* img, int row, int seg, u4v a, u4v b) {
  *(u4v*)&img[row * LDH + 16 * seg] = a; *(u4v*)&img[row * LDH + 16 * seg + 8] = b;
}
DI void img_store_T(h16* img, int row, int seg, u4v a, u4v b) {
  const h16* pa = (const h16*)&a; const h16* pb = (const h16*)&b;
#pragma unroll
  for (int i = 0; i < 8; ++i) { img[(16 * seg + i) * LDH + row] = pa[i]; img[(16 * seg + 8 + i) * LDH + row] = pb[i]; }
}

template <int NKB>
DI void attn_unit(const Params& p, int l, int mode, int grp, int head, int r0, int dil, int i0, int sub_len, int W, h16* lds) {
  unsigned char* ws = p.ws;
  const h16* P = (const h16*)(ws + OFF_PS);
  h16* Qi = lds; h16* Ki = lds + 64 * LDH; h16* Vt = lds + 128 * LDH; h16* Pi = lds + 192 * LDH;
  const int tid = otid(), lane = tid & 63, w = tid >> 6, r = lane & 15, q = lane >> 4;
  const int lrow = tid >> 2, seg = tid & 3;
  int qcol, kcol, vcol;
  if (mode == 0) { qcol = 1024 + grp * 256 + head * 64; kcol = 1792 + grp * 256 + head * 64; vcol = 2560 + grp * 256 + head * 64; }
  else { qcol = 4352 + head * 64; kcol = 4864 + (head >> 2) * 64; vcol = 4992 + (head >> 2) * 64; }
  __syncthreads();
  {
    const size_t pos = (size_t)r0 + (size_t)dil * (i0 + lrow);
    const h16* g = P + pos * NSM + qcol + 16 * seg;
    img_store_nat(Qi, lrow, seg, *(const u4v*)g, *(const u4v*)(g + 8));
  }
  float mrow[4], lsum[4];
  f4v O[4];
  float m_init = -1e30f, l_init = 0.f;
  if (mode == 1) { m_init = p.d_sink[l * 8 + head]; l_init = 1.f; }
#pragma unroll
  for (int i = 0; i < 4; ++i) { mrow[i] = m_init; lsum[i] = l_init; O[i] = (f4v){0.f, 0.f, 0.f, 0.f}; }
  u4v pk0, pk1, pv0, pv1;
#define ATT_PREFETCH(kb_) do { const int j0p_ = i0 - W + 64 * (kb_); const int j0q_ = ((j0p_ >= 0) && (j0p_ < sub_len)) ? j0p_ : i0; \
    const size_t posp_ = (size_t)r0 + (size_t)dil * (j0q_ + lrow);                                                                  \
    const h16* gk_ = P + posp_ * NSM + kcol + 16 * seg; const h16* gv_ = P + posp_ * NSM + vcol + 16 * seg;                           \
    pk0 = *(const u4v*)gk_; pk1 = *(const u4v*)(gk_ + 8); pv0 = *(const u4v*)gv_; pv1 = *(const u4v*)(gv_ + 8); } while (0)
  ATT_PREFETCH(0);
  for (int kb = 0; kb < NKB; ++kb) {
    const int j0 = i0 - W + 64 * kb;
    const bool inr = (j0 >= 0) && (j0 < sub_len);
    __syncthreads();
    img_store_nat(Ki, lrow, seg, pk0, pk1);
    img_store_T(Vt, lrow, seg, pv0, pv1);
    __syncthreads();
    if (kb + 1 < NKB) ATT_PREFETCH(kb + 1);
    f4v S[4];
#pragma unroll
    for (int i = 0; i < 4; ++i) S[i] = (f4v){0.f, 0.f, 0.f, 0.f};
    mm64(Qi, Ki, S, w, lane);
    float mx[4], al[4], rsum[4];
    bool vm[4][4];
#pragma unroll
    for (int rg = 0; rg < 4; ++rg) {
      const int row = 16 * w + 4 * q + rg;
      float m_ = -1e30f;
#pragma unroll
      for (int nt = 0; nt < 4; ++nt) {
        const int key = 16 * nt + r;
        const int delta = row - key + W - 64 * kb;
        const bool ok = inr && (delta >= -W) && (delta <= W);
        vm[nt][rg] = ok;
        float s = S[nt][rg] * 0.125f;
        S[nt][rg] = s;
        if (ok) m_ = fmaxf(m_, s);
      }
      mx[rg] = grp16_max(m_);
    }
#pragma unroll
    for (int rg = 0; rg < 4; ++rg) {
      const float mn = fmaxf(mrow[rg], mx[rg]);
      al[rg] = __expf(mrow[rg] - mn);
      mrow[rg] = mn;
      float rs_ = 0.f;
#pragma unroll
      for (int nt = 0; nt < 4; ++nt) {
        float pv = vm[nt][rg] ? __expf(S[nt][rg] - mn) : 0.f;
        rs_ += pv;
        Pi[(16 * w + 4 * q + rg) * LDH + 16 * nt + r] = (h16)pv;
      }
      rsum[rg] = grp16_sum(rs_);
      lsum[rg] = lsum[rg] * al[rg] + rsum[rg];
    }
#pragma unroll
    for (int et = 0; et < 4; ++et)
#pragma unroll
      for (int rg = 0; rg < 4; ++rg) O[et][rg] *= al[rg];
    __syncthreads();
    mm64(Pi, Vt, O, w, lane);
  }
#pragma unroll
  for (int rg = 0; rg < 4; ++rg) {
    const int row = 16 * w + 4 * q + rg;
    const size_t pos = (size_t)r0 + (size_t)dil * (i0 + row);
    const float inv = 1.f / lsum[rg];
    if (mode == 0) {
      h16* ob = (h16*)(ws + OFF_OB) + ((size_t)grp * SEQ + pos) * 256 + head * 64;
#pragma unroll
      for (int et = 0; et < 4; ++et) ob[16 * et + r] = (h16)(O[et][rg] * inv);
      if (r == 0) {
        float* ml = (float*)(ws + OFF_MLB) + (((size_t)grp * SEQ + pos) * 4 + head) * 2;
        ml[0] = mrow[rg]; ml[1] = lsum[rg];
      }
    } else {
      h16* y = (h16*)(ws + OFF_Y) + pos * 1280 + 768 + head * 64;
#pragma unroll
      for (int et = 0; et < 4; ++et) y[16 * et + r] = (h16)(O[et][rg] * inv);
    }
  }
}

DI void bcombine_unit(const Params& p, int unit) {
  unsigned char* ws = p.ws;
  const int gi = unit * 256 + otid();
  const int seg = gi & 7, head = (gi >> 3) & 3, pos = gi >> 5;
  const float* ml = (const float*)(ws + OFF_MLB);
  const h16* ob = (const h16*)(ws + OFF_OB);
  float m[3], lv[3];
#pragma unroll
  for (int g = 0; g < 3; ++g) { const float* q = ml + (((size_t)g * SEQ + pos) * 4 + head) * 2; m[g] = q[0]; lv[g] = q[1]; }
  const float M = fmaxf(m[0], fmaxf(m[1], m[2]));
  float wg[3], den = 0.f;
#pragma unroll
  for (int g = 0; g < 3; ++g) { wg[g] = __expf(m[g] - M) * lv[g]; den += wg[g]; }
  const float inv = 1.f / den;
  float o[8];
#pragma unroll
  for (int i = 0; i < 8; ++i) o[i] = 0.f;
#pragma unroll
  for (int g = 0; g < 3; ++g) {
    h8v v = *(const h8v*)&ob[((size_t)g * SEQ + pos) * 256 + head * 64 + seg * 8];
#pragma unroll
    for (int i = 0; i < 8; ++i) o[i] += wg[g] * (float)v[i];
  }
  h8v ov;
#pragma unroll
  for (int i = 0; i < 8; ++i) ov[i] = (h16)(o[i] * inv);
  *(h8v*)((h16*)(ws + OFF_Y) + (size_t)pos * 1280 + 256 + head * 64 + seg * 8) = ov;
}

DI void mlstm_a1_unit(const Params& p, int l, int head, int oc, h16* lds) {
  unsigned char* ws = p.ws;
  const h16* P = (const h16*)(ws + OFF_PS);
  const float* pscal = (const float*)(ws + OFF_PSCAL);
  float* sca = (float*)(ws + OFF_SCA);
  float* scas = (float*)(ws + OFF_SCAS);
  h16* Ks0 = lds; h16* Ks1 = lds + 64 * LDH; h16* Vt = lds + 128 * LDH;
  float* sw = (float*)(lds + 192 * LDH);
  const int tid = otid(), lane = tid & 63, w = tid >> 6, r = lane & 15, q = lane >> 4;
  __syncthreads();
  if (w < 2) {
    const int dir = w;
    const int rr = dir ? 63 - lane : lane;
    const size_t pos = (size_t)oc * 64 + rr;
    const float* gb = p.a_gate_bias + l * 16;
    const float ig = pscal[pos * 32 + dir * 8 + head] + gb[dir * 8 + head];
    const float lf = logsigmoid_(pscal[pos * 32 + dir * 8 + 4 + head] + gb[dir * 8 + 4 + head]);
    const float b = wave_incl_sum(lf, lane);
    const float blast = __shfl(b, 63);
    const float slog = blast - b + ig;
    const float mc = wave_max(slog);
    sw[dir * 64 + rr] = __expf(slog - mc) * 0.125f;
    if (lane == 0) {
      const int nloc = dir ? 255 - oc : oc;
      float* s4 = scas + ((size_t)(dir * 4 + head) * 256 + nloc) * 4;
      s4[0] = blast; s4[1] = mc;
    }
  }
  __syncthreads();
  {
    const int lrow = tid >> 2, seg = tid & 3;
    const size_t pos = (size_t)oc * 64 + lrow;
    const h16* gk = P + pos * NSM + 256 + head * 64 + 16 * seg;
    const h16* gv = P + pos * NSM + 512 + head * 64 + 16 * seg;
    h8v k0 = *(const h8v*)gk, k1 = *(const h8v*)(gk + 8);
    u4v v0 = *(const u4v*)gv, v1 = *(const u4v*)(gv + 8);
    const float s0 = sw[lrow], s1 = sw[64 + lrow];
#pragma unroll
    for (int i = 0; i < 8; ++i) {
      Ks0[(16 * seg + i) * LDH + lrow] = (h16)((float)k0[i] * s0);
      Ks0[(16 * seg + 8 + i) * LDH + lrow] = (h16)((float)k1[i] * s0);
      Ks1[(16 * seg + i) * LDH + lrow] = (h16)((float)k0[i] * s1);
      Ks1[(16 * seg + 8 + i) * LDH + lrow] = (h16)((float)k1[i] * s1);
    }
    img_store_T(Vt, lrow, seg, v0, v1);
  }
  __syncthreads();
#pragma unroll
  for (int dir = 0; dir < 2; ++dir) {
    const h16* Ks = dir ? Ks1 : Ks0;
    const int nloc = dir ? 255 - oc : oc;
    float* dst = sca + ((size_t)(dir * 4 + head) * 256 + nloc) * 4160;
    f4v acc[4];
#pragma unroll
    for (int i = 0; i < 4; ++i) acc[i] = (f4v){0.f, 0.f, 0.f, 0.f};
    mm64(Vt, Ks, acc, w, lane);
#pragma unroll
    for (int nt = 0; nt < 4; ++nt)
#pragma unroll
      for (int rg = 0; rg < 4; ++rg) dst[(16 * w + 4 * q + rg) * 64 + 16 * nt + r] = acc[nt][rg];
    if (w == dir) {
      float s = 0.f;
#pragma unroll 8
      for (int j = 0; j < 64; ++j) s += (float)Ks[lane * LDH + j];
      dst[4096 + lane] = s;
    }
  }
}

DI void mlstm_a2_unit(const Params& p, int unit) {
  unsigned char* ws = p.ws;
  float* sca = (float*)(ws + OFF_SCA);
  float* scas = (float*)(ws + OFF_SCAS);
  const int dh = unit / 17, sl = unit % 17;
  const int e = sl * 256 + otid();
  if (e >= 4160) return;
  float* base = sca + (size_t)dh * 256 * 4160 + e;
  float* s4 = scas + (size_t)dh * 256 * 4;
  float m = 0.f, c = 0.f;
  for (int n0 = 0; n0 < 256; n0 += 16) {
    float cc[16], bls[16], mcs[16];
#pragma unroll
    for (int i = 0; i < 16; ++i) { cc[i] = base[(size_t)(n0 + i) * 4160]; bls[i] = s4[(n0 + i) * 4]; mcs[i] = s4[(n0 + i) * 4 + 1]; }
#pragma unroll
    for (int i = 0; i < 16; ++i) {
      const float bl = bls[i], mc = mcs[i];
      const float mn = fmaxf(bl + m, mc);
      const float dec = __expf(bl + m - mn), gain = __expf(mc - mn);
      base[(size_t)(n0 + i) * 4160] = c;
      if (e == 0) s4[(n0 + i) * 4 + 2] = m;
      c = dec * c + gain * cc[i];
      m = mn;
    }
  }
}

DI void mlstm_a3_unit(const Params& p, int l, int head, int oc, h16* lds) {
  unsigned char* ws = p.ws;
  const h16* P = (const h16*)(ws + OFF_PS);
  const float* pscal = (const float*)(ws + OFF_PSCAL);
  const float* sca = (const float*)(ws + OFF_SCA);
  const float* scas = (const float*)(ws + OFF_SCAS);
  h16* Qi = lds; h16* Ki = lds + 64 * LDH; h16* Vt = lds + 128 * LDH; h16* Wi = lds + 192 * LDH; h16* Ci = lds + 256 * LDH;
  float* fl = (float*)(lds + 320 * LDH);
  float* rowterm = fl;
  float* colterm = fl + 128;
  float* ainter = fl + 256;
  float* emt = fl + 384;
  float* nvec = fl + 512;
  float* qn = fl + 576;
  const int tid = otid(), lane = tid & 63, w = tid >> 6, r = lane & 15, q = lane >> 4;
  const int lrow = tid >> 2, seg = tid & 3;
  __syncthreads();
  {
    const size_t pos = (size_t)oc * 64 + lrow;
    const h16* g = P + pos * NSM + head * 64 + 16 * seg;
    img_store_nat(Qi, lrow, seg, *(const u4v*)g, *(const u4v*)(g + 8));
    img_store_nat(Ki, lrow, seg, *(const u4v*)(g + 256), *(const u4v*)(g + 264));
    img_store_T(Vt, lrow, seg, *(const u4v*)(g + 512), *(const u4v*)(g + 520));
  }
  if (w < 2) {
    const int dir = w;
    const int rr = dir ? 63 - lane : lane;
    const size_t pos = (size_t)oc * 64 + rr;
    const int nloc = dir ? 255 - oc : oc;
    const float* gb = p.a_gate_bias + l * 16;
    const float ig = pscal[pos * 32 + dir * 8 + head] + gb[dir * 8 + head];
    const float lf = logsigmoid_(pscal[pos * 32 + dir * 8 + 4 + head] + gb[dir * 8 + 4 + head]);
    const float b = wave_incl_sum(lf, lane);
    const float u = ig - b;
    const float pm = wave_incl_max(u, lane);
    const float m_intra = b + pm;
    const float mprev = scas[((size_t)(dir * 4 + head) * 256 + nloc) * 4 + 2];
    const float mt = fmaxf(b + mprev, m_intra);
    rowterm[dir * 64 + rr] = b - mt;
    colterm[dir * 64 + rr] = u;
    ainter[dir * 64 + rr] = __expf(b + mprev - mt);
    emt[dir * 64 + rr] = __expf(-mt);
  }
  f4v hacc[4];
#pragma unroll
  for (int i = 0; i < 4; ++i) hacc[i] = (f4v){0.f, 0.f, 0.f, 0.f};
#pragma unroll 1
  for (int dir = 0; dir < 2; ++dir) {
    const int nloc = dir ? 255 - oc : oc;
    const float* src = sca + ((size_t)(dir * 4 + head) * 256 + nloc) * 4160;
    __syncthreads();
    {
      const float4* s4 = (const float4*)(src + lrow * 64 + 16 * seg);
      float4 a = s4[0], b = s4[1], c = s4[2], d = s4[3];
      h8v o0, o1;
      o0[0] = (h16)a.x; o0[1] = (h16)a.y; o0[2] = (h16)a.z; o0[3] = (h16)a.w; o0[4] = (h16)b.x; o0[5] = (h16)b.y; o0[6] = (h16)b.z; o0[7] = (h16)b.w;
      o1[0] = (h16)c.x; o1[1] = (h16)c.y; o1[2] = (h16)c.z; o1[3] = (h16)c.w; o1[4] = (h16)d.x; o1[5] = (h16)d.y; o1[6] = (h16)d.z; o1[7] = (h16)d.w;
      *(h8v*)&Ci[lrow * LDH + 16 * seg] = o0; *(h8v*)&Ci[lrow * LDH + 16 * seg + 8] = o1;
      if (tid < 64) nvec[tid] = src[4096 + tid];
    }
    __syncthreads();
    f4v S[4];
#pragma unroll
    for (int i = 0; i < 4; ++i) S[i] = (f4v){0.f, 0.f, 0.f, 0.f};
    mm64(Qi, Ki, S, w, lane);
    float dint[4];
#pragma unroll
    for (int rg = 0; rg < 4; ++rg) {
      const int t = 16 * w + 4 * q + rg;
      const float rt = rowterm[dir * 64 + t];
      float sum = 0.f;
#pragma unroll
      for (int nt = 0; nt < 4; ++nt) {
        const int s = 16 * nt + r;
        const bool ok = dir ? (s >= t) : (s <= t);
        const float wv = ok ? __expf(rt + colterm[dir * 64 + s]) * S[nt][rg] * 0.125f : 0.f;
        sum += wv;
        Wi[t * LDH + s] = (h16)wv;
      }
      dint[rg] = grp16_sum(sum);
    }
    {
      float s = 0.f;
#pragma unroll
      for (int i = 0; i < 16; ++i) s += (float)Qi[lrow * LDH + 16 * seg + i] * nvec[16 * seg + i];
      s += __shfl_xor(s, 1); s += __shfl_xor(s, 2);
      if (seg == 0) qn[lrow] = s;
    }
    __syncthreads();
    f4v a1[4], a2[4];
#pragma unroll
    for (int i = 0; i < 4; ++i) { a1[i] = (f4v){0.f, 0.f, 0.f, 0.f}; a2[i] = (f4v){0.f, 0.f, 0.f, 0.f}; }
    mm64(Wi, Vt, a1, w, lane);
    mm64(Qi, Ci, a2, w, lane);
#pragma unroll
    for (int rg = 0; rg < 4; ++rg) {
      const int t = 16 * w + 4 * q + rg;
      const float ai = ainter[dir * 64 + t];
      const float den = ai * qn[t] + dint[rg];
      const float dn = 1.f / fmaxf(fabsf(den), emt[dir * 64 + t]);
#pragma unroll
      for (int et = 0; et < 4; ++et) hacc[et][rg] += (a1[et][rg] + ai * a2[et][rg]) * dn;
    }
  }
  const float* nw = p.a_norm_w + l * 256 + head * 64;
#pragma unroll
  for (int rg = 0; rg < 4; ++rg) {
    const int t = 16 * w + 4 * q + rg;
    const size_t pos = (size_t)oc * 64 + t;
    float s = hacc[0][rg] + hacc[1][rg] + hacc[2][rg] + hacc[3][rg];
    const float mu = grp16_sum(s) * (1.f / 64.f);
    float vs = 0.f;
#pragma unroll
    for (int et = 0; et < 4; ++et) { float d = hacc[et][rg] - mu; vs += d * d; }
    const float var = grp16_sum(vs) * (1.f / 64.f);
    const float rstd = rsqrtf(var + 1e-5f);
    h16* y = (h16*)(ws + OFF_Y) + pos * 1280 + head * 64;
    const h16* ao = P + pos * NSM + 768 + head * 64;
#pragma unroll
    for (int et = 0; et < 4; ++et) {
      const int e = 16 * et + r;
      y[e] = (h16)((hacc[et][rg] - mu) * rstd * nw[e] * sigmoid_((float)ao[e]));
    }
  }
}

template <int DIR>
DI void dn_solve4(const float* M, const h16* Ki, const h16* Vi, const float* betal, const float* gcl, int half, int c, int pp, float (&x)[16]) {
  const h16* src = half ? (Ki + c) : (Vi + c);
#pragma unroll
  for (int k = 0; k < 16; ++k) x[k] = 0.f;
#pragma unroll
  for (int il = 0; il < 64; ++il) {
    const int ri = DIR ? 63 - il : il;
    float part = 0.f;
#pragma unroll
    for (int k = 0; k < (il + 3) / 4; ++k) {
      const int jl0 = 4 * k;
      float mv = DIR ? M[ri * MLD + 63 - jl0 - pp] : M[ri * MLD + jl0 + pp];
      if (jl0 + 3 >= il) mv = (jl0 + pp < il) ? mv : 0.f;
      part += mv * x[k];
    }
    part += __shfl_xor(part, 1); part += __shfl_xor(part, 2);
    const float e = half ? __expf(gcl[ri]) : 1.f;
    const float xi = betal[ri] * (float)src[ri * LDH] * e - part;
    if ((il & 3) == pp) x[il >> 2] = xi;
  }
}

DI void dn_c1_unit(const Params& p, int l, int head, int oc, h16* lds) {
  unsigned char* ws = p.ws;
  const h16* P = (const h16*)(ws + OFF_PS);
  const float* pscal = (const float*)(ws + OFF_PSCAL);
  h16* cq = (h16*)(ws + OFF_CQKV);
  h16* Ki = lds; h16* Vi = lds + 64 * LDH;
  float* M = (float*)(lds + 128 * LDH);
  float* betal = M + 64 * MLD;
  float* gcl = betal + 128;
  float* glast = gcl + 128;
  const int tid = otid(), lane = tid & 63, w = tid >> 6, r = lane & 15, q = lane >> 4;
  const int lrow = tid >> 2, seg = tid & 3;
  __syncthreads();
  {
    const int pos = oc * 64 + lrow;
    const float* cw = p.c_conv_w + (size_t)l * 5 * 768;
    float vq[16], vk[16], vv[16];
#pragma unroll
    for (int i = 0; i < 16; ++i) { vq[i] = 0.f; vk[i] = 0.f; vv[i] = 0.f; }
#pragma unroll
    for (int j = 0; j < 5; ++j) {
      const int pp = pos + j - 2;
      if (pp < 0 || pp >= SEQ) continue;
      const h16* g = P + (size_t)pp * NSM + 3328 + head * 64 + 16 * seg;
      h8v q0 = *(const h8v*)g, q1 = *(const h8v*)(g + 8);
      h8v k0 = *(const h8v*)(g + 256), k1 = *(const h8v*)(g + 264);
      h8v v0 = *(const h8v*)(g + 512), v1 = *(const h8v*)(g + 520);
      const float* wq = cw + j * 768 + head * 64 + 16 * seg;
#pragma unroll
      for (int i = 0; i < 8; ++i) {
        vq[i] += wq[i] * (float)q0[i]; vq[8 + i] += wq[8 + i] * (float)q1[i];
        vk[i] += wq[256 + i] * (float)k0[i]; vk[8 + i] += wq[264 + i] * (float)k1[i];
        vv[i] += wq[512 + i] * (float)v0[i]; vv[8 + i] += wq[520 + i] * (float)v1[i];
      }
    }
    float sq = 0.f, sk = 0.f;
#pragma unroll
    for (int i = 0; i < 16; ++i) { vq[i] = silu_(vq[i]); vk[i] = silu_(vk[i]); vv[i] = silu_(vv[i]); sq += vq[i] * vq[i]; sk += vk[i] * vk[i]; }
    sq += __shfl_xor(sq, 1); sq += __shfl_xor(sq, 2);
    sk += __shfl_xor(sk, 1); sk += __shfl_xor(sk, 2);
    const float rq = rsqrtf(sq + 1e-6f) * 0.125f, rk = rsqrtf(sk + 1e-6f);
    h8v oq0, oq1, ok0, ok1, ov0, ov1;
#pragma unroll
    for (int i = 0; i < 8; ++i) {
      oq0[i] = (h16)(vq[i] * rq); oq1[i] = (h16)(vq[8 + i] * rq);
      ok0[i] = (h16)(vk[i] * rk); ok1[i] = (h16)(vk[8 + i] * rk);
      ov0[i] = (h16)vv[i]; ov1[i] = (h16)vv[8 + i];
    }
    h16* o = cq + (size_t)pos * 768 + head * 64 + 16 * seg;
    *(h8v*)o = oq0; *(h8v*)(o + 8) = oq1;
    *(h8v*)(o + 256) = ok0; *(h8v*)(o + 264) = ok1;
    *(h8v*)(o + 512) = ov0; *(h8v*)(o + 520) = ov1;
    *(h8v*)&Ki[lrow * LDH + 16 * seg] = ok0; *(h8v*)&Ki[lrow * LDH + 16 * seg + 8] = ok1;
    *(h8v*)&Vi[lrow * LDH + 16 * seg] = ov0; *(h8v*)&Vi[lrow * LDH + 16 * seg + 8] = ov1;
  }
  if (w < 2) {
    const int dir = w;
    const int rr = dir ? 63 - lane : lane;
    const size_t pos = (size_t)oc * 64 + rr;
    const float beta = sigmoid_(pscal[pos * 32 + 16 + dir * 4 + head]);
    const float g = -__expf(p.c_a_log[l * 8 + dir * 4 + head]) * softplus_(pscal[pos * 32 + 24 + dir * 4 + head] + p.c_dt_bias[l * 8 + dir * 4 + head]);
    const float gc = wave_incl_sum(g, lane);
    const float gl = __shfl(gc, 63);
    betal[dir * 64 + rr] = beta; gcl[dir * 64 + rr] = gc;
    if (lane == 0) {
      glast[dir] = gl;
      const int nloc = dir ? 255 - oc : oc;
      ((float*)(ws + OFF_CDL))[(size_t)(dir * 4 + head) * 256 + nloc] = __expf(gl);
    }
  }
  __syncthreads();
  {
    f4v kk[4];
#pragma unroll
    for (int i = 0; i < 4; ++i) kk[i] = (f4v){0.f, 0.f, 0.f, 0.f};
    mm64(Ki, Ki, kk, w, lane);
#pragma unroll
    for (int nt = 0; nt < 4; ++nt)
#pragma unroll
      for (int rg = 0; rg < 4; ++rg) {
        const int i = 16 * w + 4 * q + rg, j = 16 * nt + r;
        float v = 0.f;
        if (j < i) v = betal[i] * kk[nt][rg] * __expf(gcl[i] - gcl[j]);
        else if (j > i) v = betal[64 + i] * kk[nt][rg] * __expf(gcl[64 + i] - gcl[64 + j]);
        M[i * MLD + j] = v;
      }
  }
  __syncthreads();
  {
    const int c = tid >> 2, pp = tid & 3;
#pragma unroll 1
    for (int dh2 = 0; dh2 < 4; ++dh2) {
      const int dir = dh2 >> 1, half = dh2 & 1;
      const int nloc = dir ? 255 - oc : oc;
      const size_t unit = (size_t)(dir * 4 + head) * 256 + nloc;
      float x[16];
      if (dir == 0) dn_solve4<0>(M, Ki, Vi, betal, gcl, half, c, pp, x);
      else dn_solve4<1>(M, Ki, Vi, betal + 64, gcl + 64, half, c, pp, x);
      if (half == 0) {
        float* ud = (float*)(ws + OFF_CU) + unit * 4096;
        const int slice = c >> 4, el = c & 15;
#pragma unroll
        for (int k = 0; k < 16; ++k) {
          const int il = 4 * k + pp;
          const int rr = dir ? 63 - il : il;
          ud[((slice * 4 + (rr >> 4)) * 64 + el + 16 * ((rr & 15) >> 2)) * 4 + (rr & 3)] = x[k];
        }
      } else {
        h16* wd = (h16*)(ws + OFF_CW) + unit * 4096;
        const int s = c >> 5, lq = (c & 15) >> 2, jjx = (c & 3) + 4 * ((c & 31) >> 4);
#pragma unroll
        for (int k = 0; k < 16; ++k) {
          const int il = 4 * k + pp;
          const int rr = dir ? 63 - il : il;
          wd[(((rr >> 4) * 2 + s) * 64 + (rr & 15) + 16 * lq) * 8 + jjx] = (h16)(-x[k]);
        }
      }
    }
  }
#pragma unroll
  for (int dir = 0; dir < 2; ++dir) {
    const int nloc = dir ? 255 - oc : oc;
    const size_t unit = (size_t)(dir * 4 + head) * 256 + nloc;
    h16* kd = (h16*)(ws + OFF_CKD) + unit * 4096;
    const float gl = glast[dir];
#pragma unroll
    for (int it = 0; it < 4; ++it) {
      const int e = tid + 256 * it;
      const int d = e & 63, rq = e >> 6;
      const int r0 = 4 * rq;
      h4v o;
#pragma unroll
      for (int i = 0; i < 4; ++i) o[i] = (h16)((float)Ki[(r0 + i) * LDH + d] * __expf(gl - gcl[dir * 64 + r0 + i]));
      const int tile = d >> 4, s = r0 >> 5, ln = (d & 15) + 16 * ((r0 & 15) >> 2), j4 = 4 * ((r0 & 31) >> 4);
      *(h4v*)&kd[((tile * 2 + s) * 64 + ln) * 8 + j4] = o;
    }
  }
}

DI void dn_c2_unit(const Params& p, int dh, int w) {
  unsigned char* ws = p.ws;
  const int tid = otid(), lane = tid & 63;
  if (tid >= 64) return;
  const h16* cw = (const h16*)(ws + OFF_CW) + (size_t)dh * 256 * 4096;
  const h16* ckd = (const h16*)(ws + OFF_CKD) + (size_t)dh * 256 * 4096;
  const float* cu = (const float*)(ws + OFF_CU) + (size_t)dh * 256 * 4096;
  const float* cdl = (const float*)(ws + OFF_CDL) + (size_t)dh * 256;
  h16* cs = (h16*)(ws + OFF_CS) + (size_t)dh * 256 * 4096;
  h16* cvn = (h16*)(ws + OFF_CVN) + (size_t)dh * 256 * 4096;
  f4v S[4];
#pragma unroll
  for (int i = 0; i < 4; ++i) S[i] = (f4v){0.f, 0.f, 0.f, 0.f};
  h8v wA[4][2], kA[4][2]; f4v uu[4]; float dl;
#pragma unroll
  for (int t = 0; t < 4; ++t) {
#pragma unroll
    for (int s = 0; s < 2; ++s) {
      wA[t][s] = *(const h8v*)&cw[((t * 2 + s) * 64 + lane) * 8];
      kA[t][s] = *(const h8v*)&ckd[((t * 2 + s) * 64 + lane) * 8];
    }
    uu[t] = *(const f4v*)&cu[((w * 4 + t) * 64 + lane) * 4];
  }
  dl = cdl[0];
  for (int n = 0; n < 256; ++n) {
    h8v wN[4][2], kN[4][2]; f4v uN[4]; float dlN = 0.f;
    const int nn = (n + 1 < 256) ? n + 1 : n;
    {
      const h16* cw1 = cw + (size_t)nn * 4096; const h16* ck1 = ckd + (size_t)nn * 4096; const float* cu1 = cu + (size_t)nn * 4096;
#pragma unroll
      for (int t = 0; t < 4; ++t) {
#pragma unroll
        for (int s = 0; s < 2; ++s) {
          wN[t][s] = *(const h8v*)&cw1[((t * 2 + s) * 64 + lane) * 8];
          kN[t][s] = *(const h8v*)&ck1[((t * 2 + s) * 64 + lane) * 8];
        }
        uN[t] = *(const f4v*)&cu1[((w * 4 + t) * 64 + lane) * 4];
      }
      dlN = cdl[nn];
    }
    h8v Sb[2];
    Sb[0] = pack8(S[0], S[1]); Sb[1] = pack8(S[2], S[3]);
    h16* cs1 = cs + (size_t)n * 4096; h16* cv1 = cvn + (size_t)n * 4096;
    *(h8v*)&cs1[((w * 2 + 0) * 64 + lane) * 8] = Sb[0];
    *(h8v*)&cs1[((w * 2 + 1) * 64 + lane) * 8] = Sb[1];
    f4v vn[4];
#pragma unroll
    for (int t = 0; t < 4; ++t) { vn[t] = uu[t]; vn[t] = mfma16(wA[t][0], Sb[0], vn[t]); vn[t] = mfma16(wA[t][1], Sb[1], vn[t]); }
    h8v Vb[2];
    Vb[0] = pack8(vn[0], vn[1]); Vb[1] = pack8(vn[2], vn[3]);
    *(h8v*)&cv1[((w * 2 + 0) * 64 + lane) * 8] = Vb[0];
    *(h8v*)&cv1[((w * 2 + 1) * 64 + lane) * 8] = Vb[1];
#pragma unroll
    for (int t = 0; t < 4; ++t) { S[t] *= dl; S[t] = mfma16(kA[t][0], Vb[0], S[t]); S[t] = mfma16(kA[t][1], Vb[1], S[t]); }
#pragma unroll
    for (int t = 0; t < 4; ++t) { wA[t][0] = wN[t][0]; wA[t][1] = wN[t][1]; kA[t][0] = kN[t][0]; kA[t][1] = kN[t][1]; uu[t] = uN[t]; }
    dl = dlN;
  }
}

DI void dn_c3_unit(const Params& p, int l, int head, int oc, h16* lds) {
  unsigned char* ws = p.ws;
  const h16* P = (const h16*)(ws + OFF_PS);
  const float* pscal = (const float*)(ws + OFF_PSCAL);
  const h16* cq = (const h16*)(ws + OFF_CQKV);
  h16* Qi = lds; h16* Ki = lds + 64 * LDH;
  h16* AT = lds + 128 * LDH;
  h16* QG = lds + 256 * LDH;
  float* gcl = (float*)(lds + 384 * LDH);
  float* Ol = (float*)lds;
  const int tid = otid(), lane = tid & 63, w = tid >> 6, r = lane & 15, q = lane >> 4;
  const int lrow = tid >> 2, seg = tid & 3;
  __syncthreads();
  {
    const size_t pos = (size_t)oc * 64 + lrow;
    const h16* g = cq + pos * 768 + head * 64 + 16 * seg;
    img_store_nat(Qi, lrow, seg, *(const u4v*)g, *(const u4v*)(g + 8));
    img_store_nat(Ki, lrow, seg, *(const u4v*)(g + 256), *(const u4v*)(g + 264));
  }
  if (w < 2) {
    const int dir = w;
    const int rr = dir ? 63 - lane : lane;
    const size_t pos = (size_t)oc * 64 + rr;
    const float g = -__expf(p.c_a_log[l * 8 + dir * 4 + head]) * softplus_(pscal[pos * 32 + 24 + dir * 4 + head] + p.c_dt_bias[l * 8 + dir * 4 + head]);
    gcl[dir * 64 + rr] = wave_incl_sum(g, lane);
  }
  __syncthreads();
  {
    f4v S[4];
#pragma unroll
    for (int i = 0; i < 4; ++i) S[i] = (f4v){0.f, 0.f, 0.f, 0.f};
    mm64(Qi, Ki, S, w, lane);
#pragma unroll
    for (int dir = 0; dir < 2; ++dir) {
#pragma unroll
      for (int nt = 0; nt < 4; ++nt)
#pragma unroll
        for (int rg = 0; rg < 4; ++rg) {
          const int i = 16 * w + 4 * q + rg, j = 16 * nt + r;
          const bool ok = dir ? (j >= i) : (j <= i);
          const float v = ok ? S[nt][rg] * __expf(gcl[dir * 64 + i] - gcl[dir * 64 + j]) : 0.f;
          AT[(dir * 64 + i) * LDH + j] = (h16)v;
        }
      const float eg = __expf(gcl[dir * 64 + lrow]);
#pragma unroll
      for (int i = 0; i < 16; ++i) QG[(dir * 64 + lrow) * LDH + 16 * seg + i] = (h16)((float)Qi[lrow * LDH + 16 * seg + i] * eg);
    }
  }
  __syncthreads();
  f4v o[4];
#pragma unroll
  for (int i = 0; i < 4; ++i) o[i] = (f4v){0.f, 0.f, 0.f, 0.f};
#pragma unroll
  for (int dir = 0; dir < 2; ++dir) {
    const int nloc = dir ? 255 - oc : oc;
    const size_t unit = (size_t)(dir * 4 + head) * 256 + nloc;
    const h16* cs = (const h16*)(ws + OFF_CS) + unit * 4096;
    const h16* cv = (const h16*)(ws + OFF_CVN) + unit * 4096;
#pragma unroll
    for (int s = 0; s < 2; ++s) {
      const h8v Sb = *(const h8v*)&cs[((w * 2 + s) * 64 + lane) * 8];
      const h8v Vb = *(const h8v*)&cv[((w * 2 + s) * 64 + lane) * 8];
#pragma unroll
      for (int it = 0; it < 4; ++it) {
        o[it] = mfma16(perm_frag(QG + dir * 64 * LDH, 16 * it + r, s, q), Sb, o[it]);
        o[it] = mfma16(perm_frag(AT + dir * 64 * LDH, 16 * it + r, s, q), Vb, o[it]);
      }
    }
  }
  __syncthreads();
#pragma unroll
  for (int it = 0; it < 4; ++it)
#pragma unroll
    for (int rg = 0; rg < 4; ++rg) Ol[(16 * it + 4 * q + rg) * 65 + 16 * w + r] = o[it][rg];
  __syncthreads();
  {
    const size_t pos = (size_t)oc * 64 + lrow;
    float v[16]; float ss = 0.f;
#pragma unroll
    for (int i = 0; i < 16; ++i) { v[i] = Ol[lrow * 65 + 16 * seg + i]; ss += v[i] * v[i]; }
    ss += __shfl_xor(ss, 1); ss += __shfl_xor(ss, 2);
    const float rms = rsqrtf(ss * (1.f / 64.f) + 1e-6f);
    const float* nw = p.c_norm_w + l * 64 + 16 * seg;
    const h16* cg_ = P + pos * NSM + 4096 + head * 64 + 16 * seg;
    h8v g0 = *(const h8v*)cg_, g1 = *(const h8v*)(cg_ + 8);
    h8v o0, o1;
#pragma unroll
    for (int i = 0; i < 8; ++i) {
      o0[i] = (h16)(v[i] * rms * nw[i] * silu_((float)g0[i]));
      o1[i] = (h16)(v[8 + i] * rms * nw[8 + i] * silu_((float)g1[i]));
    }
    h16* y = (h16*)(ws + OFF_Y) + pos * 1280 + 512 + head * 64 + 16 * seg;
    *(h8v*)y = o0; *(h8v*)(y + 8) = o1;
  }
}

DI void phase_m1(const Params& p, int l, int bid, int nb, h16* lds) {
  asm volatile("" : "+v"(bid));
  for (int u = bid; u < 2048; u += nb) {
    if (u < 1024) dn_c1_unit(p, l, u & 3, u >> 2, lds);
    else { const int v = u - 1024; mlstm_a1_unit(p, l, v & 3, v >> 2, lds); }
  }
}
DI void phase_m2(const Params& p, int l, int bid, int nb, h16* lds) {
  asm volatile("" : "+v"(bid));
  const int nA = conv_total(l) - 2560;
  const int nB = (l + 1 < 4) ? 2560 : 0;
  const int total = 32 + 136 + 2048 + 3072 + nA + nB;
  if (l & 1) moe_reset(p, bid, nb);
  const int ustart = (bid < 32) ? bid : bid;
  const int ustep = (bid < 32) ? total : (nb - 32);
  for (int u = ustart; u < total; u += ustep) {
    int v = u;
    if (v >= 5288) { v -= 5288; if (v < nA) conv_one(p, l, 2560 + v, lds); else conv_one(p, l + 1, v - nA, lds); continue; }
    if (v < 32) { dn_c2_unit(p, v >> 2, v & 3); continue; }
    if ((v -= 32) < 136) { mlstm_a2_unit(p, v); continue; }
    if ((v -= 136) < 2048) { attn_unit<5>(p, l, 1, 0, v & 7, 0, 1, (v >> 3) * 64, SEQ, 128, lds); continue; }
    v -= 2048;
    const int grp = v >> 10, x = v & 1023, head = x & 3, tl = x >> 2;
    const int dil = (grp == 0) ? 1 : (grp == 1) ? 4 : 16;
    const int sub = SEQ / dil, tps = sub >> 6;
    const int res = tl / tps, ti = tl % tps;
    attn_unit<3>(p, l, 0, grp, head, res, dil, ti * 64, sub, 64, lds);
  }
}
DI void phase_m3(const Params& p, int l, int bid, int nb, h16* lds) {
  asm volatile("" : "+v"(bid));
  const int total = 1024 + 1024 + 2048;
  for (int u = bid; u < total; u += nb) {
    int v = u;
    if (v < 1024) { mlstm_a3_unit(p, l, v & 3, v >> 2, lds); continue; }
    if ((v -= 1024) < 1024) { dn_c3_unit(p, l, v & 3, v >> 2, lds); continue; }
    bcombine_unit(p, v - 1024);
  }
}

DI void phase_gates(const Params& p, int bid, int nb, h16* lds) {
  unsigned char* ws = p.ws;
  const h16* x16 = (const h16*)(ws + OFF_X16);
  const h16* wg = (const h16*)(ws + OFF_WG);
  h16* G = (h16*)(ws + OFF_GATES);
  for (int u = bid; u < 64 * 16; u += nb) {
    const int m0 = (u >> 4) * 256, n0 = (u & 15) * 256;
    f16v acc[4][2]; acc256_zero(acc);
    gemm256_main<false>(x16, DM, nullptr, m0, wg, 1024, n0, 1024, lds, acc);
    gemm256_epilogue(acc, m0, n0, [&](int m, int n, f4v v0, f4v v1) {
      f4v a, b;
#pragma unroll
      for (int i = 0; i < 4; ++i) { a[i] = sigmoid_(v0[i]); b[i] = sigmoid_(v1[i]); }
      st_h4(&G[(size_t)m * 4096 + n], a); st_h4(&G[(size_t)m * 4096 + n + 32], b);
    });
  }
}
DI void phase_merge(const Params& p, int bid, int nb, h16* lds) {
  asm volatile("" : "+v"(bid));
  unsigned char* ws = p.ws;
  const h16* Y = (const h16*)(ws + OFF_Y);
  const h16* wbr = (const h16*)(ws + OFF_WBR);
  const h16* G = (const h16*)(ws + OFF_GATES);
  h16* Mg = (h16*)(ws + OFF_MERGED);
  for (int u = bid; u < 128 * 8; u += nb) {
    const int m0 = (u >> 3) * 128, n0 = (u & 7) * 128;
    f16v macc[2][2]; acc_zero(macc);
#pragma unroll 1
    for (int b = 0; b < 4; ++b) {
      const int Kb = (b == 3) ? 512 : 256;
      f16v acc[2][2]; acc_zero(acc);
      gemm_main<false>(Y + b * 256, 1280, nullptr, m0, wbr + (size_t)b * 262144, Kb, n0, Kb, lds, acc);
      const int tid = otid(), lane = tid & 63, wv = tid >> 6, wm = wv >> 1, wn = wv & 1, h = lane >> 5;
#pragma unroll
      for (int i = 0; i < 2; ++i) {
        const int m = m0 + wm * 64 + i * 32 + (lane & 31);
#pragma unroll
        for (int g = 0; g < 4; ++g) {
          const int n = n0 + wn * 64 + 8 * g + 4 * h;
          const h4v g0 = *(const h4v*)&G[(size_t)m * 4096 + b * 1024 + n];
          const h4v g1 = *(const h4v*)&G[(size_t)m * 4096 + b * 1024 + n + 32];
#pragma unroll
          for (int e = 0; e < 4; ++e) {
            macc[i][0][4 * g + e] += (float)g0[e] * acc[i][0][4 * g + e];
            macc[i][1][4 * g + e] += (float)g1[e] * acc[i][1][4 * g + e];
          }
        }
      }
    }
    gemm_epilogue(macc, m0, n0, [&](int m, int n, f4v v0, f4v v1) {
      st_h4(&Mg[(size_t)m * DM + n], v0); st_h4(&Mg[(size_t)m * DM + n + 32], v1);
    });
  }
}
DI void phase_resid_gemm(const Params& p, const h16* A, int lda, const h16* W, int K, const float* xres, int bid, int nb, h16* lds) {
  float* out = p.out;
  for (int u = bid; u < 64 * 4; u += nb) {
    const int m0 = (u >> 2) * 256, n0 = (u & 3) * 256;
    f16v acc[4][2]; acc256_zero(acc);
    gemm256_main<false>(A, lda, nullptr, m0, W, K, n0, K, lds, acc);
    gemm256_epilogue(acc, m0, n0, [&](int m, int n, f4v v0, f4v v1) {
      const f4v x0 = *(const f4v*)&xres[(size_t)m * DM + n], x1 = *(const f4v*)&xres[(size_t)m * DM + n + 32];
      *(f4v*)&out[(size_t)m * DM + n] = ALPHA * x0 + v0;
      *(f4v*)&out[(size_t)m * DM + n + 32] = ALPHA * x1 + v1;
    });
  }
}
DI void phase_ffn1_dense(const Params& p, int bid, int nb, h16* lds) {
  unsigned char* ws = p.ws;
  const h16* x16 = (const h16*)(ws + OFF_X16);
  const h16* w13 = (const h16*)(ws + OFF_WFF);
  h16* H = (h16*)(ws + OFF_H);
  for (int u = bid; u < 64 * 22; u += nb) {
    const int m0 = (u / 22) * 256, n0 = (u % 22) * 256;
    f16v acc[4][2]; acc256_zero(acc);
    gemm256_main<false>(x16, DM, nullptr, m0, w13, 1024, n0, 1024, lds, acc);
    gemm256_epilogue(acc, m0, n0, [&](int m, int n, f4v v0, f4v v1) {
      f4v hq;
#pragma unroll
      for (int i = 0; i < 4; ++i) hq[i] = silu_(v0[i]) * v1[i];
      st_h4(&H[(size_t)m * 2816 + (n >> 6) * 32 + (n & 31)], hq);
    });
  }
}
DI void moe_prefix(const int* cnt, int (&pstart)[9]) {
  int s = 0;
#pragma unroll
  for (int e = 0; e < 8; ++e) { pstart[e] = s; s += (cnt[e] + 255) & ~255; }
  pstart[8] = s;
}
DI void phase_ffn1_moe(const Params& p, int bid, int nb, h16* lds) {
  unsigned char* ws = p.ws;
  const h16* x16 = (const h16*)(ws + OFF_X16);
  const h16* w13 = (const h16*)(ws + OFF_WFF);
  h16* H = (h16*)(ws + OFF_H);
  const int* st = (const int*)(ws + MOE_ST);
  int ps[9]; moe_prefix((const int*)(ws + MOE_CNT), ps);
  const int ntl = (ps[8] >> 8) * 11;
  for (int u = bid; u < ntl; u += nb) {
    const int mt = u / 11, m0 = mt * 256, n0 = (u % 11) * 256;
    int e = 0;
#pragma unroll
    for (int i = 1; i < 8; ++i) if (m0 >= ps[i]) e = i;
    f16v acc[4][2]; acc256_zero(acc);
    gemm256_main<true>(x16, DM, st, m0, w13 + (size_t)e * 2816 * 1024, 1024, n0, 1024, lds, acc);
    gemm256_epilogue(acc, m0, n0, [&](int m, int n, f4v v0, f4v v1) {
      f4v hq;
#pragma unroll
      for (int i = 0; i < 4; ++i) hq[i] = silu_(v0[i]) * v1[i];
      st_h4(&H[(size_t)m * 1408 + (n >> 6) * 32 + (n & 31)], hq);
    });
  }
}
DI void phase_ffn2_moe(const Params& p, int bid, int nb, h16* lds) {
  unsigned char* ws = p.ws;
  const h16* H = (const h16*)(ws + OFF_H);
  const h16* w2 = (const h16*)(ws + OFF_WFF) + (size_t)8 * 2816 * 1024;
  h16* YB = (h16*)(ws + OFF_YB);
  const float* sg = (const float*)(ws + MOE_SG);
  int ps[9]; moe_prefix((const int*)(ws + MOE_CNT), ps);
  const int ntl = (ps[8] >> 8) * 4;
  for (int u = bid; u < ntl; u += nb) {
    const int mt = u >> 2, m0 = mt * 256, n0 = (u & 3) * 256;
    int e = 0;
#pragma unroll
    for (int i = 1; i < 8; ++i) if (m0 >= ps[i]) e = i;
    f16v acc[4][2]; acc256_zero(acc);
    gemm256_main<false>(H, 1408, nullptr, m0, w2 + (size_t)e * 1024 * 1408, 1408, n0, 1408, lds, acc);
    gemm256_epilogue(acc, m0, n0, [&](int m, int n, f4v v0, f4v v1) {
      const float g = sg[m];
      st_h4(&YB[(size_t)m * DM + n], g * v0); st_h4(&YB[(size_t)m * DM + n + 32], g * v1);
    });
  }
}

DI void phase_ln(const Params& p, int l, int which, int bid, int nb) {
  asm volatile("" : "+v"(bid));
  unsigned char* ws = p.ws;
  const bool moe = (l & 1);
  const bool moe_in = moe && which == 2;
  const bool router = moe && which == 1;
  const float* lw = (which == 1 ? p.ln1_w : p.ln2_w) + l * DM;
  const float* lb = (which == 1 ? p.ln1_b : p.ln2_b) + l * DM;
  float* out = p.out;
  h16* x16 = (h16*)(ws + OFF_X16);
  const int tid_ = otid(); const int lane = tid_ & 63, wv = tid_ >> 6;
  for (int row = bid * 4 + wv; row < SEQ; row += nb * 4) {
    float v[16];
#pragma unroll
    for (int i = 0; i < 4; ++i) {
      const f4v t = *(const f4v*)&out[(size_t)row * DM + 256 * i + lane * 4];
      v[4 * i] = t[0]; v[4 * i + 1] = t[1]; v[4 * i + 2] = t[2]; v[4 * i + 3] = t[3];
    }
    if (moe_in) {
      const int* ts = (const int*)(ws + MOE_TS);
      const h16* YB = (const h16*)(ws + OFF_YB);
      const int s0 = ts[row * 2], s1 = ts[row * 2 + 1];
#pragma unroll
      for (int i = 0; i < 4; ++i) {
        const h4v a = *(const h4v*)&YB[(size_t)s0 * DM + 256 * i + lane * 4];
        const h4v b = *(const h4v*)&YB[(size_t)s1 * DM + 256 * i + lane * 4];
#pragma unroll
        for (int e = 0; e < 4; ++e) v[4 * i + e] = ALPHA * v[4 * i + e] + ((float)a[e] + (float)b[e]);
      }
    }
    float s = 0.f;
#pragma unroll
    for (int i = 0; i < 16; ++i) s += v[i];
    const float mu = wave_sum(s) * (1.f / 1024.f);
    float vs = 0.f;
#pragma unroll
    for (int i = 0; i < 16; ++i) { const float d = v[i] - mu; vs += d * d; }
    const float rstd = rsqrtf(wave_sum(vs) * (1.f / 1024.f) + 1e-5f);
#pragma unroll
    for (int i = 0; i < 4; ++i) {
      const int c = 256 * i + lane * 4;
      const f4v w4 = *(const f4v*)&lw[c], b4 = *(const f4v*)&lb[c];
      f4v y;
#pragma unroll
      for (int e = 0; e < 4; ++e) { y[e] = (v[4 * i + e] - mu) * rstd * w4[e] + b4[e]; v[4 * i + e] = y[e]; }
      *(f4v*)&out[(size_t)row * DM + c] = y;
      st_h4(&x16[(size_t)row * DM + c], y);
    }
    if (router) {
      const float* rw = p.moe_router + (size_t)(l >> 1) * DM * 8;
      float lg[8];
#pragma unroll
      for (int e = 0; e < 8; ++e) lg[e] = 0.f;
#pragma unroll
      for (int i = 0; i < 4; ++i)
#pragma unroll
        for (int k = 0; k < 4; ++k) {
          const int c = 256 * i + lane * 4 + k;
          const f4v r0 = *(const f4v*)&rw[(size_t)c * 8], r1 = *(const f4v*)&rw[(size_t)c * 8 + 4];
          const float xv = v[4 * i + k];
#pragma unroll
          for (int e = 0; e < 4; ++e) { lg[e] += xv * r0[e]; lg[4 + e] += xv * r1[e]; }
        }
#pragma unroll
      for (int e = 0; e < 8; ++e) lg[e] = wave_sum(lg[e]);
      if (lane == 0) {
        int i1 = 0; float b1 = lg[0];
#pragma unroll
        for (int e = 1; e < 8; ++e) if (lg[e] > b1) { b1 = lg[e]; i1 = e; }
        int i2 = -1; float b2 = -3.4e38f;
#pragma unroll
        for (int e = 0; e < 8; ++e) if (e != i1 && lg[e] > b2) { b2 = lg[e]; i2 = e; }
        const float g1 = 1.f / (1.f + __expf(b2 - b1)), g2 = 1.f - g1;
        int* cnt = (int*)(ws + MOE_CNT);
        int* te = (int*)(ws + MOE_TE); int* tp = (int*)(ws + MOE_TP); float* tg = (float*)(ws + MOE_TG);
        te[row * 2] = i1; te[row * 2 + 1] = i2;
        tp[row * 2] = atomicAdd(&cnt[i1], 1); tp[row * 2 + 1] = atomicAdd(&cnt[i2], 1);
        tg[row * 2] = g1; tg[row * 2 + 1] = g2;
      }
    }
  }
}
DI void phase_assign(const Params& p, int bid, int nb) {
  asm volatile("" : "+v"(bid));
  unsigned char* ws = p.ws;
  int ps[9]; moe_prefix((const int*)(ws + MOE_CNT), ps);
  const int* te = (const int*)(ws + MOE_TE); const int* tp = (const int*)(ws + MOE_TP); const float* tg = (const float*)(ws + MOE_TG);
  int* ts = (int*)(ws + MOE_TS); int* st = (int*)(ws + MOE_ST); float* sg = (float*)(ws + MOE_SG);
  #pragma unroll 1
  for (int i = bid * 256 + otid(); i < 32768; i += nb * 256) {
    const int e = te[i];
    int base = 0;
#pragma unroll
    for (int k = 0; k < 8; ++k) if (e == k) base = ps[k];
    const int slot = base + tp[i];
    ts[i] = slot; st[slot] = i >> 1; sg[slot] = tg[i];
  }
}


#define XB_TMO      128
#define XB_XCNT(j)  (256  + 64 * (j))
#define XB_XSUB(j)  (1280 + 64 * (j))
#define XB_XGEN(j)  (2304 + 64 * (j))
#define XB_TOP      3328
#define XB_TOPGEN   3392
#define XCD_BAR_WORDS 3456
#define XB_SPIN_CAP (1u << 22)
#define LAS __attribute__((address_space(3)))
DI unsigned xb_ld(unsigned* p) { return __hip_atomic_load(p, __ATOMIC_RELAXED, __HIP_MEMORY_SCOPE_AGENT); }
DI unsigned xb_add(unsigned* p, unsigned v) { return __hip_atomic_fetch_add(p, v, __ATOMIC_RELAXED, __HIP_MEMORY_SCOPE_AGENT); }
DI unsigned xb_xcc_id() { return (unsigned)__builtin_amdgcn_s_getreg((3 << 11) | 20) & 0xFu; }
#define XB_SPIN(cond, bar) do { unsigned _sp = 0; while (cond) { __builtin_amdgcn_s_sleep(1); \
    if ((++_sp & 255u) == 0u) { if (xb_ld(&(bar)[XB_TMO])) break; if (_sp > XB_SPIN_CAP) { atomicAdd(&(bar)[XB_TMO], 1u); break; } } } } while (0)
struct XcdBarrier { unsigned* bar; unsigned x; volatile LAS unsigned* st; };
DI XcdBarrier xcd_barrier_post(unsigned* bar, volatile LAS unsigned* st) {
  XcdBarrier b; b.bar = bar; b.x = xb_xcc_id(); b.st = st;
  if (threadIdx.x == 0) (void)xb_add(&bar[XB_XCNT(b.x)], 1u);
  return b;
}
DI void xcd_barrier_complete(unsigned* bar, unsigned x, unsigned& nloc, unsigned& nx) {
  const unsigned G = gridDim.x * gridDim.y * gridDim.z;
  unsigned sum, cnt, mine, sp = 0u;
  for (;;) {
    sum = 0u; cnt = 0u; mine = 0u;
#pragma unroll
    for (unsigned j = 0; j < 16; ++j) { const unsigned c = xb_ld(&bar[XB_XCNT(j)]); sum += c; cnt += (c > 0u) ? 1u : 0u; mine = (j == x) ? c : mine; }
    if (sum == G) break;
    __builtin_amdgcn_s_sleep(1);
    if ((++sp & 255u) == 0u) { if (xb_ld(&bar[XB_TMO])) break; if (sp > XB_SPIN_CAP) { atomicAdd(&bar[XB_TMO], 1u); break; } }
  }
  nloc = mine > 0u ? mine : 1u; nx = cnt > 0u ? cnt : 1u;
}
DI void xcd_barrier(const XcdBarrier& b) {
  asm volatile("s_waitcnt vmcnt(0)" ::: "memory");
  __syncthreads();
  if (threadIdx.x == 0) {
    unsigned* bar = b.bar;
    __builtin_amdgcn_s_waitcnt(0);
    unsigned nloc = b.st[0], nx = b.st[1];
    if (nloc == 0u) { xcd_barrier_complete(bar, b.x, nloc, nx); b.st[0] = nloc; b.st[1] = nx; }
    const unsigned old = xb_add(&bar[XB_XSUB(b.x)], 1u);
    const unsigned gen = old / nloc;
    if (old + 1u == (gen + 1u) * nloc) {
      __builtin_amdgcn_fence(__ATOMIC_RELEASE, "agent");
      asm volatile("s_waitcnt vmcnt(0)" ::: "memory");
      const unsigned og = xb_add(&bar[XB_TOP], 1u);
      const unsigned tg = og / nx;
      if (og + 1u == (tg + 1u) * nx) xb_add(&bar[XB_TOPGEN], 1u);
      else XB_SPIN(xb_ld(&bar[XB_TOPGEN]) == tg, bar);
      __builtin_amdgcn_fence(__ATOMIC_ACQUIRE, "agent");
      xb_add(&bar[XB_XGEN(b.x)], 1u);
      asm volatile("s_waitcnt vmcnt(0)" ::: "memory");
    } else {
      XB_SPIN(xb_ld(&bar[XB_XGEN(b.x)]) == gen, bar);
      __builtin_amdgcn_fence(__ATOMIC_ACQUIRE, "agent");
      asm volatile("s_waitcnt vmcnt(0)" ::: "memory");
    }
  }
  __syncthreads();
}

extern __shared__ __attribute__((aligned(16))) unsigned char smem_dyn[];
__global__ void __launch_bounds__(512) fwd_megakernel(Params p) {
  cg::grid_group grid = cg::this_grid();
  unsigned char* smem = smem_dyn;
  const int half = threadIdx.x >> 8;
  unsigned char* smem_half = smem_dyn + half * HALF_LDS;
  h16* lds = (h16*)smem;
  h16* ldh = (h16*)smem_half;
  const int bid = blockIdx.x, nb = gridDim.x;
  const int vb = bid * 2 + half, vnb = nb * 2;
  unsigned char* ws = p.ws;
  __shared__ u4v xb_words;
  if (threadIdx.x == 0) xb_words = (u4v){0u, 0u, 0u, 0u};
  __syncthreads();
  XcdBarrier xb = xcd_barrier_post((unsigned*)(ws + OFF_BAR), (volatile LAS unsigned*)&xb_words);

  phase_init(p, vb, vnb);
  phase_convert_range(p, 0, 0, 2560, vb, vnb, ldh);
  if (p.ws == nullptr) grid.sync();
  xcd_barrier(xb);
  for (int l = 0; l < 4; ++l) {
    phase_p1(p, l, bid, nb, vb, vnb, smem, smem_half);
    xcd_barrier(xb);
    phase_m1(p, l, vb, vnb, ldh);
    xcd_barrier(xb);
    phase_m2(p, l, vb, vnb, ldh);
    xcd_barrier(xb);
    phase_m3(p, l, vb, vnb, ldh);
    xcd_barrier(xb);
    phase_gates(p, bid, nb, lds);
    xcd_barrier(xb);
    phase_merge(p, vb, vnb, ldh);
    xcd_barrier(xb);
    phase_resid_gemm(p, (const h16*)(ws + OFF_MERGED), DM, (const h16*)(ws + OFF_WOUT), 1024, (l == 0) ? p.x : p.out, bid, nb, lds);
    xcd_barrier(xb);
    phase_ln(p, l, 1, vb, vnb);
    xcd_barrier(xb);
    if (l & 1) {
      phase_assign(p, vb, vnb);
      xcd_barrier(xb);
      phase_ffn1_moe(p, bid, nb, lds);
      xcd_barrier(xb);
      phase_ffn2_moe(p, bid, nb, lds);
      xcd_barrier(xb);
    } else {
      phase_ffn1_dense(p, bid, nb, lds);
      xcd_barrier(xb);
      phase_resid_gemm(p, (const h16*)(ws + OFF_H), 2816, (const h16*)(ws + OFF_WFF) + (size_t)5632 * 1024, 2816, p.out, bid, nb, lds);
      xcd_barrier(xb);
    }
    phase_ln(p, l, 2, vb, vnb);
    if (l + 1 < 4) xcd_barrier(xb);
  }
}

extern "C" void kernel_launch(void* const* d_in, const int* in_sizes, int n_in, void* d_out, int out_size, void* d_ws, size_t ws_size, hipStream_t stream) {
  static int grid_blocks = 0;
  if (!grid_blocks) {
    int dev = 0, cus = 0, per_cu = 0;
    hipGetDevice(&dev);
    hipDeviceGetAttribute(&cus, hipDeviceAttributeMultiprocessorCount, dev);
    hipFuncSetAttribute((const void*)fwd_megakernel, hipFuncAttributeMaxDynamicSharedMemorySize, LDS_BYTES);
    hipOccupancyMaxActiveBlocksPerMultiprocessor(&per_cu, fwd_megakernel, 512, LDS_BYTES);
    if (per_cu > 1) per_cu = 1;
    if (per_cu < 1) per_cu = 1;
    grid_blocks = cus * per_cu;
    if (ws_size < WS_END) fprintf(stderr, "workspace too small: %zu < %zu\n", ws_size, (size_t)WS_END);
  }
  Params p{};
  const float* const* in = (const float* const*)d_in;
  p.x = in[0]; p.w_in = in[1]; p.a_gate_bias = in[2]; p.a_norm_w = in[3]; p.c_conv_w = in[4]; p.c_a_log = in[5]; p.c_dt_bias = in[6];
  p.c_norm_w = in[7]; p.d_sink = in[8]; p.w_br_a = in[9]; p.w_br_b = in[10]; p.w_br_c = in[11]; p.w_br_d = in[12]; p.w_out = in[13];
  p.ln1_w = in[14]; p.ln1_b = in[15]; p.ln2_w = in[16]; p.ln2_b = in[17]; p.ffn_w1 = in[18]; p.ffn_w3 = in[19]; p.ffn_w2 = in[20];
  p.moe_router = in[21]; p.moe_w1 = in[22]; p.moe_w3 = in[23]; p.moe_w2 = in[24];
  p.out = (float*)d_out; p.ws = (unsigned char*)d_ws;
  void* args[] = {&p};
  hipMemsetAsync((unsigned char*)d_ws + OFF_BAR, 0, XCD_BAR_WORDS * 4, stream);
  hipError_t e = hipLaunchCooperativeKernel((void*)fwd_megakernel, dim3(grid_blocks), dim3(512), args, LDS_BYTES, stream);
  if (e != hipSuccess) fprintf(stderr, "cooperative launch failed: %s (grid %d)\n", hipGetErrorString(e), grid_blocks);
}
```
